# Optimizing an MI355X kernel written in HIP

```python
import jax
import jax.numpy as jnp
from jax import lax
import numpy as np

D_MODEL = 1024
BATCH = 8
SEQ = 4096
DEPTH = 2

GRID_W = 64
CTX_LEN = 256
N_EVEN = (DEPTH + 1) // 2
N_ODD = DEPTH // 2
EPS = 1e-6
NEG_INF = -1e30
ROPE_THETA = 10000.0
BLOCK = 128

HG_WIDTH = D_MODEL // 2
HG_HEAD_DIM = 128
HG_HEADS = HG_WIDTH // HG_HEAD_DIM
HG_CHUNK = 64

SW_HEAD_DIM = 64
SW_Q_HEADS = (D_MODEL // 2) // SW_HEAD_DIM
SW_KV_HEADS = 2
WINDOW = 128

AB_CUTS = [HG_WIDTH, 2 * HG_WIDTH, 3 * HG_WIDTH, 4 * HG_WIDTH, 5 * HG_WIDTH,
           5 * HG_WIDTH + SW_Q_HEADS * SW_HEAD_DIM,
           5 * HG_WIDTH + (SW_Q_HEADS + SW_KV_HEADS) * SW_HEAD_DIM]
AB_IN = 5 * HG_WIDTH + (SW_Q_HEADS + 2 * SW_KV_HEADS) * SW_HEAD_DIM
AB_MIX = HG_WIDTH + SW_Q_HEADS * SW_HEAD_DIM

GA_HEAD_DIM = 128
GA_Q_HEADS = D_MODEL // GA_HEAD_DIM
GA_KV_HEADS = 2
GA_CUTS = [GA_Q_HEADS * GA_HEAD_DIM, (GA_Q_HEADS + GA_KV_HEADS) * GA_HEAD_DIM]
GA_IN = (GA_Q_HEADS + 2 * GA_KV_HEADS) * GA_HEAD_DIM

PEER_HEADS = 8
PEER_N_KEYS = 128
PEER_N_EXPERTS = PEER_N_KEYS * PEER_N_KEYS
PEER_KEY_DIM = 256
PEER_HALF = PEER_KEY_DIM // 2
PEER_TOPK = 16
PEER_TOKENS = 128

kernel_name = 'hybrid_dit_hgrn2_swa_axialgqa_peer'


def _rmsnorm(x, g):
    xf = x.astype(jnp.float32)
    y = xf * lax.rsqrt(jnp.mean(xf * xf, axis=-1, keepdims=True) + EPS)
    return (y * g.astype(jnp.float32)).astype(x.dtype)


def _axial_rope_tables(n_tokens, head_dim):
    n_rows = n_tokens // GRID_W
    row = jnp.repeat(jnp.arange(n_rows), GRID_W).astype(jnp.float32)
    col = jnp.tile(jnp.arange(GRID_W), n_rows).astype(jnp.float32)
    n_freq = head_dim // 4
    inv = ROPE_THETA ** (-jnp.arange(n_freq, dtype=jnp.float32) / n_freq)
    ang = jnp.concatenate([row[:, None] * inv, col[:, None] * inv], axis=-1)
    return jnp.cos(ang), jnp.sin(ang)


def _apply_rope(x, cos, sin):
    half = x.shape[-1] // 2
    xf = x.astype(jnp.float32)
    x1, x2 = xf[..., :half], xf[..., half:]
    cs, sn = cos[:, None, :], sin[:, None, :]
    return jnp.concatenate([x1 * cs - x2 * sn, x1 * sn + x2 * cs], axis=-1).astype(x.dtype)


def _to_groups(q, k, v):
    b, l, hq, d = q.shape
    hk = k.shape[2]
    qg = q.reshape(b, l, hk, hq // hk, d).transpose(0, 2, 3, 1, 4)
    return qg, k.transpose(0, 2, 1, 3), v.transpose(0, 2, 1, 3)


def _merge_groups(o):
    b, hk, g, l, d = o.shape
    return o.transpose(0, 3, 1, 2, 4).reshape(b, l, hk * g * d)


def _softmax_attend(q, k, v, mask, sink):
    scale = q.shape[-1] ** -0.5
    s = jnp.einsum('bhgtd,bhsd->bhgts', q, k).astype(jnp.float32) * scale
    if mask is not None:
        s = jnp.where(mask, s, NEG_INF)
    if sink is None:
        p = jax.nn.softmax(s, axis=-1)
    else:
        sk = sink.astype(jnp.float32)[None, :, :, None, None]
        m = jnp.maximum(jnp.max(s, axis=-1, keepdims=True), sk)
        e = jnp.exp(s - m)
        p = e / (jnp.sum(e, axis=-1, keepdims=True) + jnp.exp(sk - m))
    return jnp.einsum('bhgts,bhsd->bhgtd', p.astype(v.dtype), v)


def _window_latent(q, k, v, kc, vc, sink):
    b, hk, g, l, d = q.shape
    nb = l // BLOCK
    pad = [(0, 0), (0, 0), (BLOCK, BLOCK), (0, 0)]
    kp, vp = jnp.pad(k, pad), jnp.pad(v, pad)
    qb = jnp.moveaxis(q.reshape(b, hk, g, nb, BLOCK, d), 3, 0)
    q_off = jnp.arange(BLOCK)
    k_off = jnp.arange(3 * BLOCK)
    ctx_mask = jnp.ones((BLOCK, kc.shape[2]), dtype=bool)

    def one(args):
        qj, j = args
        start = j * BLOCK
        kj = lax.dynamic_slice_in_dim(kp, start, 3 * BLOCK, axis=2)
        vj = lax.dynamic_slice_in_dim(vp, start, 3 * BLOCK, axis=2)
        t = start + q_off
        s = start - BLOCK + k_off
        band = (s[None, :] >= 0) & (s[None, :] < l) & (jnp.abs(t[:, None] - s[None, :]) <= WINDOW)
        mask = jnp.concatenate([ctx_mask, band], axis=1)
        return _softmax_attend(qj, jnp.concatenate([kc, kj], axis=2),
                               jnp.concatenate([vc, vj], axis=2), mask, sink)

    out = lax.map(one, (qb, jnp.arange(nb)))
    return jnp.moveaxis(out, 0, 3).reshape(b, hk, g, l, d)


def _dense_latent(q, k_all, v_all):
    b, hk, g, l, d = q.shape
    nb = l // BLOCK
    qb = jnp.moveaxis(q.reshape(b, hk, g, nb, BLOCK, d), 3, 0)
    out = lax.map(lambda qj: _softmax_attend(qj, k_all, v_all, None, None), qb)
    return jnp.moveaxis(out, 0, 3).reshape(b, hk, g, l, d)


def _hgrn_decay(f_logit, lb):
    log_f = jnp.logaddexp(jnp.log(lb), jnp.log1p(-lb) + jax.nn.log_sigmoid(f_logit.astype(jnp.float32)))
    return log_f, -jnp.expm1(log_f)


def _hg_heads(t):
    b, l, _ = t.shape
    return t.reshape(b, l, HG_HEADS, HG_HEAD_DIM).transpose(0, 2, 1, 3)


def _gla_scan(q, k, v, log_f, s0):
    b, h, t, dk = q.shape
    dv = v.shape[-1]
    n = t // HG_CHUNK
    blocks = lambda z: jnp.moveaxis(z.reshape(b, h, n, HG_CHUNK, z.shape[-1]), 2, 0)
    causal = jnp.tril(jnp.ones((HG_CHUNK, HG_CHUNK), dtype=bool))[:, :, None]

    def step(state, inp):
        qc, kc, vc, gc = inp
        cum = jnp.cumsum(gc, axis=2)
        diff = cum[:, :, :, None, :] - cum[:, :, None, :, :]
        decay = jnp.where(causal, jnp.exp(jnp.where(causal, diff, 0.0)), 0.0)
        a = jnp.einsum('bhtk,bhsk,bhtsk->bhts', qc, kc, decay)
        o = jnp.einsum('bhtk,bhkv->bhtv', qc * jnp.exp(cum), state) + jnp.einsum('bhts,bhsv->bhtv', a, vc)
        end = cum[:, :, -1:, :]
        new_state = jnp.exp(end[:, :, 0, :])[..., None] * state + \
            jnp.einsum('bhsk,bhsv->bhkv', kc * jnp.exp(end - cum), vc)
        return new_state, o

    s_fin, o = lax.scan(step, s0, (blocks(q), blocks(k), blocks(v), blocks(log_f)))
    return jnp.moveaxis(o, 0, 2).reshape(b, h, t, dv), s_fin


def _hgrn_direction(q, k, v, lf, qc, kc, vc, lfc, reverse):
    if reverse:
        q, k, v, lf, qc, kc, vc, lfc = [jnp.flip(z, axis=2) for z in (q, k, v, lf, qc, kc, vc, lfc)]
    s0 = jnp.zeros(q.shape[:2] + (HG_HEAD_DIM, HG_HEAD_DIM), jnp.float32)
    oc, s_ctx = _gla_scan(qc, kc, vc, lfc, s0)
    o, _ = _gla_scan(q, k, v, lf, s_ctx)
    if reverse:
        o, oc = jnp.flip(o, axis=2), jnp.flip(oc, axis=2)
    return o, oc


def _mixer_ab(a, ac, w_in, w_out, lb, hg_norm_g, sink, rope, need_ctx):
    b, l, _ = a.shape
    bc, lc, _ = ac.shape
    qh, ff, fb, ih, gh, qs, ks, vs = jnp.split(a @ w_in, AB_CUTS, axis=-1)
    qhc, ffc, fbc, ihc, ghc, qsc, ksc, vsc = jnp.split(ac @ w_in, AB_CUTS, axis=-1)

    def hg_prep(q_, ff_, fb_, i_):
        lf_f, k_f = _hgrn_decay(ff_, lb)
        lf_b, k_b = _hgrn_decay(fb_, lb)
        return [_hg_heads(z) for z in (jax.nn.silu(q_.astype(jnp.float32)), i_.astype(jnp.float32),
                                       lf_f, k_f, lf_b, k_b)]
    q, v, lf_f, k_f, lf_b, k_b = hg_prep(qh, ff, fb, ih)
    qc, vc, lfc_f, kc_f, lfc_b, kc_b = hg_prep(qhc, ffc, fbc, ihc)
    o_f, oc_f = _hgrn_direction(q, k_f, v, lf_f, qc, kc_f, vc, lfc_f, reverse=False)
    o_b, oc_b = _hgrn_direction(q, k_b, v, lf_b, qc, kc_b, vc, lfc_b, reverse=True)

    def hg_out(o, g, bb, ll):
        o = _rmsnorm(o, hg_norm_g).transpose(0, 2, 1, 3).reshape(bb, ll, HG_WIDTH)
        return (o * jax.nn.silu(g.astype(jnp.float32))).astype(a.dtype)

    def sw_prep(q_, k_, v_, rope_t):
        bb, ll, _ = q_.shape
        q_ = q_.reshape(bb, ll, SW_Q_HEADS, SW_HEAD_DIM)
        k_ = k_.reshape(bb, ll, SW_KV_HEADS, SW_HEAD_DIM)
        v_ = v_.reshape(bb, ll, SW_KV_HEADS, SW_HEAD_DIM)
        if rope_t is not None:
            q_, k_ = _apply_rope(q_, *rope_t), _apply_rope(k_, *rope_t)
        return _to_groups(q_, k_, v_)
    sq, sk, sv = sw_prep(qs, ks, vs, rope)
    sqc, skc, svc = sw_prep(qsc, ksc, vsc, None)
    sink_g = sink.reshape(SW_KV_HEADS, SW_Q_HEADS // SW_KV_HEADS)
    sw = _merge_groups(_window_latent(sq, sk, sv, skc, svc, sink_g)).astype(a.dtype)

    y = (jnp.concatenate([hg_out(o_f + o_b, gh, b, l), sw], axis=-1) @ w_out).astype(a.dtype)
    if not need_ctx:
        return y, None
    swc = _merge_groups(_softmax_attend(sqc, skc, svc, None, sink_g)).astype(a.dtype)
    yc = (jnp.concatenate([hg_out(oc_f + oc_b, ghc, bc, lc), swc], axis=-1) @ w_out).astype(a.dtype)
    return y, yc


def _mixer_ga(a, ac, w_in, w_out, qn_g, kn_g, rope, need_ctx):
    def prep(t, rope_t):
        bb, ll, _ = t.shape
        q_, k_, v_ = jnp.split(t @ w_in, GA_CUTS, axis=-1)
        q_ = _rmsnorm(q_.reshape(bb, ll, GA_Q_HEADS, GA_HEAD_DIM), qn_g)
        k_ = _rmsnorm(k_.reshape(bb, ll, GA_KV_HEADS, GA_HEAD_DIM), kn_g)
        v_ = v_.reshape(bb, ll, GA_KV_HEADS, GA_HEAD_DIM)
        if rope_t is not None:
            q_, k_ = _apply_rope(q_, *rope_t), _apply_rope(k_, *rope_t)
        return _to_groups(q_, k_, v_)
    q, k, v = prep(a, rope)
    qc, kc, vc = prep(ac, None)
    k_all = jnp.concatenate([kc, k], axis=2)
    v_all = jnp.concatenate([vc, v], axis=2)
    y = (_merge_groups(_dense_latent(q, k_all, v_all)) @ w_out).astype(a.dtype)
    if not need_ctx:
        return y, None
    yc = (_merge_groups(_softmax_attend(qc, kc, vc, None, None)) @ w_out).astype(a.dtype)
    return y, yc


def _peer(x, w_q, sub_keys, u, v):
    t, d = x.shape
    nb = t // PEER_TOKENS

    def one(xb):
        qh = (xb @ w_q).reshape(PEER_TOKENS, PEER_HEADS, 2, PEER_HALF)
        s = jnp.einsum('thpd,hpnd->thpn', qh, sub_keys).astype(jnp.float32)
        s1, i1 = lax.top_k(s[:, :, 0], PEER_TOPK)
        s2, i2 = lax.top_k(s[:, :, 1], PEER_TOPK)
        cand = (s1[..., :, None] + s2[..., None, :]).reshape(PEER_TOKENS, PEER_HEADS, PEER_TOPK * PEER_TOPK)
        sc, ci = lax.top_k(cand, PEER_TOPK)
        e = jnp.take_along_axis(i1, ci // PEER_TOPK, axis=-1) * PEER_N_KEYS + \
            jnp.take_along_axis(i2, ci % PEER_TOPK, axis=-1)
        gate = jax.nn.softmax(sc, axis=-1)
        ue, ve = u[e], v[e]
        act = jax.nn.gelu(jnp.einsum('thkd,td->thk', ue, xb).astype(jnp.float32), approximate=False)
        return jnp.einsum('thk,thkd->td', (gate * act).astype(ve.dtype), ve)

    return lax.map(one, x.reshape(nb, PEER_TOKENS, d)).reshape(t, d)


def _normal(k, shape, scale):
    return jax.random.normal(k, shape, jnp.float32) * scale


def setup_inputs(seed: int = 0) -> dict:
    key = jax.random.key(seed)
    ks = jax.random.split(key, 24)
    d = D_MODEL
    return {
        'x': _normal(ks[0], (BATCH, SEQ, d), 1.0),
        'c': _normal(ks[1], (BATCH, d), 1.0),
        'ctx': _normal(ks[2], (BATCH, CTX_LEN, d), 1.0),
        'c_ctx': _normal(ks[3], (d,), 1.0),
        'ada_w': _normal(ks[4], (DEPTH, d, 6 * d), 0.5 * d ** -0.5),
        'ada_b': _normal(ks[5], (DEPTH, 6 * d), 0.01),
        'norm_mix_g': 1.0 + _normal(ks[6], (DEPTH, d), 0.05),
        'norm_ffn_g': 1.0 + _normal(ks[7], (DEPTH, d), 0.05),
        'ab_w_in': _normal(ks[8], (N_EVEN, d, AB_IN), d ** -0.5),
        'ab_w_out': _normal(ks[9], (N_EVEN, AB_MIX, d), AB_MIX ** -0.5),
        'hg_lb_logits': _normal(ks[10], (N_EVEN + 1, HG_WIDTH), 1.0),
        'hg_norm_g': 1.0 + _normal(ks[11], (N_EVEN, HG_HEAD_DIM), 0.05),
        'sw_sink': _normal(ks[12], (N_EVEN, SW_Q_HEADS), 0.5),
        'ga_w_in': _normal(ks[13], (N_ODD, d, GA_IN), d ** -0.5),
        'ga_w_out': _normal(ks[14], (N_ODD, GA_Q_HEADS * GA_HEAD_DIM, d), (GA_Q_HEADS * GA_HEAD_DIM) ** -0.5),
        'ga_q_norm_g': 1.0 + _normal(ks[15], (N_ODD, GA_HEAD_DIM), 0.05),
        'ga_k_norm_g': 1.0 + _normal(ks[16], (N_ODD, GA_HEAD_DIM), 0.05),
        'peer_w_q': _normal(ks[17], (DEPTH, d, PEER_HEADS * PEER_KEY_DIM), d ** -0.5),
        'peer_sub_keys': _normal(ks[18], (DEPTH, PEER_HEADS, 2, PEER_N_KEYS, PEER_HALF), PEER_HALF ** -0.5),
        'peer_u': _normal(ks[19], (DEPTH, PEER_N_EXPERTS, d), d ** -0.5),
        'peer_v': _normal(ks[20], (DEPTH, PEER_N_EXPERTS, d), 1.0),
        'final_norm_g': 1.0 + _normal(ks[21], (d,), 0.05),
    }


def reference(x, c, ctx, c_ctx, ada_w, ada_b, norm_mix_g, norm_ffn_g,
              ab_w_in, ab_w_out, hg_lb_logits, hg_norm_g, sw_sink,
              ga_w_in, ga_w_out, ga_q_norm_g, ga_k_norm_g,
              peer_w_q, peer_sub_keys, peer_u, peer_v, final_norm_g):
    b, l, d = x.shape
    lc = ctx.shape[1]
    rope_sw = _axial_rope_tables(l, SW_HEAD_DIM)
    rope_ga = _axial_rope_tables(l, GA_HEAD_DIM)
    lbs = jnp.cumsum(jax.nn.softmax(hg_lb_logits.astype(jnp.float32), axis=0), axis=0)
    h, hc = x, ctx
    for layer in range(DEPTH):
        need_ctx = layer < DEPTH - 1
        i = layer // 2
        mod = jax.nn.silu(c) @ ada_w[layer] + ada_b[layer]
        mod_c = jax.nn.silu(c_ctx) @ ada_w[layer] + ada_b[layer]
        sh1, sc1, gt1, sh2, sc2, gt2 = jnp.split(mod[:, None, :], 6, axis=-1)
        csh1, csc1, cgt1, csh2, csc2, cgt2 = jnp.split(mod_c, 6, axis=-1)
        a = _rmsnorm(h, norm_mix_g[layer]) * (1.0 + sc1) + sh1
        ac = _rmsnorm(hc, norm_mix_g[layer]) * (1.0 + csc1) + csh1
        if layer % 2 == 0:
            y, yc = _mixer_ab(a, ac, ab_w_in[i], ab_w_out[i], lbs[i], hg_norm_g[i], sw_sink[i], rope_sw, need_ctx)
        else:
            y, yc = _mixer_ga(a, ac, ga_w_in[i], ga_w_out[i], ga_q_norm_g[i], ga_k_norm_g[i], rope_ga, need_ctx)
        h = h + gt1 * y
        f = _rmsnorm(h, norm_ffn_g[layer]) * (1.0 + sc2) + sh2
        if need_ctx:
            hc = hc + cgt1 * yc
            fc = _rmsnorm(hc, norm_ffn_g[layer]) * (1.0 + csc2) + csh2
            tokens = jnp.concatenate([f.reshape(b * l, d), fc.reshape(b * lc, d)], axis=0)
            y_all = _peer(tokens, peer_w_q[layer], peer_sub_keys[layer], peer_u[layer], peer_v[layer])
            h = h + gt2 * y_all[:b * l].reshape(b, l, d)
            hc = hc + cgt2 * y_all[b * l:].reshape(b, lc, d)
        else:
            y_f = _peer(f.reshape(b * l, d), peer_w_q[layer], peer_sub_keys[layer], peer_u[layer], peer_v[layer])
            h = h + gt2 * y_f.reshape(b, l, d)
    return _rmsnorm(h, final_norm_g)
```

```cpp
#include <hip/hip_runtime.h>
#include <stdint.h>
#include <stdio.h>

typedef unsigned short bf16_t;
typedef short bf16x8 __attribute__((ext_vector_type(8)));
typedef float f32x4 __attribute__((ext_vector_type(4)));

constexpr int D = 1024, NB = 8, SEQ = 4096, LC = 256;
constexpr int TL = NB * SEQ;
constexpr int TC = NB * LC;
constexpr int TA = TL + TC;
constexpr int AB_IN = 3328, HGW = 2560, SWW = 768, GA_IN = 1536, PQ = 2048;
constexpr int NEXP = 16384;
constexpr float EPS = 1e-6f;

constexpr size_t OFF_WABIN = 0;
constexpr size_t OFF_WABOUT = OFF_WABIN + (size_t)AB_IN * D * 2;
constexpr size_t OFF_WGAIN = OFF_WABOUT + (size_t)D * D * 2;
constexpr size_t OFF_WGAOUT = OFF_WGAIN + (size_t)GA_IN * D * 2;
constexpr size_t OFF_WPQ = OFF_WGAOUT + (size_t)D * D * 2;
constexpr size_t OFF_SK = OFF_WPQ + (size_t)2 * PQ * D * 2;
constexpr size_t OFF_MOD = OFF_SK + (size_t)2 * 8 * 2 * 128 * 128 * 2;
constexpr size_t OFF_COSS = OFF_MOD + (size_t)2 * 9 * 6144 * 4;
constexpr size_t OFF_SINS = OFF_COSS + (size_t)SEQ * 32 * 4;
constexpr size_t OFF_COSG = OFF_SINS + (size_t)SEQ * 32 * 4;
constexpr size_t OFF_SING = OFF_COSG + (size_t)SEQ * 64 * 4;
constexpr size_t OFF_LB = OFF_SING + (size_t)SEQ * 64 * 4;
constexpr size_t OFF_U16 = OFF_LB + 2048;
constexpr size_t OFF_V16 = OFF_U16 + (size_t)NEXP * D * 2;
constexpr size_t OFF_HCTX = OFF_V16 + (size_t)NEXP * D * 2;
constexpr size_t OFF_A = OFF_HCTX + (size_t)TC * D * 4;
constexpr size_t OFF_PROJ = OFF_A + (size_t)TA * D * 2;
constexpr size_t OFF_MIX = OFF_PROJ + (size_t)TA * AB_IN * 2;
constexpr size_t OFF_SEL = OFF_MIX + (size_t)TA * D * 2;
constexpr size_t WS_NEED = OFF_SEL + (size_t)TA * 128 * 8;
static_assert(WS_NEED <= (size_t)536870912, "workspace over 512 MiB");
constexpr size_t OFF_OF = OFF_A;
constexpr size_t OFF_OB = OFF_A + (size_t)TA * 512 * 2;
constexpr size_t OFF_PROJH = OFF_PROJ;
constexpr size_t OFF_PROJS = OFF_PROJ + (size_t)TA * HGW * 2;
constexpr size_t OFF_QPEER = OFF_PROJ;
constexpr size_t OFF_TSC = OFF_QPEER + (size_t)TA * PQ * 2;
constexpr size_t OFF_TIX = OFF_TSC + (size_t)TA * 256 * 4;
static_assert(OFF_TIX + (size_t)TA * 256 * 4 <= OFF_MIX, "peer scratch overflows proj region");
constexpr size_t OFF_SELE = OFF_SEL;
constexpr size_t OFF_SELG = OFF_SEL + (size_t)TA * 128 * 4;

__device__ __forceinline__ float bf2f(bf16_t v) { return __uint_as_float(((unsigned)v) << 16); }
__device__ __forceinline__ bf16_t f2bf(float f) {
    unsigned u = __float_as_uint(f);
    u += 0x7fffu + ((u >> 16) & 1u);
    return (bf16_t)(u >> 16);
}
__device__ __forceinline__ unsigned pack2(float lo, float hi) { return (unsigned)f2bf(lo) | ((unsigned)f2bf(hi) << 16); }
__device__ __forceinline__ float sigmoidf_(float x) { return 1.0f / (1.0f + __expf(-x)); }
__device__ __forceinline__ float siluf_(float x) { return x * sigmoidf_(x); }
__device__ __forceinline__ float wave_sum(float v) {
#pragma unroll
    for (int o = 32; o >= 1; o >>= 1) v += __shfl_xor(v, o);
    return v;
}
__device__ __forceinline__ int mod_row(int row) { return row < TL ? (row >> 12) : 8; }

__device__ void ph_transpose(const float* __restrict__ in, bf16_t* __restrict__ out, int K, int N, float* lds) {
    const int tk = K / 32, tn = N / 32, nt = tk * tn;
    const int tx = threadIdx.x & 31, ty = threadIdx.x >> 5;
    for (int t = blockIdx.x; t < nt; t += gridDim.x) {
        const int k0 = (t / tn) * 32, n0 = (t % tn) * 32;
        __syncthreads();
#pragma unroll
        for (int i = 0; i < 4; ++i) lds[(ty + i * 8) * 33 + tx] = in[(size_t)(k0 + ty + i * 8) * N + n0 + tx];
        __syncthreads();
#pragma unroll
        for (int i = 0; i < 4; ++i) out[(size_t)(n0 + ty + i * 8) * K + k0 + tx] = f2bf(lds[tx * 33 + ty + i * 8]);
    }
}
__device__ void ph_cvt(const float* __restrict__ in, bf16_t* __restrict__ out, size_t n) {
    const size_t n8 = n / 8;
    for (size_t i = (size_t)blockIdx.x * blockDim.x + threadIdx.x; i < n8; i += (size_t)gridDim.x * blockDim.x) {
        const float4 a = ((const float4*)in)[i * 2], b = ((const float4*)in)[i * 2 + 1];
        uint4 w; w.x = pack2(a.x, a.y); w.y = pack2(a.z, a.w); w.z = pack2(b.x, b.y); w.w = pack2(b.z, b.w);
        ((uint4*)out)[i] = w;
    }
}
__device__ void ph_mod(const float* __restrict__ c, const float* __restrict__ c_ctx, const float* __restrict__ ada_w,
                       const float* __restrict__ ada_b, float* __restrict__ mod, float* lds) {
    float* s = lds;
    float* red = lds + 9 * 1024;
    const int tx = threadIdx.x & 63, ky = threadIdx.x >> 6;
    for (int i = threadIdx.x; i < 9 * 1024; i += 256) {
        const int r = i >> 10, k = i & 1023;
        const float v = r < 8 ? c[r * 1024 + k] : c_ctx[k];
        s[i] = siluf_(v);
    }
    __syncthreads();
    const int nitems = 2 * 96;
    for (int it = blockIdx.x; it < nitems; it += gridDim.x) {
        const int layer = it / 96, n = (it % 96) * 64 + tx;
        const float* w = ada_w + (size_t)layer * 1024 * 6144 + n;
        float acc[9];
#pragma unroll
        for (int r = 0; r < 9; ++r) acc[r] = 0.f;
        for (int k = ky * 256; k < ky * 256 + 256; ++k) {
            const float wv = w[(size_t)k * 6144];
#pragma unroll
            for (int r = 0; r < 9; ++r) acc[r] += s[r * 1024 + k] * wv;
        }
        __syncthreads();
#pragma unroll
        for (int r = 0; r < 9; ++r) red[(ky * 9 + r) * 64 + tx] = acc[r];
        __syncthreads();
        if (ky == 0) {
#pragma unroll
            for (int r = 0; r < 9; ++r) {
                const float v = red[(0 * 9 + r) * 64 + tx] + red[(1 * 9 + r) * 64 + tx] + red[(2 * 9 + r) * 64 + tx] + red[(3 * 9 + r) * 64 + tx];
                mod[((size_t)layer * 9 + r) * 6144 + n] = v + ada_b[layer * 6144 + n];
            }
        }
    }
}
__device__ void ph_tables(float* cosS, float* sinS, float* cosG, float* sinG, const float* __restrict__ lb_logits, float* lb) {
    const int gt = blockIdx.x * blockDim.x + threadIdx.x, gs = gridDim.x * blockDim.x;
    for (int i = gt; i < SEQ * 32; i += gs) {
        const int t = i >> 5, j = i & 31;
        const float pos = (float)(j < 16 ? (t >> 6) : (t & 63));
        const float inv = powf(10000.0f, -(float)(j & 15) / 16.0f);
        const float ang = pos * inv;
        cosS[i] = cosf(ang); sinS[i] = sinf(ang);
    }
    for (int i = gt; i < SEQ * 64; i += gs) {
        const int t = i >> 6, j = i & 63;
        const float pos = (float)(j < 32 ? (t >> 6) : (t & 63));
        const float inv = powf(10000.0f, -(float)(j & 31) / 32.0f);
        const float ang = pos * inv;
        cosG[i] = cosf(ang); sinG[i] = sinf(ang);
    }
    for (int i = gt; i < 512; i += gs) {
        const float l0 = lb_logits[i], l1 = lb_logits[512 + i];
        lb[i] = 1.0f / (1.0f + expf(l1 - l0));
    }
}

__device__ void ph_normmod(const float* __restrict__ hlat, const float* __restrict__ hctx, const float* __restrict__ gamma,
                           const float* __restrict__ modl  , int sc_off, int sh_off, bf16_t* __restrict__ out, int nrows) {
    const int lane = threadIdx.x & 63, wid = threadIdx.x >> 6;
    for (int row = blockIdx.x * 4 + wid; row < nrows; row += gridDim.x * 4) {
        const float* src = row < TL ? hlat + (size_t)row * D : hctx + (size_t)(row - TL) * D;
        const float* m = modl + (size_t)mod_row(row) * 6144;
        float4 x[4]; float ss = 0.f;
#pragma unroll
        for (int i = 0; i < 4; ++i) { x[i] = ((const float4*)src)[i * 64 + lane]; ss += x[i].x * x[i].x + x[i].y * x[i].y + x[i].z * x[i].z + x[i].w * x[i].w; }
        ss = wave_sum(ss);
        const float rinv = rsqrtf(ss * (1.0f / D) + EPS);
#pragma unroll
        for (int i = 0; i < 4; ++i) {
            const int col = (i * 64 + lane) * 4;
            const float4 g = *(const float4*)(gamma + col), sc = *(const float4*)(m + sc_off + col), sh = *(const float4*)(m + sh_off + col);
            const float y0 = x[i].x * rinv * g.x * (1.f + sc.x) + sh.x, y1 = x[i].y * rinv * g.y * (1.f + sc.y) + sh.y;
            const float y2 = x[i].z * rinv * g.z * (1.f + sc.z) + sh.z, y3 = x[i].w * rinv * g.w * (1.f + sc.w) + sh.w;
            uint2 w; w.x = pack2(y0, y1); w.y = pack2(y2, y3);
            *(uint2*)(out + (size_t)row * D + col) = w;
        }
    }
}

constexpr int GEMM_LDS = 65536;
template <class Epi>
__device__ __forceinline__ void gemm_tile(const bf16_t* __restrict__ A, int lda, const bf16_t* __restrict__ Bt, int ldb, int K,
                                          int m0, int n0, char* lds, Epi& epi) {
    const int tid = threadIdx.x, lane = tid & 63, wid = tid >> 6, wr = wid >> 1, wc = wid & 1, fr = lane & 15, fq = lane >> 4;
    f32x4 acc[4][4];
#pragma unroll
    for (int i = 0; i < 4; ++i)
#pragma unroll
        for (int j = 0; j < 4; ++j) acc[i][j] = (f32x4){0.f, 0.f, 0.f, 0.f};
    const int nk = K / 64;
    uint4 ra[4], rb[4];
    int srow[4], sch[4];
#pragma unroll
    for (int i = 0; i < 4; ++i) { const int id = tid + i * 256; srow[i] = id >> 3; sch[i] = id & 7; }
    auto gload = [&](int kt) {
#pragma unroll
        for (int i = 0; i < 4; ++i) {
            ra[i] = *(const uint4*)(A + (size_t)(m0 + srow[i]) * lda + kt * 64 + sch[i] * 8);
            rb[i] = *(const uint4*)(Bt + (size_t)(n0 + srow[i]) * ldb + kt * 64 + sch[i] * 8);
        }
    };
    auto lstore = [&](int buf) {
        char* base = lds + buf * 32768;
#pragma unroll
        for (int i = 0; i < 4; ++i) {
            const int off = srow[i] * 128 + ((sch[i] ^ (srow[i] & 7)) << 4);
            *(uint4*)(base + off) = ra[i];
            *(uint4*)(base + 16384 + off) = rb[i];
        }
    };
    __syncthreads();
    gload(0); lstore(0);
    __syncthreads();
    for (int kt = 0; kt < nk; ++kt) {
        if (kt + 1 < nk) gload(kt + 1);
        const char* base = lds + (kt & 1) * 32768;
#pragma unroll
        for (int kk = 0; kk < 2; ++kk) {
            bf16x8 af[4], bfr[4];
#pragma unroll
            for (int i = 0; i < 4; ++i) {
                const int ar = wr * 64 + i * 16 + fr, br = wc * 64 + i * 16 + fr;
                const int c = kk * 4 + fq;
                af[i] = *(const bf16x8*)(base + ar * 128 + ((c ^ (ar & 7)) << 4));
                bfr[i] = *(const bf16x8*)(base + 16384 + br * 128 + ((c ^ (br & 7)) << 4));
            }
#pragma unroll
            for (int i = 0; i < 4; ++i)
#pragma unroll
                for (int j = 0; j < 4; ++j) acc[i][j] = __builtin_amdgcn_mfma_f32_16x16x32_bf16(bfr[j], af[i], acc[i][j], 0, 0, 0);
        }
        if (kt + 1 < nk) lstore((kt + 1) & 1);
        __syncthreads();
    }
    epi(acc, m0 + wr * 64 + fr, n0 + wc * 64 + fq * 4, lds);
}

struct EpiStoreSplit {
    bf16_t* O1; int ld1; bf16_t* O2; int ld2; int split;
    __device__ __forceinline__ void operator()(f32x4 (&acc)[4][4], int row0, int col0, char*) const {
#pragma unroll
        for (int i = 0; i < 4; ++i)
#pragma unroll
            for (int j = 0; j < 4; ++j) {
                const int row = row0 + i * 16, col = col0 + j * 16;
                uint2 w; w.x = pack2(acc[i][j][0], acc[i][j][1]); w.y = pack2(acc[i][j][2], acc[i][j][3]);
                if (col < split) *(uint2*)(O1 + (size_t)row * ld1 + col) = w;
                else *(uint2*)(O2 + (size_t)row * ld2 + (col - split)) = w;
            }
    }
};
struct EpiResid {
    const float* hin_lat; const float* hin_ctx; float* hout_lat; float* hout_ctx; const float* gate  ;
    __device__ __forceinline__ void operator()(f32x4 (&acc)[4][4], int row0, int col0, char*) const {
#pragma unroll
        for (int i = 0; i < 4; ++i) {
            const int row = row0 + i * 16;
            const float* hi = row < TL ? hin_lat + (size_t)row * D : hin_ctx + (size_t)(row - TL) * D;
            float* ho = row < TL ? hout_lat + (size_t)row * D : hout_ctx + (size_t)(row - TL) * D;
            const float* g = gate + (size_t)mod_row(row) * 6144;
#pragma unroll
            for (int j = 0; j < 4; ++j) {
                const int col = col0 + j * 16;
                const float4 h = *(const float4*)(hi + col), gg = *(const float4*)(g + col);
                float4 o; o.x = h.x + gg.x * acc[i][j][0]; o.y = h.y + gg.y * acc[i][j][1]; o.z = h.z + gg.z * acc[i][j][2]; o.w = h.w + gg.w * acc[i][j][3];
                *(float4*)(ho + col) = o;
            }
        }
    }
};
struct EpiTop16 {
    float* tsc; int* tix; int hp; int m0;
    __device__ __forceinline__ void operator()(f32x4 (&acc)[4][4], int row0, int col0, char* lds) const {
        float* sc = (float*)lds;
        const int lr0 = row0 - m0;
#pragma unroll
        for (int i = 0; i < 4; ++i)
#pragma unroll
            for (int j = 0; j < 4; ++j) *(f32x4*)(sc + (lr0 + i * 16) * 128 + (col0 & 127) + j * 16) = acc[i][j];
        __syncthreads();
        const int r = threadIdx.x;
        if (r < 128) {
            float* my = sc + r * 128;
            const size_t ob = ((size_t)(m0 + r) * 16 + hp) * 16;
            for (int p = 0; p < 16; ++p) {
                float best = -3.0e38f; int bi = 0;
                for (int c = 0; c < 128; ++c) {
                    const int cc = (c + r) & 127;
                    const float v = my[cc];
                    if (v > best || (v == best && cc < bi)) { best = v; bi = cc; }
                }
                tsc[ob + p] = best; tix[ob + p] = bi;
                my[bi] = -3.0e38f;
            }
        }
        __syncthreads();
    }
};

template <class Epi>
__device__ void ph_gemm(const bf16_t* A, int lda, const bf16_t* Bt, int ldb, int M, int N, int K, char* lds, Epi epi) {
    const int tm = M / 128, tn = N / 128;
    for (int t = blockIdx.x; t < tm * tn; t += gridDim.x) {
        const int m0 = (t / tn) * 128, n0 = (t % tn) * 128;
        gemm_tile(A, lda, Bt, ldb, K, m0, n0, lds, epi);
    }
}
__device__ void ph_peer_scores(const bf16_t* qpeer, const bf16_t* SK, float* tsc, int* tix, int M, char* lds) {
    const int tm = M / 128;
    for (int t = blockIdx.x; t < tm * 16; t += gridDim.x) {
        const int m0 = (t >> 4) * 128, hp = t & 15;
        EpiTop16 epi{tsc, tix, hp, m0};
        gemm_tile(qpeer + hp * 128, PQ, SK + (size_t)hp * 128 * 128, 128, 128, m0, 0, lds, epi);
    }
}

constexpr int HG_LDS = (3 * 32 * 128 + 32 * 64 + 32 * 4 * 64) * 4;
__device__ __forceinline__ int hg_row(int b, int dir, int p) {
    if (p < LC) { const int s = dir ? (LC - 1 - p) : p; return TL + b * LC + s; }
    const int t = dir ? (SEQ - 1 - (p - LC)) : (p - LC);
    return b * SEQ + t;
}
__device__ void ph_hgrn(const bf16_t* __restrict__ projH, const float* __restrict__ lb, bf16_t* __restrict__ of, bf16_t* __restrict__ ob, float* lds) {
    float* sf = lds;
    float* sk = sf + 32 * 128;
    float* sq = sk + 32 * 128;
    float* sv = sq + 32 * 128;
    float* so = sv + 32 * 64;
    const int tid = threadIdx.x, lane = tid & 63, wid = tid >> 6;
    for (int it = blockIdx.x; it < NB * 4 * 2 * 2; it += gridDim.x) {
        const int vh = it & 1, dir = (it >> 1) & 1, h = (it >> 2) & 3, b = it >> 4;
        bf16_t* out = dir ? ob : of;
        float S[32];
#pragma unroll
        for (int k = 0; k < 32; ++k) S[k] = 0.f;
        for (int p0 = 0; p0 < LC + SEQ; p0 += 32) {
            __syncthreads();
            for (int idx = tid; idx < 32 * 128; idx += 256) {
                const int tok = idx >> 7, k = idx & 127, ch = h * 128 + k;
                const size_t rb = (size_t)hg_row(b, dir, p0 + tok) * HGW;
                const float xq = bf2f(projH[rb + ch]);
                const float xf = bf2f(projH[rb + (dir ? 1024 : 512) + ch]);
                const float l = lb[ch];
                const float f = l + (1.f - l) * sigmoidf_(xf);
                sf[idx] = f; sk[idx] = 1.f - f; sq[idx] = siluf_(xq);
            }
            for (int idx = tid; idx < 32 * 64; idx += 256) {
                const int tok = idx >> 6, vv = idx & 63;
                sv[idx] = bf2f(projH[(size_t)hg_row(b, dir, p0 + tok) * HGW + 1536 + h * 128 + vh * 64 + vv]);
            }
            __syncthreads();
            for (int tok = 0; tok < 32; ++tok) {
                const float vt = sv[tok * 64 + lane];
                const float* pf = sf + tok * 128 + wid * 32; const float* pk = sk + tok * 128 + wid * 32; const float* pq = sq + tok * 128 + wid * 32;
                float o = 0.f;
#pragma unroll
                for (int k = 0; k < 32; ++k) { S[k] = pf[k] * S[k] + pk[k] * vt; o += pq[k] * S[k]; }
                so[(tok * 4 + wid) * 64 + lane] = o;
            }
            __syncthreads();
            for (int idx = tid; idx < 32 * 64; idx += 256) {
                const int tok = idx >> 6, vv = idx & 63;
                const float o = so[(tok * 4 + 0) * 64 + vv] + so[(tok * 4 + 1) * 64 + vv] + so[(tok * 4 + 2) * 64 + vv] + so[(tok * 4 + 3) * 64 + vv];
                out[(size_t)hg_row(b, dir, p0 + tok) * 512 + h * 128 + vh * 64 + vv] = f2bf(o);
            }
        }
    }
}
__device__ void ph_hgpost(const bf16_t* __restrict__ of, const bf16_t* __restrict__ ob, const bf16_t* __restrict__ projH,
                          const float* __restrict__ g, bf16_t* __restrict__ mix) {
    const int lane = threadIdx.x & 63, wid = threadIdx.x >> 6;
    for (int it = blockIdx.x * 4 + wid; it < TA * 4; it += gridDim.x * 4) {
        const int row = it >> 2, h = it & 3;
        const size_t o = (size_t)row * 512 + h * 128 + lane * 2;
        const unsigned a = *(const unsigned*)(of + o), bb = *(const unsigned*)(ob + o);
        const float x0 = bf2f((bf16_t)(a & 0xffff)) + bf2f((bf16_t)(bb & 0xffff)), x1 = bf2f((bf16_t)(a >> 16)) + bf2f((bf16_t)(bb >> 16));
        const float ss = wave_sum(x0 * x0 + x1 * x1);
        const float rinv = rsqrtf(ss * (1.0f / 128.0f) + EPS);
        const unsigned gg = *(const unsigned*)(projH + (size_t)row * HGW + 2048 + h * 128 + lane * 2);
        const float y0 = x0 * rinv * g[lane * 2] * siluf_(bf2f((bf16_t)(gg & 0xffff)));
        const float y1 = x1 * rinv * g[lane * 2 + 1] * siluf_(bf2f((bf16_t)(gg >> 16)));
        *(unsigned*)(mix + (size_t)row * D + h * 128 + lane * 2) = pack2(y0, y1);
    }
}

__device__ void ph_prep_swa(bf16_t* __restrict__ P, const float* __restrict__ cosS, const float* __restrict__ sinS) {
    const size_t n = (size_t)TA * 320;
    for (size_t idx = (size_t)blockIdx.x * blockDim.x + threadIdx.x; idx < n; idx += (size_t)gridDim.x * blockDim.x) {
        const int row = (int)(idx / 320), pr = (int)(idx % 320), head = pr >> 5, d = pr & 31;
        bf16_t* p = P + (size_t)row * SWW + head * 64 + d;
        float x1 = bf2f(p[0]), x2 = bf2f(p[32]);
        if (row < TL) {
            const int t = row & (SEQ - 1);
            const float c = cosS[t * 32 + d], s = sinS[t * 32 + d];
            const float y1 = x1 * c - x2 * s, y2 = x1 * s + x2 * c;
            x1 = y1; x2 = y2;
        }
        if (head < 8) { x1 *= 0.125f; x2 *= 0.125f; }
        p[0] = f2bf(x1); p[32] = f2bf(x2);
    }
}
__device__ void ph_prep_ga(bf16_t* __restrict__ P, const float* __restrict__ qg, const float* __restrict__ kg,
                           const float* __restrict__ cosG, const float* __restrict__ sinG) {
    const int lane = threadIdx.x & 63, wid = threadIdx.x >> 6;
    for (int it = blockIdx.x * 4 + wid; it < TA * 10; it += gridDim.x * 4) {
        const int row = it / 10, head = it % 10;
        bf16_t* p = P + (size_t)row * GA_IN + head * 128;
        float x1 = bf2f(p[lane]), x2 = bf2f(p[lane + 64]);
        const float ss = wave_sum(x1 * x1 + x2 * x2);
        const float rinv = rsqrtf(ss * (1.0f / 128.0f) + EPS);
        const float* g = head < 8 ? qg : kg;
        x1 = x1 * rinv * g[lane]; x2 = x2 * rinv * g[lane + 64];
        if (row < TL) {
            const int t = row & (SEQ - 1);
            const float c = cosG[t * 64 + lane], s = sinG[t * 64 + lane];
            const float y1 = x1 * c - x2 * s, y2 = x1 * s + x2 * c;
            x1 = y1; x2 = y2;
        }
        if (head < 8) { x1 *= 0.08838834764831845f; x2 *= 0.08838834764831845f; }
        p[lane] = f2bf(x1); p[lane + 64] = f2bf(x2);
    }
}

template <int HD>
__device__ void attn_naive_item(const bf16_t* __restrict__ P, int ldp, int qcol, int kcol, int vcol,
                                int b, int qrow0  , bool q_is_latent, int nctx_tiles, int lat_lo, int lat_hi,
                                int window  , bool has_sink, float sink,
                                bf16_t* __restrict__ out, int ldo, int ocol, float* lds) {
    constexpr int SL = HD / 4;
    float* sK = lds;
    float* sV = lds + 64 * HD;
    const int tid = threadIdx.x, qi = tid >> 2, sl = tid & 3;
    const int qrow = qrow0 + qi;
    const int tq = qrow & (SEQ - 1);
    float q[SL], o[SL];
#pragma unroll
    for (int d = 0; d < SL; ++d) { q[d] = bf2f(P[(size_t)qrow * ldp + qcol + sl * SL + d]); o[d] = 0.f; }
    float m = has_sink ? sink : -1.0e30f, l = has_sink ? 1.0f : 0.0f;
    const int nlat_tiles = (lat_hi - lat_lo + 63) / 64;
    for (int ti = 0; ti < nctx_tiles + nlat_tiles; ++ti) {
        const bool isctx = ti < nctx_tiles;
        const int s0 = isctx ? ti * 64 : lat_lo + (ti - nctx_tiles) * 64;
        __syncthreads();
        for (int idx = tid; idx < 64 * HD; idx += 256) {
            const int j = idx / HD, d = idx % HD;
            const int s = s0 + j;
            float kv = 0.f, vv = 0.f;
            if (isctx || (s >= 0 && s < SEQ)) {
                const size_t r = isctx ? (size_t)(TL + b * LC + s) : (size_t)(b * SEQ + s);
                kv = bf2f(P[r * ldp + kcol + d]); vv = bf2f(P[r * ldp + vcol + d]);
            }
            sK[idx] = kv; sV[idx] = vv;
        }
        __syncthreads();
        for (int j = 0; j < 64; ++j) {
            const int s = s0 + j;
            bool valid = true;
            if (!isctx) {
                valid = (s >= 0) && (s < SEQ) && (s < lat_hi);
                if (window >= 0) { const int dlt = tq - s; valid = valid && (dlt <= window) && (dlt >= -window); }
            }
            float part = 0.f;
            const float* kr = sK + j * HD + sl * SL;
#pragma unroll
            for (int d = 0; d < SL; ++d) part += q[d] * kr[d];
            part += __shfl_xor(part, 1);
            part += __shfl_xor(part, 2);
            if (valid) {
                if (part > m) {
                    const float corr = __expf(m - part);
                    l *= corr;
#pragma unroll
                    for (int d = 0; d < SL; ++d) o[d] *= corr;
                    m = part;
                }
                const float p = __expf(part - m);
                l += p;
                const float* vr = sV + j * HD + sl * SL;
#pragma unroll
                for (int d = 0; d < SL; ++d) o[d] += p * vr[d];
            }
        }
    }
    const float rl = 1.0f / l;
#pragma unroll
    for (int d = 0; d < SL; ++d) out[(size_t)qrow * ldo + ocol + sl * SL + d] = f2bf(o[d] * rl);
}
__device__ void ph_swa(const bf16_t* __restrict__ projS, const float* __restrict__ sink, bf16_t* __restrict__ mix, float* lds) {
    const int n_lat = NB * 8 * 64, n_ctx = NB * 8 * 4;
    for (int it = blockIdx.x; it < n_lat + n_ctx; it += gridDim.x) {
        if (it < n_lat) {
            const int qb = it & 63, hq = (it >> 6) & 7, b = it >> 9, kvh = hq >> 2;
            const int t0 = qb * 64;
            int lo = t0 - 128; if (lo < 0) lo = 0;
            int hi = t0 + 64 + 128; if (hi > SEQ) hi = SEQ;
            attn_naive_item<64>(projS, SWW, hq * 64, 512 + kvh * 64, 640 + kvh * 64, b, b * SEQ + t0, true, 4, lo, hi, 128, true, sink[hq],
                                mix, D, 512 + hq * 64, lds);
        } else {
            const int i2 = it - n_lat, qb = i2 & 3, hq = (i2 >> 2) & 7, b = i2 >> 5, kvh = hq >> 2;
            attn_naive_item<64>(projS, SWW, hq * 64, 512 + kvh * 64, 640 + kvh * 64, b, TL + b * LC + qb * 64, false, 4, 0, 0, -1, true, sink[hq],
                                mix, D, 512 + hq * 64, lds);
        }
    }
}
__device__ void ph_dense(const bf16_t* __restrict__ projG, bf16_t* __restrict__ mix, float* lds) {
    for (int it = blockIdx.x; it < NB * 8 * 64; it += gridDim.x) {
        const int qb = it & 63, hq = (it >> 6) & 7, b = it >> 9, kvh = hq >> 2;
        attn_naive_item<128>(projG, GA_IN, hq * 128, 1024 + kvh * 128, 1280 + kvh * 128, b, b * SEQ + qb * 64, true, 4, 0, SEQ, -1, false, 0.f,
                             mix, D, hq * 128, lds);
    }
}

__device__ void ph_peer_combine(const float* __restrict__ tsc, const int* __restrict__ tix, int* __restrict__ sel_e, float* __restrict__ sel_g, int ntok) {
    const int lane = threadIdx.x & 63, wid = threadIdx.x >> 6;
    for (int it = blockIdx.x * 4 + wid; it < ntok * 8; it += gridDim.x * 4) {
        const size_t b1 = (size_t)it * 32, b2 = b1 + 16;
        const float s2 = tsc[b2 + (lane & 15)];
        float cv[4];
#pragma unroll
        for (int u = 0; u < 4; ++u) cv[u] = tsc[b1 + (lane >> 4) + 4 * u] + s2;
        float mysc = 0.f; int myc = 0;
        for (int j = 0; j < 16; ++j) {
            float bv = cv[0]; int bc = ((lane >> 4)) * 16 + (lane & 15);
#pragma unroll
            for (int u = 1; u < 4; ++u) { const int c = ((lane >> 4) + 4 * u) * 16 + (lane & 15); if (cv[u] > bv) { bv = cv[u]; bc = c; } }
#pragma unroll
            for (int o = 32; o >= 1; o >>= 1) {
                const float ov = __shfl_xor(bv, o); const int oc = __shfl_xor(bc, o);
                if (ov > bv || (ov == bv && oc < bc)) { bv = ov; bc = oc; }
            }
#pragma unroll
            for (int u = 0; u < 4; ++u) { const int c = ((lane >> 4) + 4 * u) * 16 + (lane & 15); if (c == bc) cv[u] = -3.0e38f; }
            if (lane == j) { mysc = bv; myc = bc; }
        }
        const float top = __shfl(mysc, 0);
        float e = lane < 16 ? __expf(mysc - top) : 0.f;
        float sum = e;
#pragma unroll
        for (int o = 8; o >= 1; o >>= 1) sum += __shfl_xor(sum, o);
        if (lane < 16) {
            const int ex = tix[b1 + (myc >> 4)] * 128 + tix[b2 + (myc & 15)];
            sel_e[(size_t)it * 16 + lane] = ex;
            sel_g[(size_t)it * 16 + lane] = e / sum;
        }
    }
}
__device__ void ph_peer_gather(const bf16_t* __restrict__ xf  , const bf16_t* __restrict__ U, const bf16_t* __restrict__ V,
                               const int* __restrict__ sel_e, const float* __restrict__ sel_g, const float* __restrict__ gate  ,
                               float* __restrict__ hlat, float* __restrict__ hctx, int ntok) {
    const int lane = threadIdx.x & 63, wid = threadIdx.x >> 6;
    for (int row = blockIdx.x * 4 + wid; row < ntok; row += gridDim.x * 4) {
        float x[16], y[16];
#pragma unroll
        for (int i = 0; i < 2; ++i) {
            const uint4 w = *(const uint4*)(xf + (size_t)row * D + (lane + 64 * i) * 8);
            const unsigned ww[4] = {w.x, w.y, w.z, w.w};
#pragma unroll
            for (int j = 0; j < 4; ++j) { x[i * 8 + j * 2] = __uint_as_float(ww[j] << 16); x[i * 8 + j * 2 + 1] = __uint_as_float(ww[j] & 0xffff0000u); }
        }
#pragma unroll
        for (int i = 0; i < 16; ++i) y[i] = 0.f;
        const int my_e0 = sel_e[(size_t)row * 128 + lane], my_e1 = sel_e[(size_t)row * 128 + 64 + lane];
        const float my_g0 = sel_g[(size_t)row * 128 + lane], my_g1 = sel_g[(size_t)row * 128 + 64 + lane];
        for (int k = 0; k < 128; ++k) {
            const int e = __shfl(k < 64 ? my_e0 : my_e1, k & 63);
            const float g = __shfl(k < 64 ? my_g0 : my_g1, k & 63);
            const bf16_t* ur = U + (size_t)e * D;
            float part = 0.f;
#pragma unroll
            for (int i = 0; i < 2; ++i) {
                const uint4 w = *(const uint4*)(ur + (lane + 64 * i) * 8);
                const unsigned ww[4] = {w.x, w.y, w.z, w.w};
#pragma unroll
                for (int j = 0; j < 4; ++j) { part += x[i * 8 + j * 2] * __uint_as_float(ww[j] << 16); part += x[i * 8 + j * 2 + 1] * __uint_as_float(ww[j] & 0xffff0000u); }
            }
            const float dot = wave_sum(part);
            const float act = 0.5f * dot * (1.0f + erff(dot * 0.70710678118654752f));
            const float wgt = g * act;
            const bf16_t* vr = V + (size_t)e * D;
#pragma unroll
            for (int i = 0; i < 2; ++i) {
                const uint4 w = *(const uint4*)(vr + (lane + 64 * i) * 8);
                const unsigned ww[4] = {w.x, w.y, w.z, w.w};
#pragma unroll
                for (int j = 0; j < 4; ++j) { y[i * 8 + j * 2] += wgt * __uint_as_float(ww[j] << 16); y[i * 8 + j * 2 + 1] += wgt * __uint_as_float(ww[j] & 0xffff0000u); }
            }
        }
        float* hp = row < TL ? hlat + (size_t)row * D : hctx + (size_t)(row - TL) * D;
        const float* gg = gate + (size_t)mod_row(row) * 6144;
#pragma unroll
        for (int i = 0; i < 2; ++i) {
            const int col = (lane + 64 * i) * 8;
#pragma unroll
            for (int j = 0; j < 2; ++j) {
                float4 h = *(float4*)(hp + col + j * 4); const float4 g4 = *(const float4*)(gg + col + j * 4);
                h.x += g4.x * y[i * 8 + j * 4 + 0]; h.y += g4.y * y[i * 8 + j * 4 + 1]; h.z += g4.z * y[i * 8 + j * 4 + 2]; h.w += g4.w * y[i * 8 + j * 4 + 3];
                *(float4*)(hp + col + j * 4) = h;
            }
        }
    }
}
__device__ void ph_final(float* __restrict__ h, const float* __restrict__ g) {
    const int lane = threadIdx.x & 63, wid = threadIdx.x >> 6;
    for (int row = blockIdx.x * 4 + wid; row < TL; row += gridDim.x * 4) {
        float4* p = (float4*)(h + (size_t)row * D);
        float4 x[4]; float ss = 0.f;
#pragma unroll
        for (int i = 0; i < 4; ++i) { x[i] = p[i * 64 + lane]; ss += x[i].x * x[i].x + x[i].y * x[i].y + x[i].z * x[i].z + x[i].w * x[i].w; }
        ss = wave_sum(ss);
        const float rinv = rsqrtf(ss * (1.0f / D) + EPS);
#pragma unroll
        for (int i = 0; i < 4; ++i) {
            const float4 gg = ((const float4*)g)[i * 64 + lane];
            float4 o; o.x = x[i].x * rinv * gg.x; o.y = x[i].y * rinv * gg.y; o.z = x[i].z * rinv * gg.z; o.w = x[i].w * rinv * gg.w;
            p[i * 64 + lane] = o;
        }
    }
}

struct Params {
    const float *x, *c, *ctx, *c_ctx, *ada_w, *ada_b, *norm_mix_g, *norm_ffn_g, *ab_w_in, *ab_w_out, *hg_lb, *hg_norm_g, *sw_sink,
        *ga_w_in, *ga_w_out, *ga_qn, *ga_kn, *peer_wq, *peer_sk, *peer_u, *peer_v, *final_g;
    float* out; char* ws;
};
extern __shared__ __attribute__((aligned(16))) char dyn_lds[];

#define WSP(T, off) ((T*)(p.ws + (off)))

__global__ void __launch_bounds__(256) k_prep_w(Params p) {
    float* l = (float*)dyn_lds;
    ph_transpose(p.ab_w_in, WSP(bf16_t, OFF_WABIN), D, AB_IN, l);
    ph_transpose(p.ab_w_out, WSP(bf16_t, OFF_WABOUT), D, D, l);
    ph_transpose(p.ga_w_in, WSP(bf16_t, OFF_WGAIN), D, GA_IN, l);
    ph_transpose(p.ga_w_out, WSP(bf16_t, OFF_WGAOUT), D, D, l);
    ph_transpose(p.peer_wq, WSP(bf16_t, OFF_WPQ), D, PQ, l);
    ph_transpose(p.peer_wq + (size_t)D * PQ, WSP(bf16_t, OFF_WPQ) + (size_t)PQ * D, D, PQ, l);
    ph_cvt(p.peer_sk, WSP(bf16_t, OFF_SK), (size_t)2 * 8 * 2 * 128 * 128);
    ph_tables(WSP(float, OFF_COSS), WSP(float, OFF_SINS), WSP(float, OFF_COSG), WSP(float, OFF_SING), p.hg_lb, WSP(float, OFF_LB));
}
__global__ void __launch_bounds__(256) k_mod(Params p) { ph_mod(p.c, p.c_ctx, p.ada_w, p.ada_b, WSP(float, OFF_MOD), (float*)dyn_lds); }
__global__ void __launch_bounds__(256) k_cvt_uv(Params p, int layer) {
    ph_cvt(p.peer_u + (size_t)layer * NEXP * D, WSP(bf16_t, OFF_U16), (size_t)NEXP * D);
    ph_cvt(p.peer_v + (size_t)layer * NEXP * D, WSP(bf16_t, OFF_V16), (size_t)NEXP * D);
}
__global__ void __launch_bounds__(256) k_normmod(Params p, int which) {
    const int layer = which >> 1, ffn = which & 1;
    const float* hl = which == 0 ? p.x : p.out;
    const float* hc = which == 0 ? p.ctx : WSP(float, OFF_HCTX);
    const float* gamma = (ffn ? p.norm_ffn_g : p.norm_mix_g) + layer * D;
    ph_normmod(hl, hc, gamma, WSP(float, OFF_MOD) + (size_t)layer * 9 * 6144, ffn ? 4 * D : 1 * D, ffn ? 3 * D : 0, WSP(bf16_t, OFF_A), which == 3 ? TL : TA);
}
__global__ void __launch_bounds__(256) k_gemm_abin(Params p) {
    EpiStoreSplit e{WSP(bf16_t, OFF_PROJH), HGW, WSP(bf16_t, OFF_PROJS), SWW, HGW};
    ph_gemm(WSP(bf16_t, OFF_A), D, WSP(bf16_t, OFF_WABIN), D, TA, AB_IN, D, dyn_lds, e);
}
__global__ void __launch_bounds__(256) k_gemm_about(Params p) {
    EpiResid e{p.x, p.ctx, p.out, WSP(float, OFF_HCTX), WSP(float, OFF_MOD) + 2 * D};
    ph_gemm(WSP(bf16_t, OFF_MIX), D, WSP(bf16_t, OFF_WABOUT), D, TA, D, D, dyn_lds, e);
}
__global__ void __launch_bounds__(256) k_gemm_pq(Params p, int layer) {
    EpiStoreSplit e{WSP(bf16_t, OFF_QPEER), PQ, WSP(bf16_t, OFF_QPEER), PQ, 1 << 30};
    ph_gemm(WSP(bf16_t, OFF_A), D, WSP(bf16_t, OFF_WPQ) + (size_t)layer * PQ * D, D, layer == 0 ? TA : TL, PQ, D, dyn_lds, e);
}
__global__ void __launch_bounds__(256) k_peer_scores(Params p, int layer) {
    ph_peer_scores(WSP(bf16_t, OFF_QPEER), WSP(bf16_t, OFF_SK) + (size_t)layer * 16 * 128 * 128, WSP(float, OFF_TSC), WSP(int, OFF_TIX), layer == 0 ? TA : TL, dyn_lds);
}
__global__ void __launch_bounds__(256) k_peer_combine(Params p, int layer) {
    ph_peer_combine(WSP(float, OFF_TSC), WSP(int, OFF_TIX), WSP(int, OFF_SELE), WSP(float, OFF_SELG), layer == 0 ? TA : TL);
}
__global__ void __launch_bounds__(256) k_peer_gather(Params p, int layer) {
    ph_peer_gather(WSP(bf16_t, OFF_A), WSP(bf16_t, OFF_U16), WSP(bf16_t, OFF_V16), WSP(int, OFF_SELE), WSP(float, OFF_SELG),
                   WSP(float, OFF_MOD) + (size_t)layer * 9 * 6144 + 5 * D, p.out, WSP(float, OFF_HCTX), layer == 0 ? TA : TL);
}
__global__ void __launch_bounds__(256) k_hgrn(Params p) { ph_hgrn(WSP(bf16_t, OFF_PROJH), WSP(float, OFF_LB), WSP(bf16_t, OFF_OF), WSP(bf16_t, OFF_OB), (float*)dyn_lds); }
__global__ void __launch_bounds__(256) k_hgpost(Params p) { ph_hgpost(WSP(bf16_t, OFF_OF), WSP(bf16_t, OFF_OB), WSP(bf16_t, OFF_PROJH), p.hg_norm_g, WSP(bf16_t, OFF_MIX)); }
__global__ void __launch_bounds__(256) k_prep_swa(Params p) { ph_prep_swa(WSP(bf16_t, OFF_PROJS), WSP(float, OFF_COSS), WSP(float, OFF_SINS)); }
__global__ void __launch_bounds__(256) k_swa(Params p) { ph_swa(WSP(bf16_t, OFF_PROJS), p.sw_sink, WSP(bf16_t, OFF_MIX), (float*)dyn_lds); }
__global__ void __launch_bounds__(256) k_gemm_gain(Params p) {
    EpiStoreSplit e{WSP(bf16_t, OFF_PROJ), GA_IN, WSP(bf16_t, OFF_PROJ), GA_IN, 1 << 30};
    ph_gemm(WSP(bf16_t, OFF_A), D, WSP(bf16_t, OFF_WGAIN), D, TA, GA_IN, D, dyn_lds, e);
}
__global__ void __launch_bounds__(256) k_prep_ga(Params p) { ph_prep_ga(WSP(bf16_t, OFF_PROJ), p.ga_qn, p.ga_kn, WSP(float, OFF_COSG), WSP(float, OFF_SING)); }
__global__ void __launch_bounds__(256) k_dense(Params p) { ph_dense(WSP(bf16_t, OFF_PROJ), WSP(bf16_t, OFF_MIX), (float*)dyn_lds); }
__global__ void __launch_bounds__(256) k_gemm_gaout(Params p) {
    EpiResid e{p.out, WSP(float, OFF_HCTX), p.out, WSP(float, OFF_HCTX), WSP(float, OFF_MOD) + (size_t)9 * 6144 + 2 * D};
    ph_gemm(WSP(bf16_t, OFF_MIX), D, WSP(bf16_t, OFF_WGAOUT), D, TL, D, D, dyn_lds, e);
}
__global__ void __launch_bounds__(256) k_final(Params p) { ph_final(p.out, p.final_g); }

extern "C" void kernel_launch(void* const* d_in, const int* in_sizes, int n_in, void* d_out, int out_size, void* d_ws, size_t ws_size,
                              hipStream_t stream) {
    Params p{};
    p.x = (const float*)d_in[0]; p.c = (const float*)d_in[1]; p.ctx = (const float*)d_in[2]; p.c_ctx = (const float*)d_in[3];
    p.ada_w = (const float*)d_in[4]; p.ada_b = (const float*)d_in[5]; p.norm_mix_g = (const float*)d_in[6]; p.norm_ffn_g = (const float*)d_in[7];
    p.ab_w_in = (const float*)d_in[8]; p.ab_w_out = (const float*)d_in[9]; p.hg_lb = (const float*)d_in[10]; p.hg_norm_g = (const float*)d_in[11];
    p.sw_sink = (const float*)d_in[12]; p.ga_w_in = (const float*)d_in[13]; p.ga_w_out = (const float*)d_in[14]; p.ga_qn = (const float*)d_in[15];
    p.ga_kn = (const float*)d_in[16]; p.peer_wq = (const float*)d_in[17]; p.peer_sk = (const float*)d_in[18]; p.peer_u = (const float*)d_in[19];
    p.peer_v = (const float*)d_in[20]; p.final_g = (const float*)d_in[21];
    p.out = (float*)d_out; p.ws = (char*)d_ws;
    if (ws_size < WS_NEED) { fprintf(stderr, "workspace too small: %zu < %zu\n", ws_size, WS_NEED); return; }
    static bool attr_done = false;
    if (!attr_done) {
        (void)hipFuncSetAttribute((const void*)k_hgrn, hipFuncAttributeMaxDynamicSharedMemorySize, HG_LDS);
        attr_done = true;
    }
    const int G = 1024;
    k_prep_w<<<G, 256, 8192, stream>>>(p);
    k_mod<<<192, 256, (9 * 1024 + 4 * 9 * 64) * 4, stream>>>(p);
    k_cvt_uv<<<G, 256, 0, stream>>>(p, 0);
    k_normmod<<<G, 256, 0, stream>>>(p, 0);
    k_gemm_abin<<<G, 256, GEMM_LDS, stream>>>(p);
    k_hgrn<<<128, 256, HG_LDS, stream>>>(p);
    k_prep_swa<<<G, 256, 0, stream>>>(p);
    k_swa<<<2048, 256, 64 * 64 * 2 * 4, stream>>>(p);
    k_hgpost<<<G, 256, 0, stream>>>(p);
    k_gemm_about<<<G, 256, GEMM_LDS, stream>>>(p);
    k_normmod<<<G, 256, 0, stream>>>(p, 1);
    k_gemm_pq<<<G, 256, GEMM_LDS, stream>>>(p, 0);
    k_peer_scores<<<G, 256, GEMM_LDS, stream>>>(p, 0);
    k_peer_combine<<<G, 256, 0, stream>>>(p, 0);
    k_peer_gather<<<2048, 256, 0, stream>>>(p, 0);
    k_cvt_uv<<<G, 256, 0, stream>>>(p, 1);
    k_normmod<<<G, 256, 0, stream>>>(p, 2);
    k_gemm_gain<<<G, 256, GEMM_LDS, stream>>>(p);
    k_prep_ga<<<G, 256, 0, stream>>>(p);
    k_dense<<<2048, 256, 64 * 128 * 2 * 4, stream>>>(p);
    k_gemm_gaout<<<G, 256, GEMM_LDS, stream>>>(p);
    k_normmod<<<G, 256, 0, stream>>>(p, 3);
    k_gemm_pq<<<G, 256, GEMM_LDS, stream>>>(p, 1);
    k_peer_scores<<<G, 256, GEMM_LDS, stream>>>(p, 1);
    k_peer_combine<<<G, 256, 0, stream>>>(p, 1);
    k_peer_gather<<<2048, 256, 0, stream>>>(p, 1);
    k_final<<<G, 256, 0, stream>>>(p);
}
```

```cpp
#include <hip/hip_runtime.h>
#include <hip/hip_cooperative_groups.h>
#include <stdint.h>
#include <stdio.h>

typedef unsigned short bf16_t;
typedef short bf16x8 __attribute__((ext_vector_type(8)));
typedef float f32x4 __attribute__((ext_vector_type(4)));

constexpr int D = 1024, NB = 8, SEQ = 4096, LC = 256;
constexpr int TL = NB * SEQ;
constexpr int TC = NB * LC;
constexpr int TA = TL + TC;
constexpr int AB_IN = 3328, HGW = 2560, SWW = 768, GA_IN = 1536, PQ = 2048;
constexpr int NEXP = 16384;
constexpr float EPS = 1e-6f;

constexpr size_t OFF_WABIN = 0;
constexpr size_t OFF_WABOUT = OFF_WABIN + (size_t)AB_IN * D * 2;
constexpr size_t OFF_WGAIN = OFF_WABOUT + (size_t)D * D * 2;
constexpr size_t OFF_WGAOUT = OFF_WGAIN + (size_t)GA_IN * D * 2;
constexpr size_t OFF_WPQ = OFF_WGAOUT + (size_t)D * D * 2;
constexpr size_t OFF_SK = OFF_WPQ + (size_t)2 * PQ * D * 2;
constexpr size_t OFF_MOD = OFF_SK + (size_t)2 * 8 * 2 * 128 * 128 * 2;
constexpr size_t OFF_COSS = OFF_MOD + (size_t)2 * 9 * 6144 * 4;
constexpr size_t OFF_SINS = OFF_COSS + (size_t)SEQ * 32 * 4;
constexpr size_t OFF_COSG = OFF_SINS + (size_t)SEQ * 32 * 4;
constexpr size_t OFF_SING = OFF_COSG + (size_t)SEQ * 64 * 4;
constexpr size_t OFF_LB = OFF_SING + (size_t)SEQ * 64 * 4;
constexpr size_t OFF_U16 = OFF_LB + 2048;
constexpr size_t OFF_V16 = OFF_U16 + (size_t)NEXP * D * 2;
constexpr size_t OFF_HCTX = OFF_V16 + (size_t)NEXP * D * 2;
constexpr size_t OFF_A = OFF_HCTX + (size_t)TC * D * 4;
constexpr size_t OFF_PROJ = OFF_A + (size_t)TA * D * 2;
constexpr size_t OFF_MIX = OFF_PROJ + (size_t)TA * AB_IN * 2;
constexpr size_t OFF_SEL = OFF_MIX + (size_t)TA * D * 2;
constexpr size_t WS_NEED = OFF_SEL + (size_t)TA * 128 * 8;
static_assert(WS_NEED <= (size_t)536870912, "workspace over 512 MiB");
constexpr size_t OFF_OF = OFF_A;
constexpr size_t OFF_OB = OFF_A + (size_t)TA * 512 * 2;
constexpr size_t OFF_PROJH = OFF_PROJ;
constexpr size_t OFF_PROJS = OFF_PROJ + (size_t)TA * HGW * 2;
constexpr size_t OFF_QPEER = OFF_PROJ;
constexpr size_t OFF_TSC = OFF_QPEER + (size_t)TA * PQ * 2;
constexpr size_t OFF_TIX = OFF_TSC + (size_t)TA * 256 * 4;
static_assert(OFF_TIX + (size_t)TA * 256 * 4 <= OFF_MIX, "peer scratch overflows proj region");
constexpr size_t OFF_SELE = OFF_SEL;
constexpr size_t OFF_SELG = OFF_SEL + (size_t)TA * 128 * 4;

__device__ __forceinline__ float bf2f(bf16_t v) { return __uint_as_float(((unsigned)v) << 16); }
__device__ __forceinline__ bf16_t f2bf(float f) {
    unsigned u = __float_as_uint(f);
    u += 0x7fffu + ((u >> 16) & 1u);
    return (bf16_t)(u >> 16);
}
__device__ __forceinline__ unsigned pack2(float lo, float hi) { return (unsigned)f2bf(lo) | ((unsigned)f2bf(hi) << 16); }
__device__ __forceinline__ float sigmoidf_(float x) { return 1.0f / (1.0f + __expf(-x)); }
__device__ __forceinline__ float siluf_(float x) { return x * sigmoidf_(x); }
__device__ __forceinline__ float wave_sum(float v) {
#pragma unroll
    for (int o = 32; o >= 1; o >>= 1) v += __shfl_xor(v, o);
    return v;
}
__device__ __forceinline__ int mod_row(int row) { return row < TL ? (row >> 12) : 8; }

__device__ void ph_transpose(int bid, int nb, const float* __restrict__ in, bf16_t* __restrict__ out, int K, int N, float* lds) {
    const int tk = K / 32, tn = N / 32, nt = tk * tn;
    const int tx = threadIdx.x & 31, ty = threadIdx.x >> 5;
    for (int t = bid; t < nt; t += nb) {
        const int k0 = (t / tn) * 32, n0 = (t % tn) * 32;
        __syncthreads();
#pragma unroll
        for (int i = 0; i < 4; ++i) lds[(ty + i * 8) * 33 + tx] = in[(size_t)(k0 + ty + i * 8) * N + n0 + tx];
        __syncthreads();
#pragma unroll
        for (int i = 0; i < 4; ++i) out[(size_t)(n0 + ty + i * 8) * K + k0 + tx] = f2bf(lds[tx * 33 + ty + i * 8]);
    }
}
__device__ void ph_cvt(int bid, int nb, const float* __restrict__ in, bf16_t* __restrict__ out, size_t n) {
    const size_t n8 = n / 8;
    for (size_t i = (size_t)bid * blockDim.x + threadIdx.x; i < n8; i += (size_t)nb * blockDim.x) {
        const float4 a = ((const float4*)in)[i * 2], b = ((const float4*)in)[i * 2 + 1];
        uint4 w; w.x = pack2(a.x, a.y); w.y = pack2(a.z, a.w); w.z = pack2(b.x, b.y); w.w = pack2(b.z, b.w);
        ((uint4*)out)[i] = w;
    }
}
__device__ void ph_mod(int bid, int nb, const float* __restrict__ c, const float* __restrict__ c_ctx, const float* __restrict__ ada_w,
                       const float* __restrict__ ada_b, float* __restrict__ mod, float* lds) {
    float* s = lds;
    float* red = lds + 9 * 1024;
    const int tx = threadIdx.x & 63, ky = threadIdx.x >> 6;
    for (int i = threadIdx.x; i < 9 * 1024; i += 256) {
        const int r = i >> 10, k = i & 1023;
        const float v = r < 8 ? c[r * 1024 + k] : c_ctx[k];
        s[i] = siluf_(v);
    }
    __syncthreads();
    const int nitems = 2 * 96;
    for (int it = bid; it < nitems; it += nb) {
        const int layer = it / 96, n = (it % 96) * 64 + tx;
        const float* w = ada_w + (size_t)layer * 1024 * 6144 + n;
        float acc[9];
#pragma unroll
        for (int r = 0; r < 9; ++r) acc[r] = 0.f;
        for (int k = ky * 256; k < ky * 256 + 256; ++k) {
            const float wv = w[(size_t)k * 6144];
#pragma unroll
            for (int r = 0; r < 9; ++r) acc[r] += s[r * 1024 + k] * wv;
        }
        __syncthreads();
#pragma unroll
        for (int r = 0; r < 9; ++r) red[(ky * 9 + r) * 64 + tx] = acc[r];
        __syncthreads();
        if (ky == 0) {
#pragma unroll
            for (int r = 0; r < 9; ++r) {
                const float v = red[(0 * 9 + r) * 64 + tx] + red[(1 * 9 + r) * 64 + tx] + red[(2 * 9 + r) * 64 + tx] + red[(3 * 9 + r) * 64 + tx];
                mod[((size_t)layer * 9 + r) * 6144 + n] = v + ada_b[layer * 6144 + n];
            }
        }
    }
}
__device__ void ph_tables(int bid, int nb, float* cosS, float* sinS, float* cosG, float* sinG, const float* __restrict__ lb_logits, float* lb) {
    const int gt = bid * blockDim.x + threadIdx.x, gs = nb * blockDim.x;
    for (int i = gt; i < SEQ * 32; i += gs) {
        const int t = i >> 5, j = i & 31;
        const float pos = (float)(j < 16 ? (t >> 6) : (t & 63));
        const float inv = powf(10000.0f, -(float)(j & 15) / 16.0f);
        const float ang = pos * inv;
        cosS[i] = cosf(ang); sinS[i] = sinf(ang);
    }
    for (int i = gt; i < SEQ * 64; i += gs) {
        const int t = i >> 6, j = i & 63;
        const float pos = (float)(j < 32 ? (t >> 6) : (t & 63));
        const float inv = powf(10000.0f, -(float)(j & 31) / 32.0f);
        const float ang = pos * inv;
        cosG[i] = cosf(ang); sinG[i] = sinf(ang);
    }
    for (int i = gt; i < 512; i += gs) {
        const float l0 = lb_logits[i], l1 = lb_logits[512 + i];
        lb[i] = 1.0f / (1.0f + expf(l1 - l0));
    }
}

__device__ void ph_normmod(int bid, int nb, const float* __restrict__ hlat, const float* __restrict__ hctx, const float* __restrict__ gamma,
                           const float* __restrict__ modl  , int sc_off, int sh_off, bf16_t* __restrict__ out, int nrows) {
    const int lane = threadIdx.x & 63, wid = threadIdx.x >> 6;
    for (int row = bid * 4 + wid; row < nrows; row += nb * 4) {
        const float* src = row < TL ? hlat + (size_t)row * D : hctx + (size_t)(row - TL) * D;
        const float* m = modl + (size_t)mod_row(row) * 6144;
        float4 x[4]; float ss = 0.f;
#pragma unroll
        for (int i = 0; i < 4; ++i) { x[i] = ((const float4*)src)[i * 64 + lane]; ss += x[i].x * x[i].x + x[i].y * x[i].y + x[i].z * x[i].z + x[i].w * x[i].w; }
        ss = wave_sum(ss);
        const float rinv = rsqrtf(ss * (1.0f / D) + EPS);
#pragma unroll
        for (int i = 0; i < 4; ++i) {
            const int col = (i * 64 + lane) * 4;
            const float4 g = *(const float4*)(gamma + col), sc = *(const float4*)(m + sc_off + col), sh = *(const float4*)(m + sh_off + col);
            const float y0 = x[i].x * rinv * g.x * (1.f + sc.x) + sh.x, y1 = x[i].y * rinv * g.y * (1.f + sc.y) + sh.y;
            const float y2 = x[i].z * rinv * g.z * (1.f + sc.z) + sh.z, y3 = x[i].w * rinv * g.w * (1.f + sc.w) + sh.w;
            uint2 w; w.x = pack2(y0, y1); w.y = pack2(y2, y3);
            *(uint2*)(out + (size_t)row * D + col) = w;
        }
    }
}

constexpr int GEMM_LDS = 65536;
template <class Epi>
__device__ __forceinline__ void gemm_tile(const bf16_t* __restrict__ A, int lda, const bf16_t* __restrict__ Bt, int ldb, int K,
                                          int m0, int n0, char* lds, Epi& epi) {
    const int tid = threadIdx.x, lane = tid & 63, wid = tid >> 6, wr = wid >> 1, wc = wid & 1, fr = lane & 15, fq = lane >> 4;
    f32x4 acc[4][4];
#pragma unroll
    for (int i = 0; i < 4; ++i)
#pragma unroll
        for (int j = 0; j < 4; ++j) acc[i][j] = (f32x4){0.f, 0.f, 0.f, 0.f};
    const int nk = K / 64;
    const int sr0 = tid >> 3, sc0 = tid & 7;
    const bf16_t* ga = A + (size_t)(m0 + sr0) * lda + sc0 * 8;
    const bf16_t* gb = Bt + (size_t)(n0 + sr0) * ldb + sc0 * 8;
    const int soff = sr0 * 128 + ((sc0 ^ (sr0 & 7)) << 4);
    uint4 ra0, ra1, ra2, ra3, rb0, rb1, rb2, rb3;
#define GT_GLOAD(kt) do { const int _ko = (kt) * 64; \
        ra0 = *(const uint4*)(ga + _ko); ra1 = *(const uint4*)(ga + (size_t)32 * lda + _ko); \
        ra2 = *(const uint4*)(ga + (size_t)64 * lda + _ko); ra3 = *(const uint4*)(ga + (size_t)96 * lda + _ko); \
        rb0 = *(const uint4*)(gb + _ko); rb1 = *(const uint4*)(gb + (size_t)32 * ldb + _ko); \
        rb2 = *(const uint4*)(gb + (size_t)64 * ldb + _ko); rb3 = *(const uint4*)(gb + (size_t)96 * ldb + _ko); } while (0)
#define GT_LSTORE(buf) do { char* _b = lds + (buf) * 32768 + soff; \
        *(uint4*)(_b) = ra0; *(uint4*)(_b + 4096) = ra1; *(uint4*)(_b + 8192) = ra2; *(uint4*)(_b + 12288) = ra3; \
        *(uint4*)(_b + 16384) = rb0; *(uint4*)(_b + 16384 + 4096) = rb1; *(uint4*)(_b + 16384 + 8192) = rb2; *(uint4*)(_b + 16384 + 12288) = rb3; } while (0)
    __syncthreads();
    GT_GLOAD(0); GT_LSTORE(0);
    __syncthreads();
    for (int kt = 0; kt < nk; ++kt) {
        if (kt + 1 < nk) GT_GLOAD(kt + 1);
        const char* base = lds + (kt & 1) * 32768;
#pragma unroll
        for (int kk = 0; kk < 2; ++kk) {
            bf16x8 af[4], bfr[4];
#pragma unroll
            for (int i = 0; i < 4; ++i) {
                const int ar = wr * 64 + i * 16 + fr, br = wc * 64 + i * 16 + fr;
                const int c = kk * 4 + fq;
                af[i] = *(const bf16x8*)(base + ar * 128 + ((c ^ (ar & 7)) << 4));
                bfr[i] = *(const bf16x8*)(base + 16384 + br * 128 + ((c ^ (br & 7)) << 4));
            }
#pragma unroll
            for (int i = 0; i < 4; ++i)
#pragma unroll
                for (int j = 0; j < 4; ++j) acc[i][j] = __builtin_amdgcn_mfma_f32_16x16x32_bf16(bfr[j], af[i], acc[i][j], 0, 0, 0);
        }
        if (kt + 1 < nk) GT_LSTORE((kt + 1) & 1);
        __syncthreads();
    }
#undef GT_GLOAD
#undef GT_LSTORE
    epi(acc, m0 + wr * 64 + fr, n0 + wc * 64 + fq * 4, lds);
}

struct EpiStoreSplit {
    bf16_t* O1; int ld1; bf16_t* O2; int ld2; int split;
    __device__ __forceinline__ void operator()(f32x4 (&acc)[4][4], int row0, int col0, char*) const {
#pragma unroll
        for (int i = 0; i < 4; ++i)
#pragma unroll
            for (int j = 0; j < 4; ++j) {
                const int row = row0 + i * 16, col = col0 + j * 16;
                uint2 w; w.x = pack2(acc[i][j][0], acc[i][j][1]); w.y = pack2(acc[i][j][2], acc[i][j][3]);
                if (col < split) *(uint2*)(O1 + (size_t)row * ld1 + col) = w;
                else *(uint2*)(O2 + (size_t)row * ld2 + (col - split)) = w;
            }
    }
};
struct EpiResid {
    const float* hin_lat; const float* hin_ctx; float* hout_lat; float* hout_ctx; const float* gate  ;
    __device__ __forceinline__ void operator()(f32x4 (&acc)[4][4], int row0, int col0, char*) const {
#pragma unroll
        for (int i = 0; i < 4; ++i) {
            const int row = row0 + i * 16;
            const float* hi = row < TL ? hin_lat + (size_t)row * D : hin_ctx + (size_t)(row - TL) * D;
            float* ho = row < TL ? hout_lat + (size_t)row * D : hout_ctx + (size_t)(row - TL) * D;
            const float* g = gate + (size_t)mod_row(row) * 6144;
#pragma unroll
            for (int j = 0; j < 4; ++j) {
                const int col = col0 + j * 16;
                const float4 h = *(const float4*)(hi + col), gg = *(const float4*)(g + col);
                float4 o; o.x = h.x + gg.x * acc[i][j][0]; o.y = h.y + gg.y * acc[i][j][1]; o.z = h.z + gg.z * acc[i][j][2]; o.w = h.w + gg.w * acc[i][j][3];
                *(float4*)(ho + col) = o;
            }
        }
    }
};
struct EpiTop16 {
    float* tsc; int* tix; int hp; int m0;
    __device__ __forceinline__ void operator()(f32x4 (&acc)[4][4], int row0, int col0, char* lds) const {
        float* sc = (float*)lds;
        const int lr0 = row0 - m0;
#pragma unroll
        for (int i = 0; i < 4; ++i)
#pragma unroll
            for (int j = 0; j < 4; ++j) *(f32x4*)(sc + (lr0 + i * 16) * 128 + (col0 & 127) + j * 16) = acc[i][j];
        __syncthreads();
        const int r = threadIdx.x;
        if (r < 128) {
            float* my = sc + r * 128;
            const size_t ob = ((size_t)(m0 + r) * 16 + hp) * 16;
            for (int p = 0; p < 16; ++p) {
                float best = -3.0e38f; int bi = 0;
                for (int c = 0; c < 128; ++c) {
                    const int cc = (c + r) & 127;
                    const float v = my[cc];
                    if (v > best || (v == best && cc < bi)) { best = v; bi = cc; }
                }
                tsc[ob + p] = best; tix[ob + p] = bi;
                my[bi] = -3.0e38f;
            }
        }
        __syncthreads();
    }
};

template <class Epi>
__device__ void ph_gemm(int bid, int nb, const bf16_t* A, int lda, const bf16_t* Bt, int ldb, int M, int N, int K, char* lds, Epi epi) {
    const int tm = M / 128, tn = N / 128;
    for (int t = bid; t < tm * tn; t += nb) {
        const int m0 = (t / tn) * 128, n0 = (t % tn) * 128;
        gemm_tile(A, lda, Bt, ldb, K, m0, n0, lds, epi);
    }
}
__device__ void ph_peer_scores(int bid, int nb, const bf16_t* qpeer, const bf16_t* SK, float* tsc, int* tix, int M, char* lds) {
    const int tm = M / 128;
    for (int t = bid; t < tm * 16; t += nb) {
        const int m0 = (t >> 4) * 128, hp = t & 15;
        EpiTop16 epi{tsc, tix, hp, m0};
        gemm_tile(qpeer + hp * 128, PQ, SK + (size_t)hp * 128 * 128, 128, 128, m0, 0, lds, epi);
    }
}

constexpr int HGC = 16;
constexpr int HG_LDS = (3 * HGC * 128 + HGC * 64 + HGC * 4 * 64) * 4;
__device__ __forceinline__ int hg_row(int b, int dir, int p) {
    if (p < LC) { const int s = dir ? (LC - 1 - p) : p; return TL + b * LC + s; }
    const int t = dir ? (SEQ - 1 - (p - LC)) : (p - LC);
    return b * SEQ + t;
}
__device__ void ph_hgrn(int bid, int nb, const bf16_t* __restrict__ projH, const float* __restrict__ lb, bf16_t* __restrict__ of, bf16_t* __restrict__ ob, float* lds) {
    float* sf = lds;
    float* sk = sf + HGC * 128;
    float* sq = sk + HGC * 128;
    float* sv = sq + HGC * 128;
    float* so = sv + HGC * 64;
    const int tid = threadIdx.x, lane = tid & 63, wid = tid >> 6;
    for (int it = bid; it < NB * 4 * 2 * 2; it += nb) {
        const int vh = it & 1, dir = (it >> 1) & 1, h = (it >> 2) & 3, b = it >> 4;
        bf16_t* out = dir ? ob : of;
        float S[32];
#pragma unroll
        for (int k = 0; k < 32; ++k) S[k] = 0.f;
        for (int p0 = 0; p0 < LC + SEQ; p0 += HGC) {
            __syncthreads();
            for (int idx = tid; idx < HGC * 128; idx += 256) {
                const int tok = idx >> 7, k = idx & 127, ch = h * 128 + k;
                const size_t rb = (size_t)hg_row(b, dir, p0 + tok) * HGW;
                const float xq = bf2f(projH[rb + ch]);
                const float xf = bf2f(projH[rb + (dir ? 1024 : 512) + ch]);
                const float l = lb[ch];
                const float f = l + (1.f - l) * sigmoidf_(xf);
                sf[idx] = f; sk[idx] = 1.f - f; sq[idx] = siluf_(xq);
            }
            for (int idx = tid; idx < HGC * 64; idx += 256) {
                const int tok = idx >> 6, vv = idx & 63;
                sv[idx] = bf2f(projH[(size_t)hg_row(b, dir, p0 + tok) * HGW + 1536 + h * 128 + vh * 64 + vv]);
            }
            __syncthreads();
            for (int tok = 0; tok < HGC; ++tok) {
                const float vt = sv[tok * 64 + lane];
                const float* pf = sf + tok * 128 + wid * 32; const float* pk = sk + tok * 128 + wid * 32; const float* pq = sq + tok * 128 + wid * 32;
                float o = 0.f;
#pragma unroll
                for (int k = 0; k < 32; ++k) { S[k] = pf[k] * S[k] + pk[k] * vt; o += pq[k] * S[k]; }
                so[(tok * 4 + wid) * 64 + lane] = o;
            }
            __syncthreads();
            for (int idx = tid; idx < HGC * 64; idx += 256) {
                const int tok = idx >> 6, vv = idx & 63;
                const float o = so[(tok * 4 + 0) * 64 + vv] + so[(tok * 4 + 1) * 64 + vv] + so[(tok * 4 + 2) * 64 + vv] + so[(tok * 4 + 3) * 64 + vv];
                out[(size_t)hg_row(b, dir, p0 + tok) * 512 + h * 128 + vh * 64 + vv] = f2bf(o);
            }
        }
    }
}
__device__ void ph_hgpost(int bid, int nb, const bf16_t* __restrict__ of, const bf16_t* __restrict__ ob, const bf16_t* __restrict__ projH,
                          const float* __restrict__ g, bf16_t* __restrict__ mix) {
    const int lane = threadIdx.x & 63, wid = threadIdx.x >> 6;
    for (int it = bid * 4 + wid; it < TA * 4; it += nb * 4) {
        const int row = it >> 2, h = it & 3;
        const size_t o = (size_t)row * 512 + h * 128 + lane * 2;
        const unsigned a = *(const unsigned*)(of + o), bb = *(const unsigned*)(ob + o);
        const float x0 = bf2f((bf16_t)(a & 0xffff)) + bf2f((bf16_t)(bb & 0xffff)), x1 = bf2f((bf16_t)(a >> 16)) + bf2f((bf16_t)(bb >> 16));
        const float ss = wave_sum(x0 * x0 + x1 * x1);
        const float rinv = rsqrtf(ss * (1.0f / 128.0f) + EPS);
        const unsigned gg = *(const unsigned*)(projH + (size_t)row * HGW + 2048 + h * 128 + lane * 2);
        const float y0 = x0 * rinv * g[lane * 2] * siluf_(bf2f((bf16_t)(gg & 0xffff)));
        const float y1 = x1 * rinv * g[lane * 2 + 1] * siluf_(bf2f((bf16_t)(gg >> 16)));
        *(unsigned*)(mix + (size_t)row * D + h * 128 + lane * 2) = pack2(y0, y1);
    }
}

__device__ void ph_prep_swa(int bid, int nb, bf16_t* __restrict__ P, const float* __restrict__ cosS, const float* __restrict__ sinS) {
    const size_t n = (size_t)TA * 320;
    for (size_t idx = (size_t)bid * blockDim.x + threadIdx.x; idx < n; idx += (size_t)nb * blockDim.x) {
        const int row = (int)(idx / 320), pr = (int)(idx % 320), head = pr >> 5, d = pr & 31;
        bf16_t* p = P + (size_t)row * SWW + head * 64 + d;
        float x1 = bf2f(p[0]), x2 = bf2f(p[32]);
        if (row < TL) {
            const int t = row & (SEQ - 1);
            const float c = cosS[t * 32 + d], s = sinS[t * 32 + d];
            const float y1 = x1 * c - x2 * s, y2 = x1 * s + x2 * c;
            x1 = y1; x2 = y2;
        }
        if (head < 8) { x1 *= 0.125f; x2 *= 0.125f; }
        p[0] = f2bf(x1); p[32] = f2bf(x2);
    }
}
__device__ void ph_prep_ga(int bid, int nb, bf16_t* __restrict__ P, const float* __restrict__ qg, const float* __restrict__ kg,
                           const float* __restrict__ cosG, const float* __restrict__ sinG) {
    const int lane = threadIdx.x & 63, wid = threadIdx.x >> 6;
    for (int it = bid * 4 + wid; it < TA * 10; it += nb * 4) {
        const int row = it / 10, head = it % 10;
        bf16_t* p = P + (size_t)row * GA_IN + head * 128;
        float x1 = bf2f(p[lane]), x2 = bf2f(p[lane + 64]);
        const float ss = wave_sum(x1 * x1 + x2 * x2);
        const float rinv = rsqrtf(ss * (1.0f / 128.0f) + EPS);
        const float* g = head < 8 ? qg : kg;
        x1 = x1 * rinv * g[lane]; x2 = x2 * rinv * g[lane + 64];
        if (row < TL) {
            const int t = row & (SEQ - 1);
            const float c = cosG[t * 64 + lane], s = sinG[t * 64 + lane];
            const float y1 = x1 * c - x2 * s, y2 = x1 * s + x2 * c;
            x1 = y1; x2 = y2;
        }
        if (head < 8) { x1 *= 0.08838834764831845f; x2 *= 0.08838834764831845f; }
        p[lane] = f2bf(x1); p[lane + 64] = f2bf(x2);
    }
}

template <int HD>
__device__ void attn_naive_item(const bf16_t* __restrict__ P, int ldp, int qcol, int kcol, int vcol,
                                int b, int qrow0  , bool q_is_latent, int nctx_tiles, int lat_lo, int lat_hi,
                                int window  , bool has_sink, float sink,
                                bf16_t* __restrict__ out, int ldo, int ocol, float* lds) {
    constexpr int SL = HD / 4;
    float* sK = lds;
    float* sV = lds + 64 * HD;
    const int tid = threadIdx.x, qi = tid >> 2, sl = tid & 3;
    const int qrow = qrow0 + qi;
    const int tq = qrow & (SEQ - 1);
    float q[SL], o[SL];
#pragma unroll
    for (int d = 0; d < SL; ++d) { q[d] = bf2f(P[(size_t)qrow * ldp + qcol + sl * SL + d]); o[d] = 0.f; }
    float m = has_sink ? sink : -1.0e30f, l = has_sink ? 1.0f : 0.0f;
    const int nlat_tiles = (lat_hi - lat_lo + 63) / 64;
    for (int ti = 0; ti < nctx_tiles + nlat_tiles; ++ti) {
        const bool isctx = ti < nctx_tiles;
        const int s0 = isctx ? ti * 64 : lat_lo + (ti - nctx_tiles) * 64;
        __syncthreads();
        for (int idx = tid; idx < 64 * HD; idx += 256) {
            const int j = idx / HD, d = idx % HD;
            const int s = s0 + j;
            float kv = 0.f, vv = 0.f;
            if (isctx || (s >= 0 && s < SEQ)) {
                const size_t r = isctx ? (size_t)(TL + b * LC + s) : (size_t)(b * SEQ + s);
                kv = bf2f(P[r * ldp + kcol + d]); vv = bf2f(P[r * ldp + vcol + d]);
            }
            sK[idx] = kv; sV[idx] = vv;
        }
        __syncthreads();
        for (int j = 0; j < 64; ++j) {
            const int s = s0 + j;
            bool valid = true;
            if (!isctx) {
                valid = (s >= 0) && (s < SEQ) && (s < lat_hi);
                if (window >= 0) { const int dlt = tq - s; valid = valid && (dlt <= window) && (dlt >= -window); }
            }
            float part = 0.f;
            const float* kr = sK + j * HD + sl * SL;
#pragma unroll
            for (int d = 0; d < SL; ++d) part += q[d] * kr[d];
            part += __shfl_xor(part, 1);
            part += __shfl_xor(part, 2);
            if (valid) {
                if (part > m) {
                    const float corr = __expf(m - part);
                    l *= corr;
#pragma unroll
                    for (int d = 0; d < SL; ++d) o[d] *= corr;
                    m = part;
                }
                const float p = __expf(part - m);
                l += p;
                const float* vr = sV + j * HD + sl * SL;
#pragma unroll
                for (int d = 0; d < SL; ++d) o[d] += p * vr[d];
            }
        }
    }
    const float rl = 1.0f / l;
#pragma unroll
    for (int d = 0; d < SL; ++d) out[(size_t)qrow * ldo + ocol + sl * SL + d] = f2bf(o[d] * rl);
}
__device__ void ph_swa(int bid, int nb, const bf16_t* __restrict__ projS, const float* __restrict__ sink, bf16_t* __restrict__ mix, float* lds) {
    const int n_lat = NB * 8 * 64, n_ctx = NB * 8 * 4;
    for (int it = bid; it < n_lat + n_ctx; it += nb) {
        if (it < n_lat) {
            const int qb = it & 63, hq = (it >> 6) & 7, b = it >> 9, kvh = hq >> 2;
            const int t0 = qb * 64;
            int lo = t0 - 128; if (lo < 0) lo = 0;
            int hi = t0 + 64 + 128; if (hi > SEQ) hi = SEQ;
            attn_naive_item<64>(projS, SWW, hq * 64, 512 + kvh * 64, 640 + kvh * 64, b, b * SEQ + t0, true, 4, lo, hi, 128, true, sink[hq],
                                mix, D, 512 + hq * 64, lds);
        } else {
            const int i2 = it - n_lat, qb = i2 & 3, hq = (i2 >> 2) & 7, b = i2 >> 5, kvh = hq >> 2;
            attn_naive_item<64>(projS, SWW, hq * 64, 512 + kvh * 64, 640 + kvh * 64, b, TL + b * LC + qb * 64, false, 4, 0, 0, -1, true, sink[hq],
                                mix, D, 512 + hq * 64, lds);
        }
    }
}
__device__ void ph_dense(int bid, int nb, const bf16_t* __restrict__ projG, bf16_t* __restrict__ mix, float* lds) {
    for (int it = bid; it < NB * 8 * 64; it += nb) {
        const int qb = it & 63, hq = (it >> 6) & 7, b = it >> 9, kvh = hq >> 2;
        attn_naive_item<128>(projG, GA_IN, hq * 128, 1024 + kvh * 128, 1280 + kvh * 128, b, b * SEQ + qb * 64, true, 4, 0, SEQ, -1, false, 0.f,
                             mix, D, hq * 128, lds);
    }
}

__device__ void ph_peer_combine(int bid, int nb, const float* __restrict__ tsc, const int* __restrict__ tix, int* __restrict__ sel_e, float* __restrict__ sel_g, int ntok) {
    const int lane = threadIdx.x & 63, wid = threadIdx.x >> 6;
    for (int it = bid * 4 + wid; it < ntok * 8; it += nb * 4) {
        const size_t b1 = (size_t)it * 32, b2 = b1 + 16;
        const float s2 = tsc[b2 + (lane & 15)];
        float cv[4];
#pragma unroll
        for (int u = 0; u < 4; ++u) cv[u] = tsc[b1 + (lane >> 4) + 4 * u] + s2;
        float mysc = 0.f; int myc = 0;
        for (int j = 0; j < 16; ++j) {
            float bv = cv[0]; int bc = ((lane >> 4)) * 16 + (lane & 15);
#pragma unroll
            for (int u = 1; u < 4; ++u) { const int c = ((lane >> 4) + 4 * u) * 16 + (lane & 15); if (cv[u] > bv) { bv = cv[u]; bc = c; } }
#pragma unroll
            for (int o = 32; o >= 1; o >>= 1) {
                const float ov = __shfl_xor(bv, o); const int oc = __shfl_xor(bc, o);
                if (ov > bv || (ov == bv && oc < bc)) { bv = ov; bc = oc; }
            }
#pragma unroll
            for (int u = 0; u < 4; ++u) { const int c = ((lane >> 4) + 4 * u) * 16 + (lane & 15); if (c == bc) cv[u] = -3.0e38f; }
            if (lane == j) { mysc = bv; myc = bc; }
        }
        const float top = __shfl(mysc, 0);
        float e = lane < 16 ? __expf(mysc - top) : 0.f;
        float sum = e;
#pragma unroll
        for (int o = 8; o >= 1; o >>= 1) sum += __shfl_xor(sum, o);
        if (lane < 16) {
            const int ex = tix[b1 + (myc >> 4)] * 128 + tix[b2 + (myc & 15)];
            sel_e[(size_t)it * 16 + lane] = ex;
            sel_g[(size_t)it * 16 + lane] = e / sum;
        }
    }
}
__device__ void ph_peer_gather(int bid, int nb, const bf16_t* __restrict__ xf  , const bf16_t* __restrict__ U, const bf16_t* __restrict__ V,
                               const int* __restrict__ sel_e, const float* __restrict__ sel_g, const float* __restrict__ gate  ,
                               float* __restrict__ hlat, float* __restrict__ hctx, int ntok) {
    const int lane = threadIdx.x & 63, wid = threadIdx.x >> 6;
    for (int row = bid * 4 + wid; row < ntok; row += nb * 4) {
        float x[16], y[16];
#pragma unroll
        for (int i = 0; i < 2; ++i) {
            const uint4 w = *(const uint4*)(xf + (size_t)row * D + (lane + 64 * i) * 8);
            const unsigned ww[4] = {w.x, w.y, w.z, w.w};
#pragma unroll
            for (int j = 0; j < 4; ++j) { x[i * 8 + j * 2] = __uint_as_float(ww[j] << 16); x[i * 8 + j * 2 + 1] = __uint_as_float(ww[j] & 0xffff0000u); }
        }
#pragma unroll
        for (int i = 0; i < 16; ++i) y[i] = 0.f;
        const int my_e0 = sel_e[(size_t)row * 128 + lane], my_e1 = sel_e[(size_t)row * 128 + 64 + lane];
        const float my_g0 = sel_g[(size_t)row * 128 + lane], my_g1 = sel_g[(size_t)row * 128 + 64 + lane];
        for (int k = 0; k < 128; ++k) {
            const int e = __shfl(k < 64 ? my_e0 : my_e1, k & 63);
            const float g = __shfl(k < 64 ? my_g0 : my_g1, k & 63);
            const bf16_t* ur = U + (size_t)e * D;
            float part = 0.f;
#pragma unroll
            for (int i = 0; i < 2; ++i) {
                const uint4 w = *(const uint4*)(ur + (lane + 64 * i) * 8);
                const unsigned ww[4] = {w.x, w.y, w.z, w.w};
#pragma unroll
                for (int j = 0; j < 4; ++j) { part += x[i * 8 + j * 2] * __uint_as_float(ww[j] << 16); part += x[i * 8 + j * 2 + 1] * __uint_as_float(ww[j] & 0xffff0000u); }
            }
            const float dot = wave_sum(part);
            const float act = 0.5f * dot * (1.0f + erff(dot * 0.70710678118654752f));
            const float wgt = g * act;
            const bf16_t* vr = V + (size_t)e * D;
#pragma unroll
            for (int i = 0; i < 2; ++i) {
                const uint4 w = *(const uint4*)(vr + (lane + 64 * i) * 8);
                const unsigned ww[4] = {w.x, w.y, w.z, w.w};
#pragma unroll
                for (int j = 0; j < 4; ++j) { y[i * 8 + j * 2] += wgt * __uint_as_float(ww[j] << 16); y[i * 8 + j * 2 + 1] += wgt * __uint_as_float(ww[j] & 0xffff0000u); }
            }
        }
        float* hp = row < TL ? hlat + (size_t)row * D : hctx + (size_t)(row - TL) * D;
        const float* gg = gate + (size_t)mod_row(row) * 6144;
#pragma unroll
        for (int i = 0; i < 2; ++i) {
            const int col = (lane + 64 * i) * 8;
#pragma unroll
            for (int j = 0; j < 2; ++j) {
                float4 h = *(float4*)(hp + col + j * 4); const float4 g4 = *(const float4*)(gg + col + j * 4);
                h.x += g4.x * y[i * 8 + j * 4 + 0]; h.y += g4.y * y[i * 8 + j * 4 + 1]; h.z += g4.z * y[i * 8 + j * 4 + 2]; h.w += g4.w * y[i * 8 + j * 4 + 3];
                *(float4*)(hp + col + j * 4) = h;
            }
        }
    }
}
__device__ void ph_final(int bid, int nb, float* __restrict__ h, const float* __restrict__ g) {
    const int lane = threadIdx.x & 63, wid = threadIdx.x >> 6;
    for (int row = bid * 4 + wid; row < TL; row += nb * 4) {
        float4* p = (float4*)(h + (size_t)row * D);
        float4 x[4]; float ss = 0.f;
#pragma unroll
        for (int i = 0; i < 4; ++i) { x[i] = p[i * 64 + lane]; ss += x[i].x * x[i].x + x[i].y * x[i].y + x[i].z * x[i].z + x[i].w * x[i].w; }
        ss = wave_sum(ss);
        const float rinv = rsqrtf(ss * (1.0f / D) + EPS);
#pragma unroll
        for (int i = 0; i < 4; ++i) {
            const float4 gg = ((const float4*)g)[i * 64 + lane];
            float4 o; o.x = x[i].x * rinv * gg.x; o.y = x[i].y * rinv * gg.y; o.z = x[i].z * rinv * gg.z; o.w = x[i].w * rinv * gg.w;
            p[i * 64 + lane] = o;
        }
    }
}

struct Params {
    const float *x, *c, *ctx, *c_ctx, *ada_w, *ada_b, *norm_mix_g, *norm_ffn_g, *ab_w_in, *ab_w_out, *hg_lb, *hg_norm_g, *sw_sink,
        *ga_w_in, *ga_w_out, *ga_qn, *ga_kn, *peer_wq, *peer_sk, *peer_u, *peer_v, *final_g;
    float* out; char* ws;
};
extern __shared__ __attribute__((aligned(16))) char dyn_lds[];

#define WSP(T, off) ((T*)(p.ws + (off)))

namespace cg = cooperative_groups;
constexpr int MEGA_LDS = 65536;
__global__ void __launch_bounds__(256) k_mega(Params p) {
    cg::grid_group grid = cg::this_grid();
    const int bid = blockIdx.x, nb = gridDim.x;
    char* lds = dyn_lds;
    float* ldf = (float*)dyn_lds;
    float* mod0 = WSP(float, OFF_MOD);
    float* mod1 = mod0 + (size_t)9 * 6144;
    float* hctx = WSP(float, OFF_HCTX);
    bf16_t* abuf = WSP(bf16_t, OFF_A);
    bf16_t* mix = WSP(bf16_t, OFF_MIX);
    ph_transpose(bid, nb, p.ab_w_in, WSP(bf16_t, OFF_WABIN), D, AB_IN, ldf);
    ph_transpose(bid, nb, p.ab_w_out, WSP(bf16_t, OFF_WABOUT), D, D, ldf);
    ph_transpose(bid, nb, p.ga_w_in, WSP(bf16_t, OFF_WGAIN), D, GA_IN, ldf);
    ph_transpose(bid, nb, p.ga_w_out, WSP(bf16_t, OFF_WGAOUT), D, D, ldf);
    ph_transpose(bid, nb, p.peer_wq, WSP(bf16_t, OFF_WPQ), D, PQ, ldf);
    ph_transpose(bid, nb, p.peer_wq + (size_t)D * PQ, WSP(bf16_t, OFF_WPQ) + (size_t)PQ * D, D, PQ, ldf);
    ph_cvt(bid, nb, p.peer_sk, WSP(bf16_t, OFF_SK), (size_t)2 * 8 * 2 * 128 * 128);
    ph_tables(bid, nb, WSP(float, OFF_COSS), WSP(float, OFF_SINS), WSP(float, OFF_COSG), WSP(float, OFF_SING), p.hg_lb, WSP(float, OFF_LB));
    __syncthreads();
    ph_mod(bid, nb, p.c, p.c_ctx, p.ada_w, p.ada_b, mod0, ldf);
    ph_cvt(bid, nb, p.peer_u, WSP(bf16_t, OFF_U16), (size_t)NEXP * D);
    ph_cvt(bid, nb, p.peer_v, WSP(bf16_t, OFF_V16), (size_t)NEXP * D);
    grid.sync();
    ph_normmod(bid, nb, p.x, p.ctx, p.norm_mix_g, mod0, 1 * D, 0, abuf, TA);
    grid.sync();
    { EpiStoreSplit e{WSP(bf16_t, OFF_PROJH), HGW, WSP(bf16_t, OFF_PROJS), SWW, HGW};
      ph_gemm(bid, nb, abuf, D, WSP(bf16_t, OFF_WABIN), D, TA, AB_IN, D, lds, e); }
    grid.sync();
    if (bid < 128) ph_hgrn(bid, 128, WSP(bf16_t, OFF_PROJH), WSP(float, OFF_LB), WSP(bf16_t, OFF_OF), WSP(bf16_t, OFF_OB), ldf);
    else ph_prep_swa(bid - 128, nb - 128, WSP(bf16_t, OFF_PROJS), WSP(float, OFF_COSS), WSP(float, OFF_SINS));
    grid.sync();
    ph_swa(bid, nb, WSP(bf16_t, OFF_PROJS), p.sw_sink, mix, ldf);
    ph_hgpost(bid, nb, WSP(bf16_t, OFF_OF), WSP(bf16_t, OFF_OB), WSP(bf16_t, OFF_PROJH), p.hg_norm_g, mix);
    grid.sync();
    { EpiResid e{p.x, p.ctx, p.out, hctx, mod0 + 2 * D};
      ph_gemm(bid, nb, mix, D, WSP(bf16_t, OFF_WABOUT), D, TA, D, D, lds, e); }
    grid.sync();
    ph_normmod(bid, nb, p.out, hctx, p.norm_ffn_g, mod0, 4 * D, 3 * D, abuf, TA);
    grid.sync();
    { EpiStoreSplit e{WSP(bf16_t, OFF_QPEER), PQ, WSP(bf16_t, OFF_QPEER), PQ, 1 << 30};
      ph_gemm(bid, nb, abuf, D, WSP(bf16_t, OFF_WPQ), D, TA, PQ, D, lds, e); }
    grid.sync();
    ph_peer_scores(bid, nb, WSP(bf16_t, OFF_QPEER), WSP(bf16_t, OFF_SK), WSP(float, OFF_TSC), WSP(int, OFF_TIX), TA, lds);
    grid.sync();
    ph_peer_combine(bid, nb, WSP(float, OFF_TSC), WSP(int, OFF_TIX), WSP(int, OFF_SELE), WSP(float, OFF_SELG), TA);
    grid.sync();
    ph_peer_gather(bid, nb, abuf, WSP(bf16_t, OFF_U16), WSP(bf16_t, OFF_V16), WSP(int, OFF_SELE), WSP(float, OFF_SELG), mod0 + 5 * D, p.out, hctx, TA);
    grid.sync();
    ph_cvt(bid, nb, p.peer_u + (size_t)NEXP * D, WSP(bf16_t, OFF_U16), (size_t)NEXP * D);
    ph_cvt(bid, nb, p.peer_v + (size_t)NEXP * D, WSP(bf16_t, OFF_V16), (size_t)NEXP * D);
    ph_normmod(bid, nb, p.out, hctx, p.norm_mix_g + D, mod1, 1 * D, 0, abuf, TA);
    grid.sync();
    { EpiStoreSplit e{WSP(bf16_t, OFF_PROJ), GA_IN, WSP(bf16_t, OFF_PROJ), GA_IN, 1 << 30};
      ph_gemm(bid, nb, abuf, D, WSP(bf16_t, OFF_WGAIN), D, TA, GA_IN, D, lds, e); }
    grid.sync();
    ph_prep_ga(bid, nb, WSP(bf16_t, OFF_PROJ), p.ga_qn, p.ga_kn, WSP(float, OFF_COSG), WSP(float, OFF_SING));
    grid.sync();
    ph_dense(bid, nb, WSP(bf16_t, OFF_PROJ), mix, ldf);
    grid.sync();
    { EpiResid e{p.out, hctx, p.out, hctx, mod1 + 2 * D};
      ph_gemm(bid, nb, mix, D, WSP(bf16_t, OFF_WGAOUT), D, TL, D, D, lds, e); }
    grid.sync();
    ph_normmod(bid, nb, p.out, hctx, p.norm_ffn_g + D, mod1, 4 * D, 3 * D, abuf, TL);
    grid.sync();
    { EpiStoreSplit e{WSP(bf16_t, OFF_QPEER), PQ, WSP(bf16_t, OFF_QPEER), PQ, 1 << 30};
      ph_gemm(bid, nb, abuf, D, WSP(bf16_t, OFF_WPQ) + (size_t)PQ * D, D, TL, PQ, D, lds, e); }
    grid.sync();
    ph_peer_scores(bid, nb, WSP(bf16_t, OFF_QPEER), WSP(bf16_t, OFF_SK) + (size_t)16 * 128 * 128, WSP(float, OFF_TSC), WSP(int, OFF_TIX), TL, lds);
    grid.sync();
    ph_peer_combine(bid, nb, WSP(float, OFF_TSC), WSP(int, OFF_TIX), WSP(int, OFF_SELE), WSP(float, OFF_SELG), TL);
    grid.sync();
    ph_peer_gather(bid, nb, abuf, WSP(bf16_t, OFF_U16), WSP(bf16_t, OFF_V16), WSP(int, OFF_SELE), WSP(float, OFF_SELG), mod1 + 5 * D, p.out, hctx, TL);
    grid.sync();
    ph_final(bid, nb, p.out, p.final_g);
}

extern "C" void kernel_launch(void* const* d_in, const int* in_sizes, int n_in, void* d_out, int out_size, void* d_ws, size_t ws_size,
                              hipStream_t stream) {
    Params p{};
    p.x = (const float*)d_in[0]; p.c = (const float*)d_in[1]; p.ctx = (const float*)d_in[2]; p.c_ctx = (const float*)d_in[3];
    p.ada_w = (const float*)d_in[4]; p.ada_b = (const float*)d_in[5]; p.norm_mix_g = (const float*)d_in[6]; p.norm_ffn_g = (const float*)d_in[7];
    p.ab_w_in = (const float*)d_in[8]; p.ab_w_out = (const float*)d_in[9]; p.hg_lb = (const float*)d_in[10]; p.hg_norm_g = (const float*)d_in[11];
    p.sw_sink = (const float*)d_in[12]; p.ga_w_in = (const float*)d_in[13]; p.ga_w_out = (const float*)d_in[14]; p.ga_qn = (const float*)d_in[15];
    p.ga_kn = (const float*)d_in[16]; p.peer_wq = (const float*)d_in[17]; p.peer_sk = (const float*)d_in[18]; p.peer_u = (const float*)d_in[19];
    p.peer_v = (const float*)d_in[20]; p.final_g = (const float*)d_in[21];
    p.out = (float*)d_out; p.ws = (char*)d_ws;
    if (ws_size < WS_NEED) { fprintf(stderr, "workspace too small: %zu < %zu\n", ws_size, WS_NEED); return; }
    static int grid_blocks = 0;
    if (!grid_blocks) {
        int dev = 0, cus = 0, per_cu = 0;
        (void)hipGetDevice(&dev);
        (void)hipDeviceGetAttribute(&cus, hipDeviceAttributeMultiprocessorCount, dev);
        (void)hipFuncSetAttribute((const void*)k_mega, hipFuncAttributeMaxDynamicSharedMemorySize, MEGA_LDS);
        (void)hipOccupancyMaxActiveBlocksPerMultiprocessor(&per_cu, k_mega, 256, MEGA_LDS);
        if (per_cu > 2) per_cu = 2;
        if (per_cu < 1) per_cu = 1;
        grid_blocks = cus * per_cu;
    }
    void* args[] = {&p};
    hipError_t e = hipLaunchCooperativeKernel((const void*)k_mega, dim3(grid_blocks), dim3(256), args, MEGA_LDS, stream);
    if (e != hipSuccess) fprintf(stderr, "cooperative launch failed: %s (grid %d)\n", hipGetErrorString(e), grid_blocks);
}
```

```cpp
#include <hip/hip_runtime.h>
#include <hip/hip_cooperative_groups.h>
#include <stdint.h>
#include <stdio.h>

typedef unsigned short bf16_t;
typedef short bf16x8 __attribute__((ext_vector_type(8)));
typedef float f32x4 __attribute__((ext_vector_type(4)));

constexpr int D = 1024, NB = 8, SEQ = 4096, LC = 256;
constexpr int TL = NB * SEQ;
constexpr int TC = NB * LC;
constexpr int TA = TL + TC;
constexpr int AB_IN = 3328, HGW = 2560, SWW = 768, GA_IN = 1536, PQ = 2048;
constexpr int NEXP = 16384;
constexpr float EPS = 1e-6f;
constexpr float LOG2E = 1.4426950408889634f;
constexpr int NKEY = LC + SEQ;

constexpr size_t OFF_WABIN = 0;
constexpr size_t OFF_WABOUT = OFF_WABIN + (size_t)AB_IN * D * 2;
constexpr size_t OFF_WGAIN = OFF_WABOUT + (size_t)D * D * 2;
constexpr size_t OFF_WGAOUT = OFF_WGAIN + (size_t)GA_IN * D * 2;
constexpr size_t OFF_WPQ = OFF_WGAOUT + (size_t)D * D * 2;
constexpr size_t OFF_SK = OFF_WPQ + (size_t)2 * PQ * D * 2;
constexpr size_t OFF_MOD = OFF_SK + (size_t)2 * 8 * 2 * 128 * 128 * 2;
constexpr size_t OFF_COSS = OFF_MOD + (size_t)2 * 9 * 6144 * 4;
constexpr size_t OFF_SINS = OFF_COSS + (size_t)SEQ * 32 * 4;
constexpr size_t OFF_COSG = OFF_SINS + (size_t)SEQ * 32 * 4;
constexpr size_t OFF_SING = OFF_COSG + (size_t)SEQ * 64 * 4;
constexpr size_t OFF_LB = OFF_SING + (size_t)SEQ * 64 * 4;
constexpr size_t OFF_U16 = OFF_LB + 2048;
constexpr size_t OFF_V16 = OFF_U16 + (size_t)NEXP * D * 2;
constexpr size_t OFF_HCTX = OFF_V16 + (size_t)NEXP * D * 2;
constexpr size_t OFF_A = OFF_HCTX + (size_t)TC * D * 4;
constexpr size_t OFF_PROJ = OFF_A + (size_t)TA * D * 2;
constexpr size_t OFF_MIX = OFF_PROJ + (size_t)TA * AB_IN * 2;
constexpr size_t OFF_SEL = OFF_MIX + (size_t)TA * D * 2;
constexpr size_t WS_NEED = OFF_SEL + (size_t)TA * 128 * 8;
static_assert(WS_NEED <= (size_t)536870912, "workspace over 512 MiB");
constexpr size_t OFF_OF = OFF_A;
constexpr size_t OFF_OB = OFF_A + (size_t)TA * 512 * 2;
constexpr size_t OFF_PROJH = OFF_PROJ;
constexpr size_t OFF_PROJS = OFF_PROJ + (size_t)TA * HGW * 2;
constexpr size_t OFF_QPEER = OFF_PROJ;
constexpr size_t OFF_TSC = OFF_QPEER + (size_t)TA * PQ * 2;
constexpr size_t OFF_TIX = OFF_TSC + (size_t)TA * 256 * 4;
static_assert(OFF_TIX + (size_t)TA * 256 * 4 <= OFF_MIX, "peer scratch overflows proj region");
constexpr size_t OFF_VT = OFF_SEL;
static_assert((size_t)NB * 2 * 128 * NKEY * 2 <= (size_t)TA * 128 * 8, "Vt overflows SEL region");
constexpr size_t OFF_SELE = OFF_SEL;
constexpr size_t OFF_SELG = OFF_SEL + (size_t)TA * 128 * 4;

__device__ __forceinline__ float bf2f(bf16_t v) { return __uint_as_float(((unsigned)v) << 16); }
__device__ __forceinline__ bf16_t f2bf(float f) {
    unsigned u = __float_as_uint(f);
    u += 0x7fffu + ((u >> 16) & 1u);
    return (bf16_t)(u >> 16);
}
typedef float f32x2 __attribute__((ext_vector_type(2)));
typedef float f32x16 __attribute__((ext_vector_type(16)));
typedef __bf16 bf16x2_t __attribute__((ext_vector_type(2)));
__device__ __forceinline__ unsigned pack2(float lo, float hi) { f32x2 v = {lo, hi}; return __builtin_bit_cast(unsigned, __builtin_convertvector(v, bf16x2_t)); }
__device__ __forceinline__ float sigmoidf_(float x) { return 1.0f / (1.0f + __expf(-x)); }
__device__ __forceinline__ float siluf_(float x) { return x * sigmoidf_(x); }
__device__ __forceinline__ float wave_sum(float v) {
#pragma unroll
    for (int o = 32; o >= 1; o >>= 1) v += __shfl_xor(v, o);
    return v;
}
__device__ __forceinline__ int mod_row(int row) { return row < TL ? (row >> 12) : 8; }

__device__ void ph_transpose(int bid, int nb, const float* __restrict__ in, bf16_t* __restrict__ out, int K, int N, float* lds) {
    const int tk = K / 32, tn = N / 32, nt = tk * tn;
    const int tx = threadIdx.x & 31, ty = threadIdx.x >> 5;
    for (int t = bid; t < nt; t += nb) {
        const int k0 = (t / tn) * 32, n0 = (t % tn) * 32;
        __syncthreads();
#pragma unroll
        for (int i = 0; i < 4; ++i) lds[(ty + i * 8) * 33 + tx] = in[(size_t)(k0 + ty + i * 8) * N + n0 + tx];
        __syncthreads();
#pragma unroll
        for (int i = 0; i < 4; ++i) out[(size_t)(n0 + ty + i * 8) * K + k0 + tx] = f2bf(lds[tx * 33 + ty + i * 8]);
    }
}
__device__ void ph_cvt(int bid, int nb, const float* __restrict__ in, bf16_t* __restrict__ out, size_t n) {
    const size_t n8 = n / 8;
    for (size_t i = (size_t)bid * blockDim.x + threadIdx.x; i < n8; i += (size_t)nb * blockDim.x) {
        const float4 a = ((const float4*)in)[i * 2], b = ((const float4*)in)[i * 2 + 1];
        uint4 w; w.x = pack2(a.x, a.y); w.y = pack2(a.z, a.w); w.z = pack2(b.x, b.y); w.w = pack2(b.z, b.w);
        ((uint4*)out)[i] = w;
    }
}
__device__ void ph_mod(int bid, int nb, const float* __restrict__ c, const float* __restrict__ c_ctx, const float* __restrict__ ada_w,
                       const float* __restrict__ ada_b, float* __restrict__ mod, float* lds) {
    float* s = lds;
    float* red = lds + 9 * 1024;
    const int tx = threadIdx.x & 63, ky = threadIdx.x >> 6;
    for (int i = threadIdx.x; i < 9 * 1024; i += 256) {
        const int r = i >> 10, k = i & 1023;
        const float v = r < 8 ? c[r * 1024 + k] : c_ctx[k];
        s[i] = siluf_(v);
    }
    __syncthreads();
    const int nitems = 2 * 96;
    for (int it = bid; it < nitems; it += nb) {
        const int layer = it / 96, n = (it % 96) * 64 + tx;
        const float* w = ada_w + (size_t)layer * 1024 * 6144 + n;
        float acc[9];
#pragma unroll
        for (int r = 0; r < 9; ++r) acc[r] = 0.f;
        for (int k = ky * 256; k < ky * 256 + 256; ++k) {
            const float wv = w[(size_t)k * 6144];
#pragma unroll
            for (int r = 0; r < 9; ++r) acc[r] += s[r * 1024 + k] * wv;
        }
        __syncthreads();
#pragma unroll
        for (int r = 0; r < 9; ++r) red[(ky * 9 + r) * 64 + tx] = acc[r];
        __syncthreads();
        if (ky == 0) {
#pragma unroll
            for (int r = 0; r < 9; ++r) {
                const float v = red[(0 * 9 + r) * 64 + tx] + red[(1 * 9 + r) * 64 + tx] + red[(2 * 9 + r) * 64 + tx] + red[(3 * 9 + r) * 64 + tx];
                mod[((size_t)layer * 9 + r) * 6144 + n] = v + ada_b[layer * 6144 + n];
            }
        }
    }
}
__device__ void ph_tables(int bid, int nb, float* cosS, float* sinS, float* cosG, float* sinG, const float* __restrict__ lb_logits, float* lb) {
    const int gt = bid * blockDim.x + threadIdx.x, gs = nb * blockDim.x;
    for (int i = gt; i < SEQ * 32; i += gs) {
        const int t = i >> 5, j = i & 31;
        const float pos = (float)(j < 16 ? (t >> 6) : (t & 63));
        const float inv = powf(10000.0f, -(float)(j & 15) / 16.0f);
        const float ang = pos * inv;
        cosS[i] = cosf(ang); sinS[i] = sinf(ang);
    }
    for (int i = gt; i < SEQ * 64; i += gs) {
        const int t = i >> 6, j = i & 63;
        const float pos = (float)(j < 32 ? (t >> 6) : (t & 63));
        const float inv = powf(10000.0f, -(float)(j & 31) / 32.0f);
        const float ang = pos * inv;
        cosG[i] = cosf(ang); sinG[i] = sinf(ang);
    }
    for (int i = gt; i < 512; i += gs) {
        const float l0 = lb_logits[i], l1 = lb_logits[512 + i];
        lb[i] = 1.0f / (1.0f + expf(l1 - l0));
    }
}

__device__ void ph_normmod(int bid, int nb, const float* __restrict__ hlat, const float* __restrict__ hctx, const float* __restrict__ gamma,
                           const float* __restrict__ modl  , int sc_off, int sh_off, bf16_t* __restrict__ out, int nrows) {
    const int lane = threadIdx.x & 63, wid = threadIdx.x >> 6;
    for (int row = bid * 4 + wid; row < nrows; row += nb * 4) {
        const float* src = row < TL ? hlat + (size_t)row * D : hctx + (size_t)(row - TL) * D;
        const float* m = modl + (size_t)mod_row(row) * 6144;
        float4 x[4]; float ss = 0.f;
#pragma unroll
        for (int i = 0; i < 4; ++i) { x[i] = ((const float4*)src)[i * 64 + lane]; ss += x[i].x * x[i].x + x[i].y * x[i].y + x[i].z * x[i].z + x[i].w * x[i].w; }
        ss = wave_sum(ss);
        const float rinv = rsqrtf(ss * (1.0f / D) + EPS);
#pragma unroll
        for (int i = 0; i < 4; ++i) {
            const int col = (i * 64 + lane) * 4;
            const float4 g = *(const float4*)(gamma + col), sc = *(const float4*)(m + sc_off + col), sh = *(const float4*)(m + sh_off + col);
            const float y0 = x[i].x * rinv * g.x * (1.f + sc.x) + sh.x, y1 = x[i].y * rinv * g.y * (1.f + sc.y) + sh.y;
            const float y2 = x[i].z * rinv * g.z * (1.f + sc.z) + sh.z, y3 = x[i].w * rinv * g.w * (1.f + sc.w) + sh.w;
            uint2 w; w.x = pack2(y0, y1); w.y = pack2(y2, y3);
            *(uint2*)(out + (size_t)row * D + col) = w;
        }
    }
}

constexpr int GEMM_LDS = 65536;
template <class Epi>
__device__ __forceinline__ void gemm_tile(const bf16_t* __restrict__ A, int lda, const bf16_t* __restrict__ Bt, int ldb, int K,
                                          int m0, int n0, char* lds, Epi& epi) {
    const int tid = threadIdx.x, lane = tid & 63, wid = tid >> 6, wr = wid >> 1, wc = wid & 1, fr = lane & 15, fq = lane >> 4;
    f32x4 acc[4][4];
#pragma unroll
    for (int i = 0; i < 4; ++i)
#pragma unroll
        for (int j = 0; j < 4; ++j) acc[i][j] = (f32x4){0.f, 0.f, 0.f, 0.f};
    const int nk = K / 64;
    const int sr0 = tid >> 3, sc0 = tid & 7;
    const bf16_t* ga = A + (size_t)(m0 + sr0) * lda + sc0 * 8;
    const bf16_t* gb = Bt + (size_t)(n0 + sr0) * ldb + sc0 * 8;
    const int soff = sr0 * 128 + ((sc0 ^ (sr0 & 7)) << 4);
    uint4 ra0, ra1, ra2, ra3, rb0, rb1, rb2, rb3;
#define GT_GLOAD(kt) do { const int _ko = (kt) * 64; \
        ra0 = *(const uint4*)(ga + _ko); ra1 = *(const uint4*)(ga + (size_t)32 * lda + _ko); \
        ra2 = *(const uint4*)(ga + (size_t)64 * lda + _ko); ra3 = *(const uint4*)(ga + (size_t)96 * lda + _ko); \
        rb0 = *(const uint4*)(gb + _ko); rb1 = *(const uint4*)(gb + (size_t)32 * ldb + _ko); \
        rb2 = *(const uint4*)(gb + (size_t)64 * ldb + _ko); rb3 = *(const uint4*)(gb + (size_t)96 * ldb + _ko); } while (0)
#define GT_LSTORE(buf) do { char* _b = lds + (buf) * 32768 + soff; \
        *(uint4*)(_b) = ra0; *(uint4*)(_b + 4096) = ra1; *(uint4*)(_b + 8192) = ra2; *(uint4*)(_b + 12288) = ra3; \
        *(uint4*)(_b + 16384) = rb0; *(uint4*)(_b + 16384 + 4096) = rb1; *(uint4*)(_b + 16384 + 8192) = rb2; *(uint4*)(_b + 16384 + 12288) = rb3; } while (0)
    __syncthreads();
    GT_GLOAD(0); GT_LSTORE(0);
    __syncthreads();
    for (int kt = 0; kt < nk; ++kt) {
        if (kt + 1 < nk) GT_GLOAD(kt + 1);
        const char* base = lds + (kt & 1) * 32768;
#pragma unroll
        for (int kk = 0; kk < 2; ++kk) {
            bf16x8 af[4], bfr[4];
#pragma unroll
            for (int i = 0; i < 4; ++i) {
                const int ar = wr * 64 + i * 16 + fr, br = wc * 64 + i * 16 + fr;
                const int c = kk * 4 + fq;
                af[i] = *(const bf16x8*)(base + ar * 128 + ((c ^ (ar & 7)) << 4));
                bfr[i] = *(const bf16x8*)(base + 16384 + br * 128 + ((c ^ (br & 7)) << 4));
            }
#pragma unroll
            for (int i = 0; i < 4; ++i)
#pragma unroll
                for (int j = 0; j < 4; ++j) acc[i][j] = __builtin_amdgcn_mfma_f32_16x16x32_bf16(bfr[j], af[i], acc[i][j], 0, 0, 0);
        }
        if (kt + 1 < nk) GT_LSTORE((kt + 1) & 1);
        __syncthreads();
    }
#undef GT_GLOAD
#undef GT_LSTORE
    epi(acc, m0 + wr * 64 + fr, n0 + wc * 64 + fq * 4, lds);
}

struct EpiStoreSplit {
    bf16_t* O1; int ld1; bf16_t* O2; int ld2; int split;
    __device__ __forceinline__ void operator()(f32x4 (&acc)[4][4], int row0, int col0, char*) const {
#pragma unroll
        for (int i = 0; i < 4; ++i)
#pragma unroll
            for (int j = 0; j < 4; ++j) {
                const int row = row0 + i * 16, col = col0 + j * 16;
                uint2 w; w.x = pack2(acc[i][j][0], acc[i][j][1]); w.y = pack2(acc[i][j][2], acc[i][j][3]);
                if (col < split) *(uint2*)(O1 + (size_t)row * ld1 + col) = w;
                else *(uint2*)(O2 + (size_t)row * ld2 + (col - split)) = w;
            }
    }
};
struct EpiResid {
    const float* hin_lat; const float* hin_ctx; float* hout_lat; float* hout_ctx; const float* gate  ;
    __device__ __forceinline__ void operator()(f32x4 (&acc)[4][4], int row0, int col0, char*) const {
#pragma unroll
        for (int i = 0; i < 4; ++i) {
            const int row = row0 + i * 16;
            const float* hi = row < TL ? hin_lat + (size_t)row * D : hin_ctx + (size_t)(row - TL) * D;
            float* ho = row < TL ? hout_lat + (size_t)row * D : hout_ctx + (size_t)(row - TL) * D;
            const float* g = gate + (size_t)mod_row(row) * 6144;
#pragma unroll
            for (int j = 0; j < 4; ++j) {
                const int col = col0 + j * 16;
                const float4 h = *(const float4*)(hi + col), gg = *(const float4*)(g + col);
                float4 o; o.x = h.x + gg.x * acc[i][j][0]; o.y = h.y + gg.y * acc[i][j][1]; o.z = h.z + gg.z * acc[i][j][2]; o.w = h.w + gg.w * acc[i][j][3];
                *(float4*)(ho + col) = o;
            }
        }
    }
};
struct EpiTop16 {
    float* tsc; int* tix; int hp; int m0;
    __device__ __forceinline__ void operator()(f32x4 (&acc)[4][4], int row0, int col0, char* lds) const {
        float* sc = (float*)lds;
        const int lr0 = row0 - m0;
#pragma unroll
        for (int i = 0; i < 4; ++i)
#pragma unroll
            for (int j = 0; j < 4; ++j) *(f32x4*)(sc + (lr0 + i * 16) * 128 + (col0 & 127) + j * 16) = acc[i][j];
        __syncthreads();
        const int r = threadIdx.x;
        if (r < 128) {
            float* my = sc + r * 128;
            const size_t ob = ((size_t)(m0 + r) * 16 + hp) * 16;
            for (int p = 0; p < 16; ++p) {
                float best = -3.0e38f; int bi = 0;
                for (int c = 0; c < 128; ++c) {
                    const int cc = (c + r) & 127;
                    const float v = my[cc];
                    if (v > best || (v == best && cc < bi)) { best = v; bi = cc; }
                }
                tsc[ob + p] = best; tix[ob + p] = bi;
                my[bi] = -3.0e38f;
            }
        }
        __syncthreads();
    }
};

template <class Epi>
__device__ void ph_gemm(int bid, int nb, const bf16_t* A, int lda, const bf16_t* Bt, int ldb, int M, int N, int K, char* lds, Epi epi) {
    const int tm = M / 128, tn = N / 128;
    for (int t = bid; t < tm * tn; t += nb) {
        const int m0 = (t / tn) * 128, n0 = (t % tn) * 128;
        gemm_tile(A, lda, Bt, ldb, K, m0, n0, lds, epi);
    }
}
__device__ void ph_peer_scores(int bid, int nb, const bf16_t* qpeer, const bf16_t* SK, float* tsc, int* tix, int M, char* lds) {
    const int tm = M / 128;
    for (int t = bid; t < tm * 16; t += nb) {
        const int m0 = (t >> 4) * 128, hp = t & 15;
        EpiTop16 epi{tsc, tix, hp, m0};
        gemm_tile(qpeer + hp * 128, PQ, SK + (size_t)hp * 128 * 128, 128, 128, m0, 0, lds, epi);
    }
}

constexpr int HGC = 16;
constexpr int HG_LDS = (3 * HGC * 128 + HGC * 64 + HGC * 4 * 64) * 4;
__device__ __forceinline__ int hg_row(int b, int dir, int p) {
    if (p < LC) { const int s = dir ? (LC - 1 - p) : p; return TL + b * LC + s; }
    const int t = dir ? (SEQ - 1 - (p - LC)) : (p - LC);
    return b * SEQ + t;
}
__device__ void ph_hgrn(int bid, int nb, const bf16_t* __restrict__ projH, const float* __restrict__ lb, bf16_t* __restrict__ of, bf16_t* __restrict__ ob, float* lds) {
    float* sf = lds;
    float* sk = sf + HGC * 128;
    float* sq = sk + HGC * 128;
    float* sv = sq + HGC * 128;
    float* so = sv + HGC * 64;
    const int tid = threadIdx.x, lane = tid & 63, wid = tid >> 6;
    for (int it = bid; it < NB * 4 * 2 * 2; it += nb) {
        const int vh = it & 1, dir = (it >> 1) & 1, h = (it >> 2) & 3, b = it >> 4;
        bf16_t* out = dir ? ob : of;
        float S[32];
#pragma unroll
        for (int k = 0; k < 32; ++k) S[k] = 0.f;
        for (int p0 = 0; p0 < LC + SEQ; p0 += HGC) {
            __syncthreads();
            for (int idx = tid; idx < HGC * 128; idx += 256) {
                const int tok = idx >> 7, k = idx & 127, ch = h * 128 + k;
                const size_t rb = (size_t)hg_row(b, dir, p0 + tok) * HGW;
                const float xq = bf2f(projH[rb + ch]);
                const float xf = bf2f(projH[rb + (dir ? 1024 : 512) + ch]);
                const float l = lb[ch];
                const float f = l + (1.f - l) * sigmoidf_(xf);
                sf[idx] = f; sk[idx] = 1.f - f; sq[idx] = siluf_(xq);
            }
            for (int idx = tid; idx < HGC * 64; idx += 256) {
                const int tok = idx >> 6, vv = idx & 63;
                sv[idx] = bf2f(projH[(size_t)hg_row(b, dir, p0 + tok) * HGW + 1536 + h * 128 + vh * 64 + vv]);
            }
            __syncthreads();
            for (int tok = 0; tok < HGC; ++tok) {
                const float vt = sv[tok * 64 + lane];
                const float* pf = sf + tok * 128 + wid * 32; const float* pk = sk + tok * 128 + wid * 32; const float* pq = sq + tok * 128 + wid * 32;
                float o = 0.f;
#pragma unroll
                for (int k = 0; k < 32; ++k) { S[k] = pf[k] * S[k] + pk[k] * vt; o += pq[k] * S[k]; }
                so[(tok * 4 + wid) * 64 + lane] = o;
            }
            __syncthreads();
            for (int idx = tid; idx < HGC * 64; idx += 256) {
                const int tok = idx >> 6, vv = idx & 63;
                const float o = so[(tok * 4 + 0) * 64 + vv] + so[(tok * 4 + 1) * 64 + vv] + so[(tok * 4 + 2) * 64 + vv] + so[(tok * 4 + 3) * 64 + vv];
                out[(size_t)hg_row(b, dir, p0 + tok) * 512 + h * 128 + vh * 64 + vv] = f2bf(o);
            }
        }
    }
}
__device__ void ph_hgpost(int bid, int nb, const bf16_t* __restrict__ of, const bf16_t* __restrict__ ob, const bf16_t* __restrict__ projH,
                          const float* __restrict__ g, bf16_t* __restrict__ mix) {
    const int lane = threadIdx.x & 63, wid = threadIdx.x >> 6;
    for (int it = bid * 4 + wid; it < TA * 4; it += nb * 4) {
        const int row = it >> 2, h = it & 3;
        const size_t o = (size_t)row * 512 + h * 128 + lane * 2;
        const unsigned a = *(const unsigned*)(of + o), bb = *(const unsigned*)(ob + o);
        const float x0 = bf2f((bf16_t)(a & 0xffff)) + bf2f((bf16_t)(bb & 0xffff)), x1 = bf2f((bf16_t)(a >> 16)) + bf2f((bf16_t)(bb >> 16));
        const float ss = wave_sum(x0 * x0 + x1 * x1);
        const float rinv = rsqrtf(ss * (1.0f / 128.0f) + EPS);
        const unsigned gg = *(const unsigned*)(projH + (size_t)row * HGW + 2048 + h * 128 + lane * 2);
        const float y0 = x0 * rinv * g[lane * 2] * siluf_(bf2f((bf16_t)(gg & 0xffff)));
        const float y1 = x1 * rinv * g[lane * 2 + 1] * siluf_(bf2f((bf16_t)(gg >> 16)));
        *(unsigned*)(mix + (size_t)row * D + h * 128 + lane * 2) = pack2(y0, y1);
    }
}

__device__ void ph_prep_swa(int bid, int nb, bf16_t* __restrict__ P, const float* __restrict__ cosS, const float* __restrict__ sinS) {
    const size_t n = (size_t)TA * 320;
    for (size_t idx = (size_t)bid * blockDim.x + threadIdx.x; idx < n; idx += (size_t)nb * blockDim.x) {
        const int row = (int)(idx / 320), pr = (int)(idx % 320), head = pr >> 5, d = pr & 31;
        bf16_t* p = P + (size_t)row * SWW + head * 64 + d;
        float x1 = bf2f(p[0]), x2 = bf2f(p[32]);
        if (row < TL) {
            const int t = row & (SEQ - 1);
            const float c = cosS[t * 32 + d], s = sinS[t * 32 + d];
            const float y1 = x1 * c - x2 * s, y2 = x1 * s + x2 * c;
            x1 = y1; x2 = y2;
        }
        if (head < 8) { x1 *= 0.125f * LOG2E; x2 *= 0.125f * LOG2E; }
        p[0] = f2bf(x1); p[32] = f2bf(x2);
    }
}
__device__ void ph_prep_ga(int bid, int nb, bf16_t* __restrict__ P, const float* __restrict__ qg, const float* __restrict__ kg,
                           const float* __restrict__ cosG, const float* __restrict__ sinG) {
    const int lane = threadIdx.x & 63, wid = threadIdx.x >> 6;
    for (int it = bid * 4 + wid; it < TA * 10; it += nb * 4) {
        const int row = it / 10, head = it % 10;
        bf16_t* p = P + (size_t)row * GA_IN + head * 128;
        float x1 = bf2f(p[lane]), x2 = bf2f(p[lane + 64]);
        const float ss = wave_sum(x1 * x1 + x2 * x2);
        const float rinv = rsqrtf(ss * (1.0f / 128.0f) + EPS);
        const float* g = head < 8 ? qg : kg;
        x1 = x1 * rinv * g[lane]; x2 = x2 * rinv * g[lane + 64];
        if (row < TL) {
            const int t = row & (SEQ - 1);
            const float c = cosG[t * 64 + lane], s = sinG[t * 64 + lane];
            const float y1 = x1 * c - x2 * s, y2 = x1 * s + x2 * c;
            x1 = y1; x2 = y2;
        }
        if (head < 8) { x1 *= 0.08838834764831845f * LOG2E; x2 *= 0.08838834764831845f * LOG2E; }
        p[lane] = f2bf(x1); p[lane + 64] = f2bf(x2);
    }
}

template <int HD>
__device__ void ph_vt(int bid, int nb, const bf16_t* __restrict__ P, int ldp, int vcol, bf16_t* __restrict__ Vt, bf16_t* lds) {
    constexpr int ND = HD / 64;
    const int tid = threadIdx.x;
    for (int it = bid; it < NB * 2 * ND * (NKEY / 64); it += nb) {
        const int kt = it % (NKEY / 64), r1 = it / (NKEY / 64), dh = r1 % ND, g = r1 / ND, b = g >> 1, kvh = g & 1;
        const int k0 = kt * 64;
        const int row0 = k0 < LC ? TL + b * LC + k0 : b * SEQ + (k0 - LC);
        __syncthreads();
#pragma unroll
        for (int i = 0; i < 2; ++i) {
            const int id = tid + i * 256, kr = id >> 3, c = id & 7;
            const uint4 w = *(const uint4*)(P + (size_t)(row0 + kr) * ldp + vcol + kvh * HD + dh * 64 + c * 8);
            const unsigned ww[4] = {w.x, w.y, w.z, w.w};
#pragma unroll
            for (int j = 0; j < 4; ++j) { lds[kr * 66 + c * 8 + j * 2] = (bf16_t)(ww[j] & 0xffff); lds[kr * 66 + c * 8 + j * 2 + 1] = (bf16_t)(ww[j] >> 16); }
        }
        __syncthreads();
#pragma unroll
        for (int i = 0; i < 2; ++i) {
            const int id = tid + i * 256, d = id >> 3, c = id & 7;
            unsigned o[4];
#pragma unroll
            for (int j = 0; j < 4; ++j) o[j] = (unsigned)lds[(c * 8 + j * 2) * 66 + d] | ((unsigned)lds[(c * 8 + j * 2 + 1) * 66 + d] << 16);
            uint4 w; w.x = o[0]; w.y = o[1]; w.z = o[2]; w.w = o[3];
            *(uint4*)(Vt + (size_t)(g * HD + dh * 64 + d) * NKEY + k0 + c * 8) = w;
        }
    }
}

template <int HD, bool MASK>
__device__ __forceinline__ void flash_item(const bf16_t* __restrict__ Qrow0, int ldq, const bf16_t* __restrict__ Kp, int ldk,
                                           const bf16_t* __restrict__ Vt, int krow_ctx0, int krow_lat0, int nctx_t, int lat_lo, int nlat_t,
                                           int tq0, float m0, float l0, bf16_t* __restrict__ Orow0, int ldo, char* lds) {
    constexpr int NCH = HD / 32;
    constexpr int KB = 64 * HD * 2;
    constexpr int NKK = HD / 16;
    constexpr int NDT = HD / 32;
    const int tid = threadIdx.x, lane = tid & 63, w = tid >> 6, r = lane & 31, h = lane >> 5;
    const int pr = (r & 0x13) | ((r & 4) << 1) | ((r & 8) >> 1);
    bf16x8 qf[NKK];
    {
        const bf16_t* qp = Qrow0 + (size_t)(32 * w + r) * ldq + 8 * h;
#pragma unroll
        for (int kk = 0; kk < NKK; ++kk) qf[kk] = *(const bf16x8*)(qp + 16 * kk);
    }
    f32x16 O[NDT];
#pragma unroll
    for (int dt = 0; dt < NDT; ++dt)
#pragma unroll
        for (int i = 0; i < 16; ++i) O[dt][i] = 0.f;
    float m_run = m0, l_run = (h == 0) ? l0 : 0.f;
    const int kc = (HD == 128) ? (tid & 15) : (tid & 7);
    const int kr = (HD == 128) ? (tid >> 4) : (tid >> 3);
    const int ksw = (HD == 128) ? (kr & 15) : ((kr >> 1) & 7);
    const int klds = kr * (HD * 2) + ((kc ^ ksw) << 4);
    constexpr int KRSTEP = (HD == 128) ? 16 : 32;
    const int vr = tid >> 3, vc = tid & 7;
    const int vlds = KB + vr * 128 + ((vc ^ ((vr >> 1) & 7)) << 4);
    const int kfo = pr * (HD * 2);
    const int kfs = (HD == 128) ? (pr & 15) : ((pr >> 1) & 7);
    const int vfo = KB + r * 128;
    const int vfs = (r >> 1) & 7;
    const int ntile = nctx_t + nlat_t;
    uint4 sg0, sg1, sg2, sg3;
    sg2 = sg3 = make_uint4(0u, 0u, 0u, 0u);
#define FA_TILE(t, krow0, kidx0, s0) const int krow0 = (t) < nctx_t ? krow_ctx0 + 64 * (t) : krow_lat0 + lat_lo + 64 * ((t) - nctx_t); \
        const int s0 = (t) < nctx_t ? -(1 << 24) : lat_lo + 64 * ((t) - nctx_t); const int kidx0 = (t) < nctx_t ? 64 * (t) : LC + lat_lo + 64 * ((t) - nctx_t);
#define FA_GLOADK(t) do { FA_TILE(t, _kr0, _ki0, _s0) (void)_s0; (void)_ki0; \
        const bf16_t* _kp = Kp + (size_t)(_kr0 + kr) * ldk + kc * 8; \
        sg0 = *(const uint4*)(_kp); sg1 = *(const uint4*)(_kp + (size_t)KRSTEP * ldk); \
        if (NCH == 4) { sg2 = *(const uint4*)(_kp + (size_t)2 * KRSTEP * ldk); sg3 = *(const uint4*)(_kp + (size_t)3 * KRSTEP * ldk); } } while (0)
#define FA_GLOADV(t) do { FA_TILE(t, _kr0, _ki0, _s0) (void)_s0; (void)_kr0; \
        const bf16_t* _vp = Vt + (size_t)vr * NKEY + _ki0 + vc * 8; \
        sg0 = *(const uint4*)(_vp); sg1 = *(const uint4*)(_vp + (size_t)32 * NKEY); \
        if (NCH == 4) { sg2 = *(const uint4*)(_vp + (size_t)64 * NKEY); sg3 = *(const uint4*)(_vp + (size_t)96 * NKEY); } } while (0)
#define FA_LSTORE(buf, off) do { char* _b = lds + (buf) * (2 * KB) + (off); \
        *(uint4*)(_b) = sg0; *(uint4*)(_b + 4096) = sg1; \
        if (NCH == 4) { *(uint4*)(_b + 8192) = sg2; *(uint4*)(_b + 12288) = sg3; } } while (0)
    __syncthreads();
    FA_GLOADK(0); FA_LSTORE(0, klds);
    FA_GLOADV(0); FA_LSTORE(0, vlds);
    __syncthreads();
    for (int t = 0; t < ntile; ++t) {
        if (t + 1 < ntile) FA_GLOADK(t + 1);
        const char* base = lds + (t & 1) * (2 * KB);
        f32x16 st[2];
#pragma unroll
        for (int rt = 0; rt < 2; ++rt) {
#pragma unroll
            for (int i = 0; i < 16; ++i) st[rt][i] = 0.f;
#pragma unroll
            for (int kk = 0; kk < NKK; ++kk) {
                const bf16x8 kf = *(const bf16x8*)(base + rt * 32 * (HD * 2) + kfo + (((2 * kk + h) ^ kfs) << 4));
                st[rt] = __builtin_amdgcn_mfma_f32_32x32x16_bf16(kf, qf[kk], st[rt], 0, 0, 0);
                if ((kk & 3) == 3) __builtin_amdgcn_sched_barrier(0);
            }
        }
        if (MASK) {
            FA_TILE(t, _kr0, _ki0, s0) (void)_kr0; (void)_ki0;
            if (t >= nctx_t) {
                const int tq = tq0 + 32 * w + r;
#pragma unroll
                for (int rt = 0; rt < 2; ++rt)
#pragma unroll
                    for (int i = 0; i < 16; ++i) {
                        const int s = s0 + 32 * rt + (i & 3) + 4 * ((i >> 2) & 1) + 8 * h + 16 * (i >> 3);
                        const int dlt = tq - s;
                        if (dlt > 128 || dlt < -128) st[rt][i] = -1.0e30f;
                    }
            }
        }
        float mx = m_run;
#pragma unroll
        for (int rt = 0; rt < 2; ++rt)
#pragma unroll
            for (int i = 0; i < 16; ++i) mx = fmaxf(mx, st[rt][i]);
        mx = fmaxf(mx, __shfl_xor(mx, 32));
        const float alpha = __builtin_amdgcn_exp2f(m_run - mx);
        m_run = mx;
        float ps = 0.f;
#pragma unroll
        for (int rt = 0; rt < 2; ++rt)
#pragma unroll
            for (int i = 0; i < 16; ++i) { const float p = __builtin_amdgcn_exp2f(st[rt][i] - mx); st[rt][i] = p; ps += p; }
        l_run = l_run * alpha + ps;
        if (!__all(alpha == 1.0f)) {
#pragma unroll
            for (int dt = 0; dt < NDT; ++dt)
#pragma unroll
                for (int i = 0; i < 16; ++i) O[dt][i] *= alpha;
        }
        if (t + 1 < ntile) { FA_LSTORE((t + 1) & 1, klds); FA_GLOADV(t + 1); }
        bf16x8 pf[2][2];
#pragma unroll
        for (int rt = 0; rt < 2; ++rt)
#pragma unroll
            for (int s2 = 0; s2 < 2; ++s2) {
                uint4 pk;
                pk.x = pack2(st[rt][8 * s2 + 0], st[rt][8 * s2 + 1]); pk.y = pack2(st[rt][8 * s2 + 2], st[rt][8 * s2 + 3]);
                pk.z = pack2(st[rt][8 * s2 + 4], st[rt][8 * s2 + 5]); pk.w = pack2(st[rt][8 * s2 + 6], st[rt][8 * s2 + 7]);
                pf[rt][s2] = __builtin_bit_cast(bf16x8, pk);
            }
#pragma unroll
        for (int dt = 0; dt < NDT; ++dt)
#pragma unroll
            for (int rt = 0; rt < 2; ++rt)
#pragma unroll
                for (int s2 = 0; s2 < 2; ++s2) {
                    const bf16x8 vf = *(const bf16x8*)(base + vfo + dt * 4096 + (((4 * rt + 2 * s2 + h) ^ vfs) << 4));
                    O[dt] = __builtin_amdgcn_mfma_f32_32x32x16_bf16(vf, pf[rt][s2], O[dt], 0, 0, 0);
                    if (rt == 1 && s2 == 1) __builtin_amdgcn_sched_barrier(0);
                }
        if (t + 1 < ntile) FA_LSTORE((t + 1) & 1, vlds);
        __syncthreads();
    }
#undef FA_TILE
#undef FA_GLOADK
#undef FA_GLOADV
#undef FA_LSTORE
    const float lt = l_run + __shfl_xor(l_run, 32);
    const float inv = 1.0f / lt;
    bf16_t* op = Orow0 + (size_t)(32 * w + r) * ldo + 4 * h;
#pragma unroll
    for (int dt = 0; dt < NDT; ++dt)
#pragma unroll
        for (int g = 0; g < 4; ++g) {
            uint2 o2; o2.x = pack2(O[dt][4 * g] * inv, O[dt][4 * g + 1] * inv); o2.y = pack2(O[dt][4 * g + 2] * inv, O[dt][4 * g + 3] * inv);
            *(uint2*)(op + 32 * dt + 8 * g) = o2;
        }
}
__device__ void ph_swa(int bid, int nb, const bf16_t* __restrict__ projS, const bf16_t* __restrict__ Vt, const float* __restrict__ sink,
                       bf16_t* __restrict__ mix, char* lds) {
    const int n_lat = NB * 8 * 32, n_ctx = NB * 8 * 2;
    for (int it = bid; it < n_lat + n_ctx; it += nb) {
        int b, hq, row0, lo, nlat, t0;
        if (it < n_lat) {
            const int qb = it & 31; hq = (it >> 5) & 7; b = it >> 8;
            t0 = qb * 128;
            lo = t0 - 128 < 0 ? 0 : t0 - 128;
            const int hi = t0 + 256 > SEQ ? SEQ : t0 + 256;
            nlat = (hi - lo) / 64; row0 = b * SEQ + t0;
        } else {
            const int i2 = it - n_lat, qb = i2 & 1; hq = (i2 >> 1) & 7; b = i2 >> 4;
            t0 = 0; lo = 0; nlat = 0; row0 = TL + b * LC + qb * 128;
        }
        const int kvh = hq >> 2;
        flash_item<64, true>(projS + (size_t)row0 * SWW + hq * 64, SWW, projS + 512 + kvh * 64, SWW, Vt + (size_t)(b * 2 + kvh) * 64 * NKEY,
                             TL + b * LC, b * SEQ, 4, lo, nlat, t0, sink[hq] * LOG2E, 1.0f, mix + (size_t)row0 * D + 512 + hq * 64, D, lds);
    }
}
__device__ void ph_dense(int bid, int nb, const bf16_t* __restrict__ projG, const bf16_t* __restrict__ Vt, bf16_t* __restrict__ mix, char* lds) {
    const bool sw = (nb & 7) == 0;
    const int nit = NB * 8 * 32;
    for (int j = sw ? (bid >> 3) : bid; j < (sw ? nit / 8 : nit); j += sw ? (nb >> 3) : nb) {
        int g, jj;
        if (sw) { g = (bid & 7) + 8 * (j >> 7); jj = j & 127; } else { g = j >> 7; jj = j & 127; }
        const int b = g >> 1, kvh = g & 1, hq = kvh * 4 + (jj >> 5), qb = jj & 31;
        const int row0 = b * SEQ + qb * 128;
        flash_item<128, false>(projG + (size_t)row0 * GA_IN + hq * 128, GA_IN, projG + 1024 + kvh * 128, GA_IN, Vt + (size_t)(b * 2 + kvh) * 128 * NKEY,
                               TL + b * LC, b * SEQ, 4, 0, SEQ / 64, 0, -1.0e30f, 0.0f, mix + (size_t)row0 * D + hq * 128, D, lds);
    }
}

__device__ void ph_peer_combine(int bid, int nb, const float* __restrict__ tsc, const int* __restrict__ tix, int* __restrict__ sel_e, float* __restrict__ sel_g, int ntok) {
    const int lane = threadIdx.x & 63, wid = threadIdx.x >> 6;
    for (int it = bid * 4 + wid; it < ntok * 8; it += nb * 4) {
        const size_t b1 = (size_t)it * 32, b2 = b1 + 16;
        const float s2 = tsc[b2 + (lane & 15)];
        float cv[4];
#pragma unroll
        for (int u = 0; u < 4; ++u) cv[u] = tsc[b1 + (lane >> 4) + 4 * u] + s2;
        float mysc = 0.f; int myc = 0;
        for (int j = 0; j < 16; ++j) {
            float bv = cv[0]; int bc = ((lane >> 4)) * 16 + (lane & 15);
#pragma unroll
            for (int u = 1; u < 4; ++u) { const int c = ((lane >> 4) + 4 * u) * 16 + (lane & 15); if (cv[u] > bv) { bv = cv[u]; bc = c; } }
#pragma unroll
            for (int o = 32; o >= 1; o >>= 1) {
                const float ov = __shfl_xor(bv, o); const int oc = __shfl_xor(bc, o);
                if (ov > bv || (ov == bv && oc < bc)) { bv = ov; bc = oc; }
            }
#pragma unroll
            for (int u = 0; u < 4; ++u) { const int c = ((lane >> 4) + 4 * u) * 16 + (lane & 15); if (c == bc) cv[u] = -3.0e38f; }
            if (lane == j) { mysc = bv; myc = bc; }
        }
        const float top = __shfl(mysc, 0);
        float e = lane < 16 ? __expf(mysc - top) : 0.f;
        float sum = e;
#pragma unroll
        for (int o = 8; o >= 1; o >>= 1) sum += __shfl_xor(sum, o);
        if (lane < 16) {
            const int ex = tix[b1 + (myc >> 4)] * 128 + tix[b2 + (myc & 15)];
            sel_e[(size_t)it * 16 + lane] = ex;
            sel_g[(size_t)it * 16 + lane] = e / sum;
        }
    }
}
__device__ void ph_peer_gather(int bid, int nb, const bf16_t* __restrict__ xf  , const bf16_t* __restrict__ U, const bf16_t* __restrict__ V,
                               const int* __restrict__ sel_e, const float* __restrict__ sel_g, const float* __restrict__ gate  ,
                               float* __restrict__ hlat, float* __restrict__ hctx, int ntok) {
    const int lane = threadIdx.x & 63, wid = threadIdx.x >> 6;
    for (int row = bid * 4 + wid; row < ntok; row += nb * 4) {
        float x[16], y[16];
#pragma unroll
        for (int i = 0; i < 2; ++i) {
            const uint4 w = *(const uint4*)(xf + (size_t)row * D + (lane + 64 * i) * 8);
            const unsigned ww[4] = {w.x, w.y, w.z, w.w};
#pragma unroll
            for (int j = 0; j < 4; ++j) { x[i * 8 + j * 2] = __uint_as_float(ww[j] << 16); x[i * 8 + j * 2 + 1] = __uint_as_float(ww[j] & 0xffff0000u); }
        }
#pragma unroll
        for (int i = 0; i < 16; ++i) y[i] = 0.f;
        const int my_e0 = sel_e[(size_t)row * 128 + lane], my_e1 = sel_e[(size_t)row * 128 + 64 + lane];
        const float my_g0 = sel_g[(size_t)row * 128 + lane], my_g1 = sel_g[(size_t)row * 128 + 64 + lane];
        for (int k = 0; k < 128; ++k) {
            const int e = __shfl(k < 64 ? my_e0 : my_e1, k & 63);
            const float g = __shfl(k < 64 ? my_g0 : my_g1, k & 63);
            const bf16_t* ur = U + (size_t)e * D;
            float part = 0.f;
#pragma unroll
            for (int i = 0; i < 2; ++i) {
                const uint4 w = *(const uint4*)(ur + (lane + 64 * i) * 8);
                const unsigned ww[4] = {w.x, w.y, w.z, w.w};
#pragma unroll
                for (int j = 0; j < 4; ++j) { part += x[i * 8 + j * 2] * __uint_as_float(ww[j] << 16); part += x[i * 8 + j * 2 + 1] * __uint_as_float(ww[j] & 0xffff0000u); }
            }
            const float dot = wave_sum(part);
            const float act = 0.5f * dot * (1.0f + erff(dot * 0.70710678118654752f));
            const float wgt = g * act;
            const bf16_t* vr = V + (size_t)e * D;
#pragma unroll
            for (int i = 0; i < 2; ++i) {
                const uint4 w = *(const uint4*)(vr + (lane + 64 * i) * 8);
                const unsigned ww[4] = {w.x, w.y, w.z, w.w};
#pragma unroll
                for (int j = 0; j < 4; ++j) { y[i * 8 + j * 2] += wgt * __uint_as_float(ww[j] << 16); y[i * 8 + j * 2 + 1] += wgt * __uint_as_float(ww[j] & 0xffff0000u); }
            }
        }
        float* hp = row < TL ? hlat + (size_t)row * D : hctx + (size_t)(row - TL) * D;
        const float* gg = gate + (size_t)mod_row(row) * 6144;
#pragma unroll
        for (int i = 0; i < 2; ++i) {
            const int col = (lane + 64 * i) * 8;
#pragma unroll
            for (int j = 0; j < 2; ++j) {
                float4 h = *(float4*)(hp + col + j * 4); const float4 g4 = *(const float4*)(gg + col + j * 4);
                h.x += g4.x * y[i * 8 + j * 4 + 0]; h.y += g4.y * y[i * 8 + j * 4 + 1]; h.z += g4.z * y[i * 8 + j * 4 + 2]; h.w += g4.w * y[i * 8 + j * 4 + 3];
                *(float4*)(hp + col + j * 4) = h;
            }
        }
    }
}
__device__ void ph_final(int bid, int nb, float* __restrict__ h, const float* __restrict__ g) {
    const int lane = threadIdx.x & 63, wid = threadIdx.x >> 6;
    for (int row = bid * 4 + wid; row < TL; row += nb * 4) {
        float4* p = (float4*)(h + (size_t)row * D);
        float4 x[4]; float ss = 0.f;
#pragma unroll
        for (int i = 0; i < 4; ++i) { x[i] = p[i * 64 + lane]; ss += x[i].x * x[i].x + x[i].y * x[i].y + x[i].z * x[i].z + x[i].w * x[i].w; }
        ss = wave_sum(ss);
        const float rinv = rsqrtf(ss * (1.0f / D) + EPS);
#pragma unroll
        for (int i = 0; i < 4; ++i) {
            const float4 gg = ((const float4*)g)[i * 64 + lane];
            float4 o; o.x = x[i].x * rinv * gg.x; o.y = x[i].y * rinv * gg.y; o.z = x[i].z * rinv * gg.z; o.w = x[i].w * rinv * gg.w;
            p[i * 64 + lane] = o;
        }
    }
}

struct Params {
    const float *x, *c, *ctx, *c_ctx, *ada_w, *ada_b, *norm_mix_g, *norm_ffn_g, *ab_w_in, *ab_w_out, *hg_lb, *hg_norm_g, *sw_sink,
        *ga_w_in, *ga_w_out, *ga_qn, *ga_kn, *peer_wq, *peer_sk, *peer_u, *peer_v, *final_g;
    float* out; char* ws;
};
extern __shared__ __attribute__((aligned(16))) char dyn_lds[];

#define WSP(T, off) ((T*)(p.ws + (off)))

namespace cg = cooperative_groups;
constexpr int MEGA_LDS = 65536;
__global__ void __launch_bounds__(256, 2) k_mega(Params p) {
    cg::grid_group grid = cg::this_grid();
    const int bid = blockIdx.x, nb = gridDim.x;
    char* lds = dyn_lds;
    float* ldf = (float*)dyn_lds;
    float* mod0 = WSP(float, OFF_MOD);
    float* mod1 = mod0 + (size_t)9 * 6144;
    float* hctx = WSP(float, OFF_HCTX);
    bf16_t* abuf = WSP(bf16_t, OFF_A);
    bf16_t* mix = WSP(bf16_t, OFF_MIX);
    ph_transpose(bid, nb, p.ab_w_in, WSP(bf16_t, OFF_WABIN), D, AB_IN, ldf);
    ph_transpose(bid, nb, p.ab_w_out, WSP(bf16_t, OFF_WABOUT), D, D, ldf);
    ph_transpose(bid, nb, p.ga_w_in, WSP(bf16_t, OFF_WGAIN), D, GA_IN, ldf);
    ph_transpose(bid, nb, p.ga_w_out, WSP(bf16_t, OFF_WGAOUT), D, D, ldf);
    ph_transpose(bid, nb, p.peer_wq, WSP(bf16_t, OFF_WPQ), D, PQ, ldf);
    ph_transpose(bid, nb, p.peer_wq + (size_t)D * PQ, WSP(bf16_t, OFF_WPQ) + (size_t)PQ * D, D, PQ, ldf);
    ph_cvt(bid, nb, p.peer_sk, WSP(bf16_t, OFF_SK), (size_t)2 * 8 * 2 * 128 * 128);
    ph_tables(bid, nb, WSP(float, OFF_COSS), WSP(float, OFF_SINS), WSP(float, OFF_COSG), WSP(float, OFF_SING), p.hg_lb, WSP(float, OFF_LB));
    __syncthreads();
    ph_mod(bid, nb, p.c, p.c_ctx, p.ada_w, p.ada_b, mod0, ldf);
    ph_cvt(bid, nb, p.peer_u, WSP(bf16_t, OFF_U16), (size_t)NEXP * D);
    ph_cvt(bid, nb, p.peer_v, WSP(bf16_t, OFF_V16), (size_t)NEXP * D);
    grid.sync();
    ph_normmod(bid, nb, p.x, p.ctx, p.norm_mix_g, mod0, 1 * D, 0, abuf, TA);
    grid.sync();
    { EpiStoreSplit e{WSP(bf16_t, OFF_PROJH), HGW, WSP(bf16_t, OFF_PROJS), SWW, HGW};
      ph_gemm(bid, nb, abuf, D, WSP(bf16_t, OFF_WABIN), D, TA, AB_IN, D, lds, e); }
    grid.sync();
    if (bid < 128) ph_hgrn(bid, 128, WSP(bf16_t, OFF_PROJH), WSP(float, OFF_LB), WSP(bf16_t, OFF_OF), WSP(bf16_t, OFF_OB), ldf);
    else {
        ph_prep_swa(bid - 128, nb - 128, WSP(bf16_t, OFF_PROJS), WSP(float, OFF_COSS), WSP(float, OFF_SINS));
        ph_vt<64>(bid - 128, nb - 128, WSP(bf16_t, OFF_PROJS), SWW, 640, WSP(bf16_t, OFF_VT), (bf16_t*)lds);
    }
    grid.sync();
    ph_swa(bid, nb, WSP(bf16_t, OFF_PROJS), WSP(bf16_t, OFF_VT), p.sw_sink, mix, lds);
    ph_hgpost(bid, nb, WSP(bf16_t, OFF_OF), WSP(bf16_t, OFF_OB), WSP(bf16_t, OFF_PROJH), p.hg_norm_g, mix);
    grid.sync();
    { EpiResid e{p.x, p.ctx, p.out, hctx, mod0 + 2 * D};
      ph_gemm(bid, nb, mix, D, WSP(bf16_t, OFF_WABOUT), D, TA, D, D, lds, e); }
    grid.sync();
    ph_normmod(bid, nb, p.out, hctx, p.norm_ffn_g, mod0, 4 * D, 3 * D, abuf, TA);
    grid.sync();
    { EpiStoreSplit e{WSP(bf16_t, OFF_QPEER), PQ, WSP(bf16_t, OFF_QPEER), PQ, 1 << 30};
      ph_gemm(bid, nb, abuf, D, WSP(bf16_t, OFF_WPQ), D, TA, PQ, D, lds, e); }
    grid.sync();
    ph_peer_scores(bid, nb, WSP(bf16_t, OFF_QPEER), WSP(bf16_t, OFF_SK), WSP(float, OFF_TSC), WSP(int, OFF_TIX), TA, lds);
    grid.sync();
    ph_peer_combine(bid, nb, WSP(float, OFF_TSC), WSP(int, OFF_TIX), WSP(int, OFF_SELE), WSP(float, OFF_SELG), TA);
    grid.sync();
    ph_peer_gather(bid, nb, abuf, WSP(bf16_t, OFF_U16), WSP(bf16_t, OFF_V16), WSP(int, OFF_SELE), WSP(float, OFF_SELG), mod0 + 5 * D, p.out, hctx, TA);
    grid.sync();
    ph_cvt(bid, nb, p.peer_u + (size_t)NEXP * D, WSP(bf16_t, OFF_U16), (size_t)NEXP * D);
    ph_cvt(bid, nb, p.peer_v + (size_t)NEXP * D, WSP(bf16_t, OFF_V16), (size_t)NEXP * D);
    ph_normmod(bid, nb, p.out, hctx, p.norm_mix_g + D, mod1, 1 * D, 0, abuf, TA);
    grid.sync();
    { EpiStoreSplit e{WSP(bf16_t, OFF_PROJ), GA_IN, WSP(bf16_t, OFF_PROJ), GA_IN, 1 << 30};
      ph_gemm(bid, nb, abuf, D, WSP(bf16_t, OFF_WGAIN), D, TA, GA_IN, D, lds, e); }
    grid.sync();
    ph_prep_ga(bid, nb, WSP(bf16_t, OFF_PROJ), p.ga_qn, p.ga_kn, WSP(float, OFF_COSG), WSP(float, OFF_SING));
    ph_vt<128>(bid, nb, WSP(bf16_t, OFF_PROJ), GA_IN, 1280, WSP(bf16_t, OFF_VT), (bf16_t*)lds);
    grid.sync();
    ph_dense(bid, nb, WSP(bf16_t, OFF_PROJ), WSP(bf16_t, OFF_VT), mix, lds);
    grid.sync();
    { EpiResid e{p.out, hctx, p.out, hctx, mod1 + 2 * D};
      ph_gemm(bid, nb, mix, D, WSP(bf16_t, OFF_WGAOUT), D, TL, D, D, lds, e); }
    grid.sync();
    ph_normmod(bid, nb, p.out, hctx, p.norm_ffn_g + D, mod1, 4 * D, 3 * D, abuf, TL);
    grid.sync();
    { EpiStoreSplit e{WSP(bf16_t, OFF_QPEER), PQ, WSP(bf16_t, OFF_QPEER), PQ, 1 << 30};
      ph_gemm(bid, nb, abuf, D, WSP(bf16_t, OFF_WPQ) + (size_t)PQ * D, D, TL, PQ, D, lds, e); }
    grid.sync();
    ph_peer_scores(bid, nb, WSP(bf16_t, OFF_QPEER), WSP(bf16_t, OFF_SK) + (size_t)16 * 128 * 128, WSP(float, OFF_TSC), WSP(int, OFF_TIX), TL, lds);
    grid.sync();
    ph_peer_combine(bid, nb, WSP(float, OFF_TSC), WSP(int, OFF_TIX), WSP(int, OFF_SELE), WSP(float, OFF_SELG), TL);
    grid.sync();
    ph_peer_gather(bid, nb, abuf, WSP(bf16_t, OFF_U16), WSP(bf16_t, OFF_V16), WSP(int, OFF_SELE), WSP(float, OFF_SELG), mod1 + 5 * D, p.out, hctx, TL);
    grid.sync();
    ph_final(bid, nb, p.out, p.final_g);
}

extern "C" void kernel_launch(void* const* d_in, const int* in_sizes, int n_in, void* d_out, int out_size, void* d_ws, size_t ws_size,
                              hipStream_t stream) {
    Params p{};
    p.x = (const float*)d_in[0]; p.c = (const float*)d_in[1]; p.ctx = (const float*)d_in[2]; p.c_ctx = (const float*)d_in[3];
    p.ada_w = (const float*)d_in[4]; p.ada_b = (const float*)d_in[5]; p.norm_mix_g = (const float*)d_in[6]; p.norm_ffn_g = (const float*)d_in[7];
    p.ab_w_in = (const float*)d_in[8]; p.ab_w_out = (const float*)d_in[9]; p.hg_lb = (const float*)d_in[10]; p.hg_norm_g = (const float*)d_in[11];
    p.sw_sink = (const float*)d_in[12]; p.ga_w_in = (const float*)d_in[13]; p.ga_w_out = (const float*)d_in[14]; p.ga_qn = (const float*)d_in[15];
    p.ga_kn = (const float*)d_in[16]; p.peer_wq = (const float*)d_in[17]; p.peer_sk = (const float*)d_in[18]; p.peer_u = (const float*)d_in[19];
    p.peer_v = (const float*)d_in[20]; p.final_g = (const float*)d_in[21];
    p.out = (float*)d_out; p.ws = (char*)d_ws;
    if (ws_size < WS_NEED) { fprintf(stderr, "workspace too small: %zu < %zu\n", ws_size, WS_NEED); return; }
    static int grid_blocks = 0;
    if (!grid_blocks) {
        int dev = 0, cus = 0, per_cu = 0;
        (void)hipGetDevice(&dev);
        (void)hipDeviceGetAttribute(&cus, hipDeviceAttributeMultiprocessorCount, dev);
        (void)hipFuncSetAttribute((const void*)k_mega, hipFuncAttributeMaxDynamicSharedMemorySize, MEGA_LDS);
        (void)hipOccupancyMaxActiveBlocksPerMultiprocessor(&per_cu, k_mega, 256, MEGA_LDS);
        if (per_cu > 2) per_cu = 2;
        if (per_cu < 1) per_cu = 1;
        grid_blocks = cus * per_cu;
    }
    void* args[] = {&p};
    hipError_t e = hipLaunchCooperativeKernel((const void*)k_mega, dim3(grid_blocks), dim3(256), args, MEGA_LDS, stream);
    if (e != hipSuccess) fprintf(stderr, "cooperative launch failed: %s (grid %d)\n", hipGetErrorString(e), grid_blocks);
}
```

```cpp
#include <hip/hip_runtime.h>
#include <hip/hip_cooperative_groups.h>
#include <stdint.h>
#include <stdio.h>

typedef unsigned short bf16_t;
typedef short bf16x8 __attribute__((ext_vector_type(8)));
typedef float f32x4 __attribute__((ext_vector_type(4)));

constexpr int D = 1024, NB = 8, SEQ = 4096, LC = 256;
constexpr int TL = NB * SEQ;
constexpr int TC = NB * LC;
constexpr int TA = TL + TC;
constexpr int AB_IN = 3328, HGW = 2560, SWW = 768, GA_IN = 1536, PQ = 2048;
constexpr int NEXP = 16384;
constexpr float EPS = 1e-6f;
constexpr float LOG2E = 1.4426950408889634f;
constexpr int NKEY = LC + SEQ;

constexpr size_t OFF_WABIN = 0;
constexpr size_t OFF_WABOUT = OFF_WABIN + (size_t)AB_IN * D * 2;
constexpr size_t OFF_WGAIN = OFF_WABOUT + (size_t)D * D * 2;
constexpr size_t OFF_WGAOUT = OFF_WGAIN + (size_t)GA_IN * D * 2;
constexpr size_t OFF_WPQ = OFF_WGAOUT + (size_t)D * D * 2;
constexpr size_t OFF_SK = OFF_WPQ + (size_t)2 * PQ * D * 2;
constexpr size_t OFF_MOD = OFF_SK + (size_t)2 * 8 * 2 * 128 * 128 * 2;
constexpr size_t OFF_COSS = OFF_MOD + (size_t)2 * 9 * 6144 * 4;
constexpr size_t OFF_SINS = OFF_COSS + (size_t)SEQ * 32 * 4;
constexpr size_t OFF_COSG = OFF_SINS + (size_t)SEQ * 32 * 4;
constexpr size_t OFF_SING = OFF_COSG + (size_t)SEQ * 64 * 4;
constexpr size_t OFF_LB = OFF_SING + (size_t)SEQ * 64 * 4;
constexpr size_t OFF_U16 = OFF_LB + 2048;
constexpr size_t OFF_V16 = OFF_U16 + (size_t)NEXP * D * 2;
constexpr size_t OFF_HCTX = OFF_V16 + (size_t)NEXP * D * 2;
constexpr size_t OFF_A = OFF_HCTX + (size_t)TC * D * 4;
constexpr size_t OFF_PROJ = OFF_A + (size_t)TA * D * 2;
constexpr size_t OFF_MIX = OFF_PROJ + (size_t)TA * AB_IN * 2;
constexpr size_t OFF_SEL = OFF_MIX + (size_t)TA * D * 2;
constexpr size_t WS_NEED = OFF_SEL + (size_t)TA * 128 * 8;
static_assert(WS_NEED <= (size_t)536870912, "workspace over 512 MiB");
constexpr size_t OFF_OF = OFF_A;
constexpr size_t OFF_OB = OFF_A + (size_t)TA * 512 * 2;
constexpr size_t OFF_PROJH = OFF_PROJ;
constexpr size_t OFF_PROJS = OFF_PROJ + (size_t)TA * HGW * 2;
constexpr size_t OFF_QPEER = OFF_PROJ;
constexpr size_t OFF_TSC = OFF_QPEER + (size_t)TA * PQ * 2;
constexpr size_t OFF_TIX = OFF_TSC + (size_t)TA * 256 * 4;
static_assert(OFF_TIX + (size_t)TA * 256 * 4 <= OFF_MIX, "peer scratch overflows proj region");
constexpr size_t OFF_VT = OFF_SEL;
static_assert((size_t)NB * 2 * 128 * NKEY * 2 <= (size_t)TA * 128 * 8, "Vt overflows SEL region");
constexpr size_t OFF_SELE = OFF_SEL;
constexpr size_t OFF_SELG = OFF_SEL + (size_t)TA * 128 * 4;

__device__ __forceinline__ float bf2f(bf16_t v) { return __uint_as_float(((unsigned)v) << 16); }
__device__ __forceinline__ bf16_t f2bf(float f) {
    unsigned u = __float_as_uint(f);
    u += 0x7fffu + ((u >> 16) & 1u);
    return (bf16_t)(u >> 16);
}
typedef float f32x2 __attribute__((ext_vector_type(2)));
typedef float f32x16 __attribute__((ext_vector_type(16)));
typedef __bf16 bf16x2_t __attribute__((ext_vector_type(2)));
__device__ __forceinline__ unsigned pack2(float lo, float hi) { f32x2 v = {lo, hi}; return __builtin_bit_cast(unsigned, __builtin_convertvector(v, bf16x2_t)); }
__device__ __forceinline__ float sigmoidf_(float x) { return 1.0f / (1.0f + __expf(-x)); }
__device__ __forceinline__ float siluf_(float x) { return x * sigmoidf_(x); }
__device__ __forceinline__ float wave_sum(float v) {
#pragma unroll
    for (int o = 32; o >= 1; o >>= 1) v += __shfl_xor(v, o);
    return v;
}
__device__ __forceinline__ int mod_row(int row) { return row < TL ? (row >> 12) : 8; }

__device__ void ph_transpose(int bid, int nb, const float* __restrict__ in, bf16_t* __restrict__ out, int K, int N, float* lds) {
    const int tk = K / 32, tn = N / 32, nt = tk * tn;
    const int tx = threadIdx.x & 31, ty = threadIdx.x >> 5;
    for (int t = bid; t < nt; t += nb) {
        const int k0 = (t / tn) * 32, n0 = (t % tn) * 32;
        __syncthreads();
#pragma unroll
        for (int i = 0; i < 4; ++i) lds[(ty + i * 8) * 33 + tx] = in[(size_t)(k0 + ty + i * 8) * N + n0 + tx];
        __syncthreads();
#pragma unroll
        for (int i = 0; i < 4; ++i) out[(size_t)(n0 + ty + i * 8) * K + k0 + tx] = f2bf(lds[tx * 33 + ty + i * 8]);
    }
}
__device__ void ph_cvt(int bid, int nb, const float* __restrict__ in, bf16_t* __restrict__ out, size_t n) {
    const size_t n8 = n / 8;
    for (size_t i = (size_t)bid * blockDim.x + threadIdx.x; i < n8; i += (size_t)nb * blockDim.x) {
        const float4 a = ((const float4*)in)[i * 2], b = ((const float4*)in)[i * 2 + 1];
        uint4 w; w.x = pack2(a.x, a.y); w.y = pack2(a.z, a.w); w.z = pack2(b.x, b.y); w.w = pack2(b.z, b.w);
        ((uint4*)out)[i] = w;
    }
}
__device__ void ph_mod(int bid, int nb, const float* __restrict__ c, const float* __restrict__ c_ctx, const float* __restrict__ ada_w,
                       const float* __restrict__ ada_b, float* __restrict__ mod, float* lds) {
    float* s = lds;
    float* red = lds + 9 * 1024;
    const int tx = threadIdx.x & 63, ky = threadIdx.x >> 6;
    for (int i = threadIdx.x; i < 9 * 1024; i += 256) {
        const int r = i >> 10, k = i & 1023;
        const float v = r < 8 ? c[r * 1024 + k] : c_ctx[k];
        s[i] = siluf_(v);
    }
    __syncthreads();
    const int nitems = 2 * 96;
    for (int it = bid; it < nitems; it += nb) {
        const int layer = it / 96, n = (it % 96) * 64 + tx;
        const float* w = ada_w + (size_t)layer * 1024 * 6144 + n;
        float acc[9];
#pragma unroll
        for (int r = 0; r < 9; ++r) acc[r] = 0.f;
        for (int k = ky * 256; k < ky * 256 + 256; ++k) {
            const float wv = w[(size_t)k * 6144];
#pragma unroll
            for (int r = 0; r < 9; ++r) acc[r] += s[r * 1024 + k] * wv;
        }
        __syncthreads();
#pragma unroll
        for (int r = 0; r < 9; ++r) red[(ky * 9 + r) * 64 + tx] = acc[r];
        __syncthreads();
        if (ky == 0) {
#pragma unroll
            for (int r = 0; r < 9; ++r) {
                const float v = red[(0 * 9 + r) * 64 + tx] + red[(1 * 9 + r) * 64 + tx] + red[(2 * 9 + r) * 64 + tx] + red[(3 * 9 + r) * 64 + tx];
                mod[((size_t)layer * 9 + r) * 6144 + n] = v + ada_b[layer * 6144 + n];
            }
        }
    }
}
__device__ void ph_tables(int bid, int nb, float* cosS, float* sinS, float* cosG, float* sinG, const float* __restrict__ lb_logits, float* lb) {
    const int gt = bid * blockDim.x + threadIdx.x, gs = nb * blockDim.x;
    for (int i = gt; i < SEQ * 32; i += gs) {
        const int t = i >> 5, j = i & 31;
        const float pos = (float)(j < 16 ? (t >> 6) : (t & 63));
        const float inv = powf(10000.0f, -(float)(j & 15) / 16.0f);
        const float ang = pos * inv;
        cosS[i] = cosf(ang); sinS[i] = sinf(ang);
    }
    for (int i = gt; i < SEQ * 64; i += gs) {
        const int t = i >> 6, j = i & 63;
        const float pos = (float)(j < 32 ? (t >> 6) : (t & 63));
        const float inv = powf(10000.0f, -(float)(j & 31) / 32.0f);
        const float ang = pos * inv;
        cosG[i] = cosf(ang); sinG[i] = sinf(ang);
    }
    for (int i = gt; i < 512; i += gs) {
        const float l0 = lb_logits[i], l1 = lb_logits[512 + i];
        lb[i] = 1.0f / (1.0f + expf(l1 - l0));
    }
}

__device__ void ph_normmod(int bid, int nb, const float* __restrict__ hlat, const float* __restrict__ hctx, const float* __restrict__ gamma,
                           const float* __restrict__ modl  , int sc_off, int sh_off, bf16_t* __restrict__ out, int nrows) {
    const int lane = threadIdx.x & 63, wid = threadIdx.x >> 6;
    for (int row = bid * 4 + wid; row < nrows; row += nb * 4) {
        const float* src = row < TL ? hlat + (size_t)row * D : hctx + (size_t)(row - TL) * D;
        const float* m = modl + (size_t)mod_row(row) * 6144;
        float4 x[4]; float ss = 0.f;
#pragma unroll
        for (int i = 0; i < 4; ++i) { x[i] = ((const float4*)src)[i * 64 + lane]; ss += x[i].x * x[i].x + x[i].y * x[i].y + x[i].z * x[i].z + x[i].w * x[i].w; }
        ss = wave_sum(ss);
        const float rinv = rsqrtf(ss * (1.0f / D) + EPS);
#pragma unroll
        for (int i = 0; i < 4; ++i) {
            const int col = (i * 64 + lane) * 4;
            const float4 g = *(const float4*)(gamma + col), sc = *(const float4*)(m + sc_off + col), sh = *(const float4*)(m + sh_off + col);
            const float y0 = x[i].x * rinv * g.x * (1.f + sc.x) + sh.x, y1 = x[i].y * rinv * g.y * (1.f + sc.y) + sh.y;
            const float y2 = x[i].z * rinv * g.z * (1.f + sc.z) + sh.z, y3 = x[i].w * rinv * g.w * (1.f + sc.w) + sh.w;
            uint2 w; w.x = pack2(y0, y1); w.y = pack2(y2, y3);
            *(uint2*)(out + (size_t)row * D + col) = w;
        }
    }
}

constexpr int GEMM_LDS = 65536;
template <class Epi>
__device__ __forceinline__ void gemm_tile(const bf16_t* __restrict__ A, int lda, const bf16_t* __restrict__ Bt, int ldb, int K,
                                          int m0, int n0, char* lds, Epi& epi) {
    const int tid = threadIdx.x, lane = tid & 63, wid = tid >> 6, wr = wid >> 1, wc = wid & 1, fr = lane & 15, fq = lane >> 4;
    f32x4 acc[4][4];
#pragma unroll
    for (int i = 0; i < 4; ++i)
#pragma unroll
        for (int j = 0; j < 4; ++j) acc[i][j] = (f32x4){0.f, 0.f, 0.f, 0.f};
    const int nk = K / 64;
    const int sr0 = tid >> 3, sc0 = tid & 7;
    const bf16_t* ga = A + (size_t)(m0 + sr0) * lda + sc0 * 8;
    const bf16_t* gb = Bt + (size_t)(n0 + sr0) * ldb + sc0 * 8;
    const int soff = sr0 * 128 + ((sc0 ^ (sr0 & 7)) << 4);
    uint4 ra0, ra1, ra2, ra3, rb0, rb1, rb2, rb3;
#define GT_GLOAD(kt) do { const int _ko = (kt) * 64; \
        ra0 = *(const uint4*)(ga + _ko); ra1 = *(const uint4*)(ga + (size_t)32 * lda + _ko); \
        ra2 = *(const uint4*)(ga + (size_t)64 * lda + _ko); ra3 = *(const uint4*)(ga + (size_t)96 * lda + _ko); \
        rb0 = *(const uint4*)(gb + _ko); rb1 = *(const uint4*)(gb + (size_t)32 * ldb + _ko); \
        rb2 = *(const uint4*)(gb + (size_t)64 * ldb + _ko); rb3 = *(const uint4*)(gb + (size_t)96 * ldb + _ko); } while (0)
#define GT_LSTORE(buf) do { char* _b = lds + (buf) * 32768 + soff; \
        *(uint4*)(_b) = ra0; *(uint4*)(_b + 4096) = ra1; *(uint4*)(_b + 8192) = ra2; *(uint4*)(_b + 12288) = ra3; \
        *(uint4*)(_b + 16384) = rb0; *(uint4*)(_b + 16384 + 4096) = rb1; *(uint4*)(_b + 16384 + 8192) = rb2; *(uint4*)(_b + 16384 + 12288) = rb3; } while (0)
    __syncthreads();
    GT_GLOAD(0); GT_LSTORE(0);
    __syncthreads();
    for (int kt = 0; kt < nk; ++kt) {
        if (kt + 1 < nk) GT_GLOAD(kt + 1);
        const char* base = lds + (kt & 1) * 32768;
#pragma unroll
        for (int kk = 0; kk < 2; ++kk) {
            bf16x8 af[4], bfr[4];
#pragma unroll
            for (int i = 0; i < 4; ++i) {
                const int ar = wr * 64 + i * 16 + fr, br = wc * 64 + i * 16 + fr;
                const int c = kk * 4 + fq;
                af[i] = *(const bf16x8*)(base + ar * 128 + ((c ^ (ar & 7)) << 4));
                bfr[i] = *(const bf16x8*)(base + 16384 + br * 128 + ((c ^ (br & 7)) << 4));
            }
#pragma unroll
            for (int i = 0; i < 4; ++i)
#pragma unroll
                for (int j = 0; j < 4; ++j) acc[i][j] = __builtin_amdgcn_mfma_f32_16x16x32_bf16(bfr[j], af[i], acc[i][j], 0, 0, 0);
        }
        if (kt + 1 < nk) GT_LSTORE((kt + 1) & 1);
        __syncthreads();
    }
#undef GT_GLOAD
#undef GT_LSTORE
    epi(acc, m0 + wr * 64 + fr, n0 + wc * 64 + fq * 4, lds);
}

struct EpiStoreSplit {
    bf16_t* O1; int ld1; bf16_t* O2; int ld2; int split;
    __device__ __forceinline__ void operator()(f32x4 (&acc)[4][4], int row0, int col0, char*) const {
#pragma unroll
        for (int i = 0; i < 4; ++i)
#pragma unroll
            for (int j = 0; j < 4; ++j) {
                const int row = row0 + i * 16, col = col0 + j * 16;
                uint2 w; w.x = pack2(acc[i][j][0], acc[i][j][1]); w.y = pack2(acc[i][j][2], acc[i][j][3]);
                if (col < split) *(uint2*)(O1 + (size_t)row * ld1 + col) = w;
                else *(uint2*)(O2 + (size_t)row * ld2 + (col - split)) = w;
            }
    }
};
struct EpiResid {
    const float* hin_lat; const float* hin_ctx; float* hout_lat; float* hout_ctx; const float* gate  ;
    __device__ __forceinline__ void operator()(f32x4 (&acc)[4][4], int row0, int col0, char*) const {
#pragma unroll
        for (int i = 0; i < 4; ++i) {
            const int row = row0 + i * 16;
            const float* hi = row < TL ? hin_lat + (size_t)row * D : hin_ctx + (size_t)(row - TL) * D;
            float* ho = row < TL ? hout_lat + (size_t)row * D : hout_ctx + (size_t)(row - TL) * D;
            const float* g = gate + (size_t)mod_row(row) * 6144;
#pragma unroll
            for (int j = 0; j < 4; ++j) {
                const int col = col0 + j * 16;
                const float4 h = *(const float4*)(hi + col), gg = *(const float4*)(g + col);
                float4 o; o.x = h.x + gg.x * acc[i][j][0]; o.y = h.y + gg.y * acc[i][j][1]; o.z = h.z + gg.z * acc[i][j][2]; o.w = h.w + gg.w * acc[i][j][3];
                *(float4*)(ho + col) = o;
            }
        }
    }
};
struct EpiTop16 {
    float* tsc; int* tix; int hp; int m0;
    __device__ __forceinline__ void operator()(f32x4 (&acc)[4][4], int row0, int col0, char* lds) const {
        float* sc = (float*)lds;
        const int lr0 = row0 - m0;
#pragma unroll
        for (int i = 0; i < 4; ++i)
#pragma unroll
            for (int j = 0; j < 4; ++j) *(f32x4*)(sc + (lr0 + i * 16) * 128 + (col0 & 127) + j * 16) = acc[i][j];
        __syncthreads();
        const int r = threadIdx.x;
        if (r < 128) {
            float* my = sc + r * 128;
            const size_t ob = ((size_t)(m0 + r) * 16 + hp) * 16;
            for (int p = 0; p < 16; ++p) {
                float best = -3.0e38f; int bi = 0;
                for (int c = 0; c < 128; ++c) {
                    const int cc = (c + r) & 127;
                    const float v = my[cc];
                    if (v > best || (v == best && cc < bi)) { best = v; bi = cc; }
                }
                tsc[ob + p] = best; tix[ob + p] = bi;
                my[bi] = -3.0e38f;
            }
        }
        __syncthreads();
    }
};

template <class Epi>
__device__ void ph_gemm(int bid, int nb, const bf16_t* A, int lda, const bf16_t* Bt, int ldb, int M, int N, int K, char* lds, Epi epi) {
    const int tm = M / 128, tn = N / 128;
    for (int t = bid; t < tm * tn; t += nb) {
        const int m0 = (t / tn) * 128, n0 = (t % tn) * 128;
        gemm_tile(A, lda, Bt, ldb, K, m0, n0, lds, epi);
    }
}
__device__ void ph_peer_scores(int bid, int nb, const bf16_t* qpeer, const bf16_t* SK, float* tsc, int* tix, int M, char* lds) {
    const int tm = M / 128;
    for (int t = bid; t < tm * 16; t += nb) {
        const int m0 = (t >> 4) * 128, hp = t & 15;
        EpiTop16 epi{tsc, tix, hp, m0};
        gemm_tile(qpeer + hp * 128, PQ, SK + (size_t)hp * 128 * 128, 128, 128, m0, 0, lds, epi);
    }
}

typedef short bf16x4 __attribute__((ext_vector_type(4)));
constexpr int HQ_OFF = 0, HK_OFF = 16384, HKT_OFF = 32768, HVT_OFF = 49152, HD_OFF = 57344, HG_LDS = 59392;
__device__ __forceinline__ int hg_row(int b, int dir, int p) {
    if (p < LC) { const int s = dir ? (LC - 1 - p) : p; return TL + b * LC + s; }
    const int t = dir ? (SEQ - 1 - (p - LC)) : (p - LC);
    return b * SEQ + t;
}
__device__ void ph_hgrn(int bid, int nb, const bf16_t* __restrict__ projH, const float* __restrict__ lb, bf16_t* __restrict__ of, bf16_t* __restrict__ ob, char* lds) {
    const int tid = threadIdx.x, lane = tid & 63, w = tid >> 6, fr = lane & 15, fq = lane >> 4;
    for (int it = bid; it < NB * 4 * 2 * 2; it += nb) {
        const int vs = it & 1, dir = (it >> 1) & 1, h = (it >> 2) & 3, b = it >> 4;
        bf16_t* out = dir ? ob : of;
        const float lb0 = lb[h * 128 + 2 * lane], lb1 = lb[h * 128 + 2 * lane + 1];
        const int fcol = (dir ? 1024 : 512) + h * 128 + 2 * lane, qcol = h * 128 + 2 * lane, vcol = 1536 + h * 128 + vs * 64 + lane;
        f32x4 S[8];
#pragma unroll
        for (int kt = 0; kt < 8; ++kt) S[kt] = (f32x4){0.f, 0.f, 0.f, 0.f};
        unsigned xf[16], xq[16]; bf16_t xv[16];
#define HG_PREFETCH(p0) do { _Pragma("unroll") for (int i = 0; i < 16; ++i) { \
            const size_t rb = (size_t)hg_row(b, dir, (p0) + 16 * w + i) * HGW; \
            xf[i] = *(const unsigned*)(projH + rb + fcol); xq[i] = *(const unsigned*)(projH + rb + qcol); xv[i] = projH[rb + vcol]; } } while (0)
        HG_PREFETCH(0);
        for (int p0 = 0; p0 < NKEY; p0 += 64) {
            __syncthreads();
            {
                float c0 = 0.f, c1 = 0.f, kp0 = 0.f, kp1 = 0.f;
                unsigned kt0[8], kt1[8], vt[8];
#pragma unroll
                for (int i = 0; i < 16; ++i) {
                    const float xf0 = __uint_as_float(xf[i] << 16), xf1 = __uint_as_float(xf[i] & 0xffff0000u);
                    const float xq0 = __uint_as_float(xq[i] << 16), xq1 = __uint_as_float(xq[i] & 0xffff0000u);
                    const float f0 = lb0 + (1.f - lb0) * __builtin_amdgcn_rcpf(1.f + __expf(-xf0));
                    const float f1 = lb1 + (1.f - lb1) * __builtin_amdgcn_rcpf(1.f + __expf(-xf1));
                    c0 += __logf(f0); c1 += __logf(f1);
                    const float q0 = xq0 * __builtin_amdgcn_rcpf(1.f + __expf(-xq0)) * __expf(c0);
                    const float q1 = xq1 * __builtin_amdgcn_rcpf(1.f + __expf(-xq1)) * __expf(c1);
                    const float k0 = (1.f - f0) * __expf(fminf(-c0, 80.f)), k1 = (1.f - f1) * __expf(fminf(-c1, 80.f));
                    const int t = 16 * w + i;
                    const int o = t * 256 + (((lane >> 2) ^ (t & 15)) << 4) + (lane & 3) * 4;
                    *(unsigned*)(lds + HQ_OFF + o) = pack2(q0, q1);
                    *(unsigned*)(lds + HK_OFF + o) = pack2(k0, k1);
                    if (i & 1) { kt0[i >> 1] = pack2(kp0, k0); kt1[i >> 1] = pack2(kp1, k1); vt[i >> 1] = (unsigned)xv[i - 1] | ((unsigned)xv[i] << 16); }
                    else { kp0 = k0; kp1 = k1; }
                }
                float2 dd; dd.x = __expf(c0); dd.y = __expf(c1);
                *(float2*)(lds + HD_OFF + (w * 128 + 2 * lane) * 4) = dd;
                char* kp = lds + HKT_OFF + w * 4096 + (2 * lane) * 32;
                *(uint4*)(kp) = make_uint4(kt0[0], kt0[1], kt0[2], kt0[3]); *(uint4*)(kp + 16) = make_uint4(kt0[4], kt0[5], kt0[6], kt0[7]);
                *(uint4*)(kp + 32) = make_uint4(kt1[0], kt1[1], kt1[2], kt1[3]); *(uint4*)(kp + 48) = make_uint4(kt1[4], kt1[5], kt1[6], kt1[7]);
                char* vp = lds + HVT_OFF + w * 2048 + lane * 32;
                *(uint4*)(vp) = make_uint4(vt[0], vt[1], vt[2], vt[3]); *(uint4*)(vp + 16) = make_uint4(vt[4], vt[5], vt[6], vt[7]);
            }
            if (p0 + 64 < NKEY) HG_PREFETCH(p0 + 64);
            __syncthreads();
#pragma unroll
            for (int I = 0; I < 4; ++I) {
                const int trow = 16 * I + fr;
                f32x4 at = (f32x4){0.f, 0.f, 0.f, 0.f};
#pragma unroll
                for (int ks = 0; ks < 4; ++ks) {
                    const int o = trow * 256 + (((ks * 4 + fq) ^ fr) << 4);
                    const bf16x8 ka = *(const bf16x8*)(lds + HK_OFF + o);
                    const bf16x8 qa = *(const bf16x8*)(lds + HQ_OFF + o);
                    at = __builtin_amdgcn_mfma_f32_16x16x32_bf16(ka, qa, at, 0, 0, 0);
                }
#pragma unroll
                for (int j = 0; j < 4; ++j) if (4 * fq + j > fr) at[j] = 0.f;
                uint2 pa2; pa2.x = pack2(at[0], at[1]); pa2.y = pack2(at[2], at[3]);
                const bf16x4 pA = __builtin_bit_cast(bf16x4, pa2);
                const bf16x4 vfrag = *(const bf16x4*)(lds + HVT_OFF + I * 2048 + (w * 16 + fr) * 32 + fq * 8);
                f32x4 o1 = __builtin_amdgcn_mfma_f32_16x16x16bf16_1k(vfrag, pA, (f32x4){0.f, 0.f, 0.f, 0.f}, 0, 0, 0);
                f32x4 o2 = (f32x4){0.f, 0.f, 0.f, 0.f};
#pragma unroll
                for (int kt = 0; kt < 8; ++kt) {
                    uint2 s2; s2.x = pack2(S[kt][0], S[kt][1]); s2.y = pack2(S[kt][2], S[kt][3]);
                    const bf16x4 sfrag = __builtin_bit_cast(bf16x4, s2);
                    const bf16x4 qfrag = *(const bf16x4*)(lds + HQ_OFF + trow * 256 + (((kt * 2 + (fq >> 1)) ^ fr) << 4) + (fq & 1) * 8);
                    if (kt & 1) o2 = __builtin_amdgcn_mfma_f32_16x16x16bf16_1k(sfrag, qfrag, o2, 0, 0, 0);
                    else o1 = __builtin_amdgcn_mfma_f32_16x16x16bf16_1k(sfrag, qfrag, o1, 0, 0, 0);
                }
#pragma unroll
                for (int kt = 0; kt < 8; ++kt) {
                    const bf16x4 kfrag = *(const bf16x4*)(lds + HKT_OFF + I * 4096 + (kt * 16 + fr) * 32 + fq * 8);
                    const f32x4 d4 = *(const f32x4*)(lds + HD_OFF + (I * 128 + kt * 16 + fq * 4) * 4);
                    S[kt] = __builtin_amdgcn_mfma_f32_16x16x16bf16_1k(kfrag, vfrag, S[kt], 0, 0, 0);
                    S[kt] = S[kt] * d4;
                }
                const size_t orow = (size_t)hg_row(b, dir, p0 + trow);
                uint2 ov; ov.x = pack2(o1[0] + o2[0], o1[1] + o2[1]); ov.y = pack2(o1[2] + o2[2], o1[3] + o2[3]);
                *(uint2*)(out + orow * 512 + h * 128 + vs * 64 + w * 16 + fq * 4) = ov;
            }
        }
#undef HG_PREFETCH
    }
}
__device__ void ph_hgpost(int bid, int nb, const bf16_t* __restrict__ of, const bf16_t* __restrict__ ob, const bf16_t* __restrict__ projH,
                          const float* __restrict__ g, bf16_t* __restrict__ mix) {
    const int lane = threadIdx.x & 63, wid = threadIdx.x >> 6;
    for (int it = bid * 4 + wid; it < TA * 4; it += nb * 4) {
        const int row = it >> 2, h = it & 3;
        const size_t o = (size_t)row * 512 + h * 128 + lane * 2;
        const unsigned a = *(const unsigned*)(of + o), bb = *(const unsigned*)(ob + o);
        const float x0 = bf2f((bf16_t)(a & 0xffff)) + bf2f((bf16_t)(bb & 0xffff)), x1 = bf2f((bf16_t)(a >> 16)) + bf2f((bf16_t)(bb >> 16));
        const float ss = wave_sum(x0 * x0 + x1 * x1);
        const float rinv = rsqrtf(ss * (1.0f / 128.0f) + EPS);
        const unsigned gg = *(const unsigned*)(projH + (size_t)row * HGW + 2048 + h * 128 + lane * 2);
        const float y0 = x0 * rinv * g[lane * 2] * siluf_(bf2f((bf16_t)(gg & 0xffff)));
        const float y1 = x1 * rinv * g[lane * 2 + 1] * siluf_(bf2f((bf16_t)(gg >> 16)));
        *(unsigned*)(mix + (size_t)row * D + h * 128 + lane * 2) = pack2(y0, y1);
    }
}

__device__ void ph_prep_swa(int bid, int nb, bf16_t* __restrict__ P, const float* __restrict__ cosS, const float* __restrict__ sinS) {
    const size_t n = (size_t)TA * 320;
    for (size_t idx = (size_t)bid * blockDim.x + threadIdx.x; idx < n; idx += (size_t)nb * blockDim.x) {
        const int row = (int)(idx / 320), pr = (int)(idx % 320), head = pr >> 5, d = pr & 31;
        bf16_t* p = P + (size_t)row * SWW + head * 64 + d;
        float x1 = bf2f(p[0]), x2 = bf2f(p[32]);
        if (row < TL) {
            const int t = row & (SEQ - 1);
            const float c = cosS[t * 32 + d], s = sinS[t * 32 + d];
            const float y1 = x1 * c - x2 * s, y2 = x1 * s + x2 * c;
            x1 = y1; x2 = y2;
        }
        if (head < 8) { x1 *= 0.125f * LOG2E; x2 *= 0.125f * LOG2E; }
        p[0] = f2bf(x1); p[32] = f2bf(x2);
    }
}
__device__ void ph_prep_ga(int bid, int nb, bf16_t* __restrict__ P, const float* __restrict__ qg, const float* __restrict__ kg,
                           const float* __restrict__ cosG, const float* __restrict__ sinG) {
    const int lane = threadIdx.x & 63, wid = threadIdx.x >> 6;
    for (int it = bid * 4 + wid; it < TA * 10; it += nb * 4) {
        const int row = it / 10, head = it % 10;
        bf16_t* p = P + (size_t)row * GA_IN + head * 128;
        float x1 = bf2f(p[lane]), x2 = bf2f(p[lane + 64]);
        const float ss = wave_sum(x1 * x1 + x2 * x2);
        const float rinv = rsqrtf(ss * (1.0f / 128.0f) + EPS);
        const float* g = head < 8 ? qg : kg;
        x1 = x1 * rinv * g[lane]; x2 = x2 * rinv * g[lane + 64];
        if (row < TL) {
            const int t = row & (SEQ - 1);
            const float c = cosG[t * 64 + lane], s = sinG[t * 64 + lane];
            const float y1 = x1 * c - x2 * s, y2 = x1 * s + x2 * c;
            x1 = y1; x2 = y2;
        }
        if (head < 8) { x1 *= 0.08838834764831845f * LOG2E; x2 *= 0.08838834764831845f * LOG2E; }
        p[lane] = f2bf(x1); p[lane + 64] = f2bf(x2);
    }
}

template <int HD>
__device__ void ph_vt(int bid, int nb, const bf16_t* __restrict__ P, int ldp, int vcol, bf16_t* __restrict__ Vt, bf16_t* lds) {
    constexpr int ND = HD / 64;
    const int tid = threadIdx.x;
    for (int it = bid; it < NB * 2 * ND * (NKEY / 64); it += nb) {
        const int kt = it % (NKEY / 64), r1 = it / (NKEY / 64), dh = r1 % ND, g = r1 / ND, b = g >> 1, kvh = g & 1;
        const int k0 = kt * 64;
        const int row0 = k0 < LC ? TL + b * LC + k0 : b * SEQ + (k0 - LC);
        __syncthreads();
#pragma unroll
        for (int i = 0; i < 2; ++i) {
            const int id = tid + i * 256, kr = id >> 3, c = id & 7;
            const uint4 w = *(const uint4*)(P + (size_t)(row0 + kr) * ldp + vcol + kvh * HD + dh * 64 + c * 8);
            const unsigned ww[4] = {w.x, w.y, w.z, w.w};
#pragma unroll
            for (int j = 0; j < 4; ++j) { lds[kr * 66 + c * 8 + j * 2] = (bf16_t)(ww[j] & 0xffff); lds[kr * 66 + c * 8 + j * 2 + 1] = (bf16_t)(ww[j] >> 16); }
        }
        __syncthreads();
#pragma unroll
        for (int i = 0; i < 2; ++i) {
            const int id = tid + i * 256, d = id >> 3, c = id & 7;
            unsigned o[4];
#pragma unroll
            for (int j = 0; j < 4; ++j) o[j] = (unsigned)lds[(c * 8 + j * 2) * 66 + d] | ((unsigned)lds[(c * 8 + j * 2 + 1) * 66 + d] << 16);
            uint4 w; w.x = o[0]; w.y = o[1]; w.z = o[2]; w.w = o[3];
            *(uint4*)(Vt + (size_t)(g * HD + dh * 64 + d) * NKEY + k0 + c * 8) = w;
        }
    }
}

template <int HD, bool MASK>
__device__ __forceinline__ void flash_item(const bf16_t* __restrict__ Qrow0, int ldq, const bf16_t* __restrict__ Kp, int ldk,
                                           const bf16_t* __restrict__ Vt, int krow_ctx0, int krow_lat0, int nctx_t, int lat_lo, int nlat_t,
                                           int tq0, float m0, float l0, bf16_t* __restrict__ Orow0, int ldo, char* lds) {
    constexpr int NCH = HD / 32;
    constexpr int KB = 64 * HD * 2;
    constexpr int NKK = HD / 16;
    constexpr int NDT = HD / 32;
    const int tid = threadIdx.x, lane = tid & 63, w = tid >> 6, r = lane & 31, h = lane >> 5;
    const int pr = (r & 0x13) | ((r & 4) << 1) | ((r & 8) >> 1);
    bf16x8 qf[NKK];
    {
        const bf16_t* qp = Qrow0 + (size_t)(32 * w + r) * ldq + 8 * h;
#pragma unroll
        for (int kk = 0; kk < NKK; ++kk) qf[kk] = *(const bf16x8*)(qp + 16 * kk);
    }
    f32x16 O[NDT];
#pragma unroll
    for (int dt = 0; dt < NDT; ++dt)
#pragma unroll
        for (int i = 0; i < 16; ++i) O[dt][i] = 0.f;
    float m_run = m0, l_run = (h == 0) ? l0 : 0.f;
    const int kc = (HD == 128) ? (tid & 15) : (tid & 7);
    const int kr = (HD == 128) ? (tid >> 4) : (tid >> 3);
    const int ksw = (HD == 128) ? (kr & 15) : ((kr >> 1) & 7);
    const int klds = kr * (HD * 2) + ((kc ^ ksw) << 4);
    constexpr int KRSTEP = (HD == 128) ? 16 : 32;
    const int vr = tid >> 3, vc = tid & 7;
    const int vlds = KB + vr * 128 + ((vc ^ ((vr >> 1) & 7)) << 4);
    const int kfo = pr * (HD * 2);
    const int kfs = (HD == 128) ? (pr & 15) : ((pr >> 1) & 7);
    const int vfo = KB + r * 128;
    const int vfs = (r >> 1) & 7;
    const int ntile = nctx_t + nlat_t;
    uint4 sg0, sg1, sg2, sg3;
    sg2 = sg3 = make_uint4(0u, 0u, 0u, 0u);
#define FA_TILE(t, krow0, kidx0, s0) const int krow0 = (t) < nctx_t ? krow_ctx0 + 64 * (t) : krow_lat0 + lat_lo + 64 * ((t) - nctx_t); \
        const int s0 = (t) < nctx_t ? -(1 << 24) : lat_lo + 64 * ((t) - nctx_t); const int kidx0 = (t) < nctx_t ? 64 * (t) : LC + lat_lo + 64 * ((t) - nctx_t);
#define FA_GLOADK(t) do { FA_TILE(t, _kr0, _ki0, _s0) (void)_s0; (void)_ki0; \
        const bf16_t* _kp = Kp + (size_t)(_kr0 + kr) * ldk + kc * 8; \
        sg0 = *(const uint4*)(_kp); sg1 = *(const uint4*)(_kp + (size_t)KRSTEP * ldk); \
        if (NCH == 4) { sg2 = *(const uint4*)(_kp + (size_t)2 * KRSTEP * ldk); sg3 = *(const uint4*)(_kp + (size_t)3 * KRSTEP * ldk); } } while (0)
#define FA_GLOADV(t) do { FA_TILE(t, _kr0, _ki0, _s0) (void)_s0; (void)_kr0; \
        const bf16_t* _vp = Vt + (size_t)vr * NKEY + _ki0 + vc * 8; \
        sg0 = *(const uint4*)(_vp); sg1 = *(const uint4*)(_vp + (size_t)32 * NKEY); \
        if (NCH == 4) { sg2 = *(const uint4*)(_vp + (size_t)64 * NKEY); sg3 = *(const uint4*)(_vp + (size_t)96 * NKEY); } } while (0)
#define FA_LSTORE(buf, off) do { char* _b = lds + (buf) * (2 * KB) + (off); \
        *(uint4*)(_b) = sg0; *(uint4*)(_b + 4096) = sg1; \
        if (NCH == 4) { *(uint4*)(_b + 8192) = sg2; *(uint4*)(_b + 12288) = sg3; } } while (0)
    __syncthreads();
    FA_GLOADK(0); FA_LSTORE(0, klds);
    FA_GLOADV(0); FA_LSTORE(0, vlds);
    __syncthreads();
    for (int t = 0; t < ntile; ++t) {
        if (t + 1 < ntile) FA_GLOADK(t + 1);
        const char* base = lds + (t & 1) * (2 * KB);
        f32x16 st[2];
#pragma unroll
        for (int rt = 0; rt < 2; ++rt) {
#pragma unroll
            for (int i = 0; i < 16; ++i) st[rt][i] = 0.f;
#pragma unroll
            for (int kk = 0; kk < NKK; ++kk) {
                const bf16x8 kf = *(const bf16x8*)(base + rt * 32 * (HD * 2) + kfo + (((2 * kk + h) ^ kfs) << 4));
                st[rt] = __builtin_amdgcn_mfma_f32_32x32x16_bf16(kf, qf[kk], st[rt], 0, 0, 0);
                if ((kk & 3) == 3) __builtin_amdgcn_sched_barrier(0);
            }
        }
        if (MASK) {
            FA_TILE(t, _kr0, _ki0, s0) (void)_kr0; (void)_ki0;
            if (t >= nctx_t) {
                const int tq = tq0 + 32 * w + r;
#pragma unroll
                for (int rt = 0; rt < 2; ++rt)
#pragma unroll
                    for (int i = 0; i < 16; ++i) {
                        const int s = s0 + 32 * rt + (i & 3) + 4 * ((i >> 2) & 1) + 8 * h + 16 * (i >> 3);
                        const int dlt = tq - s;
                        if (dlt > 128 || dlt < -128) st[rt][i] = -1.0e30f;
                    }
            }
        }
        float mx = m_run;
#pragma unroll
        for (int rt = 0; rt < 2; ++rt)
#pragma unroll
            for (int i = 0; i < 16; ++i) mx = fmaxf(mx, st[rt][i]);
        mx = fmaxf(mx, __shfl_xor(mx, 32));
        const float alpha = __builtin_amdgcn_exp2f(m_run - mx);
        m_run = mx;
        float ps = 0.f;
#pragma unroll
        for (int rt = 0; rt < 2; ++rt)
#pragma unroll
            for (int i = 0; i < 16; ++i) { const float p = __builtin_amdgcn_exp2f(st[rt][i] - mx); st[rt][i] = p; ps += p; }
        l_run = l_run * alpha + ps;
        if (!__all(alpha == 1.0f)) {
#pragma unroll
            for (int dt = 0; dt < NDT; ++dt)
#pragma unroll
                for (int i = 0; i < 16; ++i) O[dt][i] *= alpha;
        }
        if (t + 1 < ntile) { FA_LSTORE((t + 1) & 1, klds); FA_GLOADV(t + 1); }
        bf16x8 pf[2][2];
#pragma unroll
        for (int rt = 0; rt < 2; ++rt)
#pragma unroll
            for (int s2 = 0; s2 < 2; ++s2) {
                uint4 pk;
                pk.x = pack2(st[rt][8 * s2 + 0], st[rt][8 * s2 + 1]); pk.y = pack2(st[rt][8 * s2 + 2], st[rt][8 * s2 + 3]);
                pk.z = pack2(st[rt][8 * s2 + 4], st[rt][8 * s2 + 5]); pk.w = pack2(st[rt][8 * s2 + 6], st[rt][8 * s2 + 7]);
                pf[rt][s2] = __builtin_bit_cast(bf16x8, pk);
            }
#pragma unroll
        for (int dt = 0; dt < NDT; ++dt)
#pragma unroll
            for (int rt = 0; rt < 2; ++rt)
#pragma unroll
                for (int s2 = 0; s2 < 2; ++s2) {
                    const bf16x8 vf = *(const bf16x8*)(base + vfo + dt * 4096 + (((4 * rt + 2 * s2 + h) ^ vfs) << 4));
                    O[dt] = __builtin_amdgcn_mfma_f32_32x32x16_bf16(vf, pf[rt][s2], O[dt], 0, 0, 0);
                    if (rt == 1 && s2 == 1) __builtin_amdgcn_sched_barrier(0);
                }
        if (t + 1 < ntile) FA_LSTORE((t + 1) & 1, vlds);
        __syncthreads();
    }
#undef FA_TILE
#undef FA_GLOADK
#undef FA_GLOADV
#undef FA_LSTORE
    const float lt = l_run + __shfl_xor(l_run, 32);
    const float inv = 1.0f / lt;
    bf16_t* op = Orow0 + (size_t)(32 * w + r) * ldo + 4 * h;
#pragma unroll
    for (int dt = 0; dt < NDT; ++dt)
#pragma unroll
        for (int g = 0; g < 4; ++g) {
            uint2 o2; o2.x = pack2(O[dt][4 * g] * inv, O[dt][4 * g + 1] * inv); o2.y = pack2(O[dt][4 * g + 2] * inv, O[dt][4 * g + 3] * inv);
            *(uint2*)(op + 32 * dt + 8 * g) = o2;
        }
}
__device__ void ph_swa(int bid, int nb, const bf16_t* __restrict__ projS, const bf16_t* __restrict__ Vt, const float* __restrict__ sink,
                       bf16_t* __restrict__ mix, char* lds) {
    const int n_lat = NB * 8 * 32, n_ctx = NB * 8 * 2;
    for (int it = bid; it < n_lat + n_ctx; it += nb) {
        int b, hq, row0, lo, nlat, t0;
        if (it < n_lat) {
            const int qb = it & 31; hq = (it >> 5) & 7; b = it >> 8;
            t0 = qb * 128;
            lo = t0 - 128 < 0 ? 0 : t0 - 128;
            const int hi = t0 + 256 > SEQ ? SEQ : t0 + 256;
            nlat = (hi - lo) / 64; row0 = b * SEQ + t0;
        } else {
            const int i2 = it - n_lat, qb = i2 & 1; hq = (i2 >> 1) & 7; b = i2 >> 4;
            t0 = 0; lo = 0; nlat = 0; row0 = TL + b * LC + qb * 128;
        }
        const int kvh = hq >> 2;
        flash_item<64, true>(projS + (size_t)row0 * SWW + hq * 64, SWW, projS + 512 + kvh * 64, SWW, Vt + (size_t)(b * 2 + kvh) * 64 * NKEY,
                             TL + b * LC, b * SEQ, 4, lo, nlat, t0, sink[hq] * LOG2E, 1.0f, mix + (size_t)row0 * D + 512 + hq * 64, D, lds);
    }
}
__device__ void ph_dense(int bid, int nb, const bf16_t* __restrict__ projG, const bf16_t* __restrict__ Vt, bf16_t* __restrict__ mix, char* lds) {
    const bool sw = (nb & 7) == 0;
    const int nit = NB * 8 * 32;
    for (int j = sw ? (bid >> 3) : bid; j < (sw ? nit / 8 : nit); j += sw ? (nb >> 3) : nb) {
        int g, jj;
        if (sw) { g = (bid & 7) + 8 * (j >> 7); jj = j & 127; } else { g = j >> 7; jj = j & 127; }
        const int b = g >> 1, kvh = g & 1, hq = kvh * 4 + (jj >> 5), qb = jj & 31;
        const int row0 = b * SEQ + qb * 128;
        flash_item<128, false>(projG + (size_t)row0 * GA_IN + hq * 128, GA_IN, projG + 1024 + kvh * 128, GA_IN, Vt + (size_t)(b * 2 + kvh) * 128 * NKEY,
                               TL + b * LC, b * SEQ, 4, 0, SEQ / 64, 0, -1.0e30f, 0.0f, mix + (size_t)row0 * D + hq * 128, D, lds);
    }
}

__device__ void ph_peer_combine(int bid, int nb, const float* __restrict__ tsc, const int* __restrict__ tix, int* __restrict__ sel_e, float* __restrict__ sel_g, int ntok) {
    const int lane = threadIdx.x & 63, wid = threadIdx.x >> 6;
    for (int it = bid * 4 + wid; it < ntok * 8; it += nb * 4) {
        const size_t b1 = (size_t)it * 32, b2 = b1 + 16;
        const float s2 = tsc[b2 + (lane & 15)];
        float cv[4];
#pragma unroll
        for (int u = 0; u < 4; ++u) cv[u] = tsc[b1 + (lane >> 4) + 4 * u] + s2;
        float mysc = 0.f; int myc = 0;
        for (int j = 0; j < 16; ++j) {
            float bv = cv[0]; int bc = ((lane >> 4)) * 16 + (lane & 15);
#pragma unroll
            for (int u = 1; u < 4; ++u) { const int c = ((lane >> 4) + 4 * u) * 16 + (lane & 15); if (cv[u] > bv) { bv = cv[u]; bc = c; } }
#pragma unroll
            for (int o = 32; o >= 1; o >>= 1) {
                const float ov = __shfl_xor(bv, o); const int oc = __shfl_xor(bc, o);
                if (ov > bv || (ov == bv && oc < bc)) { bv = ov; bc = oc; }
            }
#pragma unroll
            for (int u = 0; u < 4; ++u) { const int c = ((lane >> 4) + 4 * u) * 16 + (lane & 15); if (c == bc) cv[u] = -3.0e38f; }
            if (lane == j) { mysc = bv; myc = bc; }
        }
        const float top = __shfl(mysc, 0);
        float e = lane < 16 ? __expf(mysc - top) : 0.f;
        float sum = e;
#pragma unroll
        for (int o = 8; o >= 1; o >>= 1) sum += __shfl_xor(sum, o);
        if (lane < 16) {
            const int ex = tix[b1 + (myc >> 4)] * 128 + tix[b2 + (myc & 15)];
            sel_e[(size_t)it * 16 + lane] = ex;
            sel_g[(size_t)it * 16 + lane] = e / sum;
        }
    }
}
__device__ void ph_peer_gather(int bid, int nb, const bf16_t* __restrict__ xf  , const bf16_t* __restrict__ U, const bf16_t* __restrict__ V,
                               const int* __restrict__ sel_e, const float* __restrict__ sel_g, const float* __restrict__ gate  ,
                               float* __restrict__ hlat, float* __restrict__ hctx, int ntok) {
    const int lane = threadIdx.x & 63, wid = threadIdx.x >> 6;
    for (int row = bid * 4 + wid; row < ntok; row += nb * 4) {
        float x[16], y[16];
#pragma unroll
        for (int i = 0; i < 2; ++i) {
            const uint4 w = *(const uint4*)(xf + (size_t)row * D + (lane + 64 * i) * 8);
            const unsigned ww[4] = {w.x, w.y, w.z, w.w};
#pragma unroll
            for (int j = 0; j < 4; ++j) { x[i * 8 + j * 2] = __uint_as_float(ww[j] << 16); x[i * 8 + j * 2 + 1] = __uint_as_float(ww[j] & 0xffff0000u); }
        }
#pragma unroll
        for (int i = 0; i < 16; ++i) y[i] = 0.f;
        const int my_e0 = sel_e[(size_t)row * 128 + lane], my_e1 = sel_e[(size_t)row * 128 + 64 + lane];
        const float my_g0 = sel_g[(size_t)row * 128 + lane], my_g1 = sel_g[(size_t)row * 128 + 64 + lane];
        for (int k = 0; k < 128; ++k) {
            const int e = __shfl(k < 64 ? my_e0 : my_e1, k & 63);
            const float g = __shfl(k < 64 ? my_g0 : my_g1, k & 63);
            const bf16_t* ur = U + (size_t)e * D;
            float part = 0.f;
#pragma unroll
            for (int i = 0; i < 2; ++i) {
                const uint4 w = *(const uint4*)(ur + (lane + 64 * i) * 8);
                const unsigned ww[4] = {w.x, w.y, w.z, w.w};
#pragma unroll
                for (int j = 0; j < 4; ++j) { part += x[i * 8 + j * 2] * __uint_as_float(ww[j] << 16); part += x[i * 8 + j * 2 + 1] * __uint_as_float(ww[j] & 0xffff0000u); }
            }
            const float dot = wave_sum(part);
            const float act = 0.5f * dot * (1.0f + erff(dot * 0.70710678118654752f));
            const float wgt = g * act;
            const bf16_t* vr = V + (size_t)e * D;
#pragma unroll
            for (int i = 0; i < 2; ++i) {
                const uint4 w = *(const uint4*)(vr + (lane + 64 * i) * 8);
                const unsigned ww[4] = {w.x, w.y, w.z, w.w};
#pragma unroll
                for (int j = 0; j < 4; ++j) { y[i * 8 + j * 2] += wgt * __uint_as_float(ww[j] << 16); y[i * 8 + j * 2 + 1] += wgt * __uint_as_float(ww[j] & 0xffff0000u); }
            }
        }
        float* hp = row < TL ? hlat + (size_t)row * D : hctx + (size_t)(row - TL) * D;
        const float* gg = gate + (size_t)mod_row(row) * 6144;
#pragma unroll
        for (int i = 0; i < 2; ++i) {
            const int col = (lane + 64 * i) * 8;
#pragma unroll
            for (int j = 0; j < 2; ++j) {
                float4 h = *(float4*)(hp + col + j * 4); const float4 g4 = *(const float4*)(gg + col + j * 4);
                h.x += g4.x * y[i * 8 + j * 4 + 0]; h.y += g4.y * y[i * 8 + j * 4 + 1]; h.z += g4.z * y[i * 8 + j * 4 + 2]; h.w += g4.w * y[i * 8 + j * 4 + 3];
                *(float4*)(hp + col + j * 4) = h;
            }
        }
    }
}
__device__ void ph_final(int bid, int nb, float* __restrict__ h, const float* __restrict__ g) {
    const int lane = threadIdx.x & 63, wid = threadIdx.x >> 6;
    for (int row = bid * 4 + wid; row < TL; row += nb * 4) {
        float4* p = (float4*)(h + (size_t)row * D);
        float4 x[4]; float ss = 0.f;
#pragma unroll
        for (int i = 0; i < 4; ++i) { x[i] = p[i * 64 + lane]; ss += x[i].x * x[i].x + x[i].y * x[i].y + x[i].z * x[i].z + x[i].w * x[i].w; }
        ss = wave_sum(ss);
        const float rinv = rsqrtf(ss * (1.0f / D) + EPS);
#pragma unroll
        for (int i = 0; i < 4; ++i) {
            const float4 gg = ((const float4*)g)[i * 64 + lane];
            float4 o; o.x = x[i].x * rinv * gg.x; o.y = x[i].y * rinv * gg.y; o.z = x[i].z * rinv * gg.z; o.w = x[i].w * rinv * gg.w;
            p[i * 64 + lane] = o;
        }
    }
}

struct Params {
    const float *x, *c, *ctx, *c_ctx, *ada_w, *ada_b, *norm_mix_g, *norm_ffn_g, *ab_w_in, *ab_w_out, *hg_lb, *hg_norm_g, *sw_sink,
        *ga_w_in, *ga_w_out, *ga_qn, *ga_kn, *peer_wq, *peer_sk, *peer_u, *peer_v, *final_g;
    float* out; char* ws;
};
extern __shared__ __attribute__((aligned(16))) char dyn_lds[];

#define WSP(T, off) ((T*)(p.ws + (off)))

namespace cg = cooperative_groups;
constexpr int MEGA_LDS = 65536;
__global__ void __launch_bounds__(256, 2) k_mega(Params p) {
    cg::grid_group grid = cg::this_grid();
    const int bid = blockIdx.x, nb = gridDim.x;
    char* lds = dyn_lds;
    float* ldf = (float*)dyn_lds;
    float* mod0 = WSP(float, OFF_MOD);
    float* mod1 = mod0 + (size_t)9 * 6144;
    float* hctx = WSP(float, OFF_HCTX);
    bf16_t* abuf = WSP(bf16_t, OFF_A);
    bf16_t* mix = WSP(bf16_t, OFF_MIX);
    ph_transpose(bid, nb, p.ab_w_in, WSP(bf16_t, OFF_WABIN), D, AB_IN, ldf);
    ph_transpose(bid, nb, p.ab_w_out, WSP(bf16_t, OFF_WABOUT), D, D, ldf);
    ph_transpose(bid, nb, p.ga_w_in, WSP(bf16_t, OFF_WGAIN), D, GA_IN, ldf);
    ph_transpose(bid, nb, p.ga_w_out, WSP(bf16_t, OFF_WGAOUT), D, D, ldf);
    ph_transpose(bid, nb, p.peer_wq, WSP(bf16_t, OFF_WPQ), D, PQ, ldf);
    ph_transpose(bid, nb, p.peer_wq + (size_t)D * PQ, WSP(bf16_t, OFF_WPQ) + (size_t)PQ * D, D, PQ, ldf);
    ph_cvt(bid, nb, p.peer_sk, WSP(bf16_t, OFF_SK), (size_t)2 * 8 * 2 * 128 * 128);
    ph_tables(bid, nb, WSP(float, OFF_COSS), WSP(float, OFF_SINS), WSP(float, OFF_COSG), WSP(float, OFF_SING), p.hg_lb, WSP(float, OFF_LB));
    __syncthreads();
    ph_mod(bid, nb, p.c, p.c_ctx, p.ada_w, p.ada_b, mod0, ldf);
    ph_cvt(bid, nb, p.peer_u, WSP(bf16_t, OFF_U16), (size_t)NEXP * D);
    ph_cvt(bid, nb, p.peer_v, WSP(bf16_t, OFF_V16), (size_t)NEXP * D);
    grid.sync();
    ph_normmod(bid, nb, p.x, p.ctx, p.norm_mix_g, mod0, 1 * D, 0, abuf, TA);
    grid.sync();
    { EpiStoreSplit e{WSP(bf16_t, OFF_PROJH), HGW, WSP(bf16_t, OFF_PROJS), SWW, HGW};
      ph_gemm(bid, nb, abuf, D, WSP(bf16_t, OFF_WABIN), D, TA, AB_IN, D, lds, e); }
    grid.sync();
    ph_prep_swa(bid, nb, WSP(bf16_t, OFF_PROJS), WSP(float, OFF_COSS), WSP(float, OFF_SINS));
    ph_vt<64>(bid, nb, WSP(bf16_t, OFF_PROJS), SWW, 640, WSP(bf16_t, OFF_VT), (bf16_t*)lds);
    grid.sync();
    {
        const int hgb = nb >= 256 ? 128 : nb / 2;
        if (bid < hgb) ph_hgrn(bid, hgb, WSP(bf16_t, OFF_PROJH), WSP(float, OFF_LB), WSP(bf16_t, OFF_OF), WSP(bf16_t, OFF_OB), lds);
        else ph_swa(bid - hgb, nb - hgb, WSP(bf16_t, OFF_PROJS), WSP(bf16_t, OFF_VT), p.sw_sink, mix, lds);
    }
    grid.sync();
    ph_hgpost(bid, nb, WSP(bf16_t, OFF_OF), WSP(bf16_t, OFF_OB), WSP(bf16_t, OFF_PROJH), p.hg_norm_g, mix);
    grid.sync();
    { EpiResid e{p.x, p.ctx, p.out, hctx, mod0 + 2 * D};
      ph_gemm(bid, nb, mix, D, WSP(bf16_t, OFF_WABOUT), D, TA, D, D, lds, e); }
    grid.sync();
    ph_normmod(bid, nb, p.out, hctx, p.norm_ffn_g, mod0, 4 * D, 3 * D, abuf, TA);
    grid.sync();
    { EpiStoreSplit e{WSP(bf16_t, OFF_QPEER), PQ, WSP(bf16_t, OFF_QPEER), PQ, 1 << 30};
      ph_gemm(bid, nb, abuf, D, WSP(bf16_t, OFF_WPQ), D, TA, PQ, D, lds, e); }
    grid.sync();
    ph_peer_scores(bid, nb, WSP(bf16_t, OFF_QPEER), WSP(bf16_t, OFF_SK), WSP(float, OFF_TSC), WSP(int, OFF_TIX), TA, lds);
    grid.sync();
    ph_peer_combine(bid, nb, WSP(float, OFF_TSC), WSP(int, OFF_TIX), WSP(int, OFF_SELE), WSP(float, OFF_SELG), TA);
    grid.sync();
    ph_peer_gather(bid, nb, abuf, WSP(bf16_t, OFF_U16), WSP(bf16_t, OFF_V16), WSP(int, OFF_SELE), WSP(float, OFF_SELG), mod0 + 5 * D, p.out, hctx, TA);
    grid.sync();
    ph_cvt(bid, nb, p.peer_u + (size_t)NEXP * D, WSP(bf16_t, OFF_U16), (size_t)NEXP * D);
    ph_cvt(bid, nb, p.peer_v + (size_t)NEXP * D, WSP(bf16_t, OFF_V16), (size_t)NEXP * D);
    ph_normmod(bid, nb, p.out, hctx, p.norm_mix_g + D, mod1, 1 * D, 0, abuf, TA);
    grid.sync();
    { EpiStoreSplit e{WSP(bf16_t, OFF_PROJ), GA_IN, WSP(bf16_t, OFF_PROJ), GA_IN, 1 << 30};
      ph_gemm(bid, nb, abuf, D, WSP(bf16_t, OFF_WGAIN), D, TA, GA_IN, D, lds, e); }
    grid.sync();
    ph_prep_ga(bid, nb, WSP(bf16_t, OFF_PROJ), p.ga_qn, p.ga_kn, WSP(float, OFF_COSG), WSP(float, OFF_SING));
    ph_vt<128>(bid, nb, WSP(bf16_t, OFF_PROJ), GA_IN, 1280, WSP(bf16_t, OFF_VT), (bf16_t*)lds);
    grid.sync();
    ph_dense(bid, nb, WSP(bf16_t, OFF_PROJ), WSP(bf16_t, OFF_VT), mix, lds);
    grid.sync();
    { EpiResid e{p.out, hctx, p.out, hctx, mod1 + 2 * D};
      ph_gemm(bid, nb, mix, D, WSP(bf16_t, OFF_WGAOUT), D, TL, D, D, lds, e); }
    grid.sync();
    ph_normmod(bid, nb, p.out, hctx, p.norm_ffn_g + D, mod1, 4 * D, 3 * D, abuf, TL);
    grid.sync();
    { EpiStoreSplit e{WSP(bf16_t, OFF_QPEER), PQ, WSP(bf16_t, OFF_QPEER), PQ, 1 << 30};
      ph_gemm(bid, nb, abuf, D, WSP(bf16_t, OFF_WPQ) + (size_t)PQ * D, D, TL, PQ, D, lds, e); }
    grid.sync();
    ph_peer_scores(bid, nb, WSP(bf16_t, OFF_QPEER), WSP(bf16_t, OFF_SK) + (size_t)16 * 128 * 128, WSP(float, OFF_TSC), WSP(int, OFF_TIX), TL, lds);
    grid.sync();
    ph_peer_combine(bid, nb, WSP(float, OFF_TSC), WSP(int, OFF_TIX), WSP(int, OFF_SELE), WSP(float, OFF_SELG), TL);
    grid.sync();
    ph_peer_gather(bid, nb, abuf, WSP(bf16_t, OFF_U16), WSP(bf16_t, OFF_V16), WSP(int, OFF_SELE), WSP(float, OFF_SELG), mod1 + 5 * D, p.out, hctx, TL);
    grid.sync();
    ph_final(bid, nb, p.out, p.final_g);
}

extern "C" void kernel_launch(void* const* d_in, const int* in_sizes, int n_in, void* d_out, int out_size, void* d_ws, size_t ws_size,
                              hipStream_t stream) {
    Params p{};
    p.x = (const float*)d_in[0]; p.c = (const float*)d_in[1]; p.ctx = (const float*)d_in[2]; p.c_ctx = (const float*)d_in[3];
    p.ada_w = (const float*)d_in[4]; p.ada_b = (const float*)d_in[5]; p.norm_mix_g = (const float*)d_in[6]; p.norm_ffn_g = (const float*)d_in[7];
    p.ab_w_in = (const float*)d_in[8]; p.ab_w_out = (const float*)d_in[9]; p.hg_lb = (const float*)d_in[10]; p.hg_norm_g = (const float*)d_in[11];
    p.sw_sink = (const float*)d_in[12]; p.ga_w_in = (const float*)d_in[13]; p.ga_w_out = (const float*)d_in[14]; p.ga_qn = (const float*)d_in[15];
    p.ga_kn = (const float*)d_in[16]; p.peer_wq = (const float*)d_in[17]; p.peer_sk = (const float*)d_in[18]; p.peer_u = (const float*)d_in[19];
    p.peer_v = (const float*)d_in[20]; p.final_g = (const float*)d_in[21];
    p.out = (float*)d_out; p.ws = (char*)d_ws;
    if (ws_size < WS_NEED) { fprintf(stderr, "workspace too small: %zu < %zu\n", ws_size, WS_NEED); return; }
    static int grid_blocks = 0;
    if (!grid_blocks) {
        int dev = 0, cus = 0, per_cu = 0;
        (void)hipGetDevice(&dev);
        (void)hipDeviceGetAttribute(&cus, hipDeviceAttributeMultiprocessorCount, dev);
        (void)hipFuncSetAttribute((const void*)k_mega, hipFuncAttributeMaxDynamicSharedMemorySize, MEGA_LDS);
        (void)hipOccupancyMaxActiveBlocksPerMultiprocessor(&per_cu, k_mega, 256, MEGA_LDS);
        if (per_cu > 2) per_cu = 2;
        if (per_cu < 1) per_cu = 1;
        grid_blocks = cus * per_cu;
    }
    void* args[] = {&p};
    hipError_t e = hipLaunchCooperativeKernel((const void*)k_mega, dim3(grid_blocks), dim3(256), args, MEGA_LDS, stream);
    if (e != hipSuccess) fprintf(stderr, "cooperative launch failed: %s (grid %d)\n", hipGetErrorString(e), grid_blocks);
}
```

```cpp
#include <hip/hip_runtime.h>
#include <hip/hip_cooperative_groups.h>
#include <stdint.h>
#include <stdio.h>

typedef unsigned short bf16_t;
typedef short bf16x8 __attribute__((ext_vector_type(8)));
typedef float f32x4 __attribute__((ext_vector_type(4)));

constexpr int D = 1024, NB = 8, SEQ = 4096, LC = 256;
constexpr int TL = NB * SEQ;
constexpr int TC = NB * LC;
constexpr int TA = TL + TC;
constexpr int AB_IN = 3328, HGW = 2560, SWW = 768, GA_IN = 1536, PQ = 2048;
constexpr int NEXP = 16384;
constexpr float EPS = 1e-6f;
constexpr float LOG2E = 1.4426950408889634f;
constexpr int NKEY = LC + SEQ;

constexpr size_t OFF_WABIN = 0;
constexpr size_t OFF_WABOUT = OFF_WABIN + (size_t)AB_IN * D * 2;
constexpr size_t OFF_WGAIN = OFF_WABOUT + (size_t)D * D * 2;
constexpr size_t OFF_WGAOUT = OFF_WGAIN + (size_t)GA_IN * D * 2;
constexpr size_t OFF_WPQ = OFF_WGAOUT + (size_t)D * D * 2;
constexpr size_t OFF_SK = OFF_WPQ + (size_t)2 * PQ * D * 2;
constexpr size_t OFF_MOD = OFF_SK + (size_t)2 * 8 * 2 * 128 * 128 * 2;
constexpr size_t OFF_COSS = OFF_MOD + (size_t)2 * 9 * 6144 * 4;
constexpr size_t OFF_SINS = OFF_COSS + (size_t)SEQ * 32 * 4;
constexpr size_t OFF_COSG = OFF_SINS + (size_t)SEQ * 32 * 4;
constexpr size_t OFF_SING = OFF_COSG + (size_t)SEQ * 64 * 4;
constexpr size_t OFF_LB = OFF_SING + (size_t)SEQ * 64 * 4;
constexpr size_t OFF_U16 = OFF_LB + 2048;
constexpr size_t OFF_V16 = OFF_U16 + (size_t)NEXP * D * 2;
constexpr size_t OFF_HCTX = OFF_V16 + (size_t)NEXP * D * 2;
constexpr size_t OFF_A = OFF_HCTX + (size_t)TC * D * 4;
constexpr size_t OFF_PROJ = OFF_A + (size_t)TA * D * 2;
constexpr size_t OFF_MIX = OFF_PROJ + (size_t)TA * AB_IN * 2;
constexpr size_t OFF_SEL = OFF_MIX + (size_t)TA * D * 2;
constexpr size_t WS_NEED = OFF_SEL + (size_t)TA * 128 * 8;
static_assert(WS_NEED <= (size_t)536870912, "workspace over 512 MiB");
constexpr size_t OFF_OF = OFF_A;
constexpr size_t OFF_OB = OFF_A + (size_t)TA * 512 * 2;
constexpr size_t OFF_PROJH = OFF_PROJ;
constexpr size_t OFF_PROJS = OFF_PROJ + (size_t)TA * HGW * 2;
constexpr size_t OFF_QPEER = OFF_PROJ;
constexpr size_t OFF_TSC = OFF_QPEER + (size_t)TA * PQ * 2;
constexpr size_t OFF_TIX = OFF_TSC + (size_t)TA * 256 * 4;
static_assert(OFF_TIX + (size_t)TA * 256 * 4 <= OFF_MIX, "peer scratch overflows proj region");
constexpr size_t OFF_VT = OFF_SEL;
static_assert((size_t)NB * 2 * 128 * NKEY * 2 <= (size_t)TA * 128 * 8, "Vt overflows SEL region");
constexpr size_t OFF_SELE = OFF_SEL;
constexpr size_t OFF_SELG = OFF_SEL + (size_t)TA * 128 * 4;

__device__ __forceinline__ float bf2f(bf16_t v) { return __uint_as_float(((unsigned)v) << 16); }
__device__ __forceinline__ bf16_t f2bf(float f) {
    unsigned u = __float_as_uint(f);
    u += 0x7fffu + ((u >> 16) & 1u);
    return (bf16_t)(u >> 16);
}
typedef float f32x2 __attribute__((ext_vector_type(2)));
typedef float f32x16 __attribute__((ext_vector_type(16)));
typedef __bf16 bf16x2_t __attribute__((ext_vector_type(2)));
__device__ __forceinline__ unsigned pack2(float lo, float hi) { f32x2 v = {lo, hi}; return __builtin_bit_cast(unsigned, __builtin_convertvector(v, bf16x2_t)); }
__device__ __forceinline__ float sigmoidf_(float x) { return 1.0f / (1.0f + __expf(-x)); }
__device__ __forceinline__ float siluf_(float x) { return x * sigmoidf_(x); }
__device__ __forceinline__ float wave_sum(float v) {
#pragma unroll
    for (int o = 32; o >= 1; o >>= 1) v += __shfl_xor(v, o);
    return v;
}
__device__ __forceinline__ int mod_row(int row) { return row < TL ? (row >> 12) : 8; }

__device__ void ph_transpose(int bid, int nb, const float* __restrict__ in, bf16_t* __restrict__ out, int K, int N, float* lds) {
    const int tk = K / 32, tn = N / 32, nt = tk * tn;
    const int tx = threadIdx.x & 31, ty = threadIdx.x >> 5;
    for (int t = bid; t < nt; t += nb) {
        const int k0 = (t / tn) * 32, n0 = (t % tn) * 32;
        __syncthreads();
#pragma unroll
        for (int i = 0; i < 4; ++i) lds[(ty + i * 8) * 33 + tx] = in[(size_t)(k0 + ty + i * 8) * N + n0 + tx];
        __syncthreads();
#pragma unroll
        for (int i = 0; i < 4; ++i) out[(size_t)(n0 + ty + i * 8) * K + k0 + tx] = f2bf(lds[tx * 33 + ty + i * 8]);
    }
}
__device__ void ph_cvt(int bid, int nb, const float* __restrict__ in, bf16_t* __restrict__ out, size_t n) {
    const size_t n8 = n / 8;
    for (size_t i = (size_t)bid * blockDim.x + threadIdx.x; i < n8; i += (size_t)nb * blockDim.x) {
        const float4 a = ((const float4*)in)[i * 2], b = ((const float4*)in)[i * 2 + 1];
        uint4 w; w.x = pack2(a.x, a.y); w.y = pack2(a.z, a.w); w.z = pack2(b.x, b.y); w.w = pack2(b.z, b.w);
        ((uint4*)out)[i] = w;
    }
}
__device__ void ph_mod(int bid, int nb, const float* __restrict__ c, const float* __restrict__ c_ctx, const float* __restrict__ ada_w,
                       const float* __restrict__ ada_b, float* __restrict__ mod, float* lds) {
    float* s = lds;
    float* red = lds + 9 * 1024;
    const int tx = threadIdx.x & 63, ky = threadIdx.x >> 6;
    for (int i = threadIdx.x; i < 9 * 1024; i += 256) {
        const int r = i >> 10, k = i & 1023;
        const float v = r < 8 ? c[r * 1024 + k] : c_ctx[k];
        s[i] = siluf_(v);
    }
    __syncthreads();
    const int nitems = 2 * 96;
    for (int it = bid; it < nitems; it += nb) {
        const int layer = it / 96, n = (it % 96) * 64 + tx;
        const float* w = ada_w + (size_t)layer * 1024 * 6144 + n;
        float acc[9];
#pragma unroll
        for (int r = 0; r < 9; ++r) acc[r] = 0.f;
        for (int k = ky * 256; k < ky * 256 + 256; ++k) {
            const float wv = w[(size_t)k * 6144];
#pragma unroll
            for (int r = 0; r < 9; ++r) acc[r] += s[r * 1024 + k] * wv;
        }
        __syncthreads();
#pragma unroll
        for (int r = 0; r < 9; ++r) red[(ky * 9 + r) * 64 + tx] = acc[r];
        __syncthreads();
        if (ky == 0) {
#pragma unroll
            for (int r = 0; r < 9; ++r) {
                const float v = red[(0 * 9 + r) * 64 + tx] + red[(1 * 9 + r) * 64 + tx] + red[(2 * 9 + r) * 64 + tx] + red[(3 * 9 + r) * 64 + tx];
                mod[((size_t)layer * 9 + r) * 6144 + n] = v + ada_b[layer * 6144 + n];
            }
        }
    }
}
__device__ void ph_tables(int bid, int nb, float* cosS, float* sinS, float* cosG, float* sinG, const float* __restrict__ lb_logits, float* lb) {
    const int gt = bid * blockDim.x + threadIdx.x, gs = nb * blockDim.x;
    for (int i = gt; i < SEQ * 32; i += gs) {
        const int t = i >> 5, j = i & 31;
        const float pos = (float)(j < 16 ? (t >> 6) : (t & 63));
        const float inv = powf(10000.0f, -(float)(j & 15) / 16.0f);
        const float ang = pos * inv;
        cosS[i] = cosf(ang); sinS[i] = sinf(ang);
    }
    for (int i = gt; i < SEQ * 64; i += gs) {
        const int t = i >> 6, j = i & 63;
        const float pos = (float)(j < 32 ? (t >> 6) : (t & 63));
        const float inv = powf(10000.0f, -(float)(j & 31) / 32.0f);
        const float ang = pos * inv;
        cosG[i] = cosf(ang); sinG[i] = sinf(ang);
    }
    for (int i = gt; i < 512; i += gs) {
        const float l0 = lb_logits[i], l1 = lb_logits[512 + i];
        lb[i] = 1.0f / (1.0f + expf(l1 - l0));
    }
}

__device__ void ph_normmod(int bid, int nb, const float* __restrict__ hlat, const float* __restrict__ hctx, const float* __restrict__ gamma,
                           const float* __restrict__ modl  , int sc_off, int sh_off, bf16_t* __restrict__ out, int nrows) {
    const int lane = threadIdx.x & 63, wid = threadIdx.x >> 6;
    for (int row = bid * 4 + wid; row < nrows; row += nb * 4) {
        const float* src = row < TL ? hlat + (size_t)row * D : hctx + (size_t)(row - TL) * D;
        const float* m = modl + (size_t)mod_row(row) * 6144;
        float4 x[4]; float ss = 0.f;
#pragma unroll
        for (int i = 0; i < 4; ++i) { x[i] = ((const float4*)src)[i * 64 + lane]; ss += x[i].x * x[i].x + x[i].y * x[i].y + x[i].z * x[i].z + x[i].w * x[i].w; }
        ss = wave_sum(ss);
        const float rinv = rsqrtf(ss * (1.0f / D) + EPS);
#pragma unroll
        for (int i = 0; i < 4; ++i) {
            const int col = (i * 64 + lane) * 4;
            const float4 g = *(const float4*)(gamma + col), sc = *(const float4*)(m + sc_off + col), sh = *(const float4*)(m + sh_off + col);
            const float y0 = x[i].x * rinv * g.x * (1.f + sc.x) + sh.x, y1 = x[i].y * rinv * g.y * (1.f + sc.y) + sh.y;
            const float y2 = x[i].z * rinv * g.z * (1.f + sc.z) + sh.z, y3 = x[i].w * rinv * g.w * (1.f + sc.w) + sh.w;
            uint2 w; w.x = pack2(y0, y1); w.y = pack2(y2, y3);
            *(uint2*)(out + (size_t)row * D + col) = w;
        }
    }
}

constexpr int GEMM_LDS = 65536;
template <class Epi>
__device__ __forceinline__ void gemm_tile(const bf16_t* __restrict__ A, int lda, const bf16_t* __restrict__ Bt, int ldb, int K,
                                          int m0, int n0, char* lds, Epi& epi) {
    const int tid = threadIdx.x, lane = tid & 63, wid = tid >> 6, wr = wid >> 1, wc = wid & 1, fr = lane & 15, fq = lane >> 4;
    f32x4 acc[4][4];
#pragma unroll
    for (int i = 0; i < 4; ++i)
#pragma unroll
        for (int j = 0; j < 4; ++j) acc[i][j] = (f32x4){0.f, 0.f, 0.f, 0.f};
    const int nk = K / 64;
    const int sr0 = tid >> 3, sc0 = tid & 7;
    const bf16_t* ga = A + (size_t)(m0 + sr0) * lda + sc0 * 8;
    const bf16_t* gb = Bt + (size_t)(n0 + sr0) * ldb + sc0 * 8;
    const int soff = sr0 * 128 + ((sc0 ^ (sr0 & 7)) << 4);
    uint4 pa0, pa1, pa2, pa3, pb0, pb1, pb2, pb3, qa0, qa1, qa2, qa3, qb0, qb1, qb2, qb3;
#define GT_GLOAD(S, kt) do { const int _ko = (kt) * 64; \
        S##a0 = *(const uint4*)(ga + _ko); S##a1 = *(const uint4*)(ga + (size_t)32 * lda + _ko); \
        S##a2 = *(const uint4*)(ga + (size_t)64 * lda + _ko); S##a3 = *(const uint4*)(ga + (size_t)96 * lda + _ko); \
        S##b0 = *(const uint4*)(gb + _ko); S##b1 = *(const uint4*)(gb + (size_t)32 * ldb + _ko); \
        S##b2 = *(const uint4*)(gb + (size_t)64 * ldb + _ko); S##b3 = *(const uint4*)(gb + (size_t)96 * ldb + _ko); } while (0)
#define GT_LSTORE(S, buf) do { char* _b = lds + (buf) * 32768 + soff; \
        *(uint4*)(_b) = S##a0; *(uint4*)(_b + 4096) = S##a1; *(uint4*)(_b + 8192) = S##a2; *(uint4*)(_b + 12288) = S##a3; \
        *(uint4*)(_b + 16384) = S##b0; *(uint4*)(_b + 16384 + 4096) = S##b1; *(uint4*)(_b + 16384 + 8192) = S##b2; *(uint4*)(_b + 16384 + 12288) = S##b3; } while (0)
#define GT_COMPUTE(buf) do { const char* base = lds + (buf) * 32768; \
        _Pragma("unroll") for (int kk = 0; kk < 2; ++kk) { \
            bf16x8 af[4], bfr[4]; \
            _Pragma("unroll") for (int i = 0; i < 4; ++i) { \
                const int ar = wr * 64 + i * 16 + fr, br = wc * 64 + i * 16 + fr; const int c = kk * 4 + fq; \
                af[i] = *(const bf16x8*)(base + ar * 128 + ((c ^ (ar & 7)) << 4)); \
                bfr[i] = *(const bf16x8*)(base + 16384 + br * 128 + ((c ^ (br & 7)) << 4)); } \
            _Pragma("unroll") for (int i = 0; i < 4; ++i) \
                _Pragma("unroll") for (int j = 0; j < 4; ++j) acc[i][j] = __builtin_amdgcn_mfma_f32_16x16x32_bf16(bfr[j], af[i], acc[i][j], 0, 0, 0); } } while (0)
    __syncthreads();
    GT_GLOAD(p, 0);
    if (nk > 1) GT_GLOAD(q, 1);
    GT_LSTORE(p, 0);
    __syncthreads();
    for (int kt = 0; kt < nk; kt += 2) {
        if (kt + 2 < nk) GT_GLOAD(p, kt + 2);
        __builtin_amdgcn_sched_barrier(0);
        GT_COMPUTE(0);
        __builtin_amdgcn_sched_barrier(0);
        GT_LSTORE(q, 1);
        __syncthreads();
        if (kt + 3 < nk) GT_GLOAD(q, kt + 3);
        __builtin_amdgcn_sched_barrier(0);
        GT_COMPUTE(1);
        __builtin_amdgcn_sched_barrier(0);
        if (kt + 2 < nk) GT_LSTORE(p, 0);
        __syncthreads();
    }
#undef GT_GLOAD
#undef GT_LSTORE
#undef GT_COMPUTE
    epi(acc, m0 + wr * 64 + fr, n0 + wc * 64 + fq * 4, lds);
}

struct EpiStoreSplit {
    bf16_t* O1; int ld1; bf16_t* O2; int ld2; int split;
    __device__ __forceinline__ void operator()(f32x4 (&acc)[4][4], int row0, int col0, char*) const {
#pragma unroll
        for (int i = 0; i < 4; ++i)
#pragma unroll
            for (int j = 0; j < 4; ++j) {
                const int row = row0 + i * 16, col = col0 + j * 16;
                uint2 w; w.x = pack2(acc[i][j][0], acc[i][j][1]); w.y = pack2(acc[i][j][2], acc[i][j][3]);
                if (col < split) *(uint2*)(O1 + (size_t)row * ld1 + col) = w;
                else *(uint2*)(O2 + (size_t)row * ld2 + (col - split)) = w;
            }
    }
};
struct EpiResid {
    const float* hin_lat; const float* hin_ctx; float* hout_lat; float* hout_ctx; const float* gate  ;
    __device__ __forceinline__ void operator()(f32x4 (&acc)[4][4], int row0, int col0, char*) const {
#pragma unroll
        for (int i = 0; i < 4; ++i) {
            const int row = row0 + i * 16;
            const float* hi = row < TL ? hin_lat + (size_t)row * D : hin_ctx + (size_t)(row - TL) * D;
            float* ho = row < TL ? hout_lat + (size_t)row * D : hout_ctx + (size_t)(row - TL) * D;
            const float* g = gate + (size_t)mod_row(row) * 6144;
#pragma unroll
            for (int j = 0; j < 4; ++j) {
                const int col = col0 + j * 16;
                const float4 h = *(const float4*)(hi + col), gg = *(const float4*)(g + col);
                float4 o; o.x = h.x + gg.x * acc[i][j][0]; o.y = h.y + gg.y * acc[i][j][1]; o.z = h.z + gg.z * acc[i][j][2]; o.w = h.w + gg.w * acc[i][j][3];
                *(float4*)(ho + col) = o;
            }
        }
    }
};
template <class Epi>
__device__ void ph_gemm(int bid, int nb, const bf16_t* A, int lda, const bf16_t* Bt, int ldb, int M, int N, int K, char* lds, Epi epi) {
    const int tm = M / 128, tn = N / 128;
    for (int t = bid; t < tm * tn; t += nb) {
        const int m0 = (t / tn) * 128, n0 = (t % tn) * 128;
        gemm_tile(A, lda, Bt, ldb, K, m0, n0, lds, epi);
    }
}
typedef short bf16x4 __attribute__((ext_vector_type(4)));
constexpr int HQ_OFF = 0, HK_OFF = 16384, HKT_OFF = 32768, HVT_OFF = 49152, HD_OFF = 57344, HG_LDS = 59392;
__device__ __forceinline__ int hg_row(int b, int dir, int p) {
    if (p < LC) { const int s = dir ? (LC - 1 - p) : p; return TL + b * LC + s; }
    const int t = dir ? (SEQ - 1 - (p - LC)) : (p - LC);
    return b * SEQ + t;
}
__device__ void ph_hgrn(int bid, int nb, const bf16_t* __restrict__ projH, const float* __restrict__ lb, bf16_t* __restrict__ of, bf16_t* __restrict__ ob, char* lds) {
    const int tid = threadIdx.x, lane = tid & 63, w = tid >> 6, fr = lane & 15, fq = lane >> 4;
    for (int it = bid; it < NB * 4 * 2 * 2; it += nb) {
        const int vs = it & 1, dir = (it >> 1) & 1, h = (it >> 2) & 3, b = it >> 4;
        bf16_t* out = dir ? ob : of;
        const float lb0 = lb[h * 128 + 2 * lane], lb1 = lb[h * 128 + 2 * lane + 1];
        const int fcol = (dir ? 1024 : 512) + h * 128 + 2 * lane, qcol = h * 128 + 2 * lane, vcol = 1536 + h * 128 + vs * 64 + lane;
        f32x4 S[8];
#pragma unroll
        for (int kt = 0; kt < 8; ++kt) S[kt] = (f32x4){0.f, 0.f, 0.f, 0.f};
        unsigned xf[16], xq[16]; bf16_t xv[16];
#define HG_PREFETCH(p0) do { _Pragma("unroll") for (int i = 0; i < 16; ++i) { \
            const size_t rb = (size_t)hg_row(b, dir, (p0) + 16 * w + i) * HGW; \
            xf[i] = *(const unsigned*)(projH + rb + fcol); xq[i] = *(const unsigned*)(projH + rb + qcol); xv[i] = projH[rb + vcol]; } } while (0)
        HG_PREFETCH(0);
        for (int p0 = 0; p0 < NKEY; p0 += 64) {
            __syncthreads();
            {
                float c0 = 0.f, c1 = 0.f, kp0 = 0.f, kp1 = 0.f;
                unsigned kt0[8], kt1[8], vt[8];
#pragma unroll
                for (int i = 0; i < 16; ++i) {
                    const float xf0 = __uint_as_float(xf[i] << 16), xf1 = __uint_as_float(xf[i] & 0xffff0000u);
                    const float xq0 = __uint_as_float(xq[i] << 16), xq1 = __uint_as_float(xq[i] & 0xffff0000u);
                    const float f0 = lb0 + (1.f - lb0) * __builtin_amdgcn_rcpf(1.f + __expf(-xf0));
                    const float f1 = lb1 + (1.f - lb1) * __builtin_amdgcn_rcpf(1.f + __expf(-xf1));
                    c0 += __logf(f0); c1 += __logf(f1);
                    const float q0 = xq0 * __builtin_amdgcn_rcpf(1.f + __expf(-xq0)) * __expf(c0);
                    const float q1 = xq1 * __builtin_amdgcn_rcpf(1.f + __expf(-xq1)) * __expf(c1);
                    const float k0 = (1.f - f0) * __expf(fminf(-c0, 80.f)), k1 = (1.f - f1) * __expf(fminf(-c1, 80.f));
                    const int t = 16 * w + i;
                    const int o = t * 256 + (((lane >> 2) ^ (t & 15)) << 4) + (lane & 3) * 4;
                    *(unsigned*)(lds + HQ_OFF + o) = pack2(q0, q1);
                    *(unsigned*)(lds + HK_OFF + o) = pack2(k0, k1);
                    if (i & 1) { kt0[i >> 1] = pack2(kp0, k0); kt1[i >> 1] = pack2(kp1, k1); vt[i >> 1] = (unsigned)xv[i - 1] | ((unsigned)xv[i] << 16); }
                    else { kp0 = k0; kp1 = k1; }
                }
                float2 dd; dd.x = __expf(c0); dd.y = __expf(c1);
                *(float2*)(lds + HD_OFF + (w * 128 + 2 * lane) * 4) = dd;
                char* kp = lds + HKT_OFF + w * 4096 + (2 * lane) * 32;
                *(uint4*)(kp) = make_uint4(kt0[0], kt0[1], kt0[2], kt0[3]); *(uint4*)(kp + 16) = make_uint4(kt0[4], kt0[5], kt0[6], kt0[7]);
                *(uint4*)(kp + 32) = make_uint4(kt1[0], kt1[1], kt1[2], kt1[3]); *(uint4*)(kp + 48) = make_uint4(kt1[4], kt1[5], kt1[6], kt1[7]);
                char* vp = lds + HVT_OFF + w * 2048 + lane * 32;
                *(uint4*)(vp) = make_uint4(vt[0], vt[1], vt[2], vt[3]); *(uint4*)(vp + 16) = make_uint4(vt[4], vt[5], vt[6], vt[7]);
            }
            if (p0 + 64 < NKEY) HG_PREFETCH(p0 + 64);
            __syncthreads();
#pragma unroll
            for (int I = 0; I < 4; ++I) {
                const int trow = 16 * I + fr;
                f32x4 at = (f32x4){0.f, 0.f, 0.f, 0.f};
#pragma unroll
                for (int ks = 0; ks < 4; ++ks) {
                    const int o = trow * 256 + (((ks * 4 + fq) ^ fr) << 4);
                    const bf16x8 ka = *(const bf16x8*)(lds + HK_OFF + o);
                    const bf16x8 qa = *(const bf16x8*)(lds + HQ_OFF + o);
                    at = __builtin_amdgcn_mfma_f32_16x16x32_bf16(ka, qa, at, 0, 0, 0);
                }
#pragma unroll
                for (int j = 0; j < 4; ++j) if (4 * fq + j > fr) at[j] = 0.f;
                uint2 pa2; pa2.x = pack2(at[0], at[1]); pa2.y = pack2(at[2], at[3]);
                const bf16x4 pA = __builtin_bit_cast(bf16x4, pa2);
                const bf16x4 vfrag = *(const bf16x4*)(lds + HVT_OFF + I * 2048 + (w * 16 + fr) * 32 + fq * 8);
                f32x4 o1 = __builtin_amdgcn_mfma_f32_16x16x16bf16_1k(vfrag, pA, (f32x4){0.f, 0.f, 0.f, 0.f}, 0, 0, 0);
                f32x4 o2 = (f32x4){0.f, 0.f, 0.f, 0.f};
#pragma unroll
                for (int kt = 0; kt < 8; ++kt) {
                    uint2 s2; s2.x = pack2(S[kt][0], S[kt][1]); s2.y = pack2(S[kt][2], S[kt][3]);
                    const bf16x4 sfrag = __builtin_bit_cast(bf16x4, s2);
                    const bf16x4 qfrag = *(const bf16x4*)(lds + HQ_OFF + trow * 256 + (((kt * 2 + (fq >> 1)) ^ fr) << 4) + (fq & 1) * 8);
                    if (kt & 1) o2 = __builtin_amdgcn_mfma_f32_16x16x16bf16_1k(sfrag, qfrag, o2, 0, 0, 0);
                    else o1 = __builtin_amdgcn_mfma_f32_16x16x16bf16_1k(sfrag, qfrag, o1, 0, 0, 0);
                }
#pragma unroll
                for (int kt = 0; kt < 8; ++kt) {
                    const bf16x4 kfrag = *(const bf16x4*)(lds + HKT_OFF + I * 4096 + (kt * 16 + fr) * 32 + fq * 8);
                    const f32x4 d4 = *(const f32x4*)(lds + HD_OFF + (I * 128 + kt * 16 + fq * 4) * 4);
                    S[kt] = __builtin_amdgcn_mfma_f32_16x16x16bf16_1k(kfrag, vfrag, S[kt], 0, 0, 0);
                    S[kt] = S[kt] * d4;
                }
                const size_t orow = (size_t)hg_row(b, dir, p0 + trow);
                uint2 ov; ov.x = pack2(o1[0] + o2[0], o1[1] + o2[1]); ov.y = pack2(o1[2] + o2[2], o1[3] + o2[3]);
                *(uint2*)(out + orow * 512 + h * 128 + vs * 64 + w * 16 + fq * 4) = ov;
            }
        }
#undef HG_PREFETCH
    }
}
__device__ void ph_hgpost(int bid, int nb, const bf16_t* __restrict__ of, const bf16_t* __restrict__ ob, const bf16_t* __restrict__ projH,
                          const float* __restrict__ g, bf16_t* __restrict__ mix) {
    const int lane = threadIdx.x & 63, wid = threadIdx.x >> 6;
    for (int it = bid * 4 + wid; it < TA * 4; it += nb * 4) {
        const int row = it >> 2, h = it & 3;
        const size_t o = (size_t)row * 512 + h * 128 + lane * 2;
        const unsigned a = *(const unsigned*)(of + o), bb = *(const unsigned*)(ob + o);
        const float x0 = bf2f((bf16_t)(a & 0xffff)) + bf2f((bf16_t)(bb & 0xffff)), x1 = bf2f((bf16_t)(a >> 16)) + bf2f((bf16_t)(bb >> 16));
        const float ss = wave_sum(x0 * x0 + x1 * x1);
        const float rinv = rsqrtf(ss * (1.0f / 128.0f) + EPS);
        const unsigned gg = *(const unsigned*)(projH + (size_t)row * HGW + 2048 + h * 128 + lane * 2);
        const float y0 = x0 * rinv * g[lane * 2] * siluf_(bf2f((bf16_t)(gg & 0xffff)));
        const float y1 = x1 * rinv * g[lane * 2 + 1] * siluf_(bf2f((bf16_t)(gg >> 16)));
        *(unsigned*)(mix + (size_t)row * D + h * 128 + lane * 2) = pack2(y0, y1);
    }
}

__device__ void ph_prep_swa(int bid, int nb, bf16_t* __restrict__ P, const float* __restrict__ cosS, const float* __restrict__ sinS) {
    const size_t n = (size_t)TA * 320;
    for (size_t idx = (size_t)bid * blockDim.x + threadIdx.x; idx < n; idx += (size_t)nb * blockDim.x) {
        const int row = (int)(idx / 320), pr = (int)(idx % 320), head = pr >> 5, d = pr & 31;
        bf16_t* p = P + (size_t)row * SWW + head * 64 + d;
        float x1 = bf2f(p[0]), x2 = bf2f(p[32]);
        if (row < TL) {
            const int t = row & (SEQ - 1);
            const float c = cosS[t * 32 + d], s = sinS[t * 32 + d];
            const float y1 = x1 * c - x2 * s, y2 = x1 * s + x2 * c;
            x1 = y1; x2 = y2;
        }
        if (head < 8) { x1 *= 0.125f * LOG2E; x2 *= 0.125f * LOG2E; }
        p[0] = f2bf(x1); p[32] = f2bf(x2);
    }
}
__device__ void ph_prep_ga(int bid, int nb, bf16_t* __restrict__ P, const float* __restrict__ qg, const float* __restrict__ kg,
                           const float* __restrict__ cosG, const float* __restrict__ sinG) {
    const int lane = threadIdx.x & 63, wid = threadIdx.x >> 6;
    for (int it = bid * 4 + wid; it < TA * 10; it += nb * 4) {
        const int row = it / 10, head = it % 10;
        bf16_t* p = P + (size_t)row * GA_IN + head * 128;
        float x1 = bf2f(p[lane]), x2 = bf2f(p[lane + 64]);
        const float ss = wave_sum(x1 * x1 + x2 * x2);
        const float rinv = rsqrtf(ss * (1.0f / 128.0f) + EPS);
        const float* g = head < 8 ? qg : kg;
        x1 = x1 * rinv * g[lane]; x2 = x2 * rinv * g[lane + 64];
        if (row < TL) {
            const int t = row & (SEQ - 1);
            const float c = cosG[t * 64 + lane], s = sinG[t * 64 + lane];
            const float y1 = x1 * c - x2 * s, y2 = x1 * s + x2 * c;
            x1 = y1; x2 = y2;
        }
        if (head < 8) { x1 *= 0.08838834764831845f * LOG2E; x2 *= 0.08838834764831845f * LOG2E; }
        p[lane] = f2bf(x1); p[lane + 64] = f2bf(x2);
    }
}

template <int HD>
__device__ void ph_vt(int bid, int nb, const bf16_t* __restrict__ P, int ldp, int vcol, bf16_t* __restrict__ Vt, bf16_t* lds) {
    constexpr int ND = HD / 64;
    const int tid = threadIdx.x;
    for (int it = bid; it < NB * 2 * ND * (NKEY / 64); it += nb) {
        const int kt = it % (NKEY / 64), r1 = it / (NKEY / 64), dh = r1 % ND, g = r1 / ND, b = g >> 1, kvh = g & 1;
        const int k0 = kt * 64;
        const int row0 = k0 < LC ? TL + b * LC + k0 : b * SEQ + (k0 - LC);
        __syncthreads();
#pragma unroll
        for (int i = 0; i < 2; ++i) {
            const int id = tid + i * 256, kr = id >> 3, c = id & 7;
            const uint4 w = *(const uint4*)(P + (size_t)(row0 + kr) * ldp + vcol + kvh * HD + dh * 64 + c * 8);
            const unsigned ww[4] = {w.x, w.y, w.z, w.w};
#pragma unroll
            for (int j = 0; j < 4; ++j) { lds[kr * 66 + c * 8 + j * 2] = (bf16_t)(ww[j] & 0xffff); lds[kr * 66 + c * 8 + j * 2 + 1] = (bf16_t)(ww[j] >> 16); }
        }
        __syncthreads();
#pragma unroll
        for (int i = 0; i < 2; ++i) {
            const int id = tid + i * 256, d = id >> 3, c = id & 7;
            unsigned o[4];
#pragma unroll
            for (int j = 0; j < 4; ++j) o[j] = (unsigned)lds[(c * 8 + j * 2) * 66 + d] | ((unsigned)lds[(c * 8 + j * 2 + 1) * 66 + d] << 16);
            uint4 w; w.x = o[0]; w.y = o[1]; w.z = o[2]; w.w = o[3];
            *(uint4*)(Vt + (size_t)(g * HD + dh * 64 + d) * NKEY + k0 + c * 8) = w;
        }
    }
}

template <int HD, bool MASK>
__device__ __forceinline__ void flash_item(const bf16_t* __restrict__ Qrow0, int ldq, const bf16_t* __restrict__ Kp, int ldk,
                                           const bf16_t* __restrict__ Vt, int krow_ctx0, int krow_lat0, int nctx_t, int lat_lo, int nlat_t,
                                           int tq0, float m0, float l0, bf16_t* __restrict__ Orow0, int ldo, char* lds) {
    constexpr int NCH = HD / 32;
    constexpr int KB = 64 * HD * 2;
    constexpr int NKK = HD / 16;
    constexpr int NDT = HD / 32;
    const int tid = threadIdx.x, lane = tid & 63, w = tid >> 6, r = lane & 31, h = lane >> 5;
    const int pr = (r & 0x13) | ((r & 4) << 1) | ((r & 8) >> 1);
    bf16x8 qf[NKK];
    {
        const bf16_t* qp = Qrow0 + (size_t)(32 * w + r) * ldq + 8 * h;
#pragma unroll
        for (int kk = 0; kk < NKK; ++kk) qf[kk] = *(const bf16x8*)(qp + 16 * kk);
    }
    f32x16 O[NDT];
#pragma unroll
    for (int dt = 0; dt < NDT; ++dt)
#pragma unroll
        for (int i = 0; i < 16; ++i) O[dt][i] = 0.f;
    float m_run = m0, l_run = (h == 0) ? l0 : 0.f;
    const int kc = (HD == 128) ? (tid & 15) : (tid & 7);
    const int kr = (HD == 128) ? (tid >> 4) : (tid >> 3);
    const int ksw = (HD == 128) ? (kr & 15) : ((kr >> 1) & 7);
    const int klds = kr * (HD * 2) + ((kc ^ ksw) << 4);
    constexpr int KRSTEP = (HD == 128) ? 16 : 32;
    const int vr = tid >> 3, vc = tid & 7;
    const int vlds = KB + vr * 128 + ((vc ^ ((vr >> 1) & 7)) << 4);
    const int kfo = pr * (HD * 2);
    const int kfs = (HD == 128) ? (pr & 15) : ((pr >> 1) & 7);
    const int vfo = KB + r * 128;
    const int vfs = (r >> 1) & 7;
    const int ntile = nctx_t + nlat_t;
    uint4 sg0, sg1, sg2, sg3;
    sg2 = sg3 = make_uint4(0u, 0u, 0u, 0u);
#define FA_TILE(t, krow0, kidx0, s0) const int krow0 = (t) < nctx_t ? krow_ctx0 + 64 * (t) : krow_lat0 + lat_lo + 64 * ((t) - nctx_t); \
        const int s0 = (t) < nctx_t ? -(1 << 24) : lat_lo + 64 * ((t) - nctx_t); const int kidx0 = (t) < nctx_t ? 64 * (t) : LC + lat_lo + 64 * ((t) - nctx_t);
#define FA_GLOADK(t) do { FA_TILE(t, _kr0, _ki0, _s0) (void)_s0; (void)_ki0; \
        const bf16_t* _kp = Kp + (size_t)(_kr0 + kr) * ldk + kc * 8; \
        sg0 = *(const uint4*)(_kp); sg1 = *(const uint4*)(_kp + (size_t)KRSTEP * ldk); \
        if (NCH == 4) { sg2 = *(const uint4*)(_kp + (size_t)2 * KRSTEP * ldk); sg3 = *(const uint4*)(_kp + (size_t)3 * KRSTEP * ldk); } } while (0)
#define FA_GLOADV(t) do { FA_TILE(t, _kr0, _ki0, _s0) (void)_s0; (void)_kr0; \
        const bf16_t* _vp = Vt + (size_t)vr * NKEY + _ki0 + vc * 8; \
        sg0 = *(const uint4*)(_vp); sg1 = *(const uint4*)(_vp + (size_t)32 * NKEY); \
        if (NCH == 4) { sg2 = *(const uint4*)(_vp + (size_t)64 * NKEY); sg3 = *(const uint4*)(_vp + (size_t)96 * NKEY); } } while (0)
#define FA_LSTORE(buf, off) do { char* _b = lds + (buf) * (2 * KB) + (off); \
        *(uint4*)(_b) = sg0; *(uint4*)(_b + 4096) = sg1; \
        if (NCH == 4) { *(uint4*)(_b + 8192) = sg2; *(uint4*)(_b + 12288) = sg3; } } while (0)
    __syncthreads();
    FA_GLOADK(0); FA_LSTORE(0, klds);
    FA_GLOADV(0); FA_LSTORE(0, vlds);
    __syncthreads();
    for (int t = 0; t < ntile; ++t) {
        if (t + 1 < ntile) FA_GLOADK(t + 1);
        const char* base = lds + (t & 1) * (2 * KB);
        f32x16 st[2];
#pragma unroll
        for (int rt = 0; rt < 2; ++rt) {
#pragma unroll
            for (int i = 0; i < 16; ++i) st[rt][i] = 0.f;
#pragma unroll
            for (int kk = 0; kk < NKK; ++kk) {
                const bf16x8 kf = *(const bf16x8*)(base + rt * 32 * (HD * 2) + kfo + (((2 * kk + h) ^ kfs) << 4));
                st[rt] = __builtin_amdgcn_mfma_f32_32x32x16_bf16(kf, qf[kk], st[rt], 0, 0, 0);
                if ((kk & 3) == 3) __builtin_amdgcn_sched_barrier(0);
            }
        }
        if (MASK) {
            FA_TILE(t, _kr0, _ki0, s0) (void)_kr0; (void)_ki0;
            if (t >= nctx_t) {
                const int tq = tq0 + 32 * w + r;
#pragma unroll
                for (int rt = 0; rt < 2; ++rt)
#pragma unroll
                    for (int i = 0; i < 16; ++i) {
                        const int s = s0 + 32 * rt + (i & 3) + 4 * ((i >> 2) & 1) + 8 * h + 16 * (i >> 3);
                        const int dlt = tq - s;
                        if (dlt > 128 || dlt < -128) st[rt][i] = -1.0e30f;
                    }
            }
        }
        float mx = m_run;
#pragma unroll
        for (int rt = 0; rt < 2; ++rt)
#pragma unroll
            for (int i = 0; i < 16; ++i) mx = fmaxf(mx, st[rt][i]);
        mx = fmaxf(mx, __shfl_xor(mx, 32));
        const float alpha = __builtin_amdgcn_exp2f(m_run - mx);
        m_run = mx;
        float ps = 0.f;
#pragma unroll
        for (int rt = 0; rt < 2; ++rt)
#pragma unroll
            for (int i = 0; i < 16; ++i) { const float p = __builtin_amdgcn_exp2f(st[rt][i] - mx); st[rt][i] = p; ps += p; }
        l_run = l_run * alpha + ps;
        if (!__all(alpha == 1.0f)) {
#pragma unroll
            for (int dt = 0; dt < NDT; ++dt)
#pragma unroll
                for (int i = 0; i < 16; ++i) O[dt][i] *= alpha;
        }
        if (t + 1 < ntile) { FA_LSTORE((t + 1) & 1, klds); FA_GLOADV(t + 1); }
        bf16x8 pf[2][2];
#pragma unroll
        for (int rt = 0; rt < 2; ++rt)
#pragma unroll
            for (int s2 = 0; s2 < 2; ++s2) {
                uint4 pk;
                pk.x = pack2(st[rt][8 * s2 + 0], st[rt][8 * s2 + 1]); pk.y = pack2(st[rt][8 * s2 + 2], st[rt][8 * s2 + 3]);
                pk.z = pack2(st[rt][8 * s2 + 4], st[rt][8 * s2 + 5]); pk.w = pack2(st[rt][8 * s2 + 6], st[rt][8 * s2 + 7]);
                pf[rt][s2] = __builtin_bit_cast(bf16x8, pk);
            }
#pragma unroll
        for (int dt = 0; dt < NDT; ++dt)
#pragma unroll
            for (int rt = 0; rt < 2; ++rt)
#pragma unroll
                for (int s2 = 0; s2 < 2; ++s2) {
                    const bf16x8 vf = *(const bf16x8*)(base + vfo + dt * 4096 + (((4 * rt + 2 * s2 + h) ^ vfs) << 4));
                    O[dt] = __builtin_amdgcn_mfma_f32_32x32x16_bf16(vf, pf[rt][s2], O[dt], 0, 0, 0);
                    if (rt == 1 && s2 == 1) __builtin_amdgcn_sched_barrier(0);
                }
        if (t + 1 < ntile) FA_LSTORE((t + 1) & 1, vlds);
        __syncthreads();
    }
#undef FA_TILE
#undef FA_GLOADK
#undef FA_GLOADV
#undef FA_LSTORE
    const float lt = l_run + __shfl_xor(l_run, 32);
    const float inv = 1.0f / lt;
    bf16_t* op = Orow0 + (size_t)(32 * w + r) * ldo + 4 * h;
#pragma unroll
    for (int dt = 0; dt < NDT; ++dt)
#pragma unroll
        for (int g = 0; g < 4; ++g) {
            uint2 o2; o2.x = pack2(O[dt][4 * g] * inv, O[dt][4 * g + 1] * inv); o2.y = pack2(O[dt][4 * g + 2] * inv, O[dt][4 * g + 3] * inv);
            *(uint2*)(op + 32 * dt + 8 * g) = o2;
        }
}
__device__ void ph_swa(int bid, int nb, const bf16_t* __restrict__ projS, const bf16_t* __restrict__ Vt, const float* __restrict__ sink,
                       bf16_t* __restrict__ mix, char* lds) {
    const int n_lat = NB * 8 * 32, n_ctx = NB * 8 * 2;
    for (int it = bid; it < n_lat + n_ctx; it += nb) {
        int b, hq, row0, lo, nlat, t0;
        if (it < n_lat) {
            const int qb = it & 31; hq = (it >> 5) & 7; b = it >> 8;
            t0 = qb * 128;
            lo = t0 - 128 < 0 ? 0 : t0 - 128;
            const int hi = t0 + 256 > SEQ ? SEQ : t0 + 256;
            nlat = (hi - lo) / 64; row0 = b * SEQ + t0;
        } else {
            const int i2 = it - n_lat, qb = i2 & 1; hq = (i2 >> 1) & 7; b = i2 >> 4;
            t0 = 0; lo = 0; nlat = 0; row0 = TL + b * LC + qb * 128;
        }
        const int kvh = hq >> 2;
        flash_item<64, true>(projS + (size_t)row0 * SWW + hq * 64, SWW, projS + 512 + kvh * 64, SWW, Vt + (size_t)(b * 2 + kvh) * 64 * NKEY,
                             TL + b * LC, b * SEQ, 4, lo, nlat, t0, sink[hq] * LOG2E, 1.0f, mix + (size_t)row0 * D + 512 + hq * 64, D, lds);
    }
}
__device__ void ph_dense(int bid, int nb, const bf16_t* __restrict__ projG, const bf16_t* __restrict__ Vt, bf16_t* __restrict__ mix, char* lds) {
    const bool sw = (nb & 7) == 0;
    const int nit = NB * 8 * 32;
    for (int j = sw ? (bid >> 3) : bid; j < (sw ? nit / 8 : nit); j += sw ? (nb >> 3) : nb) {
        int g, jj;
        if (sw) { g = (bid & 7) + 8 * (j >> 7); jj = j & 127; } else { g = j >> 7; jj = j & 127; }
        const int b = g >> 1, kvh = g & 1, hq = kvh * 4 + (jj >> 5), qb = jj & 31;
        const int row0 = b * SEQ + qb * 128;
        flash_item<128, false>(projG + (size_t)row0 * GA_IN + hq * 128, GA_IN, projG + 1024 + kvh * 128, GA_IN, Vt + (size_t)(b * 2 + kvh) * 128 * NKEY,
                               TL + b * LC, b * SEQ, 4, 0, SEQ / 64, 0, -1.0e30f, 0.0f, mix + (size_t)row0 * D + hq * 128, D, lds);
    }
}

#define CE(a, b) { const float _h = fmaxf(a, b); b = fminf(a, b); a = _h; }
__device__ __forceinline__ void net_sort16(float (&v)[16]) {
    CE(v[0], v[1]); CE(v[3], v[2]); CE(v[4], v[5]); CE(v[7], v[6]); CE(v[8], v[9]); CE(v[11], v[10]);
    CE(v[12], v[13]); CE(v[15], v[14]); CE(v[0], v[2]); CE(v[1], v[3]); CE(v[6], v[4]); CE(v[7], v[5]);
    CE(v[8], v[10]); CE(v[9], v[11]); CE(v[14], v[12]); CE(v[15], v[13]); CE(v[0], v[1]); CE(v[2], v[3]);
    CE(v[5], v[4]); CE(v[7], v[6]); CE(v[8], v[9]); CE(v[10], v[11]); CE(v[13], v[12]); CE(v[15], v[14]);
    CE(v[0], v[4]); CE(v[1], v[5]); CE(v[2], v[6]); CE(v[3], v[7]); CE(v[12], v[8]); CE(v[13], v[9]);
    CE(v[14], v[10]); CE(v[15], v[11]); CE(v[0], v[2]); CE(v[1], v[3]); CE(v[4], v[6]); CE(v[5], v[7]);
    CE(v[10], v[8]); CE(v[11], v[9]); CE(v[14], v[12]); CE(v[15], v[13]); CE(v[0], v[1]); CE(v[2], v[3]);
    CE(v[4], v[5]); CE(v[6], v[7]); CE(v[9], v[8]); CE(v[11], v[10]); CE(v[13], v[12]); CE(v[15], v[14]);
    CE(v[0], v[8]); CE(v[1], v[9]); CE(v[2], v[10]); CE(v[3], v[11]); CE(v[4], v[12]); CE(v[5], v[13]);
    CE(v[6], v[14]); CE(v[7], v[15]); CE(v[0], v[4]); CE(v[1], v[5]); CE(v[2], v[6]); CE(v[3], v[7]);
    CE(v[8], v[12]); CE(v[9], v[13]); CE(v[10], v[14]); CE(v[11], v[15]); CE(v[0], v[2]); CE(v[1], v[3]);
    CE(v[4], v[6]); CE(v[5], v[7]); CE(v[8], v[10]); CE(v[9], v[11]); CE(v[12], v[14]); CE(v[13], v[15]);
    CE(v[0], v[1]); CE(v[2], v[3]); CE(v[4], v[5]); CE(v[6], v[7]); CE(v[8], v[9]); CE(v[10], v[11]);
    CE(v[12], v[13]); CE(v[14], v[15]);
}
__device__ __forceinline__ void net_clean16(float (&v)[16]) {
    CE(v[0], v[8]); CE(v[1], v[9]); CE(v[2], v[10]); CE(v[3], v[11]); CE(v[4], v[12]); CE(v[5], v[13]);
    CE(v[6], v[14]); CE(v[7], v[15]); CE(v[0], v[4]); CE(v[1], v[5]); CE(v[2], v[6]); CE(v[3], v[7]);
    CE(v[8], v[12]); CE(v[9], v[13]); CE(v[10], v[14]); CE(v[11], v[15]); CE(v[0], v[2]); CE(v[1], v[3]);
    CE(v[4], v[6]); CE(v[5], v[7]); CE(v[8], v[10]); CE(v[9], v[11]); CE(v[12], v[14]); CE(v[13], v[15]);
    CE(v[0], v[1]); CE(v[2], v[3]); CE(v[4], v[5]); CE(v[6], v[7]); CE(v[8], v[9]); CE(v[10], v[11]);
    CE(v[12], v[13]); CE(v[14], v[15]);
}
__device__ __forceinline__ void net_merge16(float (&a)[16], const float (&b)[16]) {
#pragma unroll
    for (int i = 0; i < 16; ++i) a[i] = fmaxf(a[i], b[15 - i]);
    net_clean16(a);
}
#define PEER_CANDS(F) F(0,0,0) F(1,0,1) F(2,0,2) F(3,0,3) F(4,0,4) F(5,0,5) F(6,0,6) F(7,0,7) F(8,0,8) F(9,0,9) F(10,0,10) F(11,0,11) F(12,0,12) F(13,0,13) F(14,0,14) F(15,0,15) F(16,1,1) F(17,1,2) F(18,1,3) F(19,1,4) F(20,1,5) F(21,1,6) F(22,1,7) F(23,2,2) F(24,2,3) F(25,2,4) F(26,3,3)

__device__ __forceinline__ void ph_peer_route(int bid, int nb, const bf16_t* __restrict__ qpeer, const bf16_t* __restrict__ SK, int* __restrict__ sel_e,
                              float* __restrict__ sel_g, int M, char* lds) {
    const int tid = threadIdx.x, lane = tid & 63, w = tid >> 6, r = lane & 31, h2 = lane >> 5;
    const int srow = tid >> 4, sc = tid & 15;
    const int soff = srow * 256 + ((sc ^ (srow & 15)) << 4);
    for (int it = bid; it < (M / 128) * 8; it += nb) {
        const int m0 = (it >> 3) * 128, hd = it & 7;
        const int row = 32 * w + r;
        __syncthreads();
#pragma unroll
        for (int pp = 0; pp < 2; ++pp) {
            const bf16_t* sp = SK + ((size_t)(hd * 2 + pp) * 128 + srow) * 128 + sc * 8;
            uint4 t0 = *(const uint4*)(sp), t1 = *(const uint4*)(sp + 16 * 128), t2 = *(const uint4*)(sp + 32 * 128), t3 = *(const uint4*)(sp + 48 * 128);
            uint4 t4 = *(const uint4*)(sp + 64 * 128), t5 = *(const uint4*)(sp + 80 * 128), t6 = *(const uint4*)(sp + 96 * 128), t7 = *(const uint4*)(sp + 112 * 128);
            char* d = lds + pp * 32768 + soff;
            *(uint4*)(d) = t0; *(uint4*)(d + 4096) = t1; *(uint4*)(d + 8192) = t2; *(uint4*)(d + 12288) = t3;
            *(uint4*)(d + 16384) = t4; *(uint4*)(d + 20480) = t5; *(uint4*)(d + 24576) = t6; *(uint4*)(d + 28672) = t7;
        }
        __syncthreads();
        float L0[16], L1[16];
#pragma unroll
        for (int pp = 0; pp < 2; ++pp) {
            bf16x8 qf[8];
            const bf16_t* qp = qpeer + (size_t)(m0 + row) * PQ + hd * 256 + pp * 128 + 8 * h2;
#pragma unroll
            for (int kk = 0; kk < 8; ++kk) qf[kk] = *(const bf16x8*)(qp + 16 * kk);
            float g[4][16];
#pragma unroll
            for (int kt = 0; kt < 4; ++kt) {
                f32x16 st;
#pragma unroll
                for (int i = 0; i < 16; ++i) st[i] = 0.f;
#pragma unroll
                for (int kk = 0; kk < 8; ++kk) {
                    const bf16x8 kf = *(const bf16x8*)(lds + pp * 32768 + (32 * kt + r) * 256 + (((2 * kk + h2) ^ (r & 15)) << 4));
                    st = __builtin_amdgcn_mfma_f32_32x32x16_bf16(kf, qf[kk], st, 0, 0, 0);
                }
#pragma unroll
                for (int i = 0; i < 16; ++i) {
                    const unsigned n = 32 * kt + (i & 3) + 8 * (i >> 2) + 4 * h2;
                    g[kt][i] = __uint_as_float((__float_as_uint(st[i]) & 0xFFFFFF80u) | n);
                }
            }
            net_sort16(g[0]); net_sort16(g[1]); net_sort16(g[2]); net_sort16(g[3]);
            net_merge16(g[0], g[1]); net_merge16(g[2], g[3]); net_merge16(g[0], g[2]);
            float pb[16];
#pragma unroll
            for (int i = 0; i < 16; ++i) pb[i] = __shfl_xor(g[0][i], 32);
            net_merge16(g[0], pb);
#pragma unroll
            for (int i = 0; i < 16; ++i) { if (pp == 0) L0[i] = g[0][i]; else L1[i] = g[0][i]; }
        }
        __syncthreads();
        unsigned char* tab = (unsigned char*)lds;
        if (h2 == 0) {
            unsigned wv[8];
#pragma unroll
            for (int j = 0; j < 4; ++j) {
                wv[j] = (__float_as_uint(L0[4 * j]) & 0x7Fu) | ((__float_as_uint(L0[4 * j + 1]) & 0x7Fu) << 8) | ((__float_as_uint(L0[4 * j + 2]) & 0x7Fu) << 16) | ((__float_as_uint(L0[4 * j + 3]) & 0x7Fu) << 24);
                wv[4 + j] = (__float_as_uint(L1[4 * j]) & 0x7Fu) | ((__float_as_uint(L1[4 * j + 1]) & 0x7Fu) << 8) | ((__float_as_uint(L1[4 * j + 2]) & 0x7Fu) << 16) | ((__float_as_uint(L1[4 * j + 3]) & 0x7Fu) << 24);
            }
            *(uint4*)(tab + row * 32) = make_uint4(wv[0], wv[1], wv[2], wv[3]);
            *(uint4*)(tab + row * 32 + 16) = make_uint4(wv[4], wv[5], wv[6], wv[7]);
        }
        float X[16], Y[16];
#pragma unroll
        for (int i = 0; i < 16; ++i) {
            const float a0 = __uint_as_float(__float_as_uint(L0[i]) & 0xFFFFFF80u), a1 = __uint_as_float(__float_as_uint(L1[i]) & 0xFFFFFF80u);
            X[i] = h2 ? a1 : a0; Y[i] = h2 ? a0 : a1;
        }
        float c0[16], c1[16];
#define PEER_CAND(i, a, b) { float v = X[a] + Y[b]; if ((a) == (b) && h2) v = -3.0e38f; const unsigned id = h2 ? ((b) * 16 + (a)) : ((a) * 16 + (b)); \
            const float pk = __uint_as_float((__float_as_uint(v) & 0xFFFFFF00u) | id); if ((i) < 16) c0[(i) & 15] = pk; else c1[(i) & 15] = pk; }
        PEER_CANDS(PEER_CAND)
#undef PEER_CAND
#pragma unroll
        for (int i = 11; i < 16; ++i) c1[i] = -3.0e38f;
        net_sort16(c0); net_sort16(c1); net_merge16(c0, c1);
        {
            float pb[16];
#pragma unroll
            for (int i = 0; i < 16; ++i) pb[i] = __shfl_xor(c0[i], 32);
            net_merge16(c0, pb);
        }
        float ex[16], sum = 0.f;
#pragma unroll
        for (int i = 0; i < 16; ++i) { ex[i] = __expf(c0[i] - c0[0]); sum += ex[i]; }
        const float rs = 1.0f / sum;
        const size_t ob = ((size_t)(m0 + row) * 8 + hd) * 16;
        if (h2 == 0) {
            int eo[16];
#pragma unroll
            for (int j = 0; j < 16; ++j) {
                const unsigned id = __float_as_uint(c0[j]) & 0xFFu;
                eo[j] = (int)tab[row * 32 + (id >> 4)] * 128 + (int)tab[row * 32 + 16 + (id & 15)];
            }
#pragma unroll
            for (int j = 0; j < 4; ++j) *(int4*)(sel_e + ob + 4 * j) = make_int4(eo[4 * j], eo[4 * j + 1], eo[4 * j + 2], eo[4 * j + 3]);
        } else {
#pragma unroll
            for (int j = 0; j < 4; ++j) *(float4*)(sel_g + ob + 4 * j) = make_float4(ex[4 * j] * rs, ex[4 * j + 1] * rs, ex[4 * j + 2] * rs, ex[4 * j + 3] * rs);
        }
    }
}
__device__ void ph_peer_gather(int bid, int nb, const bf16_t* __restrict__ xf  , const bf16_t* __restrict__ U, const bf16_t* __restrict__ V,
                               const int* __restrict__ sel_e, const float* __restrict__ sel_g, const float* __restrict__ gate  ,
                               float* __restrict__ hlat, float* __restrict__ hctx, int ntok) {
    const int lane = threadIdx.x & 63, wid = threadIdx.x >> 6;
    for (int row = bid * 4 + wid; row < ntok; row += nb * 4) {
        float x[16], y[16];
#pragma unroll
        for (int i = 0; i < 2; ++i) {
            const uint4 w = *(const uint4*)(xf + (size_t)row * D + (lane + 64 * i) * 8);
            const unsigned ww[4] = {w.x, w.y, w.z, w.w};
#pragma unroll
            for (int j = 0; j < 4; ++j) { x[i * 8 + j * 2] = __uint_as_float(ww[j] << 16); x[i * 8 + j * 2 + 1] = __uint_as_float(ww[j] & 0xffff0000u); }
        }
#pragma unroll
        for (int i = 0; i < 16; ++i) y[i] = 0.f;
        const int my_e0 = sel_e[(size_t)row * 128 + lane], my_e1 = sel_e[(size_t)row * 128 + 64 + lane];
        const float my_g0 = sel_g[(size_t)row * 128 + lane], my_g1 = sel_g[(size_t)row * 128 + 64 + lane];
        for (int k = 0; k < 128; ++k) {
            const int e = __shfl(k < 64 ? my_e0 : my_e1, k & 63);
            const float g = __shfl(k < 64 ? my_g0 : my_g1, k & 63);
            const bf16_t* ur = U + (size_t)e * D;
            float part = 0.f;
#pragma unroll
            for (int i = 0; i < 2; ++i) {
                const uint4 w = *(const uint4*)(ur + (lane + 64 * i) * 8);
                const unsigned ww[4] = {w.x, w.y, w.z, w.w};
#pragma unroll
                for (int j = 0; j < 4; ++j) { part += x[i * 8 + j * 2] * __uint_as_float(ww[j] << 16); part += x[i * 8 + j * 2 + 1] * __uint_as_float(ww[j] & 0xffff0000u); }
            }
            const float dot = wave_sum(part);
            const float act = 0.5f * dot * (1.0f + erff(dot * 0.70710678118654752f));
            const float wgt = g * act;
            const bf16_t* vr = V + (size_t)e * D;
#pragma unroll
            for (int i = 0; i < 2; ++i) {
                const uint4 w = *(const uint4*)(vr + (lane + 64 * i) * 8);
                const unsigned ww[4] = {w.x, w.y, w.z, w.w};
#pragma unroll
                for (int j = 0; j < 4; ++j) { y[i * 8 + j * 2] += wgt * __uint_as_float(ww[j] << 16); y[i * 8 + j * 2 + 1] += wgt * __uint_as_float(ww[j] & 0xffff0000u); }
            }
        }
        float* hp = row < TL ? hlat + (size_t)row * D : hctx + (size_t)(row - TL) * D;
        const float* gg = gate + (size_t)mod_row(row) * 6144;
#pragma unroll
        for (int i = 0; i < 2; ++i) {
            const int col = (lane + 64 * i) * 8;
#pragma unroll
            for (int j = 0; j < 2; ++j) {
                float4 h = *(float4*)(hp + col + j * 4); const float4 g4 = *(const float4*)(gg + col + j * 4);
                h.x += g4.x * y[i * 8 + j * 4 + 0]; h.y += g4.y * y[i * 8 + j * 4 + 1]; h.z += g4.z * y[i * 8 + j * 4 + 2]; h.w += g4.w * y[i * 8 + j * 4 + 3];
                *(float4*)(hp + col + j * 4) = h;
            }
        }
    }
}
__device__ void ph_final(int bid, int nb, float* __restrict__ h, const float* __restrict__ g) {
    const int lane = threadIdx.x & 63, wid = threadIdx.x >> 6;
    for (int row = bid * 4 + wid; row < TL; row += nb * 4) {
        float4* p = (float4*)(h + (size_t)row * D);
        float4 x[4]; float ss = 0.f;
#pragma unroll
        for (int i = 0; i < 4; ++i) { x[i] = p[i * 64 + lane]; ss += x[i].x * x[i].x + x[i].y * x[i].y + x[i].z * x[i].z + x[i].w * x[i].w; }
        ss = wave_sum(ss);
        const float rinv = rsqrtf(ss * (1.0f / D) + EPS);
#pragma unroll
        for (int i = 0; i < 4; ++i) {
            const float4 gg = ((const float4*)g)[i * 64 + lane];
            float4 o; o.x = x[i].x * rinv * gg.x; o.y = x[i].y * rinv * gg.y; o.z = x[i].z * rinv * gg.z; o.w = x[i].w * rinv * gg.w;
            p[i * 64 + lane] = o;
        }
    }
}

struct Params {
    const float *x, *c, *ctx, *c_ctx, *ada_w, *ada_b, *norm_mix_g, *norm_ffn_g, *ab_w_in, *ab_w_out, *hg_lb, *hg_norm_g, *sw_sink,
        *ga_w_in, *ga_w_out, *ga_qn, *ga_kn, *peer_wq, *peer_sk, *peer_u, *peer_v, *final_g;
    float* out; char* ws;
};
extern __shared__ __attribute__((aligned(16))) char dyn_lds[];

#define WSP(T, off) ((T*)(p.ws + (off)))

namespace cg = cooperative_groups;
constexpr int MEGA_LDS = 65536;
__global__ void __launch_bounds__(256, 2) k_mega(Params p) {
    cg::grid_group grid = cg::this_grid();
    const int bid = blockIdx.x, nb = gridDim.x;
    char* lds = dyn_lds;
    float* ldf = (float*)dyn_lds;
    float* mod0 = WSP(float, OFF_MOD);
    float* mod1 = mod0 + (size_t)9 * 6144;
    float* hctx = WSP(float, OFF_HCTX);
    bf16_t* abuf = WSP(bf16_t, OFF_A);
    bf16_t* mix = WSP(bf16_t, OFF_MIX);
    ph_transpose(bid, nb, p.ab_w_in, WSP(bf16_t, OFF_WABIN), D, AB_IN, ldf);
    ph_transpose(bid, nb, p.ab_w_out, WSP(bf16_t, OFF_WABOUT), D, D, ldf);
    ph_transpose(bid, nb, p.ga_w_in, WSP(bf16_t, OFF_WGAIN), D, GA_IN, ldf);
    ph_transpose(bid, nb, p.ga_w_out, WSP(bf16_t, OFF_WGAOUT), D, D, ldf);
    ph_transpose(bid, nb, p.peer_wq, WSP(bf16_t, OFF_WPQ), D, PQ, ldf);
    ph_transpose(bid, nb, p.peer_wq + (size_t)D * PQ, WSP(bf16_t, OFF_WPQ) + (size_t)PQ * D, D, PQ, ldf);
    ph_cvt(bid, nb, p.peer_sk, WSP(bf16_t, OFF_SK), (size_t)2 * 8 * 2 * 128 * 128);
    ph_tables(bid, nb, WSP(float, OFF_COSS), WSP(float, OFF_SINS), WSP(float, OFF_COSG), WSP(float, OFF_SING), p.hg_lb, WSP(float, OFF_LB));
    __syncthreads();
    ph_mod(bid, nb, p.c, p.c_ctx, p.ada_w, p.ada_b, mod0, ldf);
    ph_cvt(bid, nb, p.peer_u, WSP(bf16_t, OFF_U16), (size_t)NEXP * D);
    ph_cvt(bid, nb, p.peer_v, WSP(bf16_t, OFF_V16), (size_t)NEXP * D);
    grid.sync();
    ph_normmod(bid, nb, p.x, p.ctx, p.norm_mix_g, mod0, 1 * D, 0, abuf, TA);
    grid.sync();
    { EpiStoreSplit e{WSP(bf16_t, OFF_PROJH), HGW, WSP(bf16_t, OFF_PROJS), SWW, HGW};
      ph_gemm(bid, nb, abuf, D, WSP(bf16_t, OFF_WABIN), D, TA, AB_IN, D, lds, e); }
    grid.sync();
    ph_prep_swa(bid, nb, WSP(bf16_t, OFF_PROJS), WSP(float, OFF_COSS), WSP(float, OFF_SINS));
    ph_vt<64>(bid, nb, WSP(bf16_t, OFF_PROJS), SWW, 640, WSP(bf16_t, OFF_VT), (bf16_t*)lds);
    grid.sync();
    {
        const int hgb = nb >= 256 ? 128 : nb / 2;
        if (bid < hgb) ph_hgrn(bid, hgb, WSP(bf16_t, OFF_PROJH), WSP(float, OFF_LB), WSP(bf16_t, OFF_OF), WSP(bf16_t, OFF_OB), lds);
        else ph_swa(bid - hgb, nb - hgb, WSP(bf16_t, OFF_PROJS), WSP(bf16_t, OFF_VT), p.sw_sink, mix, lds);
    }
    grid.sync();
    ph_hgpost(bid, nb, WSP(bf16_t, OFF_OF), WSP(bf16_t, OFF_OB), WSP(bf16_t, OFF_PROJH), p.hg_norm_g, mix);
    grid.sync();
    { EpiResid e{p.x, p.ctx, p.out, hctx, mod0 + 2 * D};
      ph_gemm(bid, nb, mix, D, WSP(bf16_t, OFF_WABOUT), D, TA, D, D, lds, e); }
    grid.sync();
    ph_normmod(bid, nb, p.out, hctx, p.norm_ffn_g, mod0, 4 * D, 3 * D, abuf, TA);
    grid.sync();
    { EpiStoreSplit e{WSP(bf16_t, OFF_QPEER), PQ, WSP(bf16_t, OFF_QPEER), PQ, 1 << 30};
      ph_gemm(bid, nb, abuf, D, WSP(bf16_t, OFF_WPQ), D, TA, PQ, D, lds, e); }
    grid.sync();
    ph_peer_route(bid, nb, WSP(bf16_t, OFF_QPEER), WSP(bf16_t, OFF_SK), WSP(int, OFF_SELE), WSP(float, OFF_SELG), TA, lds);
    grid.sync();
    ph_peer_gather(bid, nb, abuf, WSP(bf16_t, OFF_U16), WSP(bf16_t, OFF_V16), WSP(int, OFF_SELE), WSP(float, OFF_SELG), mod0 + 5 * D, p.out, hctx, TA);
    grid.sync();
    ph_cvt(bid, nb, p.peer_u + (size_t)NEXP * D, WSP(bf16_t, OFF_U16), (size_t)NEXP * D);
    ph_cvt(bid, nb, p.peer_v + (size_t)NEXP * D, WSP(bf16_t, OFF_V16), (size_t)NEXP * D);
    ph_normmod(bid, nb, p.out, hctx, p.norm_mix_g + D, mod1, 1 * D, 0, abuf, TA);
    grid.sync();
    { EpiStoreSplit e{WSP(bf16_t, OFF_PROJ), GA_IN, WSP(bf16_t, OFF_PROJ), GA_IN, 1 << 30};
      ph_gemm(bid, nb, abuf, D, WSP(bf16_t, OFF_WGAIN), D, TA, GA_IN, D, lds, e); }
    grid.sync();
    ph_prep_ga(bid, nb, WSP(bf16_t, OFF_PROJ), p.ga_qn, p.ga_kn, WSP(float, OFF_COSG), WSP(float, OFF_SING));
    ph_vt<128>(bid, nb, WSP(bf16_t, OFF_PROJ), GA_IN, 1280, WSP(bf16_t, OFF_VT), (bf16_t*)lds);
    grid.sync();
    ph_dense(bid, nb, WSP(bf16_t, OFF_PROJ), WSP(bf16_t, OFF_VT), mix, lds);
    grid.sync();
    { EpiResid e{p.out, hctx, p.out, hctx, mod1 + 2 * D};
      ph_gemm(bid, nb, mix, D, WSP(bf16_t, OFF_WGAOUT), D, TL, D, D, lds, e); }
    grid.sync();
    ph_normmod(bid, nb, p.out, hctx, p.norm_ffn_g + D, mod1, 4 * D, 3 * D, abuf, TL);
    grid.sync();
    { EpiStoreSplit e{WSP(bf16_t, OFF_QPEER), PQ, WSP(bf16_t, OFF_QPEER), PQ, 1 << 30};
      ph_gemm(bid, nb, abuf, D, WSP(bf16_t, OFF_WPQ) + (size_t)PQ * D, D, TL, PQ, D, lds, e); }
    grid.sync();
    ph_peer_route(bid, nb, WSP(bf16_t, OFF_QPEER), WSP(bf16_t, OFF_SK) + (size_t)16 * 128 * 128, WSP(int, OFF_SELE), WSP(float, OFF_SELG), TL, lds);
    grid.sync();
    ph_peer_gather(bid, nb, abuf, WSP(bf16_t, OFF_U16), WSP(bf16_t, OFF_V16), WSP(int, OFF_SELE), WSP(float, OFF_SELG), mod1 + 5 * D, p.out, hctx, TL);
    grid.sync();
    ph_final(bid, nb, p.out, p.final_g);
}

extern "C" void kernel_launch(void* const* d_in, const int* in_sizes, int n_in, void* d_out, int out_size, void* d_ws, size_t ws_size,
                              hipStream_t stream) {
    Params p{};
    p.x = (const float*)d_in[0]; p.c = (const float*)d_in[1]; p.ctx = (const float*)d_in[2]; p.c_ctx = (const float*)d_in[3];
    p.ada_w = (const float*)d_in[4]; p.ada_b = (const float*)d_in[5]; p.norm_mix_g = (const float*)d_in[6]; p.norm_ffn_g = (const float*)d_in[7];
    p.ab_w_in = (const float*)d_in[8]; p.ab_w_out = (const float*)d_in[9]; p.hg_lb = (const float*)d_in[10]; p.hg_norm_g = (const float*)d_in[11];
    p.sw_sink = (const float*)d_in[12]; p.ga_w_in = (const float*)d_in[13]; p.ga_w_out = (const float*)d_in[14]; p.ga_qn = (const float*)d_in[15];
    p.ga_kn = (const float*)d_in[16]; p.peer_wq = (const float*)d_in[17]; p.peer_sk = (const float*)d_in[18]; p.peer_u = (const float*)d_in[19];
    p.peer_v = (const float*)d_in[20]; p.final_g = (const float*)d_in[21];
    p.out = (float*)d_out; p.ws = (char*)d_ws;
    if (ws_size < WS_NEED) { fprintf(stderr, "workspace too small: %zu < %zu\n", ws_size, WS_NEED); return; }
    static int grid_blocks = 0;
    if (!grid_blocks) {
        int dev = 0, cus = 0, per_cu = 0;
        (void)hipGetDevice(&dev);
        (void)hipDeviceGetAttribute(&cus, hipDeviceAttributeMultiprocessorCount, dev);
        (void)hipFuncSetAttribute((const void*)k_mega, hipFuncAttributeMaxDynamicSharedMemorySize, MEGA_LDS);
        (void)hipOccupancyMaxActiveBlocksPerMultiprocessor(&per_cu, k_mega, 256, MEGA_LDS);
        if (per_cu > 2) per_cu = 2;
        if (per_cu < 1) per_cu = 1;
        grid_blocks = cus * per_cu;
    }
    void* args[] = {&p};
    hipError_t e = hipLaunchCooperativeKernel((const void*)k_mega, dim3(grid_blocks), dim3(256), args, MEGA_LDS, stream);
    if (e != hipSuccess) fprintf(stderr, "cooperative launch failed: %s (grid %d)\n", hipGetErrorString(e), grid_blocks);
}
```

```cpp
#include <hip/hip_runtime.h>
#include <hip/hip_cooperative_groups.h>
#include <stdint.h>
#include <stdio.h>

typedef unsigned short bf16_t;
typedef short bf16x8 __attribute__((ext_vector_type(8)));
typedef float f32x4 __attribute__((ext_vector_type(4)));

constexpr int D = 1024, NB = 8, SEQ = 4096, LC = 256;
constexpr int TL = NB * SEQ;
constexpr int TC = NB * LC;
constexpr int TA = TL + TC;
constexpr int AB_IN = 3328, HGW = 2560, SWW = 768, GA_IN = 1536, PQ = 2048;
constexpr int NEXP = 16384;
constexpr float EPS = 1e-6f;
constexpr float LOG2E = 1.4426950408889634f;
constexpr int NKEY = LC + SEQ;

constexpr size_t OFF_WABIN = 0;
constexpr size_t OFF_WABOUT = OFF_WABIN + (size_t)AB_IN * D * 2;
constexpr size_t OFF_WGAIN = OFF_WABOUT + (size_t)D * D * 2;
constexpr size_t OFF_WGAOUT = OFF_WGAIN + (size_t)GA_IN * D * 2;
constexpr size_t OFF_WPQ = OFF_WGAOUT + (size_t)D * D * 2;
constexpr size_t OFF_SK = OFF_WPQ + (size_t)2 * PQ * D * 2;
constexpr size_t OFF_MOD = OFF_SK + (size_t)2 * 8 * 2 * 128 * 128 * 2;
constexpr size_t OFF_COSS = OFF_MOD + (size_t)2 * 9 * 6144 * 4;
constexpr size_t OFF_SINS = OFF_COSS + (size_t)SEQ * 32 * 4;
constexpr size_t OFF_COSG = OFF_SINS + (size_t)SEQ * 32 * 4;
constexpr size_t OFF_SING = OFF_COSG + (size_t)SEQ * 64 * 4;
constexpr size_t OFF_LB = OFF_SING + (size_t)SEQ * 64 * 4;
constexpr size_t OFF_U16 = OFF_LB + 2048;
constexpr size_t OFF_V16 = OFF_U16 + (size_t)NEXP * D * 2;
constexpr size_t OFF_HCTX = OFF_V16 + (size_t)NEXP * D * 2;
constexpr size_t OFF_A = OFF_HCTX + (size_t)TC * D * 4;
constexpr size_t OFF_PROJ = OFF_A + (size_t)TA * D * 2;
constexpr size_t OFF_MIX = OFF_PROJ + (size_t)TA * AB_IN * 2;
constexpr size_t OFF_SEL = OFF_MIX + (size_t)TA * D * 2;
constexpr size_t OFF_BAR = OFF_SEL + (size_t)TA * 128 * 8;
constexpr size_t WS_NEED = OFF_BAR + 256;
static_assert(WS_NEED <= (size_t)536870912, "workspace over 512 MiB");
constexpr size_t OFF_OF = OFF_A;
constexpr size_t OFF_OB = OFF_A + (size_t)TA * 512 * 2;
constexpr size_t OFF_PROJH = OFF_PROJ;
constexpr size_t OFF_PROJS = OFF_PROJ + (size_t)TA * HGW * 2;
constexpr size_t OFF_QPEER = OFF_PROJ;
constexpr size_t OFF_TSC = OFF_QPEER + (size_t)TA * PQ * 2;
constexpr size_t OFF_TIX = OFF_TSC + (size_t)TA * 256 * 4;
static_assert(OFF_TIX + (size_t)TA * 256 * 4 <= OFF_MIX, "peer scratch overflows proj region");
constexpr size_t OFF_VT = OFF_SEL;
static_assert((size_t)NB * 2 * 128 * NKEY * 2 <= (size_t)TA * 128 * 8, "Vt overflows SEL region");
constexpr size_t OFF_SELE = OFF_SEL;
constexpr size_t OFF_SELG = OFF_SEL + (size_t)TA * 128 * 4;

__device__ __forceinline__ float bf2f(bf16_t v) { return __uint_as_float(((unsigned)v) << 16); }
__device__ __forceinline__ bf16_t f2bf(float f) {
    unsigned u = __float_as_uint(f);
    u += 0x7fffu + ((u >> 16) & 1u);
    return (bf16_t)(u >> 16);
}
typedef float f32x2 __attribute__((ext_vector_type(2)));
typedef float f32x16 __attribute__((ext_vector_type(16)));
typedef __bf16 bf16x2_t __attribute__((ext_vector_type(2)));
__device__ __forceinline__ unsigned pack2(float lo, float hi) { f32x2 v = {lo, hi}; return __builtin_bit_cast(unsigned, __builtin_convertvector(v, bf16x2_t)); }
__device__ __forceinline__ float sigmoidf_(float x) { return 1.0f / (1.0f + __expf(-x)); }
__device__ __forceinline__ float siluf_(float x) { return x * sigmoidf_(x); }
__device__ __forceinline__ float wave_sum(float v) {
#pragma unroll
    for (int o = 32; o >= 1; o >>= 1) v += __shfl_xor(v, o);
    return v;
}
__device__ __forceinline__ int mod_row(int row) { return row < TL ? (row >> 12) : 8; }

__device__ void ph_transpose(int bid, int nb, const float* __restrict__ in, bf16_t* __restrict__ out, int K, int N, float* lds) {
    const int tk = K / 32, tn = N / 32, nt = tk * tn;
    const int tx = threadIdx.x & 31, ty = threadIdx.x >> 5;
    for (int t = bid; t < nt; t += nb) {
        const int k0 = (t / tn) * 32, n0 = (t % tn) * 32;
        __syncthreads();
#pragma unroll
        for (int i = 0; i < 4; ++i) lds[(ty + i * 8) * 33 + tx] = in[(size_t)(k0 + ty + i * 8) * N + n0 + tx];
        __syncthreads();
#pragma unroll
        for (int i = 0; i < 4; ++i) out[(size_t)(n0 + ty + i * 8) * K + k0 + tx] = f2bf(lds[tx * 33 + ty + i * 8]);
    }
}
__device__ void ph_cvt(int bid, int nb, const float* __restrict__ in, bf16_t* __restrict__ out, size_t n) {
    const size_t n8 = n / 8;
    for (size_t i = (size_t)bid * blockDim.x + threadIdx.x; i < n8; i += (size_t)nb * blockDim.x) {
        const float4 a = ((const float4*)in)[i * 2], b = ((const float4*)in)[i * 2 + 1];
        uint4 w; w.x = pack2(a.x, a.y); w.y = pack2(a.z, a.w); w.z = pack2(b.x, b.y); w.w = pack2(b.z, b.w);
        ((uint4*)out)[i] = w;
    }
}
__device__ void ph_cvt8(int bid, int nb, const float* __restrict__ in, unsigned char* __restrict__ out, size_t n, float scale) {
    const size_t n16 = n / 16;
    for (size_t i = (size_t)bid * blockDim.x + threadIdx.x; i < n16; i += (size_t)nb * blockDim.x) {
        const float4 a = ((const float4*)in)[i * 4], b = ((const float4*)in)[i * 4 + 1], c = ((const float4*)in)[i * 4 + 2], d = ((const float4*)in)[i * 4 + 3];
        int w0 = __builtin_amdgcn_cvt_pk_fp8_f32(a.x * scale, a.y * scale, 0, false); w0 = __builtin_amdgcn_cvt_pk_fp8_f32(a.z * scale, a.w * scale, w0, true);
        int w1 = __builtin_amdgcn_cvt_pk_fp8_f32(b.x * scale, b.y * scale, 0, false); w1 = __builtin_amdgcn_cvt_pk_fp8_f32(b.z * scale, b.w * scale, w1, true);
        int w2 = __builtin_amdgcn_cvt_pk_fp8_f32(c.x * scale, c.y * scale, 0, false); w2 = __builtin_amdgcn_cvt_pk_fp8_f32(c.z * scale, c.w * scale, w2, true);
        int w3 = __builtin_amdgcn_cvt_pk_fp8_f32(d.x * scale, d.y * scale, 0, false); w3 = __builtin_amdgcn_cvt_pk_fp8_f32(d.z * scale, d.w * scale, w3, true);
        ((int4*)out)[i] = make_int4(w0, w1, w2, w3);
    }
}
__device__ void ph_mod(int bid, int nb, const float* __restrict__ c, const float* __restrict__ c_ctx, const float* __restrict__ ada_w,
                       const float* __restrict__ ada_b, float* __restrict__ mod, float* lds) {
    float* s = lds;
    float* red = lds + 9 * 1024;
    const int tx = threadIdx.x & 63, ky = threadIdx.x >> 6;
    for (int i = threadIdx.x; i < 9 * 1024; i += 256) {
        const int r = i >> 10, k = i & 1023;
        const float v = r < 8 ? c[r * 1024 + k] : c_ctx[k];
        s[i] = siluf_(v);
    }
    __syncthreads();
    const int nitems = 2 * 96;
    for (int it = bid; it < nitems; it += nb) {
        const int layer = it / 96, n = (it % 96) * 64 + tx;
        const float* w = ada_w + (size_t)layer * 1024 * 6144 + n;
        float acc[9];
#pragma unroll
        for (int r = 0; r < 9; ++r) acc[r] = 0.f;
        for (int k = ky * 256; k < ky * 256 + 256; ++k) {
            const float wv = w[(size_t)k * 6144];
#pragma unroll
            for (int r = 0; r < 9; ++r) acc[r] += s[r * 1024 + k] * wv;
        }
        __syncthreads();
#pragma unroll
        for (int r = 0; r < 9; ++r) red[(ky * 9 + r) * 64 + tx] = acc[r];
        __syncthreads();
        if (ky == 0) {
#pragma unroll
            for (int r = 0; r < 9; ++r) {
                const float v = red[(0 * 9 + r) * 64 + tx] + red[(1 * 9 + r) * 64 + tx] + red[(2 * 9 + r) * 64 + tx] + red[(3 * 9 + r) * 64 + tx];
                mod[((size_t)layer * 9 + r) * 6144 + n] = v + ada_b[layer * 6144 + n];
            }
        }
    }
}
__device__ void ph_tables(int bid, int nb, float* cosS, float* sinS, float* cosG, float* sinG, const float* __restrict__ lb_logits, float* lb) {
    const int gt = bid * blockDim.x + threadIdx.x, gs = nb * blockDim.x;
    for (int i = gt; i < SEQ * 32; i += gs) {
        const int t = i >> 5, j = i & 31;
        const float pos = (float)(j < 16 ? (t >> 6) : (t & 63));
        const float inv = powf(10000.0f, -(float)(j & 15) / 16.0f);
        const float ang = pos * inv;
        cosS[i] = cosf(ang); sinS[i] = sinf(ang);
    }
    for (int i = gt; i < SEQ * 64; i += gs) {
        const int t = i >> 6, j = i & 63;
        const float pos = (float)(j < 32 ? (t >> 6) : (t & 63));
        const float inv = powf(10000.0f, -(float)(j & 31) / 32.0f);
        const float ang = pos * inv;
        cosG[i] = cosf(ang); sinG[i] = sinf(ang);
    }
    for (int i = gt; i < 512; i += gs) {
        const float l0 = lb_logits[i], l1 = lb_logits[512 + i];
        lb[i] = 1.0f / (1.0f + expf(l1 - l0));
    }
}

__device__ void ph_normmod(int bid, int nb, const float* __restrict__ hlat, const float* __restrict__ hctx, const float* __restrict__ gamma,
                           const float* __restrict__ modl  , int sc_off, int sh_off, bf16_t* __restrict__ out, int nrows) {
    const int lane = threadIdx.x & 63, wid = threadIdx.x >> 6;
    for (int row = bid * 4 + wid; row < nrows; row += nb * 4) {
        const float* src = row < TL ? hlat + (size_t)row * D : hctx + (size_t)(row - TL) * D;
        const float* m = modl + (size_t)mod_row(row) * 6144;
        float4 x[4]; float ss = 0.f;
#pragma unroll
        for (int i = 0; i < 4; ++i) { x[i] = ((const float4*)src)[i * 64 + lane]; ss += x[i].x * x[i].x + x[i].y * x[i].y + x[i].z * x[i].z + x[i].w * x[i].w; }
        ss = wave_sum(ss);
        const float rinv = rsqrtf(ss * (1.0f / D) + EPS);
#pragma unroll
        for (int i = 0; i < 4; ++i) {
            const int col = (i * 64 + lane) * 4;
            const float4 g = *(const float4*)(gamma + col), sc = *(const float4*)(m + sc_off + col), sh = *(const float4*)(m + sh_off + col);
            const float y0 = x[i].x * rinv * g.x * (1.f + sc.x) + sh.x, y1 = x[i].y * rinv * g.y * (1.f + sc.y) + sh.y;
            const float y2 = x[i].z * rinv * g.z * (1.f + sc.z) + sh.z, y3 = x[i].w * rinv * g.w * (1.f + sc.w) + sh.w;
            uint2 w; w.x = pack2(y0, y1); w.y = pack2(y2, y3);
            *(uint2*)(out + (size_t)row * D + col) = w;
        }
    }
}

constexpr int GEMM_LDS = 65536;
template <class Epi>
__device__ __forceinline__ void gemm_tile(const bf16_t* __restrict__ A, int lda, const bf16_t* __restrict__ Bt, int ldb, int K,
                                          int m0, int n0, char* lds, Epi& epi) {
    const int tid = threadIdx.x, lane = tid & 63, wid = tid >> 6, wr = wid >> 1, wc = wid & 1, fr = lane & 15, fq = lane >> 4;
    f32x4 acc[4][4];
#pragma unroll
    for (int i = 0; i < 4; ++i)
#pragma unroll
        for (int j = 0; j < 4; ++j) acc[i][j] = (f32x4){0.f, 0.f, 0.f, 0.f};
    const int nk = K / 64;
    const int sr0 = tid >> 3, sc0 = tid & 7;
    const bf16_t* ga = A + (size_t)(m0 + sr0) * lda + sc0 * 8;
    const bf16_t* gb = Bt + (size_t)(n0 + sr0) * ldb + sc0 * 8;
    const int soff = sr0 * 128 + ((sc0 ^ (sr0 & 7)) << 4);
    uint4 pa0, pa1, pa2, pa3, pb0, pb1, pb2, pb3, qa0, qa1, qa2, qa3, qb0, qb1, qb2, qb3;
#define GT_GLOAD(S, kt) do { const int _ko = (kt) * 64; \
        S##a0 = *(const uint4*)(ga + _ko); S##a1 = *(const uint4*)(ga + (size_t)32 * lda + _ko); \
        S##a2 = *(const uint4*)(ga + (size_t)64 * lda + _ko); S##a3 = *(const uint4*)(ga + (size_t)96 * lda + _ko); \
        S##b0 = *(const uint4*)(gb + _ko); S##b1 = *(const uint4*)(gb + (size_t)32 * ldb + _ko); \
        S##b2 = *(const uint4*)(gb + (size_t)64 * ldb + _ko); S##b3 = *(const uint4*)(gb + (size_t)96 * ldb + _ko); } while (0)
#define GT_LSTORE(S, buf) do { char* _b = lds + (buf) * 32768 + soff; \
        *(uint4*)(_b) = S##a0; *(uint4*)(_b + 4096) = S##a1; *(uint4*)(_b + 8192) = S##a2; *(uint4*)(_b + 12288) = S##a3; \
        *(uint4*)(_b + 16384) = S##b0; *(uint4*)(_b + 16384 + 4096) = S##b1; *(uint4*)(_b + 16384 + 8192) = S##b2; *(uint4*)(_b + 16384 + 12288) = S##b3; } while (0)
#define GT_COMPUTE(buf) do { const char* base = lds + (buf) * 32768; \
        _Pragma("unroll") for (int kk = 0; kk < 2; ++kk) { \
            bf16x8 af[4], bfr[4]; \
            _Pragma("unroll") for (int i = 0; i < 4; ++i) { \
                const int ar = wr * 64 + i * 16 + fr, br = wc * 64 + i * 16 + fr; const int c = kk * 4 + fq; \
                af[i] = *(const bf16x8*)(base + ar * 128 + ((c ^ (ar & 7)) << 4)); \
                bfr[i] = *(const bf16x8*)(base + 16384 + br * 128 + ((c ^ (br & 7)) << 4)); } \
            _Pragma("unroll") for (int i = 0; i < 4; ++i) \
                _Pragma("unroll") for (int j = 0; j < 4; ++j) acc[i][j] = __builtin_amdgcn_mfma_f32_16x16x32_bf16(bfr[j], af[i], acc[i][j], 0, 0, 0); } } while (0)
    __syncthreads();
    GT_GLOAD(p, 0);
    if (nk > 1) GT_GLOAD(q, 1);
    GT_LSTORE(p, 0);
    __syncthreads();
    for (int kt = 0; kt < nk; kt += 2) {
        if (kt + 2 < nk) GT_GLOAD(p, kt + 2);
        __builtin_amdgcn_sched_barrier(0);
        GT_COMPUTE(0);
        __builtin_amdgcn_sched_barrier(0);
        GT_LSTORE(q, 1);
        __syncthreads();
        if (kt + 3 < nk) GT_GLOAD(q, kt + 3);
        __builtin_amdgcn_sched_barrier(0);
        GT_COMPUTE(1);
        __builtin_amdgcn_sched_barrier(0);
        if (kt + 2 < nk) GT_LSTORE(p, 0);
        __syncthreads();
    }
#undef GT_GLOAD
#undef GT_LSTORE
#undef GT_COMPUTE
    epi(acc, m0 + wr * 64 + fr, n0 + wc * 64 + fq * 4, lds);
}

struct EpiStoreSplit {
    bf16_t* O1; int ld1; bf16_t* O2; int ld2; int split;
    __device__ __forceinline__ void operator()(f32x4 (&acc)[4][4], int row0, int col0, char*) const {
#pragma unroll
        for (int i = 0; i < 4; ++i)
#pragma unroll
            for (int j = 0; j < 4; ++j) {
                const int row = row0 + i * 16, col = col0 + j * 16;
                uint2 w; w.x = pack2(acc[i][j][0], acc[i][j][1]); w.y = pack2(acc[i][j][2], acc[i][j][3]);
                if (col < split) *(uint2*)(O1 + (size_t)row * ld1 + col) = w;
                else *(uint2*)(O2 + (size_t)row * ld2 + (col - split)) = w;
            }
    }
};
struct EpiResid {
    const float* hin_lat; const float* hin_ctx; float* hout_lat; float* hout_ctx; const float* gate  ;
    __device__ __forceinline__ void operator()(f32x4 (&acc)[4][4], int row0, int col0, char*) const {
#pragma unroll
        for (int i = 0; i < 4; ++i) {
            const int row = row0 + i * 16;
            const float* hi = row < TL ? hin_lat + (size_t)row * D : hin_ctx + (size_t)(row - TL) * D;
            float* ho = row < TL ? hout_lat + (size_t)row * D : hout_ctx + (size_t)(row - TL) * D;
            const float* g = gate + (size_t)mod_row(row) * 6144;
#pragma unroll
            for (int j = 0; j < 4; ++j) {
                const int col = col0 + j * 16;
                const float4 h = *(const float4*)(hi + col), gg = *(const float4*)(g + col);
                float4 o; o.x = h.x + gg.x * acc[i][j][0]; o.y = h.y + gg.y * acc[i][j][1]; o.z = h.z + gg.z * acc[i][j][2]; o.w = h.w + gg.w * acc[i][j][3];
                *(float4*)(ho + col) = o;
            }
        }
    }
};
template <class Epi>
__device__ void ph_gemm(int bid, int nb, const bf16_t* A, int lda, const bf16_t* Bt, int ldb, int M, int N, int K, char* lds, Epi epi) {
    const int tm = M / 128, tn = N / 128;
    for (int t = bid; t < tm * tn; t += nb) {
        const int m0 = (t / tn) * 128, n0 = (t % tn) * 128;
        gemm_tile(A, lda, Bt, ldb, K, m0, n0, lds, epi);
    }
}
typedef short bf16x4 __attribute__((ext_vector_type(4)));
constexpr int HQ_OFF = 0, HK_OFF = 16384, HKT_OFF = 32768, HVT_OFF = 49152, HD_OFF = 57344, HG_LDS = 59392;
__device__ __forceinline__ int hg_row(int b, int dir, int p) {
    if (p < LC) { const int s = dir ? (LC - 1 - p) : p; return TL + b * LC + s; }
    const int t = dir ? (SEQ - 1 - (p - LC)) : (p - LC);
    return b * SEQ + t;
}
__device__ void ph_hgrn(int bid, int nb, const bf16_t* __restrict__ projH, const float* __restrict__ lb, bf16_t* __restrict__ of, bf16_t* __restrict__ ob, char* lds) {
    const int tid = threadIdx.x, lane = tid & 63, w = tid >> 6, fr = lane & 15, fq = lane >> 4;
    for (int it = bid; it < NB * 4 * 2 * 2; it += nb) {
        const int vs = it & 1, dir = (it >> 1) & 1, h = (it >> 2) & 3, b = it >> 4;
        bf16_t* out = dir ? ob : of;
        const float lb0 = lb[h * 128 + 2 * lane], lb1 = lb[h * 128 + 2 * lane + 1];
        const int fcol = (dir ? 1024 : 512) + h * 128 + 2 * lane, qcol = h * 128 + 2 * lane, vcol = 1536 + h * 128 + vs * 64 + lane;
        f32x4 S[8];
#pragma unroll
        for (int kt = 0; kt < 8; ++kt) S[kt] = (f32x4){0.f, 0.f, 0.f, 0.f};
        unsigned xf[16], xq[16]; bf16_t xv[16];
#define HG_PREFETCH(p0) do { _Pragma("unroll") for (int i = 0; i < 16; ++i) { \
            const size_t rb = (size_t)hg_row(b, dir, (p0) + 16 * w + i) * HGW; \
            xf[i] = *(const unsigned*)(projH + rb + fcol); xq[i] = *(const unsigned*)(projH + rb + qcol); xv[i] = projH[rb + vcol]; } } while (0)
        HG_PREFETCH(0);
        for (int p0 = 0; p0 < NKEY; p0 += 64) {
            __syncthreads();
            {
                float c0 = 0.f, c1 = 0.f, kp0 = 0.f, kp1 = 0.f;
                unsigned kt0[8], kt1[8], vt[8];
#pragma unroll
                for (int i = 0; i < 16; ++i) {
                    const float xf0 = __uint_as_float(xf[i] << 16), xf1 = __uint_as_float(xf[i] & 0xffff0000u);
                    const float xq0 = __uint_as_float(xq[i] << 16), xq1 = __uint_as_float(xq[i] & 0xffff0000u);
                    const float f0 = lb0 + (1.f - lb0) * __builtin_amdgcn_rcpf(1.f + __expf(-xf0));
                    const float f1 = lb1 + (1.f - lb1) * __builtin_amdgcn_rcpf(1.f + __expf(-xf1));
                    c0 += __logf(f0); c1 += __logf(f1);
                    const float q0 = xq0 * __builtin_amdgcn_rcpf(1.f + __expf(-xq0)) * __expf(c0);
                    const float q1 = xq1 * __builtin_amdgcn_rcpf(1.f + __expf(-xq1)) * __expf(c1);
                    const float k0 = (1.f - f0) * __expf(fminf(-c0, 80.f)), k1 = (1.f - f1) * __expf(fminf(-c1, 80.f));
                    const int t = 16 * w + i;
                    const int o = t * 256 + (((lane >> 2) ^ (t & 15)) << 4) + (lane & 3) * 4;
                    *(unsigned*)(lds + HQ_OFF + o) = pack2(q0, q1);
                    *(unsigned*)(lds + HK_OFF + o) = pack2(k0, k1);
                    if (i & 1) { kt0[i >> 1] = pack2(kp0, k0); kt1[i >> 1] = pack2(kp1, k1); vt[i >> 1] = (unsigned)xv[i - 1] | ((unsigned)xv[i] << 16); }
                    else { kp0 = k0; kp1 = k1; }
                }
                float2 dd; dd.x = __expf(c0); dd.y = __expf(c1);
                *(float2*)(lds + HD_OFF + (w * 128 + 2 * lane) * 4) = dd;
                char* kp = lds + HKT_OFF + w * 4096 + (2 * lane) * 32;
                *(uint4*)(kp) = make_uint4(kt0[0], kt0[1], kt0[2], kt0[3]); *(uint4*)(kp + 16) = make_uint4(kt0[4], kt0[5], kt0[6], kt0[7]);
                *(uint4*)(kp + 32) = make_uint4(kt1[0], kt1[1], kt1[2], kt1[3]); *(uint4*)(kp + 48) = make_uint4(kt1[4], kt1[5], kt1[6], kt1[7]);
                char* vp = lds + HVT_OFF + w * 2048 + lane * 32;
                *(uint4*)(vp) = make_uint4(vt[0], vt[1], vt[2], vt[3]); *(uint4*)(vp + 16) = make_uint4(vt[4], vt[5], vt[6], vt[7]);
            }
            if (p0 + 64 < NKEY) HG_PREFETCH(p0 + 64);
            __syncthreads();
#pragma unroll
            for (int I = 0; I < 4; ++I) {
                const int trow = 16 * I + fr;
                f32x4 at = (f32x4){0.f, 0.f, 0.f, 0.f};
#pragma unroll
                for (int ks = 0; ks < 4; ++ks) {
                    const int o = trow * 256 + (((ks * 4 + fq) ^ fr) << 4);
                    const bf16x8 ka = *(const bf16x8*)(lds + HK_OFF + o);
                    const bf16x8 qa = *(const bf16x8*)(lds + HQ_OFF + o);
                    at = __builtin_amdgcn_mfma_f32_16x16x32_bf16(ka, qa, at, 0, 0, 0);
                }
#pragma unroll
                for (int j = 0; j < 4; ++j) if (4 * fq + j > fr) at[j] = 0.f;
                uint2 pa2; pa2.x = pack2(at[0], at[1]); pa2.y = pack2(at[2], at[3]);
                const bf16x4 pA = __builtin_bit_cast(bf16x4, pa2);
                const bf16x4 vfrag = *(const bf16x4*)(lds + HVT_OFF + I * 2048 + (w * 16 + fr) * 32 + fq * 8);
                f32x4 o1 = __builtin_amdgcn_mfma_f32_16x16x16bf16_1k(vfrag, pA, (f32x4){0.f, 0.f, 0.f, 0.f}, 0, 0, 0);
                f32x4 o2 = (f32x4){0.f, 0.f, 0.f, 0.f};
#pragma unroll
                for (int kt = 0; kt < 8; ++kt) {
                    uint2 s2; s2.x = pack2(S[kt][0], S[kt][1]); s2.y = pack2(S[kt][2], S[kt][3]);
                    const bf16x4 sfrag = __builtin_bit_cast(bf16x4, s2);
                    const bf16x4 qfrag = *(const bf16x4*)(lds + HQ_OFF + trow * 256 + (((kt * 2 + (fq >> 1)) ^ fr) << 4) + (fq & 1) * 8);
                    if (kt & 1) o2 = __builtin_amdgcn_mfma_f32_16x16x16bf16_1k(sfrag, qfrag, o2, 0, 0, 0);
                    else o1 = __builtin_amdgcn_mfma_f32_16x16x16bf16_1k(sfrag, qfrag, o1, 0, 0, 0);
                }
#pragma unroll
                for (int kt = 0; kt < 8; ++kt) {
                    const bf16x4 kfrag = *(const bf16x4*)(lds + HKT_OFF + I * 4096 + (kt * 16 + fr) * 32 + fq * 8);
                    const f32x4 d4 = *(const f32x4*)(lds + HD_OFF + (I * 128 + kt * 16 + fq * 4) * 4);
                    S[kt] = __builtin_amdgcn_mfma_f32_16x16x16bf16_1k(kfrag, vfrag, S[kt], 0, 0, 0);
                    S[kt] = S[kt] * d4;
                }
                const size_t orow = (size_t)hg_row(b, dir, p0 + trow);
                uint2 ov; ov.x = pack2(o1[0] + o2[0], o1[1] + o2[1]); ov.y = pack2(o1[2] + o2[2], o1[3] + o2[3]);
                *(uint2*)(out + orow * 512 + h * 128 + vs * 64 + w * 16 + fq * 4) = ov;
            }
        }
#undef HG_PREFETCH
    }
}
__device__ void ph_hgpost(int bid, int nb, const bf16_t* __restrict__ of, const bf16_t* __restrict__ ob, const bf16_t* __restrict__ projH,
                          const float* __restrict__ g, bf16_t* __restrict__ mix) {
    const int lane = threadIdx.x & 63, wid = threadIdx.x >> 6;
    for (int it = bid * 4 + wid; it < TA * 4; it += nb * 4) {
        const int row = it >> 2, h = it & 3;
        const size_t o = (size_t)row * 512 + h * 128 + lane * 2;
        const unsigned a = *(const unsigned*)(of + o), bb = *(const unsigned*)(ob + o);
        const float x0 = bf2f((bf16_t)(a & 0xffff)) + bf2f((bf16_t)(bb & 0xffff)), x1 = bf2f((bf16_t)(a >> 16)) + bf2f((bf16_t)(bb >> 16));
        const float ss = wave_sum(x0 * x0 + x1 * x1);
        const float rinv = rsqrtf(ss * (1.0f / 128.0f) + EPS);
        const unsigned gg = *(const unsigned*)(projH + (size_t)row * HGW + 2048 + h * 128 + lane * 2);
        const float y0 = x0 * rinv * g[lane * 2] * siluf_(bf2f((bf16_t)(gg & 0xffff)));
        const float y1 = x1 * rinv * g[lane * 2 + 1] * siluf_(bf2f((bf16_t)(gg >> 16)));
        *(unsigned*)(mix + (size_t)row * D + h * 128 + lane * 2) = pack2(y0, y1);
    }
}

__device__ void ph_prep_swa(int bid, int nb, bf16_t* __restrict__ P, const float* __restrict__ cosS, const float* __restrict__ sinS) {
    const size_t n = (size_t)TA * 320;
    for (size_t idx = (size_t)bid * blockDim.x + threadIdx.x; idx < n; idx += (size_t)nb * blockDim.x) {
        const int row = (int)(idx / 320), pr = (int)(idx % 320), head = pr >> 5, d = pr & 31;
        bf16_t* p = P + (size_t)row * SWW + head * 64 + d;
        float x1 = bf2f(p[0]), x2 = bf2f(p[32]);
        if (row < TL) {
            const int t = row & (SEQ - 1);
            const float c = cosS[t * 32 + d], s = sinS[t * 32 + d];
            const float y1 = x1 * c - x2 * s, y2 = x1 * s + x2 * c;
            x1 = y1; x2 = y2;
        }
        if (head < 8) { x1 *= 0.125f * LOG2E; x2 *= 0.125f * LOG2E; }
        p[0] = f2bf(x1); p[32] = f2bf(x2);
    }
}
__device__ void ph_prep_ga(int bid, int nb, bf16_t* __restrict__ P, const float* __restrict__ qg, const float* __restrict__ kg,
                           const float* __restrict__ cosG, const float* __restrict__ sinG) {
    const int lane = threadIdx.x & 63, wid = threadIdx.x >> 6;
    for (int it = bid * 4 + wid; it < TA * 10; it += nb * 4) {
        const int row = it / 10, head = it % 10;
        bf16_t* p = P + (size_t)row * GA_IN + head * 128;
        float x1 = bf2f(p[lane]), x2 = bf2f(p[lane + 64]);
        const float ss = wave_sum(x1 * x1 + x2 * x2);
        const float rinv = rsqrtf(ss * (1.0f / 128.0f) + EPS);
        const float* g = head < 8 ? qg : kg;
        x1 = x1 * rinv * g[lane]; x2 = x2 * rinv * g[lane + 64];
        if (row < TL) {
            const int t = row & (SEQ - 1);
            const float c = cosG[t * 64 + lane], s = sinG[t * 64 + lane];
            const float y1 = x1 * c - x2 * s, y2 = x1 * s + x2 * c;
            x1 = y1; x2 = y2;
        }
        if (head < 8) { x1 *= 0.08838834764831845f * LOG2E; x2 *= 0.08838834764831845f * LOG2E; }
        p[lane] = f2bf(x1); p[lane + 64] = f2bf(x2);
    }
}

template <int HD>
__device__ void ph_vt(int bid, int nb, const bf16_t* __restrict__ P, int ldp, int vcol, bf16_t* __restrict__ Vt, bf16_t* lds) {
    constexpr int ND = HD / 64;
    const int tid = threadIdx.x;
    for (int it = bid; it < NB * 2 * ND * (NKEY / 64); it += nb) {
        const int kt = it % (NKEY / 64), r1 = it / (NKEY / 64), dh = r1 % ND, g = r1 / ND, b = g >> 1, kvh = g & 1;
        const int k0 = kt * 64;
        const int row0 = k0 < LC ? TL + b * LC + k0 : b * SEQ + (k0 - LC);
        __syncthreads();
#pragma unroll
        for (int i = 0; i < 2; ++i) {
            const int id = tid + i * 256, kr = id >> 3, c = id & 7;
            const uint4 w = *(const uint4*)(P + (size_t)(row0 + kr) * ldp + vcol + kvh * HD + dh * 64 + c * 8);
            const unsigned ww[4] = {w.x, w.y, w.z, w.w};
#pragma unroll
            for (int j = 0; j < 4; ++j) { lds[kr * 66 + c * 8 + j * 2] = (bf16_t)(ww[j] & 0xffff); lds[kr * 66 + c * 8 + j * 2 + 1] = (bf16_t)(ww[j] >> 16); }
        }
        __syncthreads();
#pragma unroll
        for (int i = 0; i < 2; ++i) {
            const int id = tid + i * 256, d = id >> 3, c = id & 7;
            unsigned o[4];
#pragma unroll
            for (int j = 0; j < 4; ++j) o[j] = (unsigned)lds[(c * 8 + j * 2) * 66 + d] | ((unsigned)lds[(c * 8 + j * 2 + 1) * 66 + d] << 16);
            uint4 w; w.x = o[0]; w.y = o[1]; w.z = o[2]; w.w = o[3];
            *(uint4*)(Vt + (size_t)(g * HD + dh * 64 + d) * NKEY + k0 + c * 8) = w;
        }
    }
}

template <int HD, bool MASK>
__device__ __forceinline__ void flash_item(const bf16_t* __restrict__ Qrow0, int ldq, const bf16_t* __restrict__ Kp, int ldk,
                                           const bf16_t* __restrict__ Vt, int krow_ctx0, int krow_lat0, int nctx_t, int lat_lo, int nlat_t,
                                           int tq0, float m0, float l0, bf16_t* __restrict__ Orow0, int ldo, char* lds) {
    constexpr int NCH = HD / 32;
    constexpr int KB = 64 * HD * 2;
    constexpr int NKK = HD / 16;
    constexpr int NDT = HD / 32;
    const int tid = threadIdx.x, lane = tid & 63, w = tid >> 6, r = lane & 31, h = lane >> 5;
    const int pr = (r & 0x13) | ((r & 4) << 1) | ((r & 8) >> 1);
    bf16x8 qf[NKK];
    {
        const bf16_t* qp = Qrow0 + (size_t)(32 * w + r) * ldq + 8 * h;
#pragma unroll
        for (int kk = 0; kk < NKK; ++kk) qf[kk] = *(const bf16x8*)(qp + 16 * kk);
    }
    f32x16 O[NDT];
#pragma unroll
    for (int dt = 0; dt < NDT; ++dt)
#pragma unroll
        for (int i = 0; i < 16; ++i) O[dt][i] = 0.f;
    float m_run = m0, l_run = (h == 0) ? l0 : 0.f;
    const int kc = (HD == 128) ? (tid & 15) : (tid & 7);
    const int kr = (HD == 128) ? (tid >> 4) : (tid >> 3);
    const int ksw = (HD == 128) ? (kr & 15) : ((kr >> 1) & 7);
    const int klds = kr * (HD * 2) + ((kc ^ ksw) << 4);
    constexpr int KRSTEP = (HD == 128) ? 16 : 32;
    const int vr = tid >> 3, vc = tid & 7;
    const int vlds = KB + vr * 128 + ((vc ^ ((vr >> 1) & 7)) << 4);
    const int kfo = pr * (HD * 2);
    const int kfs = (HD == 128) ? (pr & 15) : ((pr >> 1) & 7);
    const int vfo = KB + r * 128;
    const int vfs = (r >> 1) & 7;
    const int ntile = nctx_t + nlat_t;
    uint4 sg0, sg1, sg2, sg3;
    sg2 = sg3 = make_uint4(0u, 0u, 0u, 0u);
#define FA_TILE(t, krow0, kidx0, s0) const int krow0 = (t) < nctx_t ? krow_ctx0 + 64 * (t) : krow_lat0 + lat_lo + 64 * ((t) - nctx_t); \
        const int s0 = (t) < nctx_t ? -(1 << 24) : lat_lo + 64 * ((t) - nctx_t); const int kidx0 = (t) < nctx_t ? 64 * (t) : LC + lat_lo + 64 * ((t) - nctx_t);
#define FA_GLOADK(t) do { FA_TILE(t, _kr0, _ki0, _s0) (void)_s0; (void)_ki0; \
        const bf16_t* _kp = Kp + (size_t)(_kr0 + kr) * ldk + kc * 8; \
        sg0 = *(const uint4*)(_kp); sg1 = *(const uint4*)(_kp + (size_t)KRSTEP * ldk); \
        if (NCH == 4) { sg2 = *(const uint4*)(_kp + (size_t)2 * KRSTEP * ldk); sg3 = *(const uint4*)(_kp + (size_t)3 * KRSTEP * ldk); } } while (0)
#define FA_GLOADV(t) do { FA_TILE(t, _kr0, _ki0, _s0) (void)_s0; (void)_kr0; \
        const bf16_t* _vp = Vt + (size_t)vr * NKEY + _ki0 + vc * 8; \
        sg0 = *(const uint4*)(_vp); sg1 = *(const uint4*)(_vp + (size_t)32 * NKEY); \
        if (NCH == 4) { sg2 = *(const uint4*)(_vp + (size_t)64 * NKEY); sg3 = *(const uint4*)(_vp + (size_t)96 * NKEY); } } while (0)
#define FA_LSTORE(buf, off) do { char* _b = lds + (buf) * (2 * KB) + (off); \
        *(uint4*)(_b) = sg0; *(uint4*)(_b + 4096) = sg1; \
        if (NCH == 4) { *(uint4*)(_b + 8192) = sg2; *(uint4*)(_b + 12288) = sg3; } } while (0)
    __syncthreads();
    FA_GLOADK(0); FA_LSTORE(0, klds);
    FA_GLOADV(0); FA_LSTORE(0, vlds);
    __syncthreads();
    for (int t = 0; t < ntile; ++t) {
        if (t + 1 < ntile) FA_GLOADK(t + 1);
        const char* base = lds + (t & 1) * (2 * KB);
        f32x16 st[2];
#pragma unroll
        for (int rt = 0; rt < 2; ++rt) {
#pragma unroll
            for (int i = 0; i < 16; ++i) st[rt][i] = 0.f;
#pragma unroll
            for (int kk = 0; kk < NKK; ++kk) {
                const bf16x8 kf = *(const bf16x8*)(base + rt * 32 * (HD * 2) + kfo + (((2 * kk + h) ^ kfs) << 4));
                st[rt] = __builtin_amdgcn_mfma_f32_32x32x16_bf16(kf, qf[kk], st[rt], 0, 0, 0);
                if ((kk & 3) == 3) __builtin_amdgcn_sched_barrier(0);
            }
        }
        if (MASK) {
            FA_TILE(t, _kr0, _ki0, s0) (void)_kr0; (void)_ki0;
            if (t >= nctx_t) {
                const int tq = tq0 + 32 * w + r;
#pragma unroll
                for (int rt = 0; rt < 2; ++rt)
#pragma unroll
                    for (int i = 0; i < 16; ++i) {
                        const int s = s0 + 32 * rt + (i & 3) + 4 * ((i >> 2) & 1) + 8 * h + 16 * (i >> 3);
                        const int dlt = tq - s;
                        if (dlt > 128 || dlt < -128) st[rt][i] = -1.0e30f;
                    }
            }
        }
        float mx = m_run;
#pragma unroll
        for (int rt = 0; rt < 2; ++rt)
#pragma unroll
            for (int i = 0; i < 16; ++i) mx = fmaxf(mx, st[rt][i]);
        mx = fmaxf(mx, __shfl_xor(mx, 32));
        const float alpha = __builtin_amdgcn_exp2f(m_run - mx);
        m_run = mx;
        float ps = 0.f;
#pragma unroll
        for (int rt = 0; rt < 2; ++rt)
#pragma unroll
            for (int i = 0; i < 16; ++i) { const float p = __builtin_amdgcn_exp2f(st[rt][i] - mx); st[rt][i] = p; ps += p; }
        l_run = l_run * alpha + ps;
        if (!__all(alpha == 1.0f)) {
#pragma unroll
            for (int dt = 0; dt < NDT; ++dt)
#pragma unroll
                for (int i = 0; i < 16; ++i) O[dt][i] *= alpha;
        }
        if (t + 1 < ntile) { FA_LSTORE((t + 1) & 1, klds); FA_GLOADV(t + 1); }
        bf16x8 pf[2][2];
#pragma unroll
        for (int rt = 0; rt < 2; ++rt)
#pragma unroll
            for (int s2 = 0; s2 < 2; ++s2) {
                uint4 pk;
                pk.x = pack2(st[rt][8 * s2 + 0], st[rt][8 * s2 + 1]); pk.y = pack2(st[rt][8 * s2 + 2], st[rt][8 * s2 + 3]);
                pk.z = pack2(st[rt][8 * s2 + 4], st[rt][8 * s2 + 5]); pk.w = pack2(st[rt][8 * s2 + 6], st[rt][8 * s2 + 7]);
                pf[rt][s2] = __builtin_bit_cast(bf16x8, pk);
            }
#pragma unroll
        for (int dt = 0; dt < NDT; ++dt)
#pragma unroll
            for (int rt = 0; rt < 2; ++rt)
#pragma unroll
                for (int s2 = 0; s2 < 2; ++s2) {
                    const bf16x8 vf = *(const bf16x8*)(base + vfo + dt * 4096 + (((4 * rt + 2 * s2 + h) ^ vfs) << 4));
                    O[dt] = __builtin_amdgcn_mfma_f32_32x32x16_bf16(vf, pf[rt][s2], O[dt], 0, 0, 0);
                    if (rt == 1 && s2 == 1) __builtin_amdgcn_sched_barrier(0);
                }
        if (t + 1 < ntile) FA_LSTORE((t + 1) & 1, vlds);
        __syncthreads();
    }
#undef FA_TILE
#undef FA_GLOADK
#undef FA_GLOADV
#undef FA_LSTORE
    const float lt = l_run + __shfl_xor(l_run, 32);
    const float inv = 1.0f / lt;
    bf16_t* op = Orow0 + (size_t)(32 * w + r) * ldo + 4 * h;
#pragma unroll
    for (int dt = 0; dt < NDT; ++dt)
#pragma unroll
        for (int g = 0; g < 4; ++g) {
            uint2 o2; o2.x = pack2(O[dt][4 * g] * inv, O[dt][4 * g + 1] * inv); o2.y = pack2(O[dt][4 * g + 2] * inv, O[dt][4 * g + 3] * inv);
            *(uint2*)(op + 32 * dt + 8 * g) = o2;
        }
}
__device__ void ph_swa(int bid, int nb, const bf16_t* __restrict__ projS, const bf16_t* __restrict__ Vt, const float* __restrict__ sink,
                       bf16_t* __restrict__ mix, char* lds) {
    const int n_lat = NB * 8 * 32, n_ctx = NB * 8 * 2;
    for (int it = bid; it < n_lat + n_ctx; it += nb) {
        int b, hq, row0, lo, nlat, t0;
        if (it < n_lat) {
            const int qb = it & 31; hq = (it >> 5) & 7; b = it >> 8;
            t0 = qb * 128;
            lo = t0 - 128 < 0 ? 0 : t0 - 128;
            const int hi = t0 + 256 > SEQ ? SEQ : t0 + 256;
            nlat = (hi - lo) / 64; row0 = b * SEQ + t0;
        } else {
            const int i2 = it - n_lat, qb = i2 & 1; hq = (i2 >> 1) & 7; b = i2 >> 4;
            t0 = 0; lo = 0; nlat = 0; row0 = TL + b * LC + qb * 128;
        }
        const int kvh = hq >> 2;
        flash_item<64, true>(projS + (size_t)row0 * SWW + hq * 64, SWW, projS + 512 + kvh * 64, SWW, Vt + (size_t)(b * 2 + kvh) * 64 * NKEY,
                             TL + b * LC, b * SEQ, 4, lo, nlat, t0, sink[hq] * LOG2E, 1.0f, mix + (size_t)row0 * D + 512 + hq * 64, D, lds);
    }
}
__device__ void ph_dense(int bid, int nb, const bf16_t* __restrict__ projG, const bf16_t* __restrict__ Vt, bf16_t* __restrict__ mix, char* lds) {
    const bool sw = (nb & 7) == 0;
    const int nit = NB * 8 * 32;
    for (int j = sw ? (bid >> 3) : bid; j < (sw ? nit / 8 : nit); j += sw ? (nb >> 3) : nb) {
        int g, jj;
        if (sw) { g = (bid & 7) + 8 * (j >> 7); jj = j & 127; } else { g = j >> 7; jj = j & 127; }
        const int b = g >> 1, kvh = g & 1, hq = kvh * 4 + (jj >> 5), qb = jj & 31;
        const int row0 = b * SEQ + qb * 128;
        flash_item<128, false>(projG + (size_t)row0 * GA_IN + hq * 128, GA_IN, projG + 1024 + kvh * 128, GA_IN, Vt + (size_t)(b * 2 + kvh) * 128 * NKEY,
                               TL + b * LC, b * SEQ, 4, 0, SEQ / 64, 0, -1.0e30f, 0.0f, mix + (size_t)row0 * D + hq * 128, D, lds);
    }
}

#define CE(a, b) { const float _h = fmaxf(a, b); b = fminf(a, b); a = _h; }
__device__ __forceinline__ void net_sort16(float (&v)[16]) {
    CE(v[0], v[1]); CE(v[3], v[2]); CE(v[4], v[5]); CE(v[7], v[6]); CE(v[8], v[9]); CE(v[11], v[10]);
    CE(v[12], v[13]); CE(v[15], v[14]); CE(v[0], v[2]); CE(v[1], v[3]); CE(v[6], v[4]); CE(v[7], v[5]);
    CE(v[8], v[10]); CE(v[9], v[11]); CE(v[14], v[12]); CE(v[15], v[13]); CE(v[0], v[1]); CE(v[2], v[3]);
    CE(v[5], v[4]); CE(v[7], v[6]); CE(v[8], v[9]); CE(v[10], v[11]); CE(v[13], v[12]); CE(v[15], v[14]);
    CE(v[0], v[4]); CE(v[1], v[5]); CE(v[2], v[6]); CE(v[3], v[7]); CE(v[12], v[8]); CE(v[13], v[9]);
    CE(v[14], v[10]); CE(v[15], v[11]); CE(v[0], v[2]); CE(v[1], v[3]); CE(v[4], v[6]); CE(v[5], v[7]);
    CE(v[10], v[8]); CE(v[11], v[9]); CE(v[14], v[12]); CE(v[15], v[13]); CE(v[0], v[1]); CE(v[2], v[3]);
    CE(v[4], v[5]); CE(v[6], v[7]); CE(v[9], v[8]); CE(v[11], v[10]); CE(v[13], v[12]); CE(v[15], v[14]);
    CE(v[0], v[8]); CE(v[1], v[9]); CE(v[2], v[10]); CE(v[3], v[11]); CE(v[4], v[12]); CE(v[5], v[13]);
    CE(v[6], v[14]); CE(v[7], v[15]); CE(v[0], v[4]); CE(v[1], v[5]); CE(v[2], v[6]); CE(v[3], v[7]);
    CE(v[8], v[12]); CE(v[9], v[13]); CE(v[10], v[14]); CE(v[11], v[15]); CE(v[0], v[2]); CE(v[1], v[3]);
    CE(v[4], v[6]); CE(v[5], v[7]); CE(v[8], v[10]); CE(v[9], v[11]); CE(v[12], v[14]); CE(v[13], v[15]);
    CE(v[0], v[1]); CE(v[2], v[3]); CE(v[4], v[5]); CE(v[6], v[7]); CE(v[8], v[9]); CE(v[10], v[11]);
    CE(v[12], v[13]); CE(v[14], v[15]);
}
__device__ __forceinline__ void net_clean16(float (&v)[16]) {
    CE(v[0], v[8]); CE(v[1], v[9]); CE(v[2], v[10]); CE(v[3], v[11]); CE(v[4], v[12]); CE(v[5], v[13]);
    CE(v[6], v[14]); CE(v[7], v[15]); CE(v[0], v[4]); CE(v[1], v[5]); CE(v[2], v[6]); CE(v[3], v[7]);
    CE(v[8], v[12]); CE(v[9], v[13]); CE(v[10], v[14]); CE(v[11], v[15]); CE(v[0], v[2]); CE(v[1], v[3]);
    CE(v[4], v[6]); CE(v[5], v[7]); CE(v[8], v[10]); CE(v[9], v[11]); CE(v[12], v[14]); CE(v[13], v[15]);
    CE(v[0], v[1]); CE(v[2], v[3]); CE(v[4], v[5]); CE(v[6], v[7]); CE(v[8], v[9]); CE(v[10], v[11]);
    CE(v[12], v[13]); CE(v[14], v[15]);
}
__device__ __forceinline__ void net_merge16(float (&a)[16], const float (&b)[16]) {
#pragma unroll
    for (int i = 0; i < 16; ++i) a[i] = fmaxf(a[i], b[15 - i]);
    net_clean16(a);
}
#define PEER_CANDS(F) F(0,0,0) F(1,0,1) F(2,0,2) F(3,0,3) F(4,0,4) F(5,0,5) F(6,0,6) F(7,0,7) F(8,0,8) F(9,0,9) F(10,0,10) F(11,0,11) F(12,0,12) F(13,0,13) F(14,0,14) F(15,0,15) F(16,1,1) F(17,1,2) F(18,1,3) F(19,1,4) F(20,1,5) F(21,1,6) F(22,1,7) F(23,2,2) F(24,2,3) F(25,2,4) F(26,3,3)

__device__ __forceinline__ void ph_peer_route(int bid, int nb, const bf16_t* __restrict__ qpeer, const bf16_t* __restrict__ SK, int* __restrict__ sel_e,
                              float* __restrict__ sel_g, int M, char* lds) {
    const int tid = threadIdx.x, lane = tid & 63, w = tid >> 6, r = lane & 31, h2 = lane >> 5;
    const int srow = tid >> 4, sc = tid & 15;
    const int soff = srow * 256 + ((sc ^ (srow & 15)) << 4);
    for (int it = bid; it < (M / 128) * 8; it += nb) {
        const int m0 = (it >> 3) * 128, hd = it & 7;
        const int row = 32 * w + r;
        __syncthreads();
#pragma unroll
        for (int pp = 0; pp < 2; ++pp) {
            const bf16_t* sp = SK + ((size_t)(hd * 2 + pp) * 128 + srow) * 128 + sc * 8;
            uint4 t0 = *(const uint4*)(sp), t1 = *(const uint4*)(sp + 16 * 128), t2 = *(const uint4*)(sp + 32 * 128), t3 = *(const uint4*)(sp + 48 * 128);
            uint4 t4 = *(const uint4*)(sp + 64 * 128), t5 = *(const uint4*)(sp + 80 * 128), t6 = *(const uint4*)(sp + 96 * 128), t7 = *(const uint4*)(sp + 112 * 128);
            char* d = lds + pp * 32768 + soff;
            *(uint4*)(d) = t0; *(uint4*)(d + 4096) = t1; *(uint4*)(d + 8192) = t2; *(uint4*)(d + 12288) = t3;
            *(uint4*)(d + 16384) = t4; *(uint4*)(d + 20480) = t5; *(uint4*)(d + 24576) = t6; *(uint4*)(d + 28672) = t7;
        }
        __syncthreads();
        float L0[16], L1[16];
#pragma unroll
        for (int pp = 0; pp < 2; ++pp) {
            bf16x8 qf[8];
            const bf16_t* qp = qpeer + (size_t)(m0 + row) * PQ + hd * 256 + pp * 128 + 8 * h2;
#pragma unroll
            for (int kk = 0; kk < 8; ++kk) qf[kk] = *(const bf16x8*)(qp + 16 * kk);
            float g[4][16];
#pragma unroll
            for (int kt = 0; kt < 4; ++kt) {
                f32x16 st;
#pragma unroll
                for (int i = 0; i < 16; ++i) st[i] = 0.f;
#pragma unroll
                for (int kk = 0; kk < 8; ++kk) {
                    const bf16x8 kf = *(const bf16x8*)(lds + pp * 32768 + (32 * kt + r) * 256 + (((2 * kk + h2) ^ (r & 15)) << 4));
                    st = __builtin_amdgcn_mfma_f32_32x32x16_bf16(kf, qf[kk], st, 0, 0, 0);
                }
#pragma unroll
                for (int i = 0; i < 16; ++i) {
                    const unsigned n = 32 * kt + (i & 3) + 8 * (i >> 2) + 4 * h2;
                    g[kt][i] = __uint_as_float((__float_as_uint(st[i]) & 0xFFFFFF80u) | n);
                }
            }
            net_sort16(g[0]); net_sort16(g[1]); net_sort16(g[2]); net_sort16(g[3]);
            net_merge16(g[0], g[1]); net_merge16(g[2], g[3]); net_merge16(g[0], g[2]);
            float pb[16];
#pragma unroll
            for (int i = 0; i < 16; ++i) pb[i] = __shfl_xor(g[0][i], 32);
            net_merge16(g[0], pb);
#pragma unroll
            for (int i = 0; i < 16; ++i) { if (pp == 0) L0[i] = g[0][i]; else L1[i] = g[0][i]; }
        }
        __syncthreads();
        unsigned char* tab = (unsigned char*)lds;
        if (h2 == 0) {
            unsigned wv[8];
#pragma unroll
            for (int j = 0; j < 4; ++j) {
                wv[j] = (__float_as_uint(L0[4 * j]) & 0x7Fu) | ((__float_as_uint(L0[4 * j + 1]) & 0x7Fu) << 8) | ((__float_as_uint(L0[4 * j + 2]) & 0x7Fu) << 16) | ((__float_as_uint(L0[4 * j + 3]) & 0x7Fu) << 24);
                wv[4 + j] = (__float_as_uint(L1[4 * j]) & 0x7Fu) | ((__float_as_uint(L1[4 * j + 1]) & 0x7Fu) << 8) | ((__float_as_uint(L1[4 * j + 2]) & 0x7Fu) << 16) | ((__float_as_uint(L1[4 * j + 3]) & 0x7Fu) << 24);
            }
            *(uint4*)(tab + row * 32) = make_uint4(wv[0], wv[1], wv[2], wv[3]);
            *(uint4*)(tab + row * 32 + 16) = make_uint4(wv[4], wv[5], wv[6], wv[7]);
        }
        float X[16], Y[16];
#pragma unroll
        for (int i = 0; i < 16; ++i) {
            const float a0 = __uint_as_float(__float_as_uint(L0[i]) & 0xFFFFFF80u), a1 = __uint_as_float(__float_as_uint(L1[i]) & 0xFFFFFF80u);
            X[i] = h2 ? a1 : a0; Y[i] = h2 ? a0 : a1;
        }
        float c0[16], c1[16];
#define PEER_CAND(i, a, b) { float v = X[a] + Y[b]; if ((a) == (b) && h2) v = -3.0e38f; const unsigned id = h2 ? ((b) * 16 + (a)) : ((a) * 16 + (b)); \
            const float pk = __uint_as_float((__float_as_uint(v) & 0xFFFFFF00u) | id); if ((i) < 16) c0[(i) & 15] = pk; else c1[(i) & 15] = pk; }
        PEER_CANDS(PEER_CAND)
#undef PEER_CAND
#pragma unroll
        for (int i = 11; i < 16; ++i) c1[i] = -3.0e38f;
        net_sort16(c0); net_sort16(c1); net_merge16(c0, c1);
        {
            float pb[16];
#pragma unroll
            for (int i = 0; i < 16; ++i) pb[i] = __shfl_xor(c0[i], 32);
            net_merge16(c0, pb);
        }
        float ex[16], sum = 0.f;
#pragma unroll
        for (int i = 0; i < 16; ++i) { ex[i] = __expf(c0[i] - c0[0]); sum += ex[i]; }
        const float rs = 1.0f / sum;
        const size_t ob = ((size_t)(m0 + row) * 8 + hd) * 16;
        if (h2 == 0) {
            int eo[16];
#pragma unroll
            for (int j = 0; j < 16; ++j) {
                const unsigned id = __float_as_uint(c0[j]) & 0xFFu;
                eo[j] = (int)tab[row * 32 + (id >> 4)] * 128 + (int)tab[row * 32 + 16 + (id & 15)];
            }
#pragma unroll
            for (int j = 0; j < 4; ++j) *(int4*)(sel_e + ob + 4 * j) = make_int4(eo[4 * j], eo[4 * j + 1], eo[4 * j + 2], eo[4 * j + 3]);
        } else {
#pragma unroll
            for (int j = 0; j < 4; ++j) *(float4*)(sel_g + ob + 4 * j) = make_float4(ex[4 * j] * rs, ex[4 * j + 1] * rs, ex[4 * j + 2] * rs, ex[4 * j + 3] * rs);
        }
    }
}
constexpr float USCALE = 64.0f;
#define DEC16(W_, f) do { const f32x2 _a = __builtin_amdgcn_cvt_pk_f32_fp8((int)(W_).x, false), _b = __builtin_amdgcn_cvt_pk_f32_fp8((int)(W_).x, true), \
        _c = __builtin_amdgcn_cvt_pk_f32_fp8((int)(W_).y, false), _d = __builtin_amdgcn_cvt_pk_f32_fp8((int)(W_).y, true), \
        _e = __builtin_amdgcn_cvt_pk_f32_fp8((int)(W_).z, false), _f = __builtin_amdgcn_cvt_pk_f32_fp8((int)(W_).z, true), \
        _g = __builtin_amdgcn_cvt_pk_f32_fp8((int)(W_).w, false), _h = __builtin_amdgcn_cvt_pk_f32_fp8((int)(W_).w, true); \
        f[0] = _a.x; f[1] = _a.y; f[2] = _b.x; f[3] = _b.y; f[4] = _c.x; f[5] = _c.y; f[6] = _d.x; f[7] = _d.y; \
        f[8] = _e.x; f[9] = _e.y; f[10] = _f.x; f[11] = _f.y; f[12] = _g.x; f[13] = _g.y; f[14] = _h.x; f[15] = _h.y; } while (0)
__device__ __forceinline__ void ph_peer_gather(int bid, int nb, const bf16_t* __restrict__ xf  , const unsigned char* __restrict__ U,
                               const unsigned char* __restrict__ V, const int* __restrict__ sel_e, const float* __restrict__ sel_g,
                               const float* __restrict__ gate  , float* __restrict__ hlat, float* __restrict__ hctx, int ntok, float* lds) {
    const int lane = threadIdx.x & 63, wid = threadIdx.x >> 6;
    float* wl = lds + wid * 128;
    const bool b5 = (lane & 32) != 0, b4 = (lane & 16) != 0, b3 = (lane & 8) != 0;
    const int jj = ((lane >> 5) & 1) * 4 + ((lane >> 4) & 1) * 2 + ((lane >> 3) & 1);
    for (int row = bid * 4 + wid; row < ntok; row += nb * 4) {
        float x[16];
        {
            const uint4 w0 = *(const uint4*)(xf + (size_t)row * D + lane * 16), w1 = *(const uint4*)(xf + (size_t)row * D + lane * 16 + 8);
            const unsigned ww[8] = {w0.x, w0.y, w0.z, w0.w, w1.x, w1.y, w1.z, w1.w};
#pragma unroll
            for (int j = 0; j < 8; ++j) { x[2 * j] = __uint_as_float(ww[j] << 16); x[2 * j + 1] = __uint_as_float(ww[j] & 0xffff0000u); }
        }
        const int my_e0 = sel_e[(size_t)row * 128 + lane], my_e1 = sel_e[(size_t)row * 128 + 64 + lane];
        wl[lane] = sel_g[(size_t)row * 128 + lane]; wl[64 + lane] = sel_g[(size_t)row * 128 + 64 + lane];
#pragma unroll 1
        for (int k0 = 0; k0 < 128; k0 += 8) {
            uint4 ur[8];
#pragma unroll
            for (int j = 0; j < 8; ++j) {
                const int e = __shfl((k0 + j) < 64 ? my_e0 : my_e1, (k0 + j) & 63);
                ur[j] = *(const uint4*)(U + (size_t)e * D + lane * 16);
            }
            float p[8];
#pragma unroll
            for (int j = 0; j < 8; ++j) {
                float f[16]; DEC16(ur[j], f);
                float a = 0.f;
#pragma unroll
                for (int i = 0; i < 16; ++i) a += x[i] * f[i];
                p[j] = a;
            }
            float q[4];
#pragma unroll
            for (int j = 0; j < 4; ++j) { const float keep = b5 ? p[j + 4] : p[j], send = b5 ? p[j] : p[j + 4]; q[j] = keep + __shfl_xor(send, 32); }
            float r2[2];
#pragma unroll
            for (int j = 0; j < 2; ++j) { const float keep = b4 ? q[j + 2] : q[j], send = b4 ? q[j] : q[j + 2]; r2[j] = keep + __shfl_xor(send, 16); }
            float sdot = (b3 ? r2[1] : r2[0]) + __shfl_xor(b3 ? r2[0] : r2[1], 8);
            sdot += __shfl_xor(sdot, 4); sdot += __shfl_xor(sdot, 2); sdot += __shfl_xor(sdot, 1);
            if ((lane & 7) == 0) {
                const float dot = sdot * (1.0f / USCALE);
                const float act = 0.5f * dot * (1.0f + erff(dot * 0.70710678118654752f));
                wl[k0 + jj] = wl[k0 + jj] * act;
            }
        }
        float y[16];
#pragma unroll
        for (int i = 0; i < 16; ++i) y[i] = 0.f;
#pragma unroll 1
        for (int k0 = 0; k0 < 128; k0 += 8) {
            uint4 vr[8];
#pragma unroll
            for (int j = 0; j < 8; ++j) {
                const int e = __shfl((k0 + j) < 64 ? my_e0 : my_e1, (k0 + j) & 63);
                vr[j] = *(const uint4*)(V + (size_t)e * D + lane * 16);
            }
            const float4 wa = *(const float4*)(wl + k0), wb = *(const float4*)(wl + k0 + 4);
            const float wv[8] = {wa.x, wa.y, wa.z, wa.w, wb.x, wb.y, wb.z, wb.w};
#pragma unroll
            for (int j = 0; j < 8; ++j) {
                float f[16]; DEC16(vr[j], f);
#pragma unroll
                for (int i = 0; i < 16; ++i) y[i] += wv[j] * f[i];
            }
        }
        float* hp = row < TL ? hlat + (size_t)row * D : hctx + (size_t)(row - TL) * D;
        const float* gg = gate + (size_t)mod_row(row) * 6144;
#pragma unroll
        for (int j = 0; j < 4; ++j) {
            float4 h = *(float4*)(hp + lane * 16 + j * 4); const float4 g4 = *(const float4*)(gg + lane * 16 + j * 4);
            h.x += g4.x * y[j * 4 + 0]; h.y += g4.y * y[j * 4 + 1]; h.z += g4.z * y[j * 4 + 2]; h.w += g4.w * y[j * 4 + 3];
            *(float4*)(hp + lane * 16 + j * 4) = h;
        }
    }
}
__device__ void ph_final(int bid, int nb, float* __restrict__ h, const float* __restrict__ g) {
    const int lane = threadIdx.x & 63, wid = threadIdx.x >> 6;
    for (int row = bid * 4 + wid; row < TL; row += nb * 4) {
        float4* p = (float4*)(h + (size_t)row * D);
        float4 x[4]; float ss = 0.f;
#pragma unroll
        for (int i = 0; i < 4; ++i) { x[i] = p[i * 64 + lane]; ss += x[i].x * x[i].x + x[i].y * x[i].y + x[i].z * x[i].z + x[i].w * x[i].w; }
        ss = wave_sum(ss);
        const float rinv = rsqrtf(ss * (1.0f / D) + EPS);
#pragma unroll
        for (int i = 0; i < 4; ++i) {
            const float4 gg = ((const float4*)g)[i * 64 + lane];
            float4 o; o.x = x[i].x * rinv * gg.x; o.y = x[i].y * rinv * gg.y; o.z = x[i].z * rinv * gg.z; o.w = x[i].w * rinv * gg.w;
            p[i * 64 + lane] = o;
        }
    }
}

struct Params {
    const float *x, *c, *ctx, *c_ctx, *ada_w, *ada_b, *norm_mix_g, *norm_ffn_g, *ab_w_in, *ab_w_out, *hg_lb, *hg_norm_g, *sw_sink,
        *ga_w_in, *ga_w_out, *ga_qn, *ga_kn, *peer_wq, *peer_sk, *peer_u, *peer_v, *final_g;
    float* out; char* ws;
};
extern __shared__ __attribute__((aligned(16))) char dyn_lds[];

#define WSP(T, off) ((T*)(p.ws + (off)))

__device__ __forceinline__ void grid_bar(unsigned* ctr, unsigned& epoch, unsigned nblk) {
    asm volatile("s_waitcnt vmcnt(0)" ::: "memory");
    __syncthreads();
    epoch += nblk;
    if (threadIdx.x == 0) {
        __builtin_amdgcn_fence(__ATOMIC_RELEASE, "agent");
        asm volatile("s_waitcnt vmcnt(0)" ::: "memory");
        __hip_atomic_fetch_add(ctr, 1u, __ATOMIC_RELAXED, __HIP_MEMORY_SCOPE_AGENT);
        while (__hip_atomic_load(ctr, __ATOMIC_RELAXED, __HIP_MEMORY_SCOPE_AGENT) < epoch) __builtin_amdgcn_s_sleep(1);
        __builtin_amdgcn_fence(__ATOMIC_ACQUIRE, "agent");
        asm volatile("s_waitcnt vmcnt(0)" ::: "memory");
    }
    __syncthreads();
}

namespace cg = cooperative_groups;
constexpr int MEGA_LDS = 65536;
__global__ void __launch_bounds__(256, 2) k_mega(Params p) {
    cg::grid_group grid = cg::this_grid();
    const int bid = blockIdx.x, nb = gridDim.x;
    char* lds = dyn_lds;
    float* ldf = (float*)dyn_lds;
    float* mod0 = WSP(float, OFF_MOD);
    float* mod1 = mod0 + (size_t)9 * 6144;
    float* hctx = WSP(float, OFF_HCTX);
    bf16_t* abuf = WSP(bf16_t, OFF_A);
    bf16_t* mix = WSP(bf16_t, OFF_MIX);
    unsigned* bar = WSP(unsigned, OFF_BAR);
    unsigned epoch = 0;
    ph_transpose(bid, nb, p.ab_w_in, WSP(bf16_t, OFF_WABIN), D, AB_IN, ldf);
    ph_transpose(bid, nb, p.ab_w_out, WSP(bf16_t, OFF_WABOUT), D, D, ldf);
    ph_transpose(bid, nb, p.ga_w_in, WSP(bf16_t, OFF_WGAIN), D, GA_IN, ldf);
    ph_transpose(bid, nb, p.ga_w_out, WSP(bf16_t, OFF_WGAOUT), D, D, ldf);
    ph_transpose(bid, nb, p.peer_wq, WSP(bf16_t, OFF_WPQ), D, PQ, ldf);
    ph_transpose(bid, nb, p.peer_wq + (size_t)D * PQ, WSP(bf16_t, OFF_WPQ) + (size_t)PQ * D, D, PQ, ldf);
    ph_cvt(bid, nb, p.peer_sk, WSP(bf16_t, OFF_SK), (size_t)2 * 8 * 2 * 128 * 128);
    ph_tables(bid, nb, WSP(float, OFF_COSS), WSP(float, OFF_SINS), WSP(float, OFF_COSG), WSP(float, OFF_SING), p.hg_lb, WSP(float, OFF_LB));
    __syncthreads();
    ph_mod(bid, nb, p.c, p.c_ctx, p.ada_w, p.ada_b, mod0, ldf);
    ph_cvt8(bid, nb, p.peer_u, WSP(unsigned char, OFF_U16), (size_t)2 * NEXP * D, USCALE);
    ph_cvt8(bid, nb, p.peer_v, WSP(unsigned char, OFF_V16), (size_t)2 * NEXP * D, 1.0f);
    grid.sync();
    ph_normmod(bid, nb, p.x, p.ctx, p.norm_mix_g, mod0, 1 * D, 0, abuf, TA);
    grid_bar(bar, epoch, (unsigned)nb);
    { EpiStoreSplit e{WSP(bf16_t, OFF_PROJH), HGW, WSP(bf16_t, OFF_PROJS), SWW, HGW};
      ph_gemm(bid, nb, abuf, D, WSP(bf16_t, OFF_WABIN), D, TA, AB_IN, D, lds, e); }
    grid_bar(bar, epoch, (unsigned)nb);
    ph_prep_swa(bid, nb, WSP(bf16_t, OFF_PROJS), WSP(float, OFF_COSS), WSP(float, OFF_SINS));
    ph_vt<64>(bid, nb, WSP(bf16_t, OFF_PROJS), SWW, 640, WSP(bf16_t, OFF_VT), (bf16_t*)lds);
    grid_bar(bar, epoch, (unsigned)nb);
    {
        const int hgb = nb >= 256 ? 128 : nb / 2;
        if (bid < hgb) ph_hgrn(bid, hgb, WSP(bf16_t, OFF_PROJH), WSP(float, OFF_LB), WSP(bf16_t, OFF_OF), WSP(bf16_t, OFF_OB), lds);
        else ph_swa(bid - hgb, nb - hgb, WSP(bf16_t, OFF_PROJS), WSP(bf16_t, OFF_VT), p.sw_sink, mix, lds);
    }
    grid_bar(bar, epoch, (unsigned)nb);
    ph_hgpost(bid, nb, WSP(bf16_t, OFF_OF), WSP(bf16_t, OFF_OB), WSP(bf16_t, OFF_PROJH), p.hg_norm_g, mix);
    grid_bar(bar, epoch, (unsigned)nb);
    { EpiResid e{p.x, p.ctx, p.out, hctx, mod0 + 2 * D};
      ph_gemm(bid, nb, mix, D, WSP(bf16_t, OFF_WABOUT), D, TA, D, D, lds, e); }
    grid_bar(bar, epoch, (unsigned)nb);
    ph_normmod(bid, nb, p.out, hctx, p.norm_ffn_g, mod0, 4 * D, 3 * D, abuf, TA);
    grid_bar(bar, epoch, (unsigned)nb);
    { EpiStoreSplit e{WSP(bf16_t, OFF_QPEER), PQ, WSP(bf16_t, OFF_QPEER), PQ, 1 << 30};
      ph_gemm(bid, nb, abuf, D, WSP(bf16_t, OFF_WPQ), D, TA, PQ, D, lds, e); }
    grid_bar(bar, epoch, (unsigned)nb);
    ph_peer_route(bid, nb, WSP(bf16_t, OFF_QPEER), WSP(bf16_t, OFF_SK), WSP(int, OFF_SELE), WSP(float, OFF_SELG), TA, lds);
    grid_bar(bar, epoch, (unsigned)nb);
    ph_peer_gather(bid, nb, abuf, WSP(unsigned char, OFF_U16), WSP(unsigned char, OFF_V16), WSP(int, OFF_SELE), WSP(float, OFF_SELG), mod0 + 5 * D, p.out, hctx, TA, ldf);
    grid_bar(bar, epoch, (unsigned)nb);
    ph_normmod(bid, nb, p.out, hctx, p.norm_mix_g + D, mod1, 1 * D, 0, abuf, TA);
    grid_bar(bar, epoch, (unsigned)nb);
    { EpiStoreSplit e{WSP(bf16_t, OFF_PROJ), GA_IN, WSP(bf16_t, OFF_PROJ), GA_IN, 1 << 30};
      ph_gemm(bid, nb, abuf, D, WSP(bf16_t, OFF_WGAIN), D, TA, GA_IN, D, lds, e); }
    grid_bar(bar, epoch, (unsigned)nb);
    ph_prep_ga(bid, nb, WSP(bf16_t, OFF_PROJ), p.ga_qn, p.ga_kn, WSP(float, OFF_COSG), WSP(float, OFF_SING));
    ph_vt<128>(bid, nb, WSP(bf16_t, OFF_PROJ), GA_IN, 1280, WSP(bf16_t, OFF_VT), (bf16_t*)lds);
    grid_bar(bar, epoch, (unsigned)nb);
    ph_dense(bid, nb, WSP(bf16_t, OFF_PROJ), WSP(bf16_t, OFF_VT), mix, lds);
    grid_bar(bar, epoch, (unsigned)nb);
    { EpiResid e{p.out, hctx, p.out, hctx, mod1 + 2 * D};
      ph_gemm(bid, nb, mix, D, WSP(bf16_t, OFF_WGAOUT), D, TL, D, D, lds, e); }
    grid_bar(bar, epoch, (unsigned)nb);
    ph_normmod(bid, nb, p.out, hctx, p.norm_ffn_g + D, mod1, 4 * D, 3 * D, abuf, TL);
    grid_bar(bar, epoch, (unsigned)nb);
    { EpiStoreSplit e{WSP(bf16_t, OFF_QPEER), PQ, WSP(bf16_t, OFF_QPEER), PQ, 1 << 30};
      ph_gemm(bid, nb, abuf, D, WSP(bf16_t, OFF_WPQ) + (size_t)PQ * D, D, TL, PQ, D, lds, e); }
    grid_bar(bar, epoch, (unsigned)nb);
    ph_peer_route(bid, nb, WSP(bf16_t, OFF_QPEER), WSP(bf16_t, OFF_SK) + (size_t)16 * 128 * 128, WSP(int, OFF_SELE), WSP(float, OFF_SELG), TL, lds);
    grid_bar(bar, epoch, (unsigned)nb);
    ph_peer_gather(bid, nb, abuf, WSP(unsigned char, OFF_U16) + (size_t)NEXP * D, WSP(unsigned char, OFF_V16) + (size_t)NEXP * D, WSP(int, OFF_SELE), WSP(float, OFF_SELG), mod1 + 5 * D, p.out, hctx, TL, ldf);
    grid_bar(bar, epoch, (unsigned)nb);
    ph_final(bid, nb, p.out, p.final_g);
}

extern "C" void kernel_launch(void* const* d_in, const int* in_sizes, int n_in, void* d_out, int out_size, void* d_ws, size_t ws_size,
                              hipStream_t stream) {
    Params p{};
    p.x = (const float*)d_in[0]; p.c = (const float*)d_in[1]; p.ctx = (const float*)d_in[2]; p.c_ctx = (const float*)d_in[3];
    p.ada_w = (const float*)d_in[4]; p.ada_b = (const float*)d_in[5]; p.norm_mix_g = (const float*)d_in[6]; p.norm_ffn_g = (const float*)d_in[7];
    p.ab_w_in = (const float*)d_in[8]; p.ab_w_out = (const float*)d_in[9]; p.hg_lb = (const float*)d_in[10]; p.hg_norm_g = (const float*)d_in[11];
    p.sw_sink = (const float*)d_in[12]; p.ga_w_in = (const float*)d_in[13]; p.ga_w_out = (const float*)d_in[14]; p.ga_qn = (const float*)d_in[15];
    p.ga_kn = (const float*)d_in[16]; p.peer_wq = (const float*)d_in[17]; p.peer_sk = (const float*)d_in[18]; p.peer_u = (const float*)d_in[19];
    p.peer_v = (const float*)d_in[20]; p.final_g = (const float*)d_in[21];
    p.out = (float*)d_out; p.ws = (char*)d_ws;
    if (ws_size < WS_NEED) { fprintf(stderr, "workspace too small: %zu < %zu\n", ws_size, WS_NEED); return; }
    static int grid_blocks = 0;
    if (!grid_blocks) {
        int dev = 0, cus = 0, per_cu = 0;
        (void)hipGetDevice(&dev);
        (void)hipDeviceGetAttribute(&cus, hipDeviceAttributeMultiprocessorCount, dev);
        (void)hipFuncSetAttribute((const void*)k_mega, hipFuncAttributeMaxDynamicSharedMemorySize, MEGA_LDS);
        (void)hipOccupancyMaxActiveBlocksPerMultiprocessor(&per_cu, k_mega, 256, MEGA_LDS);
        if (per_cu > 2) per_cu = 2;
        if (per_cu < 1) per_cu = 1;
        grid_blocks = cus * per_cu;
    }
    (void)hipMemsetAsync((char*)d_ws + OFF_BAR, 0, 256, stream);
    void* args[] = {&p};
    hipError_t e = hipLaunchCooperativeKernel((const void*)k_mega, dim3(grid_blocks), dim3(256), args, MEGA_LDS, stream);
    if (e != hipSuccess) fprintf(stderr, "cooperative launch failed: %s (grid %d)\n", hipGetErrorString(e), grid_blocks);
}
```

```cpp
#include <hip/hip_runtime.h>
#include <hip/hip_cooperative_groups.h>
#include <stdint.h>
#include <stdio.h>

typedef unsigned short bf16_t;
typedef short bf16x8 __attribute__((ext_vector_type(8)));
typedef float f32x4 __attribute__((ext_vector_type(4)));

constexpr int D = 1024, NB = 8, SEQ = 4096, LC = 256;
constexpr int TL = NB * SEQ;
constexpr int TC = NB * LC;
constexpr int TA = TL + TC;
constexpr int AB_IN = 3328, HGW = 2560, SWW = 768, GA_IN = 1536, PQ = 2048;
constexpr int NEXP = 16384;
constexpr float EPS = 1e-6f;
constexpr float LOG2E = 1.4426950408889634f;
constexpr int NKEY = LC + SEQ;

constexpr size_t OFF_WABIN = 0;
constexpr size_t OFF_WABOUT = OFF_WABIN + (size_t)AB_IN * D * 2;
constexpr size_t OFF_WGAIN = OFF_WABOUT + (size_t)D * D * 2;
constexpr size_t OFF_WGAOUT = OFF_WGAIN + (size_t)GA_IN * D * 2;
constexpr size_t OFF_WPQ = OFF_WGAOUT + (size_t)D * D * 2;
constexpr size_t OFF_SK = OFF_WPQ + (size_t)2 * PQ * D * 2;
constexpr size_t OFF_MOD = OFF_SK + (size_t)2 * 8 * 2 * 128 * 128 * 2;
constexpr size_t OFF_COSS = OFF_MOD + (size_t)2 * 9 * 6144 * 4;
constexpr size_t OFF_SINS = OFF_COSS + (size_t)SEQ * 32 * 4;
constexpr size_t OFF_COSG = OFF_SINS + (size_t)SEQ * 32 * 4;
constexpr size_t OFF_SING = OFF_COSG + (size_t)SEQ * 64 * 4;
constexpr size_t OFF_LB = OFF_SING + (size_t)SEQ * 64 * 4;
constexpr size_t OFF_U16 = OFF_LB + 2048;
constexpr size_t OFF_V16 = OFF_U16 + (size_t)NEXP * D * 2;
constexpr size_t OFF_HCTX = OFF_V16 + (size_t)NEXP * D * 2;
constexpr size_t OFF_A = OFF_HCTX + (size_t)TC * D * 4;
constexpr size_t OFF_PROJ = OFF_A + (size_t)TA * D * 2;
constexpr size_t OFF_MIX = OFF_PROJ + (size_t)TA * AB_IN * 2;
constexpr size_t OFF_SEL = OFF_MIX + (size_t)TA * D * 2;
constexpr size_t OFF_BAR = OFF_SEL + (size_t)TA * 128 * 8;
constexpr size_t WS_NEED = OFF_BAR + 256;
static_assert(WS_NEED <= (size_t)536870912, "workspace over 512 MiB");
constexpr size_t OFF_OF = OFF_A;
constexpr size_t OFF_OB = OFF_A + (size_t)TA * 512 * 2;
constexpr size_t OFF_PROJH = OFF_PROJ;
constexpr size_t OFF_PROJS = OFF_PROJ + (size_t)TA * HGW * 2;
constexpr size_t OFF_QPEER = OFF_PROJ;
constexpr size_t OFF_TSC = OFF_QPEER + (size_t)TA * PQ * 2;
constexpr size_t OFF_TIX = OFF_TSC + (size_t)TA * 256 * 4;
static_assert(OFF_TIX + (size_t)TA * 256 * 4 <= OFF_MIX, "peer scratch overflows proj region");
constexpr size_t OFF_VT = OFF_SEL;
static_assert((size_t)NB * 2 * 128 * NKEY * 2 <= (size_t)TA * 128 * 8, "Vt overflows SEL region");
constexpr size_t OFF_SELE = OFF_SEL;
constexpr size_t OFF_SELG = OFF_SEL + (size_t)TA * 128 * 4;

__device__ __forceinline__ float bf2f(bf16_t v) { return __uint_as_float(((unsigned)v) << 16); }
__device__ __forceinline__ bf16_t f2bf(float f) {
    unsigned u = __float_as_uint(f);
    u += 0x7fffu + ((u >> 16) & 1u);
    return (bf16_t)(u >> 16);
}
typedef float f32x2 __attribute__((ext_vector_type(2)));
typedef float f32x16 __attribute__((ext_vector_type(16)));
typedef __bf16 bf16x2_t __attribute__((ext_vector_type(2)));
__device__ __forceinline__ unsigned pack2(float lo, float hi) { f32x2 v = {lo, hi}; return __builtin_bit_cast(unsigned, __builtin_convertvector(v, bf16x2_t)); }
__device__ __forceinline__ float sigmoidf_(float x) { return 1.0f / (1.0f + __expf(-x)); }
__device__ __forceinline__ float siluf_(float x) { return x * sigmoidf_(x); }
__device__ __forceinline__ float wave_sum(float v) {
#pragma unroll
    for (int o = 32; o >= 1; o >>= 1) v += __shfl_xor(v, o);
    return v;
}
__device__ __forceinline__ int mod_row(int row) { return row < TL ? (row >> 12) : 8; }

__device__ void ph_transpose(int bid, int nb, const float* __restrict__ in, bf16_t* __restrict__ out, int K, int N, float* lds) {
    const int tk = K / 32, tn = N / 32, nt = tk * tn;
    const int tx = threadIdx.x & 31, ty = threadIdx.x >> 5;
    for (int t = bid; t < nt; t += nb) {
        const int k0 = (t / tn) * 32, n0 = (t % tn) * 32;
        __syncthreads();
#pragma unroll
        for (int i = 0; i < 4; ++i) lds[(ty + i * 8) * 33 + tx] = in[(size_t)(k0 + ty + i * 8) * N + n0 + tx];
        __syncthreads();
#pragma unroll
        for (int i = 0; i < 4; ++i) out[(size_t)(n0 + ty + i * 8) * K + k0 + tx] = f2bf(lds[tx * 33 + ty + i * 8]);
    }
}
__device__ void ph_cvt(int bid, int nb, const float* __restrict__ in, bf16_t* __restrict__ out, size_t n) {
    const size_t n8 = n / 8;
    for (size_t i = (size_t)bid * blockDim.x + threadIdx.x; i < n8; i += (size_t)nb * blockDim.x) {
        const float4 a = ((const float4*)in)[i * 2], b = ((const float4*)in)[i * 2 + 1];
        uint4 w; w.x = pack2(a.x, a.y); w.y = pack2(a.z, a.w); w.z = pack2(b.x, b.y); w.w = pack2(b.z, b.w);
        ((uint4*)out)[i] = w;
    }
}
__device__ void ph_cvt8(int bid, int nb, const float* __restrict__ in, unsigned char* __restrict__ out, size_t n, float scale) {
    const size_t n16 = n / 16;
    for (size_t i = (size_t)bid * blockDim.x + threadIdx.x; i < n16; i += (size_t)nb * blockDim.x) {
        const float4 a = ((const float4*)in)[i * 4], b = ((const float4*)in)[i * 4 + 1], c = ((const float4*)in)[i * 4 + 2], d = ((const float4*)in)[i * 4 + 3];
        int w0 = __builtin_amdgcn_cvt_pk_fp8_f32(a.x * scale, a.y * scale, 0, false); w0 = __builtin_amdgcn_cvt_pk_fp8_f32(a.z * scale, a.w * scale, w0, true);
        int w1 = __builtin_amdgcn_cvt_pk_fp8_f32(b.x * scale, b.y * scale, 0, false); w1 = __builtin_amdgcn_cvt_pk_fp8_f32(b.z * scale, b.w * scale, w1, true);
        int w2 = __builtin_amdgcn_cvt_pk_fp8_f32(c.x * scale, c.y * scale, 0, false); w2 = __builtin_amdgcn_cvt_pk_fp8_f32(c.z * scale, c.w * scale, w2, true);
        int w3 = __builtin_amdgcn_cvt_pk_fp8_f32(d.x * scale, d.y * scale, 0, false); w3 = __builtin_amdgcn_cvt_pk_fp8_f32(d.z * scale, d.w * scale, w3, true);
        ((int4*)out)[i] = make_int4(w0, w1, w2, w3);
    }
}
__device__ void ph_mod(int bid, int nb, const float* __restrict__ c, const float* __restrict__ c_ctx, const float* __restrict__ ada_w,
                       const float* __restrict__ ada_b, float* __restrict__ mod, float* lds) {
    float* s = lds;
    float* red = lds + 9 * 1024;
    const int tx = threadIdx.x & 63, ky = threadIdx.x >> 6;
    for (int i = threadIdx.x; i < 9 * 1024; i += 256) {
        const int r = i >> 10, k = i & 1023;
        const float v = r < 8 ? c[r * 1024 + k] : c_ctx[k];
        s[i] = siluf_(v);
    }
    __syncthreads();
    const int nitems = 2 * 96;
    for (int it = bid; it < nitems; it += nb) {
        const int layer = it / 96, n = (it % 96) * 64 + tx;
        const float* w = ada_w + (size_t)layer * 1024 * 6144 + n;
        float acc[9];
#pragma unroll
        for (int r = 0; r < 9; ++r) acc[r] = 0.f;
        for (int k = ky * 256; k < ky * 256 + 256; ++k) {
            const float wv = w[(size_t)k * 6144];
#pragma unroll
            for (int r = 0; r < 9; ++r) acc[r] += s[r * 1024 + k] * wv;
        }
        __syncthreads();
#pragma unroll
        for (int r = 0; r < 9; ++r) red[(ky * 9 + r) * 64 + tx] = acc[r];
        __syncthreads();
        if (ky == 0) {
#pragma unroll
            for (int r = 0; r < 9; ++r) {
                const float v = red[(0 * 9 + r) * 64 + tx] + red[(1 * 9 + r) * 64 + tx] + red[(2 * 9 + r) * 64 + tx] + red[(3 * 9 + r) * 64 + tx];
                mod[((size_t)layer * 9 + r) * 6144 + n] = v + ada_b[layer * 6144 + n];
            }
        }
    }
}
__device__ void ph_tables(int bid, int nb, float* cosS, float* sinS, float* cosG, float* sinG, const float* __restrict__ lb_logits, float* lb) {
    const int gt = bid * blockDim.x + threadIdx.x, gs = nb * blockDim.x;
    for (int i = gt; i < SEQ * 32; i += gs) {
        const int t = i >> 5, j = i & 31;
        const float pos = (float)(j < 16 ? (t >> 6) : (t & 63));
        const float inv = powf(10000.0f, -(float)(j & 15) / 16.0f);
        const float ang = pos * inv;
        cosS[i] = cosf(ang); sinS[i] = sinf(ang);
    }
    for (int i = gt; i < SEQ * 64; i += gs) {
        const int t = i >> 6, j = i & 63;
        const float pos = (float)(j < 32 ? (t >> 6) : (t & 63));
        const float inv = powf(10000.0f, -(float)(j & 31) / 32.0f);
        const float ang = pos * inv;
        cosG[i] = cosf(ang); sinG[i] = sinf(ang);
    }
    for (int i = gt; i < 512; i += gs) {
        const float l0 = lb_logits[i], l1 = lb_logits[512 + i];
        lb[i] = 1.0f / (1.0f + expf(l1 - l0));
    }
}

__device__ void ph_normmod(int bid, int nb, const float* __restrict__ hlat, const float* __restrict__ hctx, const float* __restrict__ gamma,
                           const float* __restrict__ modl  , int sc_off, int sh_off, bf16_t* __restrict__ out, int nrows) {
    const int lane = threadIdx.x & 63, wid = threadIdx.x >> 6;
    for (int row = bid * 4 + wid; row < nrows; row += nb * 4) {
        const float* src = row < TL ? hlat + (size_t)row * D : hctx + (size_t)(row - TL) * D;
        const float* m = modl + (size_t)mod_row(row) * 6144;
        float4 x[4]; float ss = 0.f;
#pragma unroll
        for (int i = 0; i < 4; ++i) { x[i] = ((const float4*)src)[i * 64 + lane]; ss += x[i].x * x[i].x + x[i].y * x[i].y + x[i].z * x[i].z + x[i].w * x[i].w; }
        ss = wave_sum(ss);
        const float rinv = rsqrtf(ss * (1.0f / D) + EPS);
#pragma unroll
        for (int i = 0; i < 4; ++i) {
            const int col = (i * 64 + lane) * 4;
            const float4 g = *(const float4*)(gamma + col), sc = *(const float4*)(m + sc_off + col), sh = *(const float4*)(m + sh_off + col);
            const float y0 = x[i].x * rinv * g.x * (1.f + sc.x) + sh.x, y1 = x[i].y * rinv * g.y * (1.f + sc.y) + sh.y;
            const float y2 = x[i].z * rinv * g.z * (1.f + sc.z) + sh.z, y3 = x[i].w * rinv * g.w * (1.f + sc.w) + sh.w;
            uint2 w; w.x = pack2(y0, y1); w.y = pack2(y2, y3);
            *(uint2*)(out + (size_t)row * D + col) = w;
        }
    }
}

constexpr int GEMM_LDS = 65536;
template <class Epi>
__device__ __forceinline__ void gemm_tile(const bf16_t* __restrict__ A, int lda, const bf16_t* __restrict__ Bt, int ldb, int K,
                                          int m0, int n0, char* lds, Epi& epi) {
    const int tid = threadIdx.x, lane = tid & 63, wid = tid >> 6, wr = wid >> 1, wc = wid & 1, fr = lane & 15, fq = lane >> 4;
    f32x4 acc[4][4];
#pragma unroll
    for (int i = 0; i < 4; ++i)
#pragma unroll
        for (int j = 0; j < 4; ++j) acc[i][j] = (f32x4){0.f, 0.f, 0.f, 0.f};
    const int nk = K / 64;
    typedef __attribute__((address_space(3))) char las_char;
    las_char* l3 = (las_char*)lds;
    const int drow = 32 * wid + (lane >> 3), dch = (lane & 7) ^ ((lane >> 3) & 7);
    const bf16_t* ga = A + (size_t)(m0 + drow) * lda + dch * 8;
    const bf16_t* gb = Bt + (size_t)(n0 + drow) * ldb + dch * 8;
    const int dlds = 32 * wid * 128;
#define GT_STAGE(kt, buf) do { _Pragma("unroll") for (int i = 0; i < 4; ++i) { \
        __builtin_amdgcn_global_load_lds((const unsigned*)(ga + (size_t)(8 * i) * lda + (kt) * 64), (__attribute__((address_space(3))) unsigned*)(l3 + (buf) * 32768 + dlds + i * 1024), 16, 0, 0); \
        __builtin_amdgcn_global_load_lds((const unsigned*)(gb + (size_t)(8 * i) * ldb + (kt) * 64), (__attribute__((address_space(3))) unsigned*)(l3 + (buf) * 32768 + 16384 + dlds + i * 1024), 16, 0, 0); } } while (0)
#define GT_COMPUTE(buf) do { const char* base = lds + (buf) * 32768; \
        _Pragma("unroll") for (int kk = 0; kk < 2; ++kk) { \
            bf16x8 af[4], bfr[4]; \
            _Pragma("unroll") for (int i = 0; i < 4; ++i) { \
                const int ar = wr * 64 + i * 16 + fr, br = wc * 64 + i * 16 + fr; const int c = kk * 4 + fq; \
                af[i] = *(const bf16x8*)(base + ar * 128 + ((c ^ (ar & 7)) << 4)); \
                bfr[i] = *(const bf16x8*)(base + 16384 + br * 128 + ((c ^ (br & 7)) << 4)); } \
            _Pragma("unroll") for (int i = 0; i < 4; ++i) \
                _Pragma("unroll") for (int j = 0; j < 4; ++j) acc[i][j] = __builtin_amdgcn_mfma_f32_16x16x32_bf16(bfr[j], af[i], acc[i][j], 0, 0, 0); } } while (0)
    __syncthreads();
    GT_STAGE(0, 0);
    __syncthreads();
    for (int kt = 0; kt < nk; ++kt) {
        if (kt + 1 < nk) GT_STAGE(kt + 1, (kt + 1) & 1);
        GT_COMPUTE(kt & 1);
        __syncthreads();
    }
#undef GT_STAGE
#undef GT_COMPUTE
    epi(acc, m0 + wr * 64 + fr, n0 + wc * 64 + fq * 4, lds);
}

struct EpiStoreSplit {
    bf16_t* O1; int ld1; bf16_t* O2; int ld2; int split;
    __device__ __forceinline__ void operator()(f32x4 (&acc)[4][4], int row0, int col0, char*) const {
#pragma unroll
        for (int i = 0; i < 4; ++i)
#pragma unroll
            for (int j = 0; j < 4; ++j) {
                const int row = row0 + i * 16, col = col0 + j * 16;
                uint2 w; w.x = pack2(acc[i][j][0], acc[i][j][1]); w.y = pack2(acc[i][j][2], acc[i][j][3]);
                if (col < split) *(uint2*)(O1 + (size_t)row * ld1 + col) = w;
                else *(uint2*)(O2 + (size_t)row * ld2 + (col - split)) = w;
            }
    }
};
struct EpiResid {
    const float* hin_lat; const float* hin_ctx; float* hout_lat; float* hout_ctx; const float* gate  ;
    __device__ __forceinline__ void operator()(f32x4 (&acc)[4][4], int row0, int col0, char*) const {
#pragma unroll
        for (int i = 0; i < 4; ++i) {
            const int row = row0 + i * 16;
            const float* hi = row < TL ? hin_lat + (size_t)row * D : hin_ctx + (size_t)(row - TL) * D;
            float* ho = row < TL ? hout_lat + (size_t)row * D : hout_ctx + (size_t)(row - TL) * D;
            const float* g = gate + (size_t)mod_row(row) * 6144;
#pragma unroll
            for (int j = 0; j < 4; ++j) {
                const int col = col0 + j * 16;
                const float4 h = *(const float4*)(hi + col), gg = *(const float4*)(g + col);
                float4 o; o.x = h.x + gg.x * acc[i][j][0]; o.y = h.y + gg.y * acc[i][j][1]; o.z = h.z + gg.z * acc[i][j][2]; o.w = h.w + gg.w * acc[i][j][3];
                *(float4*)(ho + col) = o;
            }
        }
    }
};
template <class Epi>
__device__ void ph_gemm(int bid, int nb, const bf16_t* A, int lda, const bf16_t* Bt, int ldb, int M, int N, int K, char* lds, Epi epi) {
    const int nM = M / 128, nN = N / 128, nwg = nM * nN;
    const bool sw = (nb & 7) == 0;
    for (int L = bid; L < nwg; L += nb) {
        int wg = L;
        if (sw) { const int q = nwg >> 3, r = nwg & 7, xcd = L & 7, off = L >> 3; wg = (xcd < r ? xcd * (q + 1) : r * (q + 1) + (xcd - r) * q) + off; }
        const int nig = 8 * nN, gid = wg / nig, fm = gid * 8, gsz = (nM - fm) < 8 ? (nM - fm) : 8;
        const int pm = fm + (wg % nig) % gsz, pn = (wg % nig) / gsz;
        gemm_tile(A, lda, Bt, ldb, K, pm * 128, pn * 128, lds, epi);
    }
}

typedef short bf16x4 __attribute__((ext_vector_type(4)));
constexpr int HQ_OFF = 0, HK_OFF = 16384, HKT_OFF = 32768, HVT_OFF = 49152, HD_OFF = 57344, HG_LDS = 59392;
__device__ __forceinline__ int hg_row(int b, int dir, int p) {
    if (p < LC) { const int s = dir ? (LC - 1 - p) : p; return TL + b * LC + s; }
    const int t = dir ? (SEQ - 1 - (p - LC)) : (p - LC);
    return b * SEQ + t;
}
__device__ void ph_hgrn(int bid, int nb, const bf16_t* __restrict__ projH, const float* __restrict__ lb, bf16_t* __restrict__ of, bf16_t* __restrict__ ob, char* lds) {
    const int tid = threadIdx.x, lane = tid & 63, w = tid >> 6, fr = lane & 15, fq = lane >> 4;
    for (int it = bid; it < NB * 4 * 2 * 2; it += nb) {
        const int vs = it & 1, dir = (it >> 1) & 1, h = (it >> 2) & 3, b = it >> 4;
        bf16_t* out = dir ? ob : of;
        const float lb0 = lb[h * 128 + 2 * lane], lb1 = lb[h * 128 + 2 * lane + 1];
        const int fcol = (dir ? 1024 : 512) + h * 128 + 2 * lane, qcol = h * 128 + 2 * lane, vcol = 1536 + h * 128 + vs * 64 + lane;
        f32x4 S[8];
#pragma unroll
        for (int kt = 0; kt < 8; ++kt) S[kt] = (f32x4){0.f, 0.f, 0.f, 0.f};
        unsigned xf[16], xq[16]; bf16_t xv[16];
#define HG_PREFETCH(p0) do { _Pragma("unroll") for (int i = 0; i < 16; ++i) { \
            const size_t rb = (size_t)hg_row(b, dir, (p0) + 16 * w + i) * HGW; \
            xf[i] = *(const unsigned*)(projH + rb + fcol); xq[i] = *(const unsigned*)(projH + rb + qcol); xv[i] = projH[rb + vcol]; } } while (0)
        HG_PREFETCH(0);
        for (int p0 = 0; p0 < NKEY; p0 += 64) {
            __syncthreads();
            {
                float c0 = 0.f, c1 = 0.f, kp0 = 0.f, kp1 = 0.f;
                unsigned kt0[8], kt1[8], vt[8];
#pragma unroll
                for (int i = 0; i < 16; ++i) {
                    const float xf0 = __uint_as_float(xf[i] << 16), xf1 = __uint_as_float(xf[i] & 0xffff0000u);
                    const float xq0 = __uint_as_float(xq[i] << 16), xq1 = __uint_as_float(xq[i] & 0xffff0000u);
                    const float f0 = lb0 + (1.f - lb0) * __builtin_amdgcn_rcpf(1.f + __expf(-xf0));
                    const float f1 = lb1 + (1.f - lb1) * __builtin_amdgcn_rcpf(1.f + __expf(-xf1));
                    c0 += __logf(f0); c1 += __logf(f1);
                    const float q0 = xq0 * __builtin_amdgcn_rcpf(1.f + __expf(-xq0)) * __expf(c0);
                    const float q1 = xq1 * __builtin_amdgcn_rcpf(1.f + __expf(-xq1)) * __expf(c1);
                    const float k0 = (1.f - f0) * __expf(fminf(-c0, 80.f)), k1 = (1.f - f1) * __expf(fminf(-c1, 80.f));
                    const int t = 16 * w + i;
                    const int o = t * 256 + (((lane >> 2) ^ (t & 15)) << 4) + (lane & 3) * 4;
                    *(unsigned*)(lds + HQ_OFF + o) = pack2(q0, q1);
                    *(unsigned*)(lds + HK_OFF + o) = pack2(k0, k1);
                    if (i & 1) { kt0[i >> 1] = pack2(kp0, k0); kt1[i >> 1] = pack2(kp1, k1); vt[i >> 1] = (unsigned)xv[i - 1] | ((unsigned)xv[i] << 16); }
                    else { kp0 = k0; kp1 = k1; }
                }
                float2 dd; dd.x = __expf(c0); dd.y = __expf(c1);
                *(float2*)(lds + HD_OFF + (w * 128 + 2 * lane) * 4) = dd;
                char* kp = lds + HKT_OFF + w * 4096 + (2 * lane) * 32;
                *(uint4*)(kp) = make_uint4(kt0[0], kt0[1], kt0[2], kt0[3]); *(uint4*)(kp + 16) = make_uint4(kt0[4], kt0[5], kt0[6], kt0[7]);
                *(uint4*)(kp + 32) = make_uint4(kt1[0], kt1[1], kt1[2], kt1[3]); *(uint4*)(kp + 48) = make_uint4(kt1[4], kt1[5], kt1[6], kt1[7]);
                char* vp = lds + HVT_OFF + w * 2048 + lane * 32;
                *(uint4*)(vp) = make_uint4(vt[0], vt[1], vt[2], vt[3]); *(uint4*)(vp + 16) = make_uint4(vt[4], vt[5], vt[6], vt[7]);
            }
            if (p0 + 64 < NKEY) HG_PREFETCH(p0 + 64);
            __syncthreads();
#pragma unroll
            for (int I = 0; I < 4; ++I) {
                const int trow = 16 * I + fr;
                f32x4 at = (f32x4){0.f, 0.f, 0.f, 0.f};
#pragma unroll
                for (int ks = 0; ks < 4; ++ks) {
                    const int o = trow * 256 + (((ks * 4 + fq) ^ fr) << 4);
                    const bf16x8 ka = *(const bf16x8*)(lds + HK_OFF + o);
                    const bf16x8 qa = *(const bf16x8*)(lds + HQ_OFF + o);
                    at = __builtin_amdgcn_mfma_f32_16x16x32_bf16(ka, qa, at, 0, 0, 0);
                }
#pragma unroll
                for (int j = 0; j < 4; ++j) if (4 * fq + j > fr) at[j] = 0.f;
                uint2 pa2; pa2.x = pack2(at[0], at[1]); pa2.y = pack2(at[2], at[3]);
                const bf16x4 pA = __builtin_bit_cast(bf16x4, pa2);
                const bf16x4 vfrag = *(const bf16x4*)(lds + HVT_OFF + I * 2048 + (w * 16 + fr) * 32 + fq * 8);
                f32x4 o1 = __builtin_amdgcn_mfma_f32_16x16x16bf16_1k(vfrag, pA, (f32x4){0.f, 0.f, 0.f, 0.f}, 0, 0, 0);
                f32x4 o2 = (f32x4){0.f, 0.f, 0.f, 0.f};
#pragma unroll
                for (int kt = 0; kt < 8; ++kt) {
                    uint2 s2; s2.x = pack2(S[kt][0], S[kt][1]); s2.y = pack2(S[kt][2], S[kt][3]);
                    const bf16x4 sfrag = __builtin_bit_cast(bf16x4, s2);
                    const bf16x4 qfrag = *(const bf16x4*)(lds + HQ_OFF + trow * 256 + (((kt * 2 + (fq >> 1)) ^ fr) << 4) + (fq & 1) * 8);
                    if (kt & 1) o2 = __builtin_amdgcn_mfma_f32_16x16x16bf16_1k(sfrag, qfrag, o2, 0, 0, 0);
                    else o1 = __builtin_amdgcn_mfma_f32_16x16x16bf16_1k(sfrag, qfrag, o1, 0, 0, 0);
                }
#pragma unroll
                for (int kt = 0; kt < 8; ++kt) {
                    const bf16x4 kfrag = *(const bf16x4*)(lds + HKT_OFF + I * 4096 + (kt * 16 + fr) * 32 + fq * 8);
                    const f32x4 d4 = *(const f32x4*)(lds + HD_OFF + (I * 128 + kt * 16 + fq * 4) * 4);
                    S[kt] = __builtin_amdgcn_mfma_f32_16x16x16bf16_1k(kfrag, vfrag, S[kt], 0, 0, 0);
                    S[kt] = S[kt] * d4;
                }
                const size_t orow = (size_t)hg_row(b, dir, p0 + trow);
                uint2 ov; ov.x = pack2(o1[0] + o2[0], o1[1] + o2[1]); ov.y = pack2(o1[2] + o2[2], o1[3] + o2[3]);
                *(uint2*)(out + orow * 512 + h * 128 + vs * 64 + w * 16 + fq * 4) = ov;
            }
        }
#undef HG_PREFETCH
    }
}
__device__ void ph_hgpost(int bid, int nb, const bf16_t* __restrict__ of, const bf16_t* __restrict__ ob, const bf16_t* __restrict__ projH,
                          const float* __restrict__ g, bf16_t* __restrict__ mix) {
    const int lane = threadIdx.x & 63, wid = threadIdx.x >> 6;
    for (int it = bid * 4 + wid; it < TA * 4; it += nb * 4) {
        const int row = it >> 2, h = it & 3;
        const size_t o = (size_t)row * 512 + h * 128 + lane * 2;
        const unsigned a = *(const unsigned*)(of + o), bb = *(const unsigned*)(ob + o);
        const float x0 = bf2f((bf16_t)(a & 0xffff)) + bf2f((bf16_t)(bb & 0xffff)), x1 = bf2f((bf16_t)(a >> 16)) + bf2f((bf16_t)(bb >> 16));
        const float ss = wave_sum(x0 * x0 + x1 * x1);
        const float rinv = rsqrtf(ss * (1.0f / 128.0f) + EPS);
        const unsigned gg = *(const unsigned*)(projH + (size_t)row * HGW + 2048 + h * 128 + lane * 2);
        const float y0 = x0 * rinv * g[lane * 2] * siluf_(bf2f((bf16_t)(gg & 0xffff)));
        const float y1 = x1 * rinv * g[lane * 2 + 1] * siluf_(bf2f((bf16_t)(gg >> 16)));
        *(unsigned*)(mix + (size_t)row * D + h * 128 + lane * 2) = pack2(y0, y1);
    }
}

__device__ void ph_prep_swa(int bid, int nb, bf16_t* __restrict__ P, const float* __restrict__ cosS, const float* __restrict__ sinS) {
    const size_t n = (size_t)TA * 320;
    for (size_t idx = (size_t)bid * blockDim.x + threadIdx.x; idx < n; idx += (size_t)nb * blockDim.x) {
        const int row = (int)(idx / 320), pr = (int)(idx % 320), head = pr >> 5, d = pr & 31;
        bf16_t* p = P + (size_t)row * SWW + head * 64 + d;
        float x1 = bf2f(p[0]), x2 = bf2f(p[32]);
        if (row < TL) {
            const int t = row & (SEQ - 1);
            const float c = cosS[t * 32 + d], s = sinS[t * 32 + d];
            const float y1 = x1 * c - x2 * s, y2 = x1 * s + x2 * c;
            x1 = y1; x2 = y2;
        }
        if (head < 8) { x1 *= 0.125f * LOG2E; x2 *= 0.125f * LOG2E; }
        p[0] = f2bf(x1); p[32] = f2bf(x2);
    }
}
__device__ void ph_prep_ga(int bid, int nb, bf16_t* __restrict__ P, const float* __restrict__ qg, const float* __restrict__ kg,
                           const float* __restrict__ cosG, const float* __restrict__ sinG) {
    const int lane = threadIdx.x & 63, wid = threadIdx.x >> 6;
    for (int it = bid * 4 + wid; it < TA * 10; it += nb * 4) {
        const int row = it / 10, head = it % 10;
        bf16_t* p = P + (size_t)row * GA_IN + head * 128;
        float x1 = bf2f(p[lane]), x2 = bf2f(p[lane + 64]);
        const float ss = wave_sum(x1 * x1 + x2 * x2);
        const float rinv = rsqrtf(ss * (1.0f / 128.0f) + EPS);
        const float* g = head < 8 ? qg : kg;
        x1 = x1 * rinv * g[lane]; x2 = x2 * rinv * g[lane + 64];
        if (row < TL) {
            const int t = row & (SEQ - 1);
            const float c = cosG[t * 64 + lane], s = sinG[t * 64 + lane];
            const float y1 = x1 * c - x2 * s, y2 = x1 * s + x2 * c;
            x1 = y1; x2 = y2;
        }
        if (head < 8) { x1 *= 0.08838834764831845f * LOG2E; x2 *= 0.08838834764831845f * LOG2E; }
        p[lane] = f2bf(x1); p[lane + 64] = f2bf(x2);
    }
}

template <int HD>
__device__ void ph_vt(int bid, int nb, const bf16_t* __restrict__ P, int ldp, int vcol, bf16_t* __restrict__ Vt, bf16_t* lds) {
    constexpr int ND = HD / 64;
    const int tid = threadIdx.x;
    for (int it = bid; it < NB * 2 * ND * (NKEY / 64); it += nb) {
        const int kt = it % (NKEY / 64), r1 = it / (NKEY / 64), dh = r1 % ND, g = r1 / ND, b = g >> 1, kvh = g & 1;
        const int k0 = kt * 64;
        const int row0 = k0 < LC ? TL + b * LC + k0 : b * SEQ + (k0 - LC);
        __syncthreads();
#pragma unroll
        for (int i = 0; i < 2; ++i) {
            const int id = tid + i * 256, kr = id >> 3, c = id & 7;
            const uint4 w = *(const uint4*)(P + (size_t)(row0 + kr) * ldp + vcol + kvh * HD + dh * 64 + c * 8);
            const unsigned ww[4] = {w.x, w.y, w.z, w.w};
#pragma unroll
            for (int j = 0; j < 4; ++j) { lds[kr * 66 + c * 8 + j * 2] = (bf16_t)(ww[j] & 0xffff); lds[kr * 66 + c * 8 + j * 2 + 1] = (bf16_t)(ww[j] >> 16); }
        }
        __syncthreads();
#pragma unroll
        for (int i = 0; i < 2; ++i) {
            const int id = tid + i * 256, d = id >> 3, c = id & 7;
            unsigned o[4];
#pragma unroll
            for (int j = 0; j < 4; ++j) o[j] = (unsigned)lds[(c * 8 + j * 2) * 66 + d] | ((unsigned)lds[(c * 8 + j * 2 + 1) * 66 + d] << 16);
            uint4 w; w.x = o[0]; w.y = o[1]; w.z = o[2]; w.w = o[3];
            *(uint4*)(Vt + (size_t)(g * HD + dh * 64 + d) * NKEY + k0 + c * 8) = w;
        }
    }
}

template <int HD, bool MASK>
__device__ __forceinline__ void flash_item(const bf16_t* __restrict__ Qrow0, int ldq, const bf16_t* __restrict__ Kp, int ldk,
                                           const bf16_t* __restrict__ Vt, int krow_ctx0, int krow_lat0, int nctx_t, int lat_lo, int nlat_t,
                                           int tq0, float m0, float l0, bf16_t* __restrict__ Orow0, int ldo, char* lds) {
    constexpr int NCH = HD / 32;
    constexpr int KB = 64 * HD * 2;
    constexpr int NKK = HD / 16;
    constexpr int NDT = HD / 32;
    const int tid = threadIdx.x, lane = tid & 63, w = tid >> 6, r = lane & 31, h = lane >> 5;
    const int pr = (r & 0x13) | ((r & 4) << 1) | ((r & 8) >> 1);
    bf16x8 qf[NKK];
    {
        const bf16_t* qp = Qrow0 + (size_t)(32 * w + r) * ldq + 8 * h;
#pragma unroll
        for (int kk = 0; kk < NKK; ++kk) qf[kk] = *(const bf16x8*)(qp + 16 * kk);
    }
    f32x16 O[NDT];
#pragma unroll
    for (int dt = 0; dt < NDT; ++dt)
#pragma unroll
        for (int i = 0; i < 16; ++i) O[dt][i] = 0.f;
    float m_run = m0, l_run = (h == 0) ? l0 : 0.f;
    const int kc = (HD == 128) ? (tid & 15) : (tid & 7);
    const int kr = (HD == 128) ? (tid >> 4) : (tid >> 3);
    const int ksw = (HD == 128) ? (kr & 15) : ((kr >> 1) & 7);
    const int klds = kr * (HD * 2) + ((kc ^ ksw) << 4);
    constexpr int KRSTEP = (HD == 128) ? 16 : 32;
    const int vr = tid >> 3, vc = tid & 7;
    const int vlds = KB + vr * 128 + ((vc ^ ((vr >> 1) & 7)) << 4);
    const int kfo = pr * (HD * 2);
    const int kfs = (HD == 128) ? (pr & 15) : ((pr >> 1) & 7);
    const int vfo = KB + r * 128;
    const int vfs = (r >> 1) & 7;
    const int ntile = nctx_t + nlat_t;
    uint4 sg0, sg1, sg2, sg3;
    sg2 = sg3 = make_uint4(0u, 0u, 0u, 0u);
#define FA_TILE(t, krow0, kidx0, s0) const int krow0 = (t) < nctx_t ? krow_ctx0 + 64 * (t) : krow_lat0 + lat_lo + 64 * ((t) - nctx_t); \
        const int s0 = (t) < nctx_t ? -(1 << 24) : lat_lo + 64 * ((t) - nctx_t); const int kidx0 = (t) < nctx_t ? 64 * (t) : LC + lat_lo + 64 * ((t) - nctx_t);
#define FA_GLOADK(t) do { FA_TILE(t, _kr0, _ki0, _s0) (void)_s0; (void)_ki0; \
        const bf16_t* _kp = Kp + (size_t)(_kr0 + kr) * ldk + kc * 8; \
        sg0 = *(const uint4*)(_kp); sg1 = *(const uint4*)(_kp + (size_t)KRSTEP * ldk); \
        if (NCH == 4) { sg2 = *(const uint4*)(_kp + (size_t)2 * KRSTEP * ldk); sg3 = *(const uint4*)(_kp + (size_t)3 * KRSTEP * ldk); } } while (0)
#define FA_GLOADV(t) do { FA_TILE(t, _kr0, _ki0, _s0) (void)_s0; (void)_kr0; \
        const bf16_t* _vp = Vt + (size_t)vr * NKEY + _ki0 + vc * 8; \
        sg0 = *(const uint4*)(_vp); sg1 = *(const uint4*)(_vp + (size_t)32 * NKEY); \
        if (NCH == 4) { sg2 = *(const uint4*)(_vp + (size_t)64 * NKEY); sg3 = *(const uint4*)(_vp + (size_t)96 * NKEY); } } while (0)
#define FA_LSTORE(buf, off) do { char* _b = lds + (buf) * (2 * KB) + (off); \
        *(uint4*)(_b) = sg0; *(uint4*)(_b + 4096) = sg1; \
        if (NCH == 4) { *(uint4*)(_b + 8192) = sg2; *(uint4*)(_b + 12288) = sg3; } } while (0)
    __syncthreads();
    FA_GLOADK(0); FA_LSTORE(0, klds);
    FA_GLOADV(0); FA_LSTORE(0, vlds);
    __syncthreads();
    for (int t = 0; t < ntile; ++t) {
        if (t + 1 < ntile) FA_GLOADK(t + 1);
        const char* base = lds + (t & 1) * (2 * KB);
        f32x16 st[2];
#pragma unroll
        for (int rt = 0; rt < 2; ++rt) {
#pragma unroll
            for (int i = 0; i < 16; ++i) st[rt][i] = 0.f;
#pragma unroll
            for (int kk = 0; kk < NKK; ++kk) {
                const bf16x8 kf = *(const bf16x8*)(base + rt * 32 * (HD * 2) + kfo + (((2 * kk + h) ^ kfs) << 4));
                st[rt] = __builtin_amdgcn_mfma_f32_32x32x16_bf16(kf, qf[kk], st[rt], 0, 0, 0);
                if ((kk & 3) == 3) __builtin_amdgcn_sched_barrier(0);
            }
        }
        if (MASK) {
            FA_TILE(t, _kr0, _ki0, s0) (void)_kr0; (void)_ki0;
            if (t >= nctx_t) {
                const int tq = tq0 + 32 * w + r;
#pragma unroll
                for (int rt = 0; rt < 2; ++rt)
#pragma unroll
                    for (int i = 0; i < 16; ++i) {
                        const int s = s0 + 32 * rt + (i & 3) + 4 * ((i >> 2) & 1) + 8 * h + 16 * (i >> 3);
                        const int dlt = tq - s;
                        if (dlt > 128 || dlt < -128) st[rt][i] = -1.0e30f;
                    }
            }
        }
        float mx = m_run;
#pragma unroll
        for (int rt = 0; rt < 2; ++rt)
#pragma unroll
            for (int i = 0; i < 16; ++i) mx = fmaxf(mx, st[rt][i]);
        mx = fmaxf(mx, __shfl_xor(mx, 32));
        const float alpha = __builtin_amdgcn_exp2f(m_run - mx);
        m_run = mx;
        float ps = 0.f;
#pragma unroll
        for (int rt = 0; rt < 2; ++rt)
#pragma unroll
            for (int i = 0; i < 16; ++i) { const float p = __builtin_amdgcn_exp2f(st[rt][i] - mx); st[rt][i] = p; ps += p; }
        l_run = l_run * alpha + ps;
        if (!__all(alpha == 1.0f)) {
#pragma unroll
            for (int dt = 0; dt < NDT; ++dt)
#pragma unroll
                for (int i = 0; i < 16; ++i) O[dt][i] *= alpha;
        }
        if (t + 1 < ntile) { FA_LSTORE((t + 1) & 1, klds); FA_GLOADV(t + 1); }
        bf16x8 pf[2][2];
#pragma unroll
        for (int rt = 0; rt < 2; ++rt)
#pragma unroll
            for (int s2 = 0; s2 < 2; ++s2) {
                uint4 pk;
                pk.x = pack2(st[rt][8 * s2 + 0], st[rt][8 * s2 + 1]); pk.y = pack2(st[rt][8 * s2 + 2], st[rt][8 * s2 + 3]);
                pk.z = pack2(st[rt][8 * s2 + 4], st[rt][8 * s2 + 5]); pk.w = pack2(st[rt][8 * s2 + 6], st[rt][8 * s2 + 7]);
                pf[rt][s2] = __builtin_bit_cast(bf16x8, pk);
            }
#pragma unroll
        for (int dt = 0; dt < NDT; ++dt)
#pragma unroll
            for (int rt = 0; rt < 2; ++rt)
#pragma unroll
                for (int s2 = 0; s2 < 2; ++s2) {
                    const bf16x8 vf = *(const bf16x8*)(base + vfo + dt * 4096 + (((4 * rt + 2 * s2 + h) ^ vfs) << 4));
                    O[dt] = __builtin_amdgcn_mfma_f32_32x32x16_bf16(vf, pf[rt][s2], O[dt], 0, 0, 0);
                    if (rt == 1 && s2 == 1) __builtin_amdgcn_sched_barrier(0);
                }
        if (t + 1 < ntile) FA_LSTORE((t + 1) & 1, vlds);
        __syncthreads();
    }
#undef FA_TILE
#undef FA_GLOADK
#undef FA_GLOADV
#undef FA_LSTORE
    const float lt = l_run + __shfl_xor(l_run, 32);
    const float inv = 1.0f / lt;
    bf16_t* op = Orow0 + (size_t)(32 * w + r) * ldo + 4 * h;
#pragma unroll
    for (int dt = 0; dt < NDT; ++dt)
#pragma unroll
        for (int g = 0; g < 4; ++g) {
            uint2 o2; o2.x = pack2(O[dt][4 * g] * inv, O[dt][4 * g + 1] * inv); o2.y = pack2(O[dt][4 * g + 2] * inv, O[dt][4 * g + 3] * inv);
            *(uint2*)(op + 32 * dt + 8 * g) = o2;
        }
}
__device__ void ph_swa(int bid, int nb, const bf16_t* __restrict__ projS, const bf16_t* __restrict__ Vt, const float* __restrict__ sink,
                       bf16_t* __restrict__ mix, char* lds) {
    const int n_lat = NB * 8 * 32, n_ctx = NB * 8 * 2;
    for (int it = bid; it < n_lat + n_ctx; it += nb) {
        int b, hq, row0, lo, nlat, t0;
        if (it < n_lat) {
            const int qb = it & 31; hq = (it >> 5) & 7; b = it >> 8;
            t0 = qb * 128;
            lo = t0 - 128 < 0 ? 0 : t0 - 128;
            const int hi = t0 + 256 > SEQ ? SEQ : t0 + 256;
            nlat = (hi - lo) / 64; row0 = b * SEQ + t0;
        } else {
            const int i2 = it - n_lat, qb = i2 & 1; hq = (i2 >> 1) & 7; b = i2 >> 4;
            t0 = 0; lo = 0; nlat = 0; row0 = TL + b * LC + qb * 128;
        }
        const int kvh = hq >> 2;
        flash_item<64, true>(projS + (size_t)row0 * SWW + hq * 64, SWW, projS + 512 + kvh * 64, SWW, Vt + (size_t)(b * 2 + kvh) * 64 * NKEY,
                             TL + b * LC, b * SEQ, 4, lo, nlat, t0, sink[hq] * LOG2E, 1.0f, mix + (size_t)row0 * D + 512 + hq * 64, D, lds);
    }
}
__device__ void ph_dense(int bid, int nb, const bf16_t* __restrict__ projG, const bf16_t* __restrict__ Vt, bf16_t* __restrict__ mix, char* lds) {
    const bool sw = (nb & 7) == 0;
    const int nit = NB * 8 * 32;
    for (int j = sw ? (bid >> 3) : bid; j < (sw ? nit / 8 : nit); j += sw ? (nb >> 3) : nb) {
        int g, jj;
        if (sw) { g = (bid & 7) + 8 * (j >> 7); jj = j & 127; } else { g = j >> 7; jj = j & 127; }
        const int b = g >> 1, kvh = g & 1, hq = kvh * 4 + (jj >> 5), qb = jj & 31;
        const int row0 = b * SEQ + qb * 128;
        flash_item<128, false>(projG + (size_t)row0 * GA_IN + hq * 128, GA_IN, projG + 1024 + kvh * 128, GA_IN, Vt + (size_t)(b * 2 + kvh) * 128 * NKEY,
                               TL + b * LC, b * SEQ, 4, 0, SEQ / 64, 0, -1.0e30f, 0.0f, mix + (size_t)row0 * D + hq * 128, D, lds);
    }
}

#define CE(a, b) { const float _h = fmaxf(a, b); b = fminf(a, b); a = _h; }
__device__ __forceinline__ void net_sort16(float (&v)[16]) {
    CE(v[0], v[1]); CE(v[3], v[2]); CE(v[4], v[5]); CE(v[7], v[6]); CE(v[8], v[9]); CE(v[11], v[10]);
    CE(v[12], v[13]); CE(v[15], v[14]); CE(v[0], v[2]); CE(v[1], v[3]); CE(v[6], v[4]); CE(v[7], v[5]);
    CE(v[8], v[10]); CE(v[9], v[11]); CE(v[14], v[12]); CE(v[15], v[13]); CE(v[0], v[1]); CE(v[2], v[3]);
    CE(v[5], v[4]); CE(v[7], v[6]); CE(v[8], v[9]); CE(v[10], v[11]); CE(v[13], v[12]); CE(v[15], v[14]);
    CE(v[0], v[4]); CE(v[1], v[5]); CE(v[2], v[6]); CE(v[3], v[7]); CE(v[12], v[8]); CE(v[13], v[9]);
    CE(v[14], v[10]); CE(v[15], v[11]); CE(v[0], v[2]); CE(v[1], v[3]); CE(v[4], v[6]); CE(v[5], v[7]);
    CE(v[10], v[8]); CE(v[11], v[9]); CE(v[14], v[12]); CE(v[15], v[13]); CE(v[0], v[1]); CE(v[2], v[3]);
    CE(v[4], v[5]); CE(v[6], v[7]); CE(v[9], v[8]); CE(v[11], v[10]); CE(v[13], v[12]); CE(v[15], v[14]);
    CE(v[0], v[8]); CE(v[1], v[9]); CE(v[2], v[10]); CE(v[3], v[11]); CE(v[4], v[12]); CE(v[5], v[13]);
    CE(v[6], v[14]); CE(v[7], v[15]); CE(v[0], v[4]); CE(v[1], v[5]); CE(v[2], v[6]); CE(v[3], v[7]);
    CE(v[8], v[12]); CE(v[9], v[13]); CE(v[10], v[14]); CE(v[11], v[15]); CE(v[0], v[2]); CE(v[1], v[3]);
    CE(v[4], v[6]); CE(v[5], v[7]); CE(v[8], v[10]); CE(v[9], v[11]); CE(v[12], v[14]); CE(v[13], v[15]);
    CE(v[0], v[1]); CE(v[2], v[3]); CE(v[4], v[5]); CE(v[6], v[7]); CE(v[8], v[9]); CE(v[10], v[11]);
    CE(v[12], v[13]); CE(v[14], v[15]);
}
__device__ __forceinline__ void net_clean16(float (&v)[16]) {
    CE(v[0], v[8]); CE(v[1], v[9]); CE(v[2], v[10]); CE(v[3], v[11]); CE(v[4], v[12]); CE(v[5], v[13]);
    CE(v[6], v[14]); CE(v[7], v[15]); CE(v[0], v[4]); CE(v[1], v[5]); CE(v[2], v[6]); CE(v[3], v[7]);
    CE(v[8], v[12]); CE(v[9], v[13]); CE(v[10], v[14]); CE(v[11], v[15]); CE(v[0], v[2]); CE(v[1], v[3]);
    CE(v[4], v[6]); CE(v[5], v[7]); CE(v[8], v[10]); CE(v[9], v[11]); CE(v[12], v[14]); CE(v[13], v[15]);
    CE(v[0], v[1]); CE(v[2], v[3]); CE(v[4], v[5]); CE(v[6], v[7]); CE(v[8], v[9]); CE(v[10], v[11]);
    CE(v[12], v[13]); CE(v[14], v[15]);
}
__device__ __forceinline__ void net_merge16(float (&a)[16], const float (&b)[16]) {
#pragma unroll
    for (int i = 0; i < 16; ++i) a[i] = fmaxf(a[i], b[15 - i]);
    net_clean16(a);
}
#define PEER_CANDS(F) F(0,0,0) F(1,0,1) F(2,0,2) F(3,0,3) F(4,0,4) F(5,0,5) F(6,0,6) F(7,0,7) F(8,0,8) F(9,0,9) F(10,0,10) F(11,0,11) F(12,0,12) F(13,0,13) F(14,0,14) F(15,0,15) F(16,1,1) F(17,1,2) F(18,1,3) F(19,1,4) F(20,1,5) F(21,1,6) F(22,1,7) F(23,2,2) F(24,2,3) F(25,2,4) F(26,3,3)

__device__ __forceinline__ void ph_peer_route(int bid, int nb, const bf16_t* __restrict__ qpeer, const bf16_t* __restrict__ SK, int* __restrict__ sel_e,
                              float* __restrict__ sel_g, int M, char* lds) {
    const int tid = threadIdx.x, lane = tid & 63, w = tid >> 6, r = lane & 31, h2 = lane >> 5;
    const int srow = tid >> 4, sc = tid & 15;
    const int soff = srow * 256 + ((sc ^ (srow & 15)) << 4);
    for (int it = bid; it < (M / 128) * 8; it += nb) {
        const int m0 = (it >> 3) * 128, hd = it & 7;
        const int row = 32 * w + r;
        __syncthreads();
#pragma unroll
        for (int pp = 0; pp < 2; ++pp) {
            const bf16_t* sp = SK + ((size_t)(hd * 2 + pp) * 128 + srow) * 128 + sc * 8;
            uint4 t0 = *(const uint4*)(sp), t1 = *(const uint4*)(sp + 16 * 128), t2 = *(const uint4*)(sp + 32 * 128), t3 = *(const uint4*)(sp + 48 * 128);
            uint4 t4 = *(const uint4*)(sp + 64 * 128), t5 = *(const uint4*)(sp + 80 * 128), t6 = *(const uint4*)(sp + 96 * 128), t7 = *(const uint4*)(sp + 112 * 128);
            char* d = lds + pp * 32768 + soff;
            *(uint4*)(d) = t0; *(uint4*)(d + 4096) = t1; *(uint4*)(d + 8192) = t2; *(uint4*)(d + 12288) = t3;
            *(uint4*)(d + 16384) = t4; *(uint4*)(d + 20480) = t5; *(uint4*)(d + 24576) = t6; *(uint4*)(d + 28672) = t7;
        }
        __syncthreads();
        float L0[16], L1[16];
#pragma unroll
        for (int pp = 0; pp < 2; ++pp) {
            bf16x8 qf[8];
            const bf16_t* qp = qpeer + (size_t)(m0 + row) * PQ + hd * 256 + pp * 128 + 8 * h2;
#pragma unroll
            for (int kk = 0; kk < 8; ++kk) qf[kk] = *(const bf16x8*)(qp + 16 * kk);
            float g[4][16];
#pragma unroll
            for (int kt = 0; kt < 4; ++kt) {
                f32x16 st;
#pragma unroll
                for (int i = 0; i < 16; ++i) st[i] = 0.f;
#pragma unroll
                for (int kk = 0; kk < 8; ++kk) {
                    const bf16x8 kf = *(const bf16x8*)(lds + pp * 32768 + (32 * kt + r) * 256 + (((2 * kk + h2) ^ (r & 15)) << 4));
                    st = __builtin_amdgcn_mfma_f32_32x32x16_bf16(kf, qf[kk], st, 0, 0, 0);
                }
#pragma unroll
                for (int i = 0; i < 16; ++i) {
                    const unsigned n = 32 * kt + (i & 3) + 8 * (i >> 2) + 4 * h2;
                    g[kt][i] = __uint_as_float((__float_as_uint(st[i]) & 0xFFFFFF80u) | n);
                }
            }
            net_sort16(g[0]); net_sort16(g[1]); net_sort16(g[2]); net_sort16(g[3]);
            net_merge16(g[0], g[1]); net_merge16(g[2], g[3]); net_merge16(g[0], g[2]);
            float pb[16];
#pragma unroll
            for (int i = 0; i < 16; ++i) pb[i] = __shfl_xor(g[0][i], 32);
            net_merge16(g[0], pb);
#pragma unroll
            for (int i = 0; i < 16; ++i) { if (pp == 0) L0[i] = g[0][i]; else L1[i] = g[0][i]; }
        }
        __syncthreads();
        unsigned char* tab = (unsigned char*)lds;
        if (h2 == 0) {
            unsigned wv[8];
#pragma unroll
            for (int j = 0; j < 4; ++j) {
                wv[j] = (__float_as_uint(L0[4 * j]) & 0x7Fu) | ((__float_as_uint(L0[4 * j + 1]) & 0x7Fu) << 8) | ((__float_as_uint(L0[4 * j + 2]) & 0x7Fu) << 16) | ((__float_as_uint(L0[4 * j + 3]) & 0x7Fu) << 24);
                wv[4 + j] = (__float_as_uint(L1[4 * j]) & 0x7Fu) | ((__float_as_uint(L1[4 * j + 1]) & 0x7Fu) << 8) | ((__float_as_uint(L1[4 * j + 2]) & 0x7Fu) << 16) | ((__float_as_uint(L1[4 * j + 3]) & 0x7Fu) << 24);
            }
            *(uint4*)(tab + row * 32) = make_uint4(wv[0], wv[1], wv[2], wv[3]);
            *(uint4*)(tab + row * 32 + 16) = make_uint4(wv[4], wv[5], wv[6], wv[7]);
        }
        float X[16], Y[16];
#pragma unroll
        for (int i = 0; i < 16; ++i) {
            const float a0 = __uint_as_float(__float_as_uint(L0[i]) & 0xFFFFFF80u), a1 = __uint_as_float(__float_as_uint(L1[i]) & 0xFFFFFF80u);
            X[i] = h2 ? a1 : a0; Y[i] = h2 ? a0 : a1;
        }
        float c0[16], c1[16];
#define PEER_CAND(i, a, b) { float v = X[a] + Y[b]; if ((a) == (b) && h2) v = -3.0e38f; const unsigned id = h2 ? ((b) * 16 + (a)) : ((a) * 16 + (b)); \
            const float pk = __uint_as_float((__float_as_uint(v) & 0xFFFFFF00u) | id); if ((i) < 16) c0[(i) & 15] = pk; else c1[(i) & 15] = pk; }
        PEER_CANDS(PEER_CAND)
#undef PEER_CAND
#pragma unroll
        for (int i = 11; i < 16; ++i) c1[i] = -3.0e38f;
        net_sort16(c0); net_sort16(c1); net_merge16(c0, c1);
        {
            float pb[16];
#pragma unroll
            for (int i = 0; i < 16; ++i) pb[i] = __shfl_xor(c0[i], 32);
            net_merge16(c0, pb);
        }
        float ex[16], sum = 0.f;
#pragma unroll
        for (int i = 0; i < 16; ++i) { ex[i] = __expf(c0[i] - c0[0]); sum += ex[i]; }
        const float rs = 1.0f / sum;
        const size_t ob = ((size_t)(m0 + row) * 8 + hd) * 16;
        if (h2 == 0) {
            int eo[16];
#pragma unroll
            for (int j = 0; j < 16; ++j) {
                const unsigned id = __float_as_uint(c0[j]) & 0xFFu;
                eo[j] = (int)tab[row * 32 + (id >> 4)] * 128 + (int)tab[row * 32 + 16 + (id & 15)];
            }
#pragma unroll
            for (int j = 0; j < 4; ++j) *(int4*)(sel_e + ob + 4 * j) = make_int4(eo[4 * j], eo[4 * j + 1], eo[4 * j + 2], eo[4 * j + 3]);
        } else {
#pragma unroll
            for (int j = 0; j < 4; ++j) *(float4*)(sel_g + ob + 4 * j) = make_float4(ex[4 * j] * rs, ex[4 * j + 1] * rs, ex[4 * j + 2] * rs, ex[4 * j + 3] * rs);
        }
    }
}
constexpr float USCALE = 64.0f;
#define DEC16(W_, f) do { const f32x2 _a = __builtin_amdgcn_cvt_pk_f32_fp8((int)(W_).x, false), _b = __builtin_amdgcn_cvt_pk_f32_fp8((int)(W_).x, true), \
        _c = __builtin_amdgcn_cvt_pk_f32_fp8((int)(W_).y, false), _d = __builtin_amdgcn_cvt_pk_f32_fp8((int)(W_).y, true), \
        _e = __builtin_amdgcn_cvt_pk_f32_fp8((int)(W_).z, false), _f = __builtin_amdgcn_cvt_pk_f32_fp8((int)(W_).z, true), \
        _g = __builtin_amdgcn_cvt_pk_f32_fp8((int)(W_).w, false), _h = __builtin_amdgcn_cvt_pk_f32_fp8((int)(W_).w, true); \
        f[0] = _a.x; f[1] = _a.y; f[2] = _b.x; f[3] = _b.y; f[4] = _c.x; f[5] = _c.y; f[6] = _d.x; f[7] = _d.y; \
        f[8] = _e.x; f[9] = _e.y; f[10] = _f.x; f[11] = _f.y; f[12] = _g.x; f[13] = _g.y; f[14] = _h.x; f[15] = _h.y; } while (0)
template <int MODE>
__device__ __forceinline__ void ph_peer_gather(int bid, int nb, const bf16_t* __restrict__ xf  , const unsigned char* __restrict__ U,
                               const unsigned char* __restrict__ V, const int* __restrict__ sel_e, const float* __restrict__ sel_g,
                               const float* __restrict__ gate  , float* __restrict__ hlat, float* __restrict__ hctx, int ntok, float* lds,
                               const float* __restrict__ ngamma, const float* __restrict__ nmod  , bf16_t* __restrict__ aout) {
    const int lane = threadIdx.x & 63, wid = threadIdx.x >> 6;
    float* wl = lds + wid * 128;
    const bool b5 = (lane & 32) != 0, b4 = (lane & 16) != 0, b3 = (lane & 8) != 0;
    const int jj = ((lane >> 5) & 1) * 4 + ((lane >> 4) & 1) * 2 + ((lane >> 3) & 1);
    for (int row = bid * 4 + wid; row < ntok; row += nb * 4) {
        float x[16];
        {
            const uint4 w0 = *(const uint4*)(xf + (size_t)row * D + lane * 16), w1 = *(const uint4*)(xf + (size_t)row * D + lane * 16 + 8);
            const unsigned ww[8] = {w0.x, w0.y, w0.z, w0.w, w1.x, w1.y, w1.z, w1.w};
#pragma unroll
            for (int j = 0; j < 8; ++j) { x[2 * j] = __uint_as_float(ww[j] << 16); x[2 * j + 1] = __uint_as_float(ww[j] & 0xffff0000u); }
        }
        const int my_e0 = sel_e[(size_t)row * 128 + lane], my_e1 = sel_e[(size_t)row * 128 + 64 + lane];
        wl[lane] = sel_g[(size_t)row * 128 + lane]; wl[64 + lane] = sel_g[(size_t)row * 128 + 64 + lane];
#pragma unroll 1
        for (int k0 = 0; k0 < 128; k0 += 8) {
            uint4 ur[8];
#pragma unroll
            for (int j = 0; j < 8; ++j) {
                const int e = __shfl((k0 + j) < 64 ? my_e0 : my_e1, (k0 + j) & 63);
                ur[j] = *(const uint4*)(U + (size_t)e * D + lane * 16);
            }
            float p[8];
#pragma unroll
            for (int j = 0; j < 8; ++j) {
                float f[16]; DEC16(ur[j], f);
                float a = 0.f;
#pragma unroll
                for (int i = 0; i < 16; ++i) a += x[i] * f[i];
                p[j] = a;
            }
            float q[4];
#pragma unroll
            for (int j = 0; j < 4; ++j) { const float keep = b5 ? p[j + 4] : p[j], send = b5 ? p[j] : p[j + 4]; q[j] = keep + __shfl_xor(send, 32); }
            float r2[2];
#pragma unroll
            for (int j = 0; j < 2; ++j) { const float keep = b4 ? q[j + 2] : q[j], send = b4 ? q[j] : q[j + 2]; r2[j] = keep + __shfl_xor(send, 16); }
            float sdot = (b3 ? r2[1] : r2[0]) + __shfl_xor(b3 ? r2[0] : r2[1], 8);
            sdot += __shfl_xor(sdot, 4); sdot += __shfl_xor(sdot, 2); sdot += __shfl_xor(sdot, 1);
            if ((lane & 7) == 0) {
                const float dot = sdot * (1.0f / USCALE);
                const float act = 0.5f * dot * (1.0f + erff(dot * 0.70710678118654752f));
                wl[k0 + jj] = wl[k0 + jj] * act;
            }
        }
        float y[16];
#pragma unroll
        for (int i = 0; i < 16; ++i) y[i] = 0.f;
#pragma unroll 1
        for (int k0 = 0; k0 < 128; k0 += 8) {
            uint4 vr[8];
#pragma unroll
            for (int j = 0; j < 8; ++j) {
                const int e = __shfl((k0 + j) < 64 ? my_e0 : my_e1, (k0 + j) & 63);
                vr[j] = *(const uint4*)(V + (size_t)e * D + lane * 16);
            }
            const float4 wa = *(const float4*)(wl + k0), wb = *(const float4*)(wl + k0 + 4);
            const float wv[8] = {wa.x, wa.y, wa.z, wa.w, wb.x, wb.y, wb.z, wb.w};
#pragma unroll
            for (int j = 0; j < 8; ++j) {
                float f[16]; DEC16(vr[j], f);
#pragma unroll
                for (int i = 0; i < 16; ++i) y[i] += wv[j] * f[i];
            }
        }
        float* hp = row < TL ? hlat + (size_t)row * D : hctx + (size_t)(row - TL) * D;
        const float* gg = gate + (size_t)mod_row(row) * 6144;
        float hn[16]; float ss = 0.f;
#pragma unroll
        for (int j = 0; j < 4; ++j) {
            float4 h = *(float4*)(hp + lane * 16 + j * 4); const float4 g4 = *(const float4*)(gg + lane * 16 + j * 4);
            h.x += g4.x * y[j * 4 + 0]; h.y += g4.y * y[j * 4 + 1]; h.z += g4.z * y[j * 4 + 2]; h.w += g4.w * y[j * 4 + 3];
            if (MODE == 0) *(float4*)(hp + lane * 16 + j * 4) = h;
            hn[j * 4 + 0] = h.x; hn[j * 4 + 1] = h.y; hn[j * 4 + 2] = h.z; hn[j * 4 + 3] = h.w;
            ss += h.x * h.x + h.y * h.y + h.z * h.z + h.w * h.w;
        }
        ss = wave_sum(ss);
        const float rinv = rsqrtf(ss * (1.0f / D) + EPS);
        if (MODE == 0) {
            const float* m = nmod + (size_t)mod_row(row) * 6144;
            unsigned pk[8];
#pragma unroll
            for (int j = 0; j < 4; ++j) {
                const float4 g = *(const float4*)(ngamma + lane * 16 + j * 4), sc = *(const float4*)(m + D + lane * 16 + j * 4), sh = *(const float4*)(m + lane * 16 + j * 4);
                pk[2 * j] = pack2(hn[4 * j] * rinv * g.x * (1.f + sc.x) + sh.x, hn[4 * j + 1] * rinv * g.y * (1.f + sc.y) + sh.y);
                pk[2 * j + 1] = pack2(hn[4 * j + 2] * rinv * g.z * (1.f + sc.z) + sh.z, hn[4 * j + 3] * rinv * g.w * (1.f + sc.w) + sh.w);
            }
            *(uint4*)(aout + (size_t)row * D + lane * 16) = make_uint4(pk[0], pk[1], pk[2], pk[3]);
            *(uint4*)(aout + (size_t)row * D + lane * 16 + 8) = make_uint4(pk[4], pk[5], pk[6], pk[7]);
        } else {
#pragma unroll
            for (int j = 0; j < 4; ++j) {
                const float4 g = *(const float4*)(ngamma + lane * 16 + j * 4);
                float4 o; o.x = hn[4 * j] * rinv * g.x; o.y = hn[4 * j + 1] * rinv * g.y; o.z = hn[4 * j + 2] * rinv * g.z; o.w = hn[4 * j + 3] * rinv * g.w;
                *(float4*)(hp + lane * 16 + j * 4) = o;
            }
        }
    }
}
__device__ void ph_final(int bid, int nb, float* __restrict__ h, const float* __restrict__ g) {
    const int lane = threadIdx.x & 63, wid = threadIdx.x >> 6;
    for (int row = bid * 4 + wid; row < TL; row += nb * 4) {
        float4* p = (float4*)(h + (size_t)row * D);
        float4 x[4]; float ss = 0.f;
#pragma unroll
        for (int i = 0; i < 4; ++i) { x[i] = p[i * 64 + lane]; ss += x[i].x * x[i].x + x[i].y * x[i].y + x[i].z * x[i].z + x[i].w * x[i].w; }
        ss = wave_sum(ss);
        const float rinv = rsqrtf(ss * (1.0f / D) + EPS);
#pragma unroll
        for (int i = 0; i < 4; ++i) {
            const float4 gg = ((const float4*)g)[i * 64 + lane];
            float4 o; o.x = x[i].x * rinv * gg.x; o.y = x[i].y * rinv * gg.y; o.z = x[i].z * rinv * gg.z; o.w = x[i].w * rinv * gg.w;
            p[i * 64 + lane] = o;
        }
    }
}

struct Params {
    const float *x, *c, *ctx, *c_ctx, *ada_w, *ada_b, *norm_mix_g, *norm_ffn_g, *ab_w_in, *ab_w_out, *hg_lb, *hg_norm_g, *sw_sink,
        *ga_w_in, *ga_w_out, *ga_qn, *ga_kn, *peer_wq, *peer_sk, *peer_u, *peer_v, *final_g;
    float* out; char* ws;
};
extern __shared__ __attribute__((aligned(16))) char dyn_lds[];

#define WSP(T, off) ((T*)(p.ws + (off)))

__device__ __forceinline__ void grid_bar(unsigned* ctr, unsigned& epoch, unsigned nblk) {
    asm volatile("s_waitcnt vmcnt(0)" ::: "memory");
    __syncthreads();
    epoch += nblk;
    if (threadIdx.x == 0) {
        __builtin_amdgcn_fence(__ATOMIC_RELEASE, "agent");
        asm volatile("s_waitcnt vmcnt(0)" ::: "memory");
        __hip_atomic_fetch_add(ctr, 1u, __ATOMIC_RELAXED, __HIP_MEMORY_SCOPE_AGENT);
        while (__hip_atomic_load(ctr, __ATOMIC_RELAXED, __HIP_MEMORY_SCOPE_AGENT) < epoch) __builtin_amdgcn_s_sleep(1);
        __builtin_amdgcn_fence(__ATOMIC_ACQUIRE, "agent");
        asm volatile("s_waitcnt vmcnt(0)" ::: "memory");
    }
    __syncthreads();
}

namespace cg = cooperative_groups;
constexpr int MEGA_LDS = 65536;
__global__ void __launch_bounds__(256, 2) k_mega(Params p) {
    cg::grid_group grid = cg::this_grid();
    const int bid = blockIdx.x, nb = gridDim.x;
    char* lds = dyn_lds;
    float* ldf = (float*)dyn_lds;
    float* mod0 = WSP(float, OFF_MOD);
    float* mod1 = mod0 + (size_t)9 * 6144;
    float* hctx = WSP(float, OFF_HCTX);
    bf16_t* abuf = WSP(bf16_t, OFF_A);
    bf16_t* mix = WSP(bf16_t, OFF_MIX);
    unsigned* bar = WSP(unsigned, OFF_BAR);
    unsigned epoch = 0;
    ph_transpose(bid, nb, p.ab_w_in, WSP(bf16_t, OFF_WABIN), D, AB_IN, ldf);
    ph_transpose(bid, nb, p.ab_w_out, WSP(bf16_t, OFF_WABOUT), D, D, ldf);
    ph_transpose(bid, nb, p.ga_w_in, WSP(bf16_t, OFF_WGAIN), D, GA_IN, ldf);
    ph_transpose(bid, nb, p.ga_w_out, WSP(bf16_t, OFF_WGAOUT), D, D, ldf);
    ph_transpose(bid, nb, p.peer_wq, WSP(bf16_t, OFF_WPQ), D, PQ, ldf);
    ph_transpose(bid, nb, p.peer_wq + (size_t)D * PQ, WSP(bf16_t, OFF_WPQ) + (size_t)PQ * D, D, PQ, ldf);
    ph_cvt(bid, nb, p.peer_sk, WSP(bf16_t, OFF_SK), (size_t)2 * 8 * 2 * 128 * 128);
    ph_tables(bid, nb, WSP(float, OFF_COSS), WSP(float, OFF_SINS), WSP(float, OFF_COSG), WSP(float, OFF_SING), p.hg_lb, WSP(float, OFF_LB));
    __syncthreads();
    ph_mod(bid, nb, p.c, p.c_ctx, p.ada_w, p.ada_b, mod0, ldf);
    ph_cvt8(bid, nb, p.peer_u, WSP(unsigned char, OFF_U16), (size_t)2 * NEXP * D, USCALE);
    ph_cvt8(bid, nb, p.peer_v, WSP(unsigned char, OFF_V16), (size_t)2 * NEXP * D, 1.0f);
    grid.sync();
    ph_normmod(bid, nb, p.x, p.ctx, p.norm_mix_g, mod0, 1 * D, 0, abuf, TA);
    grid_bar(bar, epoch, (unsigned)nb);
    { EpiStoreSplit e{WSP(bf16_t, OFF_PROJH), HGW, WSP(bf16_t, OFF_PROJS), SWW, HGW};
      ph_gemm(bid, nb, abuf, D, WSP(bf16_t, OFF_WABIN), D, TA, AB_IN, D, lds, e); }
    grid_bar(bar, epoch, (unsigned)nb);
    ph_prep_swa(bid, nb, WSP(bf16_t, OFF_PROJS), WSP(float, OFF_COSS), WSP(float, OFF_SINS));
    ph_vt<64>(bid, nb, WSP(bf16_t, OFF_PROJS), SWW, 640, WSP(bf16_t, OFF_VT), (bf16_t*)lds);
    grid_bar(bar, epoch, (unsigned)nb);
    {
        const int hgb = nb >= 256 ? 128 : nb / 2;
        if (bid < hgb) ph_hgrn(bid, hgb, WSP(bf16_t, OFF_PROJH), WSP(float, OFF_LB), WSP(bf16_t, OFF_OF), WSP(bf16_t, OFF_OB), lds);
        else ph_swa(bid - hgb, nb - hgb, WSP(bf16_t, OFF_PROJS), WSP(bf16_t, OFF_VT), p.sw_sink, mix, lds);
    }
    grid_bar(bar, epoch, (unsigned)nb);
    ph_hgpost(bid, nb, WSP(bf16_t, OFF_OF), WSP(bf16_t, OFF_OB), WSP(bf16_t, OFF_PROJH), p.hg_norm_g, mix);
    grid_bar(bar, epoch, (unsigned)nb);
    { EpiResid e{p.x, p.ctx, p.out, hctx, mod0 + 2 * D};
      ph_gemm(bid, nb, mix, D, WSP(bf16_t, OFF_WABOUT), D, TA, D, D, lds, e); }
    grid_bar(bar, epoch, (unsigned)nb);
    ph_normmod(bid, nb, p.out, hctx, p.norm_ffn_g, mod0, 4 * D, 3 * D, abuf, TA);
    grid_bar(bar, epoch, (unsigned)nb);
    { EpiStoreSplit e{WSP(bf16_t, OFF_QPEER), PQ, WSP(bf16_t, OFF_QPEER), PQ, 1 << 30};
      ph_gemm(bid, nb, abuf, D, WSP(bf16_t, OFF_WPQ), D, TA, PQ, D, lds, e); }
    grid_bar(bar, epoch, (unsigned)nb);
    ph_peer_route(bid, nb, WSP(bf16_t, OFF_QPEER), WSP(bf16_t, OFF_SK), WSP(int, OFF_SELE), WSP(float, OFF_SELG), TA, lds);
    grid_bar(bar, epoch, (unsigned)nb);
    ph_peer_gather<0>(bid, nb, abuf, WSP(unsigned char, OFF_U16), WSP(unsigned char, OFF_V16), WSP(int, OFF_SELE), WSP(float, OFF_SELG), mod0 + 5 * D, p.out, hctx, TA, ldf,
                      p.norm_mix_g + D, mod1, abuf);
    grid_bar(bar, epoch, (unsigned)nb);
    { EpiStoreSplit e{WSP(bf16_t, OFF_PROJ), GA_IN, WSP(bf16_t, OFF_PROJ), GA_IN, 1 << 30};
      ph_gemm(bid, nb, abuf, D, WSP(bf16_t, OFF_WGAIN), D, TA, GA_IN, D, lds, e); }
    grid_bar(bar, epoch, (unsigned)nb);
    ph_prep_ga(bid, nb, WSP(bf16_t, OFF_PROJ), p.ga_qn, p.ga_kn, WSP(float, OFF_COSG), WSP(float, OFF_SING));
    ph_vt<128>(bid, nb, WSP(bf16_t, OFF_PROJ), GA_IN, 1280, WSP(bf16_t, OFF_VT), (bf16_t*)lds);
    grid_bar(bar, epoch, (unsigned)nb);
    ph_dense(bid, nb, WSP(bf16_t, OFF_PROJ), WSP(bf16_t, OFF_VT), mix, lds);
    grid_bar(bar, epoch, (unsigned)nb);
    { EpiResid e{p.out, hctx, p.out, hctx, mod1 + 2 * D};
      ph_gemm(bid, nb, mix, D, WSP(bf16_t, OFF_WGAOUT), D, TL, D, D, lds, e); }
    grid_bar(bar, epoch, (unsigned)nb);
    ph_normmod(bid, nb, p.out, hctx, p.norm_ffn_g + D, mod1, 4 * D, 3 * D, abuf, TL);
    grid_bar(bar, epoch, (unsigned)nb);
    { EpiStoreSplit e{WSP(bf16_t, OFF_QPEER), PQ, WSP(bf16_t, OFF_QPEER), PQ, 1 << 30};
      ph_gemm(bid, nb, abuf, D, WSP(bf16_t, OFF_WPQ) + (size_t)PQ * D, D, TL, PQ, D, lds, e); }
    grid_bar(bar, epoch, (unsigned)nb);
    ph_peer_route(bid, nb, WSP(bf16_t, OFF_QPEER), WSP(bf16_t, OFF_SK) + (size_t)16 * 128 * 128, WSP(int, OFF_SELE), WSP(float, OFF_SELG), TL, lds);
    grid_bar(bar, epoch, (unsigned)nb);
    ph_peer_gather<1>(bid, nb, abuf, WSP(unsigned char, OFF_U16) + (size_t)NEXP * D, WSP(unsigned char, OFF_V16) + (size_t)NEXP * D, WSP(int, OFF_SELE), WSP(float, OFF_SELG), mod1 + 5 * D, p.out, hctx, TL, ldf,
                      p.final_g, mod1, abuf);
}

extern "C" void kernel_launch(void* const* d_in, const int* in_sizes, int n_in, void* d_out, int out_size, void* d_ws, size_t ws_size,
                              hipStream_t stream) {
    Params p{};
    p.x = (const float*)d_in[0]; p.c = (const float*)d_in[1]; p.ctx = (const float*)d_in[2]; p.c_ctx = (const float*)d_in[3];
    p.ada_w = (const float*)d_in[4]; p.ada_b = (const float*)d_in[5]; p.norm_mix_g = (const float*)d_in[6]; p.norm_ffn_g = (const float*)d_in[7];
    p.ab_w_in = (const float*)d_in[8]; p.ab_w_out = (const float*)d_in[9]; p.hg_lb = (const float*)d_in[10]; p.hg_norm_g = (const float*)d_in[11];
    p.sw_sink = (const float*)d_in[12]; p.ga_w_in = (const float*)d_in[13]; p.ga_w_out = (const float*)d_in[14]; p.ga_qn = (const float*)d_in[15];
    p.ga_kn = (const float*)d_in[16]; p.peer_wq = (const float*)d_in[17]; p.peer_sk = (const float*)d_in[18]; p.peer_u = (const float*)d_in[19];
    p.peer_v = (const float*)d_in[20]; p.final_g = (const float*)d_in[21];
    p.out = (float*)d_out; p.ws = (char*)d_ws;
    if (ws_size < WS_NEED) { fprintf(stderr, "workspace too small: %zu < %zu\n", ws_size, WS_NEED); return; }
    static int grid_blocks = 0;
    if (!grid_blocks) {
        int dev = 0, cus = 0, per_cu = 0;
        (void)hipGetDevice(&dev);
        (void)hipDeviceGetAttribute(&cus, hipDeviceAttributeMultiprocessorCount, dev);
        (void)hipFuncSetAttribute((const void*)k_mega, hipFuncAttributeMaxDynamicSharedMemorySize, MEGA_LDS);
        (void)hipOccupancyMaxActiveBlocksPerMultiprocessor(&per_cu, k_mega, 256, MEGA_LDS);
        if (per_cu > 2) per_cu = 2;
        if (per_cu < 1) per_cu = 1;
        grid_blocks = cus * per_cu;
    }
    (void)hipMemsetAsync((char*)d_ws + OFF_BAR, 0, 256, stream);
    void* args[] = {&p};
    hipError_t e = hipLaunchCooperativeKernel((const void*)k_mega, dim3(grid_blocks), dim3(256), args, MEGA_LDS, stream);
    if (e != hipSuccess) fprintf(stderr, "cooperative launch failed: %s (grid %d)\n", hipGetErrorString(e), grid_blocks);
}
```

```cpp
#include <hip/hip_runtime.h>
#include <hip/hip_cooperative_groups.h>
#include <stdint.h>
#include <stdio.h>

typedef unsigned short bf16_t;
typedef short bf16x8 __attribute__((ext_vector_type(8)));
typedef float f32x4 __attribute__((ext_vector_type(4)));

constexpr int D = 1024, NB = 8, SEQ = 4096, LC = 256;
constexpr int TL = NB * SEQ;
constexpr int TC = NB * LC;
constexpr int TA = TL + TC;
constexpr int AB_IN = 3328, HGW = 2560, SWW = 768, GA_IN = 1536, PQ = 2048;
constexpr int NEXP = 16384;
constexpr float EPS = 1e-6f;
constexpr float LOG2E = 1.4426950408889634f;
constexpr int NKEY = LC + SEQ;

constexpr size_t OFF_WABIN = 0;
constexpr size_t OFF_WABOUT = OFF_WABIN + (size_t)AB_IN * D * 2;
constexpr size_t OFF_WGAIN = OFF_WABOUT + (size_t)D * D * 2;
constexpr size_t OFF_WGAOUT = OFF_WGAIN + (size_t)GA_IN * D * 2;
constexpr size_t OFF_WPQ = OFF_WGAOUT + (size_t)D * D * 2;
constexpr size_t OFF_SK = OFF_WPQ + (size_t)2 * PQ * D * 2;
constexpr size_t OFF_MOD = OFF_SK + (size_t)2 * 8 * 2 * 128 * 128 * 2;
constexpr size_t OFF_COSS = OFF_MOD + (size_t)2 * 9 * 6144 * 4;
constexpr size_t OFF_SINS = OFF_COSS + (size_t)SEQ * 32 * 4;
constexpr size_t OFF_COSG = OFF_SINS + (size_t)SEQ * 32 * 4;
constexpr size_t OFF_SING = OFF_COSG + (size_t)SEQ * 64 * 4;
constexpr size_t OFF_LB = OFF_SING + (size_t)SEQ * 64 * 4;
constexpr size_t OFF_U16 = OFF_LB + 2048;
constexpr size_t OFF_V16 = OFF_U16 + (size_t)NEXP * D * 2;
constexpr size_t OFF_HCTX = OFF_V16 + (size_t)NEXP * D * 2;
constexpr size_t OFF_A = OFF_HCTX + (size_t)TC * D * 4;
constexpr size_t OFF_PROJ = OFF_A + (size_t)TA * D * 2;
constexpr size_t OFF_MIX = OFF_PROJ + (size_t)TA * AB_IN * 2;
constexpr size_t OFF_SEL = OFF_MIX + (size_t)TA * D * 2;
constexpr size_t OFF_BAR = OFF_SEL + (size_t)TA * 128 * 8;
constexpr size_t BAR_BYTES = 16384;
constexpr size_t WS_NEED = OFF_BAR + BAR_BYTES;
static_assert(WS_NEED <= (size_t)536870912, "workspace over 512 MiB");
constexpr size_t OFF_OF = OFF_A;
constexpr size_t OFF_OB = OFF_A + (size_t)TA * 512 * 2;
constexpr size_t OFF_PROJH = OFF_PROJ;
constexpr size_t OFF_PROJS = OFF_PROJ + (size_t)TA * HGW * 2;
constexpr size_t OFF_QPEER = OFF_PROJ;
constexpr size_t OFF_TSC = OFF_QPEER + (size_t)TA * PQ * 2;
constexpr size_t OFF_TIX = OFF_TSC + (size_t)TA * 256 * 4;
static_assert(OFF_TIX + (size_t)TA * 256 * 4 <= OFF_MIX, "peer scratch overflows proj region");
constexpr size_t OFF_VT = OFF_SEL;
static_assert((size_t)NB * 2 * 128 * NKEY * 2 <= (size_t)TA * 128 * 8, "Vt overflows SEL region");
constexpr size_t OFF_SELE = OFF_SEL;
constexpr size_t OFF_SELG = OFF_SEL + (size_t)TA * 128 * 4;

__device__ __forceinline__ float bf2f(bf16_t v) { return __uint_as_float(((unsigned)v) << 16); }
__device__ __forceinline__ bf16_t f2bf(float f) {
    unsigned u = __float_as_uint(f);
    u += 0x7fffu + ((u >> 16) & 1u);
    return (bf16_t)(u >> 16);
}
typedef float f32x2 __attribute__((ext_vector_type(2)));
typedef float f32x16 __attribute__((ext_vector_type(16)));
typedef __bf16 bf16x2_t __attribute__((ext_vector_type(2)));
__device__ __forceinline__ unsigned pack2(float lo, float hi) { f32x2 v = {lo, hi}; return __builtin_bit_cast(unsigned, __builtin_convertvector(v, bf16x2_t)); }
__device__ __forceinline__ float sigmoidf_(float x) { return 1.0f / (1.0f + __expf(-x)); }
__device__ __forceinline__ float siluf_(float x) { return x * sigmoidf_(x); }
__device__ __forceinline__ float wave_sum(float v) {
#pragma unroll
    for (int o = 32; o >= 1; o >>= 1) v += __shfl_xor(v, o);
    return v;
}
__device__ __forceinline__ int mod_row(int row) { return row < TL ? (row >> 12) : 8; }

__device__ void ph_transpose(int bid, int nb, const float* __restrict__ in, bf16_t* __restrict__ out, int K, int N, float* lds) {
    const int tk = K / 32, tn = N / 32, nt = tk * tn;
    const int tx = threadIdx.x & 31, ty = threadIdx.x >> 5;
    for (int t = bid; t < nt; t += nb) {
        const int k0 = (t / tn) * 32, n0 = (t % tn) * 32;
        __syncthreads();
#pragma unroll
        for (int i = 0; i < 4; ++i) lds[(ty + i * 8) * 33 + tx] = in[(size_t)(k0 + ty + i * 8) * N + n0 + tx];
        __syncthreads();
#pragma unroll
        for (int i = 0; i < 4; ++i) out[(size_t)(n0 + ty + i * 8) * K + k0 + tx] = f2bf(lds[tx * 33 + ty + i * 8]);
    }
}
__device__ void ph_cvt(int bid, int nb, const float* __restrict__ in, bf16_t* __restrict__ out, size_t n) {
    const size_t n8 = n / 8;
    for (size_t i = (size_t)bid * blockDim.x + threadIdx.x; i < n8; i += (size_t)nb * blockDim.x) {
        const float4 a = ((const float4*)in)[i * 2], b = ((const float4*)in)[i * 2 + 1];
        uint4 w; w.x = pack2(a.x, a.y); w.y = pack2(a.z, a.w); w.z = pack2(b.x, b.y); w.w = pack2(b.z, b.w);
        ((uint4*)out)[i] = w;
    }
}
__device__ void ph_cvt8(int bid, int nb, const float* __restrict__ in, unsigned char* __restrict__ out, size_t n, float scale) {
    const size_t n16 = n / 16;
    for (size_t i = (size_t)bid * blockDim.x + threadIdx.x; i < n16; i += (size_t)nb * blockDim.x) {
        const float4 a = ((const float4*)in)[i * 4], b = ((const float4*)in)[i * 4 + 1], c = ((const float4*)in)[i * 4 + 2], d = ((const float4*)in)[i * 4 + 3];
        int w0 = __builtin_amdgcn_cvt_pk_fp8_f32(a.x * scale, a.y * scale, 0, false); w0 = __builtin_amdgcn_cvt_pk_fp8_f32(a.z * scale, a.w * scale, w0, true);
        int w1 = __builtin_amdgcn_cvt_pk_fp8_f32(b.x * scale, b.y * scale, 0, false); w1 = __builtin_amdgcn_cvt_pk_fp8_f32(b.z * scale, b.w * scale, w1, true);
        int w2 = __builtin_amdgcn_cvt_pk_fp8_f32(c.x * scale, c.y * scale, 0, false); w2 = __builtin_amdgcn_cvt_pk_fp8_f32(c.z * scale, c.w * scale, w2, true);
        int w3 = __builtin_amdgcn_cvt_pk_fp8_f32(d.x * scale, d.y * scale, 0, false); w3 = __builtin_amdgcn_cvt_pk_fp8_f32(d.z * scale, d.w * scale, w3, true);
        ((int4*)out)[i] = make_int4(w0, w1, w2, w3);
    }
}
__device__ void ph_mod(int bid, int nb, const float* __restrict__ c, const float* __restrict__ c_ctx, const float* __restrict__ ada_w,
                       const float* __restrict__ ada_b, float* __restrict__ mod, float* lds) {
    float* s = lds;
    float* red = lds + 9 * 1024;
    const int tx = threadIdx.x & 63, ky = threadIdx.x >> 6;
    for (int i = threadIdx.x; i < 9 * 1024; i += 256) {
        const int r = i >> 10, k = i & 1023;
        const float v = r < 8 ? c[r * 1024 + k] : c_ctx[k];
        s[i] = siluf_(v);
    }
    __syncthreads();
    const int nitems = 2 * 96;
    for (int it = bid; it < nitems; it += nb) {
        const int layer = it / 96, n = (it % 96) * 64 + tx;
        const float* w = ada_w + (size_t)layer * 1024 * 6144 + n;
        float acc[9];
#pragma unroll
        for (int r = 0; r < 9; ++r) acc[r] = 0.f;
        for (int k = ky * 256; k < ky * 256 + 256; ++k) {
            const float wv = w[(size_t)k * 6144];
#pragma unroll
            for (int r = 0; r < 9; ++r) acc[r] += s[r * 1024 + k] * wv;
        }
        __syncthreads();
#pragma unroll
        for (int r = 0; r < 9; ++r) red[(ky * 9 + r) * 64 + tx] = acc[r];
        __syncthreads();
        if (ky == 0) {
#pragma unroll
            for (int r = 0; r < 9; ++r) {
                const float v = red[(0 * 9 + r) * 64 + tx] + red[(1 * 9 + r) * 64 + tx] + red[(2 * 9 + r) * 64 + tx] + red[(3 * 9 + r) * 64 + tx];
                mod[((size_t)layer * 9 + r) * 6144 + n] = v + ada_b[layer * 6144 + n];
            }
        }
    }
}
__device__ void ph_tables(int bid, int nb, float* cosS, float* sinS, float* cosG, float* sinG, const float* __restrict__ lb_logits, float* lb) {
    const int gt = bid * blockDim.x + threadIdx.x, gs = nb * blockDim.x;
    for (int i = gt; i < SEQ * 32; i += gs) {
        const int t = i >> 5, j = i & 31;
        const float pos = (float)(j < 16 ? (t >> 6) : (t & 63));
        const float inv = powf(10000.0f, -(float)(j & 15) / 16.0f);
        const float ang = pos * inv;
        cosS[i] = cosf(ang); sinS[i] = sinf(ang);
    }
    for (int i = gt; i < SEQ * 64; i += gs) {
        const int t = i >> 6, j = i & 63;
        const float pos = (float)(j < 32 ? (t >> 6) : (t & 63));
        const float inv = powf(10000.0f, -(float)(j & 31) / 32.0f);
        const float ang = pos * inv;
        cosG[i] = cosf(ang); sinG[i] = sinf(ang);
    }
    for (int i = gt; i < 512; i += gs) {
        const float l0 = lb_logits[i], l1 = lb_logits[512 + i];
        lb[i] = 1.0f / (1.0f + expf(l1 - l0));
    }
}

__device__ void ph_normmod(int bid, int nb, const float* __restrict__ hlat, const float* __restrict__ hctx, const float* __restrict__ gamma,
                           const float* __restrict__ modl  , int sc_off, int sh_off, bf16_t* __restrict__ out, int nrows) {
    const int lane = threadIdx.x & 63, wid = threadIdx.x >> 6;
    for (int row = bid * 4 + wid; row < nrows; row += nb * 4) {
        const float* src = row < TL ? hlat + (size_t)row * D : hctx + (size_t)(row - TL) * D;
        const float* m = modl + (size_t)mod_row(row) * 6144;
        float4 x[4]; float ss = 0.f;
#pragma unroll
        for (int i = 0; i < 4; ++i) { x[i] = ((const float4*)src)[i * 64 + lane]; ss += x[i].x * x[i].x + x[i].y * x[i].y + x[i].z * x[i].z + x[i].w * x[i].w; }
        ss = wave_sum(ss);
        const float rinv = rsqrtf(ss * (1.0f / D) + EPS);
#pragma unroll
        for (int i = 0; i < 4; ++i) {
            const int col = (i * 64 + lane) * 4;
            const float4 g = *(const float4*)(gamma + col), sc = *(const float4*)(m + sc_off + col), sh = *(const float4*)(m + sh_off + col);
            const float y0 = x[i].x * rinv * g.x * (1.f + sc.x) + sh.x, y1 = x[i].y * rinv * g.y * (1.f + sc.y) + sh.y;
            const float y2 = x[i].z * rinv * g.z * (1.f + sc.z) + sh.z, y3 = x[i].w * rinv * g.w * (1.f + sc.w) + sh.w;
            uint2 w; w.x = pack2(y0, y1); w.y = pack2(y2, y3);
            *(uint2*)(out + (size_t)row * D + col) = w;
        }
    }
}

constexpr int GEMM_LDS = 65536;
template <class Epi>
__device__ __forceinline__ void gemm_tile(const bf16_t* __restrict__ A, int lda, const bf16_t* __restrict__ Bt, int ldb, int K,
                                          int m0, int n0, char* lds, Epi& epi) {
    const int tid = threadIdx.x, lane = tid & 63, wid = tid >> 6, wr = wid >> 1, wc = wid & 1, fr = lane & 15, fq = lane >> 4;
    f32x4 acc[4][4];
#pragma unroll
    for (int i = 0; i < 4; ++i)
#pragma unroll
        for (int j = 0; j < 4; ++j) acc[i][j] = (f32x4){0.f, 0.f, 0.f, 0.f};
    const int nk = K / 64;
    typedef __attribute__((address_space(3))) char las_char;
    las_char* l3 = (las_char*)lds;
    const int drow = 32 * wid + (lane >> 3), dch = (lane & 7) ^ ((lane >> 3) & 7);
    const bf16_t* ga = A + (size_t)(m0 + drow) * lda + dch * 8;
    const bf16_t* gb = Bt + (size_t)(n0 + drow) * ldb + dch * 8;
    const int dlds = 32 * wid * 128;
#define GT_STAGE(kt, buf) do { _Pragma("unroll") for (int i = 0; i < 4; ++i) { \
        __builtin_amdgcn_global_load_lds((const unsigned*)(ga + (size_t)(8 * i) * lda + (kt) * 64), (__attribute__((address_space(3))) unsigned*)(l3 + (buf) * 32768 + dlds + i * 1024), 16, 0, 0); \
        __builtin_amdgcn_global_load_lds((const unsigned*)(gb + (size_t)(8 * i) * ldb + (kt) * 64), (__attribute__((address_space(3))) unsigned*)(l3 + (buf) * 32768 + 16384 + dlds + i * 1024), 16, 0, 0); } } while (0)
#define GT_COMPUTE(buf) do { const char* base = lds + (buf) * 32768; \
        _Pragma("unroll") for (int kk = 0; kk < 2; ++kk) { \
            bf16x8 af[4], bfr[4]; \
            _Pragma("unroll") for (int i = 0; i < 4; ++i) { \
                const int ar = wr * 64 + i * 16 + fr, br = wc * 64 + i * 16 + fr; const int c = kk * 4 + fq; \
                af[i] = *(const bf16x8*)(base + ar * 128 + ((c ^ (ar & 7)) << 4)); \
                bfr[i] = *(const bf16x8*)(base + 16384 + br * 128 + ((c ^ (br & 7)) << 4)); } \
            _Pragma("unroll") for (int i = 0; i < 4; ++i) \
                _Pragma("unroll") for (int j = 0; j < 4; ++j) acc[i][j] = __builtin_amdgcn_mfma_f32_16x16x32_bf16(bfr[j], af[i], acc[i][j], 0, 0, 0); } } while (0)
    __syncthreads();
    GT_STAGE(0, 0);
    __syncthreads();
    for (int kt = 0; kt < nk; ++kt) {
        if (kt + 1 < nk) GT_STAGE(kt + 1, (kt + 1) & 1);
        GT_COMPUTE(kt & 1);
        __syncthreads();
    }
#undef GT_STAGE
#undef GT_COMPUTE
    epi(acc, m0 + wr * 64 + fr, n0 + wc * 64 + fq * 4, lds);
}

struct EpiStoreSplit {
    bf16_t* O1; int ld1; bf16_t* O2; int ld2; int split;
    __device__ __forceinline__ void operator()(f32x4 (&acc)[4][4], int row0, int col0, char*) const {
#pragma unroll
        for (int i = 0; i < 4; ++i)
#pragma unroll
            for (int j = 0; j < 4; ++j) {
                const int row = row0 + i * 16, col = col0 + j * 16;
                uint2 w; w.x = pack2(acc[i][j][0], acc[i][j][1]); w.y = pack2(acc[i][j][2], acc[i][j][3]);
                if (col < split) *(uint2*)(O1 + (size_t)row * ld1 + col) = w;
                else *(uint2*)(O2 + (size_t)row * ld2 + (col - split)) = w;
            }
    }
};
struct EpiResid {
    const float* hin_lat; const float* hin_ctx; float* hout_lat; float* hout_ctx; const float* gate  ;
    __device__ __forceinline__ void operator()(f32x4 (&acc)[4][4], int row0, int col0, char*) const {
#pragma unroll
        for (int i = 0; i < 4; ++i) {
            const int row = row0 + i * 16;
            const float* hi = row < TL ? hin_lat + (size_t)row * D : hin_ctx + (size_t)(row - TL) * D;
            float* ho = row < TL ? hout_lat + (size_t)row * D : hout_ctx + (size_t)(row - TL) * D;
            const float* g = gate + (size_t)mod_row(row) * 6144;
#pragma unroll
            for (int j = 0; j < 4; ++j) {
                const int col = col0 + j * 16;
                const float4 h = *(const float4*)(hi + col), gg = *(const float4*)(g + col);
                float4 o; o.x = h.x + gg.x * acc[i][j][0]; o.y = h.y + gg.y * acc[i][j][1]; o.z = h.z + gg.z * acc[i][j][2]; o.w = h.w + gg.w * acc[i][j][3];
                *(float4*)(ho + col) = o;
            }
        }
    }
};
template <class Epi>
__device__ void ph_gemm(int bid, int nb, const bf16_t* A, int lda, const bf16_t* Bt, int ldb, int M, int N, int K, char* lds, Epi epi) {
    const int nM = M / 128, nN = N / 128, nwg = nM * nN;
    const bool sw = (nb & 7) == 0;
    for (int L = bid; L < nwg; L += nb) {
        int wg = L;
        if (sw) { const int q = nwg >> 3, r = nwg & 7, xcd = L & 7, off = L >> 3; wg = (xcd < r ? xcd * (q + 1) : r * (q + 1) + (xcd - r) * q) + off; }
        const int nig = 8 * nN, gid = wg / nig, fm = gid * 8, gsz = (nM - fm) < 8 ? (nM - fm) : 8;
        const int pm = fm + (wg % nig) % gsz, pn = (wg % nig) / gsz;
        gemm_tile(A, lda, Bt, ldb, K, pm * 128, pn * 128, lds, epi);
    }
}

typedef short bf16x4 __attribute__((ext_vector_type(4)));
constexpr int HQ_OFF = 0, HK_OFF = 16384, HKT_OFF = 32768, HVT_OFF = 49152, HD_OFF = 57344, HG_LDS = 59392;
__device__ __forceinline__ int hg_row(int b, int dir, int p) {
    if (p < LC) { const int s = dir ? (LC - 1 - p) : p; return TL + b * LC + s; }
    const int t = dir ? (SEQ - 1 - (p - LC)) : (p - LC);
    return b * SEQ + t;
}
__device__ void ph_hgrn(int bid, int nb, const bf16_t* __restrict__ projH, const float* __restrict__ lb, bf16_t* __restrict__ of, bf16_t* __restrict__ ob, char* lds) {
    const int tid = threadIdx.x, lane = tid & 63, w = tid >> 6, fr = lane & 15, fq = lane >> 4;
    for (int it = bid; it < NB * 4 * 2 * 2; it += nb) {
        const int vs = it & 1, dir = (it >> 1) & 1, h = (it >> 2) & 3, b = it >> 4;
        bf16_t* out = dir ? ob : of;
        const float lb0 = lb[h * 128 + 2 * lane], lb1 = lb[h * 128 + 2 * lane + 1];
        const int fcol = (dir ? 1024 : 512) + h * 128 + 2 * lane, qcol = h * 128 + 2 * lane, vcol = 1536 + h * 128 + vs * 64 + lane;
        f32x4 S[8];
#pragma unroll
        for (int kt = 0; kt < 8; ++kt) S[kt] = (f32x4){0.f, 0.f, 0.f, 0.f};
        unsigned xf[16], xq[16]; bf16_t xv[16];
#define HG_PREFETCH(p0) do { _Pragma("unroll") for (int i = 0; i < 16; ++i) { \
            const size_t rb = (size_t)hg_row(b, dir, (p0) + 16 * w + i) * HGW; \
            xf[i] = *(const unsigned*)(projH + rb + fcol); xq[i] = *(const unsigned*)(projH + rb + qcol); xv[i] = projH[rb + vcol]; } } while (0)
        HG_PREFETCH(0);
        for (int p0 = 0; p0 < NKEY; p0 += 64) {
            __syncthreads();
            {
                float c0 = 0.f, c1 = 0.f, kp0 = 0.f, kp1 = 0.f;
                unsigned kt0[8], kt1[8], vt[8];
#pragma unroll
                for (int i = 0; i < 16; ++i) {
                    const float xf0 = __uint_as_float(xf[i] << 16), xf1 = __uint_as_float(xf[i] & 0xffff0000u);
                    const float xq0 = __uint_as_float(xq[i] << 16), xq1 = __uint_as_float(xq[i] & 0xffff0000u);
                    const float f0 = lb0 + (1.f - lb0) * __builtin_amdgcn_rcpf(1.f + __expf(-xf0));
                    const float f1 = lb1 + (1.f - lb1) * __builtin_amdgcn_rcpf(1.f + __expf(-xf1));
                    c0 += __logf(f0); c1 += __logf(f1);
                    const float q0 = xq0 * __builtin_amdgcn_rcpf(1.f + __expf(-xq0)) * __expf(c0);
                    const float q1 = xq1 * __builtin_amdgcn_rcpf(1.f + __expf(-xq1)) * __expf(c1);
                    const float k0 = (1.f - f0) * __expf(fminf(-c0, 80.f)), k1 = (1.f - f1) * __expf(fminf(-c1, 80.f));
                    const int t = 16 * w + i;
                    const int o = t * 256 + (((lane >> 2) ^ (t & 15)) << 4) + (lane & 3) * 4;
                    *(unsigned*)(lds + HQ_OFF + o) = pack2(q0, q1);
                    *(unsigned*)(lds + HK_OFF + o) = pack2(k0, k1);
                    if (i & 1) { kt0[i >> 1] = pack2(kp0, k0); kt1[i >> 1] = pack2(kp1, k1); vt[i >> 1] = (unsigned)xv[i - 1] | ((unsigned)xv[i] << 16); }
                    else { kp0 = k0; kp1 = k1; }
                }
                float2 dd; dd.x = __expf(c0); dd.y = __expf(c1);
                *(float2*)(lds + HD_OFF + (w * 128 + 2 * lane) * 4) = dd;
                char* kp = lds + HKT_OFF + w * 4096 + (2 * lane) * 32;
                *(uint4*)(kp) = make_uint4(kt0[0], kt0[1], kt0[2], kt0[3]); *(uint4*)(kp + 16) = make_uint4(kt0[4], kt0[5], kt0[6], kt0[7]);
                *(uint4*)(kp + 32) = make_uint4(kt1[0], kt1[1], kt1[2], kt1[3]); *(uint4*)(kp + 48) = make_uint4(kt1[4], kt1[5], kt1[6], kt1[7]);
                char* vp = lds + HVT_OFF + w * 2048 + lane * 32;
                *(uint4*)(vp) = make_uint4(vt[0], vt[1], vt[2], vt[3]); *(uint4*)(vp + 16) = make_uint4(vt[4], vt[5], vt[6], vt[7]);
            }
            if (p0 + 64 < NKEY) HG_PREFETCH(p0 + 64);
            __syncthreads();
#pragma unroll
            for (int I = 0; I < 4; ++I) {
                const int trow = 16 * I + fr;
                f32x4 at = (f32x4){0.f, 0.f, 0.f, 0.f};
#pragma unroll
                for (int ks = 0; ks < 4; ++ks) {
                    const int o = trow * 256 + (((ks * 4 + fq) ^ fr) << 4);
                    const bf16x8 ka = *(const bf16x8*)(lds + HK_OFF + o);
                    const bf16x8 qa = *(const bf16x8*)(lds + HQ_OFF + o);
                    at = __builtin_amdgcn_mfma_f32_16x16x32_bf16(ka, qa, at, 0, 0, 0);
                }
#pragma unroll
                for (int j = 0; j < 4; ++j) if (4 * fq + j > fr) at[j] = 0.f;
                uint2 pa2; pa2.x = pack2(at[0], at[1]); pa2.y = pack2(at[2], at[3]);
                const bf16x4 pA = __builtin_bit_cast(bf16x4, pa2);
                const bf16x4 vfrag = *(const bf16x4*)(lds + HVT_OFF + I * 2048 + (w * 16 + fr) * 32 + fq * 8);
                f32x4 o1 = __builtin_amdgcn_mfma_f32_16x16x16bf16_1k(vfrag, pA, (f32x4){0.f, 0.f, 0.f, 0.f}, 0, 0, 0);
                f32x4 o2 = (f32x4){0.f, 0.f, 0.f, 0.f};
#pragma unroll
                for (int kt = 0; kt < 8; ++kt) {
                    uint2 s2; s2.x = pack2(S[kt][0], S[kt][1]); s2.y = pack2(S[kt][2], S[kt][3]);
                    const bf16x4 sfrag = __builtin_bit_cast(bf16x4, s2);
                    const bf16x4 qfrag = *(const bf16x4*)(lds + HQ_OFF + trow * 256 + (((kt * 2 + (fq >> 1)) ^ fr) << 4) + (fq & 1) * 8);
                    if (kt & 1) o2 = __builtin_amdgcn_mfma_f32_16x16x16bf16_1k(sfrag, qfrag, o2, 0, 0, 0);
                    else o1 = __builtin_amdgcn_mfma_f32_16x16x16bf16_1k(sfrag, qfrag, o1, 0, 0, 0);
                }
#pragma unroll
                for (int kt = 0; kt < 8; ++kt) {
                    const bf16x4 kfrag = *(const bf16x4*)(lds + HKT_OFF + I * 4096 + (kt * 16 + fr) * 32 + fq * 8);
                    const f32x4 d4 = *(const f32x4*)(lds + HD_OFF + (I * 128 + kt * 16 + fq * 4) * 4);
                    S[kt] = __builtin_amdgcn_mfma_f32_16x16x16bf16_1k(kfrag, vfrag, S[kt], 0, 0, 0);
                    S[kt] = S[kt] * d4;
                }
                const size_t orow = (size_t)hg_row(b, dir, p0 + trow);
                uint2 ov; ov.x = pack2(o1[0] + o2[0], o1[1] + o2[1]); ov.y = pack2(o1[2] + o2[2], o1[3] + o2[3]);
                *(uint2*)(out + orow * 512 + h * 128 + vs * 64 + w * 16 + fq * 4) = ov;
            }
        }
#undef HG_PREFETCH
    }
}
__device__ void ph_hgpost(int bid, int nb, const bf16_t* __restrict__ of, const bf16_t* __restrict__ ob, const bf16_t* __restrict__ projH,
                          const float* __restrict__ g, bf16_t* __restrict__ mix) {
    const int lane = threadIdx.x & 63, wid = threadIdx.x >> 6;
    for (int it = bid * 4 + wid; it < TA * 4; it += nb * 4) {
        const int row = it >> 2, h = it & 3;
        const size_t o = (size_t)row * 512 + h * 128 + lane * 2;
        const unsigned a = *(const unsigned*)(of + o), bb = *(const unsigned*)(ob + o);
        const float x0 = bf2f((bf16_t)(a & 0xffff)) + bf2f((bf16_t)(bb & 0xffff)), x1 = bf2f((bf16_t)(a >> 16)) + bf2f((bf16_t)(bb >> 16));
        const float ss = wave_sum(x0 * x0 + x1 * x1);
        const float rinv = rsqrtf(ss * (1.0f / 128.0f) + EPS);
        const unsigned gg = *(const unsigned*)(projH + (size_t)row * HGW + 2048 + h * 128 + lane * 2);
        const float y0 = x0 * rinv * g[lane * 2] * siluf_(bf2f((bf16_t)(gg & 0xffff)));
        const float y1 = x1 * rinv * g[lane * 2 + 1] * siluf_(bf2f((bf16_t)(gg >> 16)));
        *(unsigned*)(mix + (size_t)row * D + h * 128 + lane * 2) = pack2(y0, y1);
    }
}

__device__ void ph_prep_swa(int bid, int nb, bf16_t* __restrict__ P, const float* __restrict__ cosS, const float* __restrict__ sinS) {
    const size_t n = (size_t)TA * 320;
    for (size_t idx = (size_t)bid * blockDim.x + threadIdx.x; idx < n; idx += (size_t)nb * blockDim.x) {
        const int row = (int)(idx / 320), pr = (int)(idx % 320), head = pr >> 5, d = pr & 31;
        bf16_t* p = P + (size_t)row * SWW + head * 64 + d;
        float x1 = bf2f(p[0]), x2 = bf2f(p[32]);
        if (row < TL) {
            const int t = row & (SEQ - 1);
            const float c = cosS[t * 32 + d], s = sinS[t * 32 + d];
            const float y1 = x1 * c - x2 * s, y2 = x1 * s + x2 * c;
            x1 = y1; x2 = y2;
        }
        if (head < 8) { x1 *= 0.125f * LOG2E; x2 *= 0.125f * LOG2E; }
        p[0] = f2bf(x1); p[32] = f2bf(x2);
    }
}
__device__ void ph_prep_ga(int bid, int nb, bf16_t* __restrict__ P, const float* __restrict__ qg, const float* __restrict__ kg,
                           const float* __restrict__ cosG, const float* __restrict__ sinG) {
    const int lane = threadIdx.x & 63, wid = threadIdx.x >> 6;
    for (int it = bid * 4 + wid; it < TA * 10; it += nb * 4) {
        const int row = it / 10, head = it % 10;
        bf16_t* p = P + (size_t)row * GA_IN + head * 128;
        float x1 = bf2f(p[lane]), x2 = bf2f(p[lane + 64]);
        const float ss = wave_sum(x1 * x1 + x2 * x2);
        const float rinv = rsqrtf(ss * (1.0f / 128.0f) + EPS);
        const float* g = head < 8 ? qg : kg;
        x1 = x1 * rinv * g[lane]; x2 = x2 * rinv * g[lane + 64];
        if (row < TL) {
            const int t = row & (SEQ - 1);
            const float c = cosG[t * 64 + lane], s = sinG[t * 64 + lane];
            const float y1 = x1 * c - x2 * s, y2 = x1 * s + x2 * c;
            x1 = y1; x2 = y2;
        }
        if (head < 8) { x1 *= 0.08838834764831845f * LOG2E; x2 *= 0.08838834764831845f * LOG2E; }
        p[lane] = f2bf(x1); p[lane + 64] = f2bf(x2);
    }
}

template <int HD>
__device__ void ph_vt(int bid, int nb, const bf16_t* __restrict__ P, int ldp, int vcol, bf16_t* __restrict__ Vt, bf16_t* lds) {
    constexpr int ND = HD / 64;
    const int tid = threadIdx.x;
    for (int it = bid; it < NB * 2 * ND * (NKEY / 64); it += nb) {
        const int kt = it % (NKEY / 64), r1 = it / (NKEY / 64), dh = r1 % ND, g = r1 / ND, b = g >> 1, kvh = g & 1;
        const int k0 = kt * 64;
        const int row0 = k0 < LC ? TL + b * LC + k0 : b * SEQ + (k0 - LC);
        __syncthreads();
#pragma unroll
        for (int i = 0; i < 2; ++i) {
            const int id = tid + i * 256, kr = id >> 3, c = id & 7;
            const uint4 w = *(const uint4*)(P + (size_t)(row0 + kr) * ldp + vcol + kvh * HD + dh * 64 + c * 8);
            const unsigned ww[4] = {w.x, w.y, w.z, w.w};
#pragma unroll
            for (int j = 0; j < 4; ++j) { lds[kr * 66 + c * 8 + j * 2] = (bf16_t)(ww[j] & 0xffff); lds[kr * 66 + c * 8 + j * 2 + 1] = (bf16_t)(ww[j] >> 16); }
        }
        __syncthreads();
#pragma unroll
        for (int i = 0; i < 2; ++i) {
            const int id = tid + i * 256, d = id >> 3, c = id & 7;
            unsigned o[4];
#pragma unroll
            for (int j = 0; j < 4; ++j) o[j] = (unsigned)lds[(c * 8 + j * 2) * 66 + d] | ((unsigned)lds[(c * 8 + j * 2 + 1) * 66 + d] << 16);
            uint4 w; w.x = o[0]; w.y = o[1]; w.z = o[2]; w.w = o[3];
            *(uint4*)(Vt + (size_t)(g * HD + dh * 64 + d) * NKEY + k0 + c * 8) = w;
        }
    }
}

template <int HD, bool MASK>
__device__ __forceinline__ void flash_item(const bf16_t* __restrict__ Qrow0, int ldq, const bf16_t* __restrict__ Kp, int ldk,
                                           const bf16_t* __restrict__ Vt, int krow_ctx0, int krow_lat0, int nctx_t, int lat_lo, int nlat_t,
                                           int tq0, float m0, float l0, bf16_t* __restrict__ Orow0, int ldo, char* lds) {
    constexpr int NCH = HD / 32;
    constexpr int KB = 64 * HD * 2;
    constexpr int NKK = HD / 16;
    constexpr int NDT = HD / 32;
    const int tid = threadIdx.x, lane = tid & 63, w = tid >> 6, r = lane & 31, h = lane >> 5;
    const int pr = (r & 0x13) | ((r & 4) << 1) | ((r & 8) >> 1);
    bf16x8 qf[NKK];
    {
        const bf16_t* qp = Qrow0 + (size_t)(32 * w + r) * ldq + 8 * h;
#pragma unroll
        for (int kk = 0; kk < NKK; ++kk) qf[kk] = *(const bf16x8*)(qp + 16 * kk);
    }
    f32x16 O[NDT];
#pragma unroll
    for (int dt = 0; dt < NDT; ++dt)
#pragma unroll
        for (int i = 0; i < 16; ++i) O[dt][i] = 0.f;
    float m_run = m0, l_run = (h == 0) ? l0 : 0.f;
    const int kc = (HD == 128) ? (tid & 15) : (tid & 7);
    const int kr = (HD == 128) ? (tid >> 4) : (tid >> 3);
    const int ksw = (HD == 128) ? (kr & 15) : ((kr >> 1) & 7);
    const int klds = kr * (HD * 2) + ((kc ^ ksw) << 4);
    constexpr int KRSTEP = (HD == 128) ? 16 : 32;
    const int vr = tid >> 3, vc = tid & 7;
    const int vlds = KB + vr * 128 + ((vc ^ ((vr >> 1) & 7)) << 4);
    const int kfo = pr * (HD * 2);
    const int kfs = (HD == 128) ? (pr & 15) : ((pr >> 1) & 7);
    const int vfo = KB + r * 128;
    const int vfs = (r >> 1) & 7;
    const int ntile = nctx_t + nlat_t;
    uint4 sg0, sg1, sg2, sg3;
    sg2 = sg3 = make_uint4(0u, 0u, 0u, 0u);
#define FA_TILE(t, krow0, kidx0, s0) const int krow0 = (t) < nctx_t ? krow_ctx0 + 64 * (t) : krow_lat0 + lat_lo + 64 * ((t) - nctx_t); \
        const int s0 = (t) < nctx_t ? -(1 << 24) : lat_lo + 64 * ((t) - nctx_t); const int kidx0 = (t) < nctx_t ? 64 * (t) : LC + lat_lo + 64 * ((t) - nctx_t);
#define FA_GLOADK(t) do { FA_TILE(t, _kr0, _ki0, _s0) (void)_s0; (void)_ki0; \
        const bf16_t* _kp = Kp + (size_t)(_kr0 + kr) * ldk + kc * 8; \
        sg0 = *(const uint4*)(_kp); sg1 = *(const uint4*)(_kp + (size_t)KRSTEP * ldk); \
        if (NCH == 4) { sg2 = *(const uint4*)(_kp + (size_t)2 * KRSTEP * ldk); sg3 = *(const uint4*)(_kp + (size_t)3 * KRSTEP * ldk); } } while (0)
#define FA_GLOADV(t) do { FA_TILE(t, _kr0, _ki0, _s0) (void)_s0; (void)_kr0; \
        const bf16_t* _vp = Vt + (size_t)vr * NKEY + _ki0 + vc * 8; \
        sg0 = *(const uint4*)(_vp); sg1 = *(const uint4*)(_vp + (size_t)32 * NKEY); \
        if (NCH == 4) { sg2 = *(const uint4*)(_vp + (size_t)64 * NKEY); sg3 = *(const uint4*)(_vp + (size_t)96 * NKEY); } } while (0)
#define FA_LSTORE(buf, off) do { char* _b = lds + (buf) * (2 * KB) + (off); \
        *(uint4*)(_b) = sg0; *(uint4*)(_b + 4096) = sg1; \
        if (NCH == 4) { *(uint4*)(_b + 8192) = sg2; *(uint4*)(_b + 12288) = sg3; } } while (0)
    __syncthreads();
    FA_GLOADK(0); FA_LSTORE(0, klds);
    FA_GLOADV(0); FA_LSTORE(0, vlds);
    __syncthreads();
    for (int t = 0; t < ntile; ++t) {
        if (t + 1 < ntile) FA_GLOADK(t + 1);
        const char* base = lds + (t & 1) * (2 * KB);
        f32x16 st[2];
#pragma unroll
        for (int rt = 0; rt < 2; ++rt) {
#pragma unroll
            for (int i = 0; i < 16; ++i) st[rt][i] = 0.f;
#pragma unroll
            for (int kk = 0; kk < NKK; ++kk) {
                const bf16x8 kf = *(const bf16x8*)(base + rt * 32 * (HD * 2) + kfo + (((2 * kk + h) ^ kfs) << 4));
                st[rt] = __builtin_amdgcn_mfma_f32_32x32x16_bf16(kf, qf[kk], st[rt], 0, 0, 0);
                if ((kk & 3) == 3) __builtin_amdgcn_sched_barrier(0);
            }
        }
        if (MASK) {
            FA_TILE(t, _kr0, _ki0, s0) (void)_kr0; (void)_ki0;
            if (t >= nctx_t) {
                const int tq = tq0 + 32 * w + r;
#pragma unroll
                for (int rt = 0; rt < 2; ++rt)
#pragma unroll
                    for (int i = 0; i < 16; ++i) {
                        const int s = s0 + 32 * rt + (i & 3) + 4 * ((i >> 2) & 1) + 8 * h + 16 * (i >> 3);
                        const int dlt = tq - s;
                        if (dlt > 128 || dlt < -128) st[rt][i] = -1.0e30f;
                    }
            }
        }
        float mx = m_run;
#pragma unroll
        for (int rt = 0; rt < 2; ++rt)
#pragma unroll
            for (int i = 0; i < 16; ++i) mx = fmaxf(mx, st[rt][i]);
        mx = fmaxf(mx, __shfl_xor(mx, 32));
        const float alpha = __builtin_amdgcn_exp2f(m_run - mx);
        m_run = mx;
        float ps = 0.f;
#pragma unroll
        for (int rt = 0; rt < 2; ++rt)
#pragma unroll
            for (int i = 0; i < 16; ++i) { const float p = __builtin_amdgcn_exp2f(st[rt][i] - mx); st[rt][i] = p; ps += p; }
        l_run = l_run * alpha + ps;
        if (!__all(alpha == 1.0f)) {
#pragma unroll
            for (int dt = 0; dt < NDT; ++dt)
#pragma unroll
                for (int i = 0; i < 16; ++i) O[dt][i] *= alpha;
        }
        if (t + 1 < ntile) { FA_LSTORE((t + 1) & 1, klds); FA_GLOADV(t + 1); }
        bf16x8 pf[2][2];
#pragma unroll
        for (int rt = 0; rt < 2; ++rt)
#pragma unroll
            for (int s2 = 0; s2 < 2; ++s2) {
                uint4 pk;
                pk.x = pack2(st[rt][8 * s2 + 0], st[rt][8 * s2 + 1]); pk.y = pack2(st[rt][8 * s2 + 2], st[rt][8 * s2 + 3]);
                pk.z = pack2(st[rt][8 * s2 + 4], st[rt][8 * s2 + 5]); pk.w = pack2(st[rt][8 * s2 + 6], st[rt][8 * s2 + 7]);
                pf[rt][s2] = __builtin_bit_cast(bf16x8, pk);
            }
#pragma unroll
        for (int dt = 0; dt < NDT; ++dt)
#pragma unroll
            for (int rt = 0; rt < 2; ++rt)
#pragma unroll
                for (int s2 = 0; s2 < 2; ++s2) {
                    const bf16x8 vf = *(const bf16x8*)(base + vfo + dt * 4096 + (((4 * rt + 2 * s2 + h) ^ vfs) << 4));
                    O[dt] = __builtin_amdgcn_mfma_f32_32x32x16_bf16(vf, pf[rt][s2], O[dt], 0, 0, 0);
                    if (rt == 1 && s2 == 1) __builtin_amdgcn_sched_barrier(0);
                }
        if (t + 1 < ntile) FA_LSTORE((t + 1) & 1, vlds);
        __syncthreads();
    }
#undef FA_TILE
#undef FA_GLOADK
#undef FA_GLOADV
#undef FA_LSTORE
    const float lt = l_run + __shfl_xor(l_run, 32);
    const float inv = 1.0f / lt;
    bf16_t* op = Orow0 + (size_t)(32 * w + r) * ldo + 4 * h;
#pragma unroll
    for (int dt = 0; dt < NDT; ++dt)
#pragma unroll
        for (int g = 0; g < 4; ++g) {
            uint2 o2; o2.x = pack2(O[dt][4 * g] * inv, O[dt][4 * g + 1] * inv); o2.y = pack2(O[dt][4 * g + 2] * inv, O[dt][4 * g + 3] * inv);
            *(uint2*)(op + 32 * dt + 8 * g) = o2;
        }
}
__device__ void ph_swa(int bid, int nb, const bf16_t* __restrict__ projS, const bf16_t* __restrict__ Vt, const float* __restrict__ sink,
                       bf16_t* __restrict__ mix, char* lds) {
    const int n_lat = NB * 8 * 32, n_ctx = NB * 8 * 2;
    for (int it = bid; it < n_lat + n_ctx; it += nb) {
        int b, hq, row0, lo, nlat, t0;
        if (it < n_lat) {
            const int qb = it & 31; hq = (it >> 5) & 7; b = it >> 8;
            t0 = qb * 128;
            lo = t0 - 128 < 0 ? 0 : t0 - 128;
            const int hi = t0 + 256 > SEQ ? SEQ : t0 + 256;
            nlat = (hi - lo) / 64; row0 = b * SEQ + t0;
        } else {
            const int i2 = it - n_lat, qb = i2 & 1; hq = (i2 >> 1) & 7; b = i2 >> 4;
            t0 = 0; lo = 0; nlat = 0; row0 = TL + b * LC + qb * 128;
        }
        const int kvh = hq >> 2;
        flash_item<64, true>(projS + (size_t)row0 * SWW + hq * 64, SWW, projS + 512 + kvh * 64, SWW, Vt + (size_t)(b * 2 + kvh) * 64 * NKEY,
                             TL + b * LC, b * SEQ, 4, lo, nlat, t0, sink[hq] * LOG2E, 1.0f, mix + (size_t)row0 * D + 512 + hq * 64, D, lds);
    }
}
__device__ void ph_dense(int bid, int nb, const bf16_t* __restrict__ projG, const bf16_t* __restrict__ Vt, bf16_t* __restrict__ mix, char* lds) {
    const bool sw = (nb & 7) == 0;
    const int nit = NB * 8 * 32;
    for (int j = sw ? (bid >> 3) : bid; j < (sw ? nit / 8 : nit); j += sw ? (nb >> 3) : nb) {
        int g, jj;
        if (sw) { g = (bid & 7) + 8 * (j >> 7); jj = j & 127; } else { g = j >> 7; jj = j & 127; }
        const int b = g >> 1, kvh = g & 1, hq = kvh * 4 + (jj >> 5), qb = jj & 31;
        const int row0 = b * SEQ + qb * 128;
        flash_item<128, false>(projG + (size_t)row0 * GA_IN + hq * 128, GA_IN, projG + 1024 + kvh * 128, GA_IN, Vt + (size_t)(b * 2 + kvh) * 128 * NKEY,
                               TL + b * LC, b * SEQ, 4, 0, SEQ / 64, 0, -1.0e30f, 0.0f, mix + (size_t)row0 * D + hq * 128, D, lds);
    }
}

#define CE(a, b) { const float _h = fmaxf(a, b); b = fminf(a, b); a = _h; }
__device__ __forceinline__ void net_sort16(float (&v)[16]) {
    CE(v[0], v[1]); CE(v[3], v[2]); CE(v[4], v[5]); CE(v[7], v[6]); CE(v[8], v[9]); CE(v[11], v[10]);
    CE(v[12], v[13]); CE(v[15], v[14]); CE(v[0], v[2]); CE(v[1], v[3]); CE(v[6], v[4]); CE(v[7], v[5]);
    CE(v[8], v[10]); CE(v[9], v[11]); CE(v[14], v[12]); CE(v[15], v[13]); CE(v[0], v[1]); CE(v[2], v[3]);
    CE(v[5], v[4]); CE(v[7], v[6]); CE(v[8], v[9]); CE(v[10], v[11]); CE(v[13], v[12]); CE(v[15], v[14]);
    CE(v[0], v[4]); CE(v[1], v[5]); CE(v[2], v[6]); CE(v[3], v[7]); CE(v[12], v[8]); CE(v[13], v[9]);
    CE(v[14], v[10]); CE(v[15], v[11]); CE(v[0], v[2]); CE(v[1], v[3]); CE(v[4], v[6]); CE(v[5], v[7]);
    CE(v[10], v[8]); CE(v[11], v[9]); CE(v[14], v[12]); CE(v[15], v[13]); CE(v[0], v[1]); CE(v[2], v[3]);
    CE(v[4], v[5]); CE(v[6], v[7]); CE(v[9], v[8]); CE(v[11], v[10]); CE(v[13], v[12]); CE(v[15], v[14]);
    CE(v[0], v[8]); CE(v[1], v[9]); CE(v[2], v[10]); CE(v[3], v[11]); CE(v[4], v[12]); CE(v[5], v[13]);
    CE(v[6], v[14]); CE(v[7], v[15]); CE(v[0], v[4]); CE(v[1], v[5]); CE(v[2], v[6]); CE(v[3], v[7]);
    CE(v[8], v[12]); CE(v[9], v[13]); CE(v[10], v[14]); CE(v[11], v[15]); CE(v[0], v[2]); CE(v[1], v[3]);
    CE(v[4], v[6]); CE(v[5], v[7]); CE(v[8], v[10]); CE(v[9], v[11]); CE(v[12], v[14]); CE(v[13], v[15]);
    CE(v[0], v[1]); CE(v[2], v[3]); CE(v[4], v[5]); CE(v[6], v[7]); CE(v[8], v[9]); CE(v[10], v[11]);
    CE(v[12], v[13]); CE(v[14], v[15]);
}
__device__ __forceinline__ void net_clean16(float (&v)[16]) {
    CE(v[0], v[8]); CE(v[1], v[9]); CE(v[2], v[10]); CE(v[3], v[11]); CE(v[4], v[12]); CE(v[5], v[13]);
    CE(v[6], v[14]); CE(v[7], v[15]); CE(v[0], v[4]); CE(v[1], v[5]); CE(v[2], v[6]); CE(v[3], v[7]);
    CE(v[8], v[12]); CE(v[9], v[13]); CE(v[10], v[14]); CE(v[11], v[15]); CE(v[0], v[2]); CE(v[1], v[3]);
    CE(v[4], v[6]); CE(v[5], v[7]); CE(v[8], v[10]); CE(v[9], v[11]); CE(v[12], v[14]); CE(v[13], v[15]);
    CE(v[0], v[1]); CE(v[2], v[3]); CE(v[4], v[5]); CE(v[6], v[7]); CE(v[8], v[9]); CE(v[10], v[11]);
    CE(v[12], v[13]); CE(v[14], v[15]);
}
__device__ __forceinline__ void net_merge16(float (&a)[16], const float (&b)[16]) {
#pragma unroll
    for (int i = 0; i < 16; ++i) a[i] = fmaxf(a[i], b[15 - i]);
    net_clean16(a);
}
#define PEER_CANDS(F) F(0,0,0) F(1,0,1) F(2,0,2) F(3,0,3) F(4,0,4) F(5,0,5) F(6,0,6) F(7,0,7) F(8,0,8) F(9,0,9) F(10,0,10) F(11,0,11) F(12,0,12) F(13,0,13) F(14,0,14) F(15,0,15) F(16,1,1) F(17,1,2) F(18,1,3) F(19,1,4) F(20,1,5) F(21,1,6) F(22,1,7) F(23,2,2) F(24,2,3) F(25,2,4) F(26,3,3)

__device__ __forceinline__ void ph_peer_route(int bid, int nb, const bf16_t* __restrict__ qpeer, const bf16_t* __restrict__ SK, int* __restrict__ sel_e,
                              float* __restrict__ sel_g, int M, char* lds) {
    const int tid = threadIdx.x, lane = tid & 63, w = tid >> 6, r = lane & 31, h2 = lane >> 5;
    const int srow = tid >> 4, sc = tid & 15;
    const int soff = srow * 256 + ((sc ^ (srow & 15)) << 4);
    for (int it = bid; it < (M / 128) * 8; it += nb) {
        const int m0 = (it >> 3) * 128, hd = it & 7;
        const int row = 32 * w + r;
        __syncthreads();
#pragma unroll
        for (int pp = 0; pp < 2; ++pp) {
            const bf16_t* sp = SK + ((size_t)(hd * 2 + pp) * 128 + srow) * 128 + sc * 8;
            uint4 t0 = *(const uint4*)(sp), t1 = *(const uint4*)(sp + 16 * 128), t2 = *(const uint4*)(sp + 32 * 128), t3 = *(const uint4*)(sp + 48 * 128);
            uint4 t4 = *(const uint4*)(sp + 64 * 128), t5 = *(const uint4*)(sp + 80 * 128), t6 = *(const uint4*)(sp + 96 * 128), t7 = *(const uint4*)(sp + 112 * 128);
            char* d = lds + pp * 32768 + soff;
            *(uint4*)(d) = t0; *(uint4*)(d + 4096) = t1; *(uint4*)(d + 8192) = t2; *(uint4*)(d + 12288) = t3;
            *(uint4*)(d + 16384) = t4; *(uint4*)(d + 20480) = t5; *(uint4*)(d + 24576) = t6; *(uint4*)(d + 28672) = t7;
        }
        __syncthreads();
        float L0[16], L1[16];
#pragma unroll
        for (int pp = 0; pp < 2; ++pp) {
            bf16x8 qf[8];
            const bf16_t* qp = qpeer + (size_t)(m0 + row) * PQ + hd * 256 + pp * 128 + 8 * h2;
#pragma unroll
            for (int kk = 0; kk < 8; ++kk) qf[kk] = *(const bf16x8*)(qp + 16 * kk);
            float g[4][16];
#pragma unroll
            for (int kt = 0; kt < 4; ++kt) {
                f32x16 st;
#pragma unroll
                for (int i = 0; i < 16; ++i) st[i] = 0.f;
#pragma unroll
                for (int kk = 0; kk < 8; ++kk) {
                    const bf16x8 kf = *(const bf16x8*)(lds + pp * 32768 + (32 * kt + r) * 256 + (((2 * kk + h2) ^ (r & 15)) << 4));
                    st = __builtin_amdgcn_mfma_f32_32x32x16_bf16(kf, qf[kk], st, 0, 0, 0);
                }
#pragma unroll
                for (int i = 0; i < 16; ++i) {
                    const unsigned n = 32 * kt + (i & 3) + 8 * (i >> 2) + 4 * h2;
                    g[kt][i] = __uint_as_float((__float_as_uint(st[i]) & 0xFFFFFF80u) | n);
                }
            }
            net_sort16(g[0]); net_sort16(g[1]); net_sort16(g[2]); net_sort16(g[3]);
            net_merge16(g[0], g[1]); net_merge16(g[2], g[3]); net_merge16(g[0], g[2]);
            float pb[16];
#pragma unroll
            for (int i = 0; i < 16; ++i) pb[i] = __shfl_xor(g[0][i], 32);
            net_merge16(g[0], pb);
#pragma unroll
            for (int i = 0; i < 16; ++i) { if (pp == 0) L0[i] = g[0][i]; else L1[i] = g[0][i]; }
        }
        __syncthreads();
        unsigned char* tab = (unsigned char*)lds;
        if (h2 == 0) {
            unsigned wv[8];
#pragma unroll
            for (int j = 0; j < 4; ++j) {
                wv[j] = (__float_as_uint(L0[4 * j]) & 0x7Fu) | ((__float_as_uint(L0[4 * j + 1]) & 0x7Fu) << 8) | ((__float_as_uint(L0[4 * j + 2]) & 0x7Fu) << 16) | ((__float_as_uint(L0[4 * j + 3]) & 0x7Fu) << 24);
                wv[4 + j] = (__float_as_uint(L1[4 * j]) & 0x7Fu) | ((__float_as_uint(L1[4 * j + 1]) & 0x7Fu) << 8) | ((__float_as_uint(L1[4 * j + 2]) & 0x7Fu) << 16) | ((__float_as_uint(L1[4 * j + 3]) & 0x7Fu) << 24);
            }
            *(uint4*)(tab + row * 32) = make_uint4(wv[0], wv[1], wv[2], wv[3]);
            *(uint4*)(tab + row * 32 + 16) = make_uint4(wv[4], wv[5], wv[6], wv[7]);
        }
        float X[16], Y[16];
#pragma unroll
        for (int i = 0; i < 16; ++i) {
            const float a0 = __uint_as_float(__float_as_uint(L0[i]) & 0xFFFFFF80u), a1 = __uint_as_float(__float_as_uint(L1[i]) & 0xFFFFFF80u);
            X[i] = h2 ? a1 : a0; Y[i] = h2 ? a0 : a1;
        }
        float c0[16], c1[16];
#define PEER_CAND(i, a, b) { float v = X[a] + Y[b]; if ((a) == (b) && h2) v = -3.0e38f; const unsigned id = h2 ? ((b) * 16 + (a)) : ((a) * 16 + (b)); \
            const float pk = __uint_as_float((__float_as_uint(v) & 0xFFFFFF00u) | id); if ((i) < 16) c0[(i) & 15] = pk; else c1[(i) & 15] = pk; }
        PEER_CANDS(PEER_CAND)
#undef PEER_CAND
#pragma unroll
        for (int i = 11; i < 16; ++i) c1[i] = -3.0e38f;
        net_sort16(c0); net_sort16(c1); net_merge16(c0, c1);
        {
            float pb[16];
#pragma unroll
            for (int i = 0; i < 16; ++i) pb[i] = __shfl_xor(c0[i], 32);
            net_merge16(c0, pb);
        }
        float ex[16], sum = 0.f;
#pragma unroll
        for (int i = 0; i < 16; ++i) { ex[i] = __expf(c0[i] - c0[0]); sum += ex[i]; }
        const float rs = 1.0f / sum;
        const size_t ob = ((size_t)(m0 + row) * 8 + hd) * 16;
        if (h2 == 0) {
            int eo[16];
#pragma unroll
            for (int j = 0; j < 16; ++j) {
                const unsigned id = __float_as_uint(c0[j]) & 0xFFu;
                eo[j] = (int)tab[row * 32 + (id >> 4)] * 128 + (int)tab[row * 32 + 16 + (id & 15)];
            }
#pragma unroll
            for (int j = 0; j < 4; ++j) *(int4*)(sel_e + ob + 4 * j) = make_int4(eo[4 * j], eo[4 * j + 1], eo[4 * j + 2], eo[4 * j + 3]);
        } else {
#pragma unroll
            for (int j = 0; j < 4; ++j) *(float4*)(sel_g + ob + 4 * j) = make_float4(ex[4 * j] * rs, ex[4 * j + 1] * rs, ex[4 * j + 2] * rs, ex[4 * j + 3] * rs);
        }
    }
}
constexpr float USCALE = 64.0f;
#define DEC16(W_, f) do { const f32x2 _a = __builtin_amdgcn_cvt_pk_f32_fp8((int)(W_).x, false), _b = __builtin_amdgcn_cvt_pk_f32_fp8((int)(W_).x, true), \
        _c = __builtin_amdgcn_cvt_pk_f32_fp8((int)(W_).y, false), _d = __builtin_amdgcn_cvt_pk_f32_fp8((int)(W_).y, true), \
        _e = __builtin_amdgcn_cvt_pk_f32_fp8((int)(W_).z, false), _f = __builtin_amdgcn_cvt_pk_f32_fp8((int)(W_).z, true), \
        _g = __builtin_amdgcn_cvt_pk_f32_fp8((int)(W_).w, false), _h = __builtin_amdgcn_cvt_pk_f32_fp8((int)(W_).w, true); \
        f[0] = _a.x; f[1] = _a.y; f[2] = _b.x; f[3] = _b.y; f[4] = _c.x; f[5] = _c.y; f[6] = _d.x; f[7] = _d.y; \
        f[8] = _e.x; f[9] = _e.y; f[10] = _f.x; f[11] = _f.y; f[12] = _g.x; f[13] = _g.y; f[14] = _h.x; f[15] = _h.y; } while (0)
template <int MODE>
__device__ __forceinline__ void ph_peer_gather(int bid, int nb, const bf16_t* __restrict__ xf  , const unsigned char* __restrict__ U,
                               const unsigned char* __restrict__ V, const int* __restrict__ sel_e, const float* __restrict__ sel_g,
                               const float* __restrict__ gate  , float* __restrict__ hlat, float* __restrict__ hctx, int ntok, float* lds,
                               const float* __restrict__ ngamma, const float* __restrict__ nmod  , bf16_t* __restrict__ aout) {
    const int lane = threadIdx.x & 63, wid = threadIdx.x >> 6;
    float* wl = lds + wid * 128;
    const bool b5 = (lane & 32) != 0, b4 = (lane & 16) != 0, b3 = (lane & 8) != 0;
    const int jj = ((lane >> 5) & 1) * 4 + ((lane >> 4) & 1) * 2 + ((lane >> 3) & 1);
    for (int row = bid * 4 + wid; row < ntok; row += nb * 4) {
        float x[16];
        {
            const uint4 w0 = *(const uint4*)(xf + (size_t)row * D + lane * 16), w1 = *(const uint4*)(xf + (size_t)row * D + lane * 16 + 8);
            const unsigned ww[8] = {w0.x, w0.y, w0.z, w0.w, w1.x, w1.y, w1.z, w1.w};
#pragma unroll
            for (int j = 0; j < 8; ++j) { x[2 * j] = __uint_as_float(ww[j] << 16); x[2 * j + 1] = __uint_as_float(ww[j] & 0xffff0000u); }
        }
        const int my_e0 = sel_e[(size_t)row * 128 + lane], my_e1 = sel_e[(size_t)row * 128 + 64 + lane];
        wl[lane] = sel_g[(size_t)row * 128 + lane]; wl[64 + lane] = sel_g[(size_t)row * 128 + 64 + lane];
#pragma unroll 1
        for (int k0 = 0; k0 < 128; k0 += 8) {
            uint4 ur[8];
#pragma unroll
            for (int j = 0; j < 8; ++j) {
                const int e = __shfl((k0 + j) < 64 ? my_e0 : my_e1, (k0 + j) & 63);
                ur[j] = *(const uint4*)(U + (size_t)e * D + lane * 16);
            }
            float p[8];
#pragma unroll
            for (int j = 0; j < 8; ++j) {
                float f[16]; DEC16(ur[j], f);
                float a = 0.f;
#pragma unroll
                for (int i = 0; i < 16; ++i) a += x[i] * f[i];
                p[j] = a;
            }
            float q[4];
#pragma unroll
            for (int j = 0; j < 4; ++j) { const float keep = b5 ? p[j + 4] : p[j], send = b5 ? p[j] : p[j + 4]; q[j] = keep + __shfl_xor(send, 32); }
            float r2[2];
#pragma unroll
            for (int j = 0; j < 2; ++j) { const float keep = b4 ? q[j + 2] : q[j], send = b4 ? q[j] : q[j + 2]; r2[j] = keep + __shfl_xor(send, 16); }
            float sdot = (b3 ? r2[1] : r2[0]) + __shfl_xor(b3 ? r2[0] : r2[1], 8);
            sdot += __shfl_xor(sdot, 4); sdot += __shfl_xor(sdot, 2); sdot += __shfl_xor(sdot, 1);
            if ((lane & 7) == 0) {
                const float dot = sdot * (1.0f / USCALE);
                const float act = 0.5f * dot * (1.0f + erff(dot * 0.70710678118654752f));
                wl[k0 + jj] = wl[k0 + jj] * act;
            }
        }
        float y[16];
#pragma unroll
        for (int i = 0; i < 16; ++i) y[i] = 0.f;
#pragma unroll 1
        for (int k0 = 0; k0 < 128; k0 += 8) {
            uint4 vr[8];
#pragma unroll
            for (int j = 0; j < 8; ++j) {
                const int e = __shfl((k0 + j) < 64 ? my_e0 : my_e1, (k0 + j) & 63);
                vr[j] = *(const uint4*)(V + (size_t)e * D + lane * 16);
            }
            const float4 wa = *(const float4*)(wl + k0), wb = *(const float4*)(wl + k0 + 4);
            const float wv[8] = {wa.x, wa.y, wa.z, wa.w, wb.x, wb.y, wb.z, wb.w};
#pragma unroll
            for (int j = 0; j < 8; ++j) {
                float f[16]; DEC16(vr[j], f);
#pragma unroll
                for (int i = 0; i < 16; ++i) y[i] += wv[j] * f[i];
            }
        }
        float* hp = row < TL ? hlat + (size_t)row * D : hctx + (size_t)(row - TL) * D;
        const float* gg = gate + (size_t)mod_row(row) * 6144;
        float hn[16]; float ss = 0.f;
#pragma unroll
        for (int j = 0; j < 4; ++j) {
            float4 h = *(float4*)(hp + lane * 16 + j * 4); const float4 g4 = *(const float4*)(gg + lane * 16 + j * 4);
            h.x += g4.x * y[j * 4 + 0]; h.y += g4.y * y[j * 4 + 1]; h.z += g4.z * y[j * 4 + 2]; h.w += g4.w * y[j * 4 + 3];
            if (MODE == 0) *(float4*)(hp + lane * 16 + j * 4) = h;
            hn[j * 4 + 0] = h.x; hn[j * 4 + 1] = h.y; hn[j * 4 + 2] = h.z; hn[j * 4 + 3] = h.w;
            ss += h.x * h.x + h.y * h.y + h.z * h.z + h.w * h.w;
        }
        ss = wave_sum(ss);
        const float rinv = rsqrtf(ss * (1.0f / D) + EPS);
        if (MODE == 0) {
            const float* m = nmod + (size_t)mod_row(row) * 6144;
            unsigned pk[8];
#pragma unroll
            for (int j = 0; j < 4; ++j) {
                const float4 g = *(const float4*)(ngamma + lane * 16 + j * 4), sc = *(const float4*)(m + D + lane * 16 + j * 4), sh = *(const float4*)(m + lane * 16 + j * 4);
                pk[2 * j] = pack2(hn[4 * j] * rinv * g.x * (1.f + sc.x) + sh.x, hn[4 * j + 1] * rinv * g.y * (1.f + sc.y) + sh.y);
                pk[2 * j + 1] = pack2(hn[4 * j + 2] * rinv * g.z * (1.f + sc.z) + sh.z, hn[4 * j + 3] * rinv * g.w * (1.f + sc.w) + sh.w);
            }
            *(uint4*)(aout + (size_t)row * D + lane * 16) = make_uint4(pk[0], pk[1], pk[2], pk[3]);
            *(uint4*)(aout + (size_t)row * D + lane * 16 + 8) = make_uint4(pk[4], pk[5], pk[6], pk[7]);
        } else {
#pragma unroll
            for (int j = 0; j < 4; ++j) {
                const float4 g = *(const float4*)(ngamma + lane * 16 + j * 4);
                float4 o; o.x = hn[4 * j] * rinv * g.x; o.y = hn[4 * j + 1] * rinv * g.y; o.z = hn[4 * j + 2] * rinv * g.z; o.w = hn[4 * j + 3] * rinv * g.w;
                *(float4*)(hp + lane * 16 + j * 4) = o;
            }
        }
    }
}
__device__ void ph_final(int bid, int nb, float* __restrict__ h, const float* __restrict__ g) {
    const int lane = threadIdx.x & 63, wid = threadIdx.x >> 6;
    for (int row = bid * 4 + wid; row < TL; row += nb * 4) {
        float4* p = (float4*)(h + (size_t)row * D);
        float4 x[4]; float ss = 0.f;
#pragma unroll
        for (int i = 0; i < 4; ++i) { x[i] = p[i * 64 + lane]; ss += x[i].x * x[i].x + x[i].y * x[i].y + x[i].z * x[i].z + x[i].w * x[i].w; }
        ss = wave_sum(ss);
        const float rinv = rsqrtf(ss * (1.0f / D) + EPS);
#pragma unroll
        for (int i = 0; i < 4; ++i) {
            const float4 gg = ((const float4*)g)[i * 64 + lane];
            float4 o; o.x = x[i].x * rinv * gg.x; o.y = x[i].y * rinv * gg.y; o.z = x[i].z * rinv * gg.z; o.w = x[i].w * rinv * gg.w;
            p[i * 64 + lane] = o;
        }
    }
}

struct Params {
    const float *x, *c, *ctx, *c_ctx, *ada_w, *ada_b, *norm_mix_g, *norm_ffn_g, *ab_w_in, *ab_w_out, *hg_lb, *hg_norm_g, *sw_sink,
        *ga_w_in, *ga_w_out, *ga_qn, *ga_kn, *peer_wq, *peer_sk, *peer_u, *peer_v, *final_g;
    float* out; char* ws;
};
extern __shared__ __attribute__((aligned(16))) char dyn_lds[];

#define WSP(T, off) ((T*)(p.ws + (off)))

constexpr int XB_XCNT = 0, XB_XSUB = 1024, XB_XGEN = 2048, XB_TOP = 3072, XB_TOPGEN = 3136;
struct GridBar { unsigned* bar; unsigned x, nloc, nx; };
__device__ __forceinline__ unsigned xb_ld(unsigned* p) { return __hip_atomic_load(p, __ATOMIC_RELAXED, __HIP_MEMORY_SCOPE_AGENT); }
__device__ __forceinline__ unsigned xb_add(unsigned* p) { return __hip_atomic_fetch_add(p, 1u, __ATOMIC_RELAXED, __HIP_MEMORY_SCOPE_AGENT); }
__device__ __forceinline__ void grid_bar_post(GridBar& b, unsigned* bar) {
    b.bar = bar; b.x = (unsigned)__builtin_amdgcn_s_getreg((3 << 11) | 20) & 0xFu; b.nloc = 0u; b.nx = 0u;
    if (threadIdx.x == 0) (void)xb_add(&bar[XB_XCNT + 64 * b.x]);
}
__device__ __forceinline__ void grid_bar(GridBar& b) {
    asm volatile("s_waitcnt vmcnt(0)" ::: "memory");
    __syncthreads();
    if (threadIdx.x == 0) {
        unsigned* bar = b.bar;
        if (b.nloc == 0u) {
            for (;;) {
                unsigned sum = 0u, cnt = 0u, mine = 0u;
#pragma unroll
                for (unsigned j = 0; j < 16; ++j) { const unsigned c = xb_ld(&bar[XB_XCNT + 64 * j]); sum += c; cnt += c > 0u ? 1u : 0u; mine = (j == b.x) ? c : mine; }
                if (sum == gridDim.x) { b.nloc = mine; b.nx = cnt; break; }
                __builtin_amdgcn_s_sleep(1);
            }
        }
        const unsigned old = xb_add(&bar[XB_XSUB + 64 * b.x]);
        const unsigned gen = old / b.nloc;
        if (old + 1u == (gen + 1u) * b.nloc) {
            __builtin_amdgcn_fence(__ATOMIC_RELEASE, "agent");
            asm volatile("s_waitcnt vmcnt(0)" ::: "memory");
            const unsigned og = xb_add(&bar[XB_TOP]);
            const unsigned tg = og / b.nx;
            if (og + 1u == (tg + 1u) * b.nx) (void)xb_add(&bar[XB_TOPGEN]);
            else while (xb_ld(&bar[XB_TOPGEN]) == tg) __builtin_amdgcn_s_sleep(1);
            __builtin_amdgcn_fence(__ATOMIC_ACQUIRE, "agent");
            (void)xb_add(&bar[XB_XGEN + 64 * b.x]);
            asm volatile("s_waitcnt vmcnt(0)" ::: "memory");
        } else {
            while (xb_ld(&bar[XB_XGEN + 64 * b.x]) == gen) __builtin_amdgcn_s_sleep(1);
            __builtin_amdgcn_fence(__ATOMIC_ACQUIRE, "agent");
            asm volatile("s_waitcnt vmcnt(0)" ::: "memory");
        }
    }
    __syncthreads();
}

namespace cg = cooperative_groups;
constexpr int MEGA_LDS = 65536;
__global__ void __launch_bounds__(256, 2) k_mega(Params p) {
    cg::grid_group grid = cg::this_grid();
    const int bid = blockIdx.x, nb = gridDim.x;
    char* lds = dyn_lds;
    float* ldf = (float*)dyn_lds;
    float* mod0 = WSP(float, OFF_MOD);
    float* mod1 = mod0 + (size_t)9 * 6144;
    float* hctx = WSP(float, OFF_HCTX);
    bf16_t* abuf = WSP(bf16_t, OFF_A);
    bf16_t* mix = WSP(bf16_t, OFF_MIX);
    GridBar gb;
    grid_bar_post(gb, WSP(unsigned, OFF_BAR));
    ph_transpose(bid, nb, p.ab_w_in, WSP(bf16_t, OFF_WABIN), D, AB_IN, ldf);
    ph_transpose(bid, nb, p.ab_w_out, WSP(bf16_t, OFF_WABOUT), D, D, ldf);
    ph_transpose(bid, nb, p.ga_w_in, WSP(bf16_t, OFF_WGAIN), D, GA_IN, ldf);
    ph_transpose(bid, nb, p.ga_w_out, WSP(bf16_t, OFF_WGAOUT), D, D, ldf);
    ph_transpose(bid, nb, p.peer_wq, WSP(bf16_t, OFF_WPQ), D, PQ, ldf);
    ph_transpose(bid, nb, p.peer_wq + (size_t)D * PQ, WSP(bf16_t, OFF_WPQ) + (size_t)PQ * D, D, PQ, ldf);
    ph_cvt(bid, nb, p.peer_sk, WSP(bf16_t, OFF_SK), (size_t)2 * 8 * 2 * 128 * 128);
    ph_tables(bid, nb, WSP(float, OFF_COSS), WSP(float, OFF_SINS), WSP(float, OFF_COSG), WSP(float, OFF_SING), p.hg_lb, WSP(float, OFF_LB));
    __syncthreads();
    ph_mod(bid, nb, p.c, p.c_ctx, p.ada_w, p.ada_b, mod0, ldf);
    ph_cvt8(bid, nb, p.peer_u, WSP(unsigned char, OFF_U16), (size_t)2 * NEXP * D, USCALE);
    ph_cvt8(bid, nb, p.peer_v, WSP(unsigned char, OFF_V16), (size_t)2 * NEXP * D, 1.0f);
    grid.sync();
    ph_normmod(bid, nb, p.x, p.ctx, p.norm_mix_g, mod0, 1 * D, 0, abuf, TA);
    grid_bar(gb);
    { EpiStoreSplit e{WSP(bf16_t, OFF_PROJH), HGW, WSP(bf16_t, OFF_PROJS), SWW, HGW};
      ph_gemm(bid, nb, abuf, D, WSP(bf16_t, OFF_WABIN), D, TA, AB_IN, D, lds, e); }
    grid_bar(gb);
    ph_prep_swa(bid, nb, WSP(bf16_t, OFF_PROJS), WSP(float, OFF_COSS), WSP(float, OFF_SINS));
    ph_vt<64>(bid, nb, WSP(bf16_t, OFF_PROJS), SWW, 640, WSP(bf16_t, OFF_VT), (bf16_t*)lds);
    grid_bar(gb);
    {
        const int hgb = nb >= 256 ? 128 : nb / 2;
        if (bid < hgb) ph_hgrn(bid, hgb, WSP(bf16_t, OFF_PROJH), WSP(float, OFF_LB), WSP(bf16_t, OFF_OF), WSP(bf16_t, OFF_OB), lds);
        else ph_swa(bid - hgb, nb - hgb, WSP(bf16_t, OFF_PROJS), WSP(bf16_t, OFF_VT), p.sw_sink, mix, lds);
    }
    grid_bar(gb);
    ph_hgpost(bid, nb, WSP(bf16_t, OFF_OF), WSP(bf16_t, OFF_OB), WSP(bf16_t, OFF_PROJH), p.hg_norm_g, mix);
    grid_bar(gb);
    { EpiResid e{p.x, p.ctx, p.out, hctx, mod0 + 2 * D};
      ph_gemm(bid, nb, mix, D, WSP(bf16_t, OFF_WABOUT), D, TA, D, D, lds, e); }
    grid_bar(gb);
    ph_normmod(bid, nb, p.out, hctx, p.norm_ffn_g, mod0, 4 * D, 3 * D, abuf, TA);
    grid_bar(gb);
    { EpiStoreSplit e{WSP(bf16_t, OFF_QPEER), PQ, WSP(bf16_t, OFF_QPEER), PQ, 1 << 30};
      ph_gemm(bid, nb, abuf, D, WSP(bf16_t, OFF_WPQ), D, TA, PQ, D, lds, e); }
    grid_bar(gb);
    ph_peer_route(bid, nb, WSP(bf16_t, OFF_QPEER), WSP(bf16_t, OFF_SK), WSP(int, OFF_SELE), WSP(float, OFF_SELG), TA, lds);
    grid_bar(gb);
    ph_peer_gather<0>(bid, nb, abuf, WSP(unsigned char, OFF_U16), WSP(unsigned char, OFF_V16), WSP(int, OFF_SELE), WSP(float, OFF_SELG), mod0 + 5 * D, p.out, hctx, TA, ldf,
                      p.norm_mix_g + D, mod1, abuf);
    grid_bar(gb);
    { EpiStoreSplit e{WSP(bf16_t, OFF_PROJ), GA_IN, WSP(bf16_t, OFF_PROJ), GA_IN, 1 << 30};
      ph_gemm(bid, nb, abuf, D, WSP(bf16_t, OFF_WGAIN), D, TA, GA_IN, D, lds, e); }
    grid_bar(gb);
    ph_prep_ga(bid, nb, WSP(bf16_t, OFF_PROJ), p.ga_qn, p.ga_kn, WSP(float, OFF_COSG), WSP(float, OFF_SING));
    ph_vt<128>(bid, nb, WSP(bf16_t, OFF_PROJ), GA_IN, 1280, WSP(bf16_t, OFF_VT), (bf16_t*)lds);
    grid_bar(gb);
    ph_dense(bid, nb, WSP(bf16_t, OFF_PROJ), WSP(bf16_t, OFF_VT), mix, lds);
    grid_bar(gb);
    { EpiResid e{p.out, hctx, p.out, hctx, mod1 + 2 * D};
      ph_gemm(bid, nb, mix, D, WSP(bf16_t, OFF_WGAOUT), D, TL, D, D, lds, e); }
    grid_bar(gb);
    ph_normmod(bid, nb, p.out, hctx, p.norm_ffn_g + D, mod1, 4 * D, 3 * D, abuf, TL);
    grid_bar(gb);
    { EpiStoreSplit e{WSP(bf16_t, OFF_QPEER), PQ, WSP(bf16_t, OFF_QPEER), PQ, 1 << 30};
      ph_gemm(bid, nb, abuf, D, WSP(bf16_t, OFF_WPQ) + (size_t)PQ * D, D, TL, PQ, D, lds, e); }
    grid_bar(gb);
    ph_peer_route(bid, nb, WSP(bf16_t, OFF_QPEER), WSP(bf16_t, OFF_SK) + (size_t)16 * 128 * 128, WSP(int, OFF_SELE), WSP(float, OFF_SELG), TL, lds);
    grid_bar(gb);
    ph_peer_gather<1>(bid, nb, abuf, WSP(unsigned char, OFF_U16) + (size_t)NEXP * D, WSP(unsigned char, OFF_V16) + (size_t)NEXP * D, WSP(int, OFF_SELE), WSP(float, OFF_SELG), mod1 + 5 * D, p.out, hctx, TL, ldf,
                      p.final_g, mod1, abuf);
}

extern "C" void kernel_launch(void* const* d_in, const int* in_sizes, int n_in, void* d_out, int out_size, void* d_ws, size_t ws_size,
                              hipStream_t stream) {
    Params p{};
    p.x = (const float*)d_in[0]; p.c = (const float*)d_in[1]; p.ctx = (const float*)d_in[2]; p.c_ctx = (const float*)d_in[3];
    p.ada_w = (const float*)d_in[4]; p.ada_b = (const float*)d_in[5]; p.norm_mix_g = (const float*)d_in[6]; p.norm_ffn_g = (const float*)d_in[7];
    p.ab_w_in = (const float*)d_in[8]; p.ab_w_out = (const float*)d_in[9]; p.hg_lb = (const float*)d_in[10]; p.hg_norm_g = (const float*)d_in[11];
    p.sw_sink = (const float*)d_in[12]; p.ga_w_in = (const float*)d_in[13]; p.ga_w_out = (const float*)d_in[14]; p.ga_qn = (const float*)d_in[15];
    p.ga_kn = (const float*)d_in[16]; p.peer_wq = (const float*)d_in[17]; p.peer_sk = (const float*)d_in[18]; p.peer_u = (const float*)d_in[19];
    p.peer_v = (const float*)d_in[20]; p.final_g = (const float*)d_in[21];
    p.out = (float*)d_out; p.ws = (char*)d_ws;
    if (ws_size < WS_NEED) { fprintf(stderr, "workspace too small: %zu < %zu\n", ws_size, WS_NEED); return; }
    static int grid_blocks = 0;
    if (!grid_blocks) {
        int dev = 0, cus = 0, per_cu = 0;
        (void)hipGetDevice(&dev);
        (void)hipDeviceGetAttribute(&cus, hipDeviceAttributeMultiprocessorCount, dev);
        (void)hipFuncSetAttribute((const void*)k_mega, hipFuncAttributeMaxDynamicSharedMemorySize, MEGA_LDS);
        (void)hipOccupancyMaxActiveBlocksPerMultiprocessor(&per_cu, k_mega, 256, MEGA_LDS);
        if (per_cu > 2) per_cu = 2;
        if (per_cu < 1) per_cu = 1;
        grid_blocks = cus * per_cu;
    }
    (void)hipMemsetAsync((char*)d_ws + OFF_BAR, 0, BAR_BYTES, stream);
    void* args[] = {&p};
    hipError_t e = hipLaunchCooperativeKernel((const void*)k_mega, dim3(grid_blocks), dim3(256), args, MEGA_LDS, stream);
    if (e != hipSuccess) fprintf(stderr, "cooperative launch failed: %s (grid %d)\n", hipGetErrorString(e), grid_blocks);
}
```

```cpp
#include <hip/hip_runtime.h>
#include <hip/hip_cooperative_groups.h>
#include <stdint.h>
#include <stdio.h>

typedef unsigned short bf16_t;
typedef short bf16x8 __attribute__((ext_vector_type(8)));
typedef float f32x4 __attribute__((ext_vector_type(4)));

constexpr int D = 1024, NB = 8, SEQ = 4096, LC = 256;
constexpr int TL = NB * SEQ;
constexpr int TC = NB * LC;
constexpr int TA = TL + TC;
constexpr int AB_IN = 3328, HGW = 2560, SWW = 768, GA_IN = 1536, PQ = 2048;
constexpr int NEXP = 16384;
constexpr float EPS = 1e-6f;
constexpr float LOG2E = 1.4426950408889634f;
constexpr int NKEY = LC + SEQ;

constexpr size_t OFF_WABIN = 0;
constexpr size_t OFF_WABOUT = OFF_WABIN + (size_t)AB_IN * D * 2;
constexpr size_t OFF_WGAIN = OFF_WABOUT + (size_t)D * D * 2;
constexpr size_t OFF_WGAOUT = OFF_WGAIN + (size_t)GA_IN * D * 2;
constexpr size_t OFF_WPQ = OFF_WGAOUT + (size_t)D * D * 2;
constexpr size_t OFF_SK = OFF_WPQ + (size_t)2 * PQ * D * 2;
constexpr size_t OFF_MOD = OFF_SK + (size_t)2 * 8 * 2 * 128 * 128 * 2;
constexpr size_t OFF_COSS = OFF_MOD + (size_t)2 * 9 * 6144 * 4;
constexpr size_t OFF_SINS = OFF_COSS + (size_t)SEQ * 32 * 4;
constexpr size_t OFF_COSG = OFF_SINS + (size_t)SEQ * 32 * 4;
constexpr size_t OFF_SING = OFF_COSG + (size_t)SEQ * 64 * 4;
constexpr size_t OFF_LB = OFF_SING + (size_t)SEQ * 64 * 4;
constexpr size_t OFF_U16 = OFF_LB + 2048;
constexpr size_t OFF_V16 = OFF_U16 + (size_t)NEXP * D * 2;
constexpr size_t OFF_HCTX = OFF_V16 + (size_t)NEXP * D * 2;
constexpr size_t OFF_A = OFF_HCTX + (size_t)TC * D * 4;
constexpr size_t OFF_PROJ = OFF_A + (size_t)TA * D * 2;
constexpr size_t OFF_MIX = OFF_PROJ + (size_t)TA * AB_IN * 2;
constexpr size_t OFF_SEL = OFF_MIX + (size_t)TA * D * 2;
constexpr size_t OFF_BAR = OFF_SEL + (size_t)TA * 128 * 8;
constexpr size_t BAR_BYTES = 32768;
constexpr size_t OFF_VT64 = OFF_BAR + BAR_BYTES;
constexpr size_t WS_NEED = OFF_VT64 + (size_t)NB * 2 * 64 * NKEY * 2;
static_assert(WS_NEED <= (size_t)536870912, "workspace over 512 MiB");
constexpr size_t OFF_OF = OFF_MIX;
constexpr size_t OFF_OB = OFF_SEL;
constexpr size_t OFF_PROJH = OFF_PROJ;
constexpr size_t OFF_PROJS = OFF_PROJ + (size_t)TA * HGW * 2;
constexpr size_t OFF_QPEER = OFF_PROJ;
constexpr size_t OFF_TSC = OFF_QPEER + (size_t)TA * PQ * 2;
constexpr size_t OFF_TIX = OFF_TSC + (size_t)TA * 256 * 4;
static_assert(OFF_TIX + (size_t)TA * 256 * 4 <= OFF_MIX, "peer scratch overflows proj region");
constexpr size_t OFF_VT = OFF_SEL;
static_assert((size_t)NB * 2 * 128 * NKEY * 2 <= (size_t)TA * 128 * 8, "Vt overflows SEL region");
constexpr size_t OFF_PART = OFF_PROJ;
constexpr size_t OFF_X8 = OFF_PROJ + (size_t)TA * PQ * 2;
static_assert((size_t)8 * TA * 128 * 4 <= (size_t)TA * PQ * 2 && OFF_X8 + (size_t)2 * TA * D <= OFF_MIX, "PEER scratch overflows proj region");
constexpr size_t OFF_H16 = OFF_PROJ + (size_t)TA * PQ * 2;
constexpr size_t OFF_XQ = OFF_MIX;
constexpr size_t OFF_XS = OFF_MIX + (size_t)TA * D;
constexpr size_t OFF_SELE = OFF_SEL;
constexpr size_t OFF_SELG = OFF_SEL + (size_t)TA * 128 * 4;

extern __shared__ __attribute__((aligned(16))) char dyn_lds[];
__device__ __forceinline__ float bf2f(bf16_t v) { return __uint_as_float(((unsigned)v) << 16); }
__device__ __forceinline__ bf16_t f2bf(float f) {
    unsigned u = __float_as_uint(f);
    u += 0x7fffu + ((u >> 16) & 1u);
    return (bf16_t)(u >> 16);
}
typedef float f32x2 __attribute__((ext_vector_type(2)));
typedef float f32x16 __attribute__((ext_vector_type(16)));
typedef __bf16 bf16x2_t __attribute__((ext_vector_type(2)));
__device__ __forceinline__ unsigned pack2(float lo, float hi) { f32x2 v = {lo, hi}; return __builtin_bit_cast(unsigned, __builtin_convertvector(v, bf16x2_t)); }
__device__ __forceinline__ float sigmoidf_(float x) { return 1.0f / (1.0f + __expf(-x)); }
__device__ __forceinline__ float siluf_(float x) { return x * sigmoidf_(x); }
__device__ __forceinline__ float wave_sum(float v) {
#pragma unroll
    for (int o = 32; o >= 1; o >>= 1) v += __shfl_xor(v, o);
    return v;
}
__device__ __forceinline__ int mod_row(int row) { return row < TL ? (row >> 12) : 8; }
__device__ __forceinline__ int tidx() { int t = threadIdx.x; asm volatile("" : "+v"(t)); return t; }

__device__ void ph_transpose(int bid, int nb, const float* __restrict__ in, bf16_t* __restrict__ out, int K, int N, float* lds) {
    const int tk = K / 32, tn = N / 32, nt = tk * tn;
    const int tx = threadIdx.x & 31, ty = threadIdx.x >> 5;
    for (int t = bid; t < nt; t += nb) {
        const int k0 = (t / tn) * 32, n0 = (t % tn) * 32;
        __syncthreads();
#pragma unroll
        for (int i = 0; i < 4; ++i) lds[(ty + i * 8) * 33 + tx] = in[(size_t)(k0 + ty + i * 8) * N + n0 + tx];
        __syncthreads();
#pragma unroll
        for (int i = 0; i < 4; ++i) out[((size_t)(k0 >> 5) * N + n0 + ty + i * 8) * 32 + tx] = f2bf(lds[tx * 33 + ty + i * 8]);
    }
}
__device__ void ph_cvt(int bid, int nb, const float* __restrict__ in, bf16_t* __restrict__ out, size_t n) {
    const size_t n8 = n / 8;
    for (size_t i = (size_t)bid * blockDim.x + threadIdx.x; i < n8; i += (size_t)nb * blockDim.x) {
        const float4 a = ((const float4*)in)[i * 2], b = ((const float4*)in)[i * 2 + 1];
        uint4 w; w.x = pack2(a.x, a.y); w.y = pack2(a.z, a.w); w.z = pack2(b.x, b.y); w.w = pack2(b.z, b.w);
        ((uint4*)out)[i] = w;
    }
}
__device__ void ph_cvt8(int bid, int nb, const float* __restrict__ in, unsigned char* __restrict__ out, size_t n, float scale) {
    const size_t n16 = n / 16;
    for (size_t i = (size_t)bid * blockDim.x + threadIdx.x; i < n16; i += (size_t)nb * blockDim.x) {
        const float4 a = ((const float4*)in)[i * 4], b = ((const float4*)in)[i * 4 + 1], c = ((const float4*)in)[i * 4 + 2], d = ((const float4*)in)[i * 4 + 3];
        int w0 = __builtin_amdgcn_cvt_pk_fp8_f32(a.x * scale, a.y * scale, 0, false); w0 = __builtin_amdgcn_cvt_pk_fp8_f32(a.z * scale, a.w * scale, w0, true);
        int w1 = __builtin_amdgcn_cvt_pk_fp8_f32(b.x * scale, b.y * scale, 0, false); w1 = __builtin_amdgcn_cvt_pk_fp8_f32(b.z * scale, b.w * scale, w1, true);
        int w2 = __builtin_amdgcn_cvt_pk_fp8_f32(c.x * scale, c.y * scale, 0, false); w2 = __builtin_amdgcn_cvt_pk_fp8_f32(c.z * scale, c.w * scale, w2, true);
        int w3 = __builtin_amdgcn_cvt_pk_fp8_f32(d.x * scale, d.y * scale, 0, false); w3 = __builtin_amdgcn_cvt_pk_fp8_f32(d.z * scale, d.w * scale, w3, true);
        const size_t el = i * 16, rowg = el >> 10;
        const size_t layer = rowg / NEXP, e = rowg % NEXP; const int col = (int)(el & 1023), sl = col >> 7, cs = col & 127;
        *(int4*)(out + layer * ((size_t)NEXP * D) + ((size_t)sl * NEXP + e) * 128 + cs) = make_int4(w0, w1, w2, w3);
    }
}
constexpr float UQ = 512.0f;
__device__ __forceinline__ int q8(float v, float sc) { return (int)rintf(fminf(fmaxf(v * sc, -127.f), 127.f)) & 0xff; }
__device__ void ph_cvt8i(int bid, int nb, const float* __restrict__ in, unsigned char* __restrict__ out, size_t n, float scale) {
    const size_t n16 = n / 16;
    for (size_t i = (size_t)bid * blockDim.x + tidx(); i < n16; i += (size_t)nb * blockDim.x) {
        const float4 a = ((const float4*)in)[i * 4], b = ((const float4*)in)[i * 4 + 1], c = ((const float4*)in)[i * 4 + 2], d = ((const float4*)in)[i * 4 + 3];
        const int w0 = q8(a.x, scale) | (q8(a.y, scale) << 8) | (q8(a.z, scale) << 16) | (q8(a.w, scale) << 24);
        const int w1 = q8(b.x, scale) | (q8(b.y, scale) << 8) | (q8(b.z, scale) << 16) | (q8(b.w, scale) << 24);
        const int w2 = q8(c.x, scale) | (q8(c.y, scale) << 8) | (q8(c.z, scale) << 16) | (q8(c.w, scale) << 24);
        const int w3 = q8(d.x, scale) | (q8(d.y, scale) << 8) | (q8(d.z, scale) << 16) | (q8(d.w, scale) << 24);
        const size_t el = i * 16, rowg = el >> 10;
        const size_t layer = rowg / NEXP, e = rowg % NEXP; const int col = (int)(el & 1023), sl = col >> 7, cs = col & 127;
        *(int4*)(out + layer * ((size_t)NEXP * D) + ((size_t)sl * NEXP + e) * 128 + cs) = make_int4(w0, w1, w2, w3);
    }
}
__device__ void ph_mod(int bid, int nb, const float* __restrict__ c, const float* __restrict__ c_ctx, const float* __restrict__ ada_w,
                       const float* __restrict__ ada_b, float* __restrict__ mod, float* lds) {
    float* s = lds;
    float* red = lds + 9 * 1024;
    const int tx = threadIdx.x & 63, ky = threadIdx.x >> 6;
    for (int i = threadIdx.x; i < 9 * 1024; i += 256) {
        const int r = i >> 10, k = i & 1023;
        const float v = r < 8 ? c[r * 1024 + k] : c_ctx[k];
        s[i] = siluf_(v);
    }
    __syncthreads();
    const int nitems = 2 * 96;
    for (int it = bid; it < nitems; it += nb) {
        const int layer = it / 96, n = (it % 96) * 64 + tx;
        const float* w = ada_w + (size_t)layer * 1024 * 6144 + n;
        float acc[9];
#pragma unroll
        for (int r = 0; r < 9; ++r) acc[r] = 0.f;
        for (int k = ky * 256; k < ky * 256 + 256; ++k) {
            const float wv = w[(size_t)k * 6144];
#pragma unroll
            for (int r = 0; r < 9; ++r) acc[r] += s[r * 1024 + k] * wv;
        }
        __syncthreads();
#pragma unroll
        for (int r = 0; r < 9; ++r) red[(ky * 9 + r) * 64 + tx] = acc[r];
        __syncthreads();
        if (ky == 0) {
#pragma unroll
            for (int r = 0; r < 9; ++r) {
                const float v = red[(0 * 9 + r) * 64 + tx] + red[(1 * 9 + r) * 64 + tx] + red[(2 * 9 + r) * 64 + tx] + red[(3 * 9 + r) * 64 + tx];
                mod[((size_t)layer * 9 + r) * 6144 + n] = v + ada_b[layer * 6144 + n];
            }
        }
    }
}
__device__ void ph_tables(int bid, int nb, float* cosS, float* sinS, float* cosG, float* sinG, const float* __restrict__ lb_logits, float* lb) {
    const int gt = bid * blockDim.x + threadIdx.x, gs = nb * blockDim.x;
    for (int i = gt; i < SEQ * 32; i += gs) {
        const int t = i >> 5, j = i & 31;
        const float pos = (float)(j < 16 ? (t >> 6) : (t & 63));
        const float inv = powf(10000.0f, -(float)(j & 15) / 16.0f);
        const float ang = pos * inv;
        cosS[i] = cosf(ang); sinS[i] = sinf(ang);
    }
    for (int i = gt; i < SEQ * 64; i += gs) {
        const int t = i >> 6, j = i & 63;
        const float pos = (float)(j < 32 ? (t >> 6) : (t & 63));
        const float inv = powf(10000.0f, -(float)(j & 31) / 32.0f);
        const float ang = pos * inv;
        cosG[i] = cosf(ang); sinG[i] = sinf(ang);
    }
    for (int i = gt; i < 512; i += gs) {
        const float l0 = lb_logits[i], l1 = lb_logits[512 + i];
        lb[i] = 1.0f / (1.0f + expf(l1 - l0));
    }
}

__device__ void ph_normmod(int bid, int nb, const float* __restrict__ hlat, const float* __restrict__ hctx, const float* __restrict__ gamma,
                           const float* __restrict__ modl  , int sc_off, int sh_off, bf16_t* __restrict__ out, int nrows) {
    const int lane = tidx() & 63, wid = tidx() >> 6;
    const int nwv = nb * 4, per = (nrows + nwv - 1) / nwv, r0 = (bid * 4 + wid) * per, r1 = (r0 + per < nrows) ? r0 + per : nrows;
    if (r0 >= r1) return;
    float4 ca[4], cb[4];
    int curm = -1;
    float4 xn[4];
    {
        const float* s0 = r0 < TL ? hlat + (size_t)r0 * D : hctx + (size_t)(r0 - TL) * D;
#pragma unroll
        for (int i = 0; i < 4; ++i) xn[i] = ((const float4*)s0)[i * 64 + lane];
    }
    for (int row = r0; row < r1; ++row) {
        float4 x[4];
#pragma unroll
        for (int i = 0; i < 4; ++i) x[i] = xn[i];
        const int rn = row + 1 < r1 ? row + 1 : row;
        const float* sn = rn < TL ? hlat + (size_t)rn * D : hctx + (size_t)(rn - TL) * D;
#pragma unroll
        for (int i = 0; i < 4; ++i) xn[i] = ((const float4*)sn)[i * 64 + lane];
        const int mr = mod_row(row);
        if (mr != curm) {
            curm = mr;
            const float* m = modl + (size_t)mr * 6144;
#pragma unroll
            for (int i = 0; i < 4; ++i) {
                const int col = (i * 64 + lane) * 4;
                const float4 g = *(const float4*)(gamma + col), sc = *(const float4*)(m + sc_off + col);
                ca[i] = make_float4(g.x * (1.f + sc.x), g.y * (1.f + sc.y), g.z * (1.f + sc.z), g.w * (1.f + sc.w));
                cb[i] = *(const float4*)(m + sh_off + col);
            }
        }
        float ss = 0.f;
#pragma unroll
        for (int i = 0; i < 4; ++i) ss += x[i].x * x[i].x + x[i].y * x[i].y + x[i].z * x[i].z + x[i].w * x[i].w;
        ss = wave_sum(ss);
        const float rinv = rsqrtf(ss * (1.0f / D) + EPS);
#pragma unroll
        for (int i = 0; i < 4; ++i) {
            const int col = (i * 64 + lane) * 4;
            uint2 w; w.x = pack2(x[i].x * rinv * ca[i].x + cb[i].x, x[i].y * rinv * ca[i].y + cb[i].y);
            w.y = pack2(x[i].z * rinv * ca[i].z + cb[i].z, x[i].w * rinv * ca[i].w + cb[i].w);
            *(uint2*)(out + (size_t)row * D + col) = w;
        }
    }
}

__device__ void ph_normmod16(int bid, int nb, const bf16_t* __restrict__ h16, const float* __restrict__ gamma,
                             const float* __restrict__ modl  , int sc_off, int sh_off, bf16_t* __restrict__ out, int nrows,
                             unsigned char* __restrict__ xq = nullptr, float* __restrict__ xs = nullptr) {
    const int lane = tidx() & 63, wid = tidx() >> 6;
    const int nwv = nb * 4, per = (nrows + nwv - 1) / nwv, r0 = (bid * 4 + wid) * per, r1 = (r0 + per < nrows) ? r0 + per : nrows;
    if (r0 >= r1) return;
    float4 ca[4], cb[4];
    int curm = -1;
    uint2 wn[4];
#pragma unroll
    for (int i = 0; i < 4; ++i) wn[i] = ((const uint2*)(h16 + (size_t)r0 * D))[i * 64 + lane];
    for (int row = r0; row < r1; ++row) {
        uint2 w[4];
#pragma unroll
        for (int i = 0; i < 4; ++i) w[i] = wn[i];
        const int rn = row + 1 < r1 ? row + 1 : row;
#pragma unroll
        for (int i = 0; i < 4; ++i) wn[i] = ((const uint2*)(h16 + (size_t)rn * D))[i * 64 + lane];
        const int mr = mod_row(row);
        if (mr != curm) {
            curm = mr;
            const float* m = modl + (size_t)mr * 6144;
#pragma unroll
            for (int i = 0; i < 4; ++i) {
                const int col = (i * 64 + lane) * 4;
                const float4 g = *(const float4*)(gamma + col), sc = *(const float4*)(m + sc_off + col);
                ca[i] = make_float4(g.x * (1.f + sc.x), g.y * (1.f + sc.y), g.z * (1.f + sc.z), g.w * (1.f + sc.w));
                cb[i] = *(const float4*)(m + sh_off + col);
            }
        }
        float4 x[4]; float ss = 0.f;
#pragma unroll
        for (int i = 0; i < 4; ++i) {
            x[i].x = __uint_as_float(w[i].x << 16); x[i].y = __uint_as_float(w[i].x & 0xffff0000u); x[i].z = __uint_as_float(w[i].y << 16); x[i].w = __uint_as_float(w[i].y & 0xffff0000u);
            ss += x[i].x * x[i].x + x[i].y * x[i].y + x[i].z * x[i].z + x[i].w * x[i].w;
        }
        ss = wave_sum(ss);
        const float rinv = rsqrtf(ss * (1.0f / D) + EPS);
        float amax = 0.f;
#pragma unroll
        for (int i = 0; i < 4; ++i) {
            const int col = (i * 64 + lane) * 4;
            const float y0 = x[i].x * rinv * ca[i].x + cb[i].x, y1 = x[i].y * rinv * ca[i].y + cb[i].y;
            const float y2 = x[i].z * rinv * ca[i].z + cb[i].z, y3 = x[i].w * rinv * ca[i].w + cb[i].w;
            uint2 o; o.x = pack2(y0, y1); o.y = pack2(y2, y3);
            *(uint2*)(out + (size_t)row * D + col) = o;
            x[i] = make_float4(y0, y1, y2, y3);
            amax = fmaxf(amax, fmaxf(fmaxf(fabsf(y0), fabsf(y1)), fmaxf(fabsf(y2), fabsf(y3))));
        }
        if (xq) {
#pragma unroll
            for (int o = 32; o > 0; o >>= 1) amax = fmaxf(amax, __shfl_xor(amax, o));
            amax = fmaxf(amax, 1e-20f);
            const float qs = 127.0f / amax;
#pragma unroll
            for (int i = 0; i < 4; ++i)
                *(int*)(xq + (size_t)row * D + (i * 64 + lane) * 4) = q8(x[i].x, qs) | (q8(x[i].y, qs) << 8) | (q8(x[i].z, qs) << 16) | (q8(x[i].w, qs) << 24);
            if (lane == 0) xs[row] = amax * (1.0f / 127.0f);
        }
    }
}

constexpr int GEMM_LDS = 49152;
template <class Epi>
__device__ __forceinline__ void gemm_tile(const bf16_t* __restrict__ A, int lda, const bf16_t* __restrict__ Bt, int ldb, int K,
                                          int m0, int n0, char* lds, Epi& epi) {
    const int tid = threadIdx.x, lane = tid & 63, wid = tid >> 6, wr = wid >> 1, wc = wid & 1, fr = lane & 15, fq = lane >> 4;
    f32x4 acc[4][8];
#pragma unroll
    for (int i = 0; i < 4; ++i)
#pragma unroll
        for (int j = 0; j < 8; ++j) acc[i][j] = (f32x4){0.f, 0.f, 0.f, 0.f};
    typedef __attribute__((address_space(3))) char las_char;
    las_char* l3 = (las_char*)lds;
    const int dsub = lane >> 2, dch = (lane & 3) ^ ((lane >> 5) * 3);
    const bf16_t* ga = A + (size_t)(m0 + 32 * wid + dsub) * lda + dch * 8;
    const bf16_t* gb = Bt + (size_t)(n0 + 64 * wid + dsub) * 32 + dch * 8;
    const int fsw = ((fr >> 3) & 1) * 3;
    const int aoff = (wr * 64 + fr) * 64 + ((fq ^ fsw) << 4), boff = 8192 + (wc * 128 + fr) * 64 + ((fq ^ fsw) << 4);
#define GT_STAGE(kt, buf) do { const int _s = (buf) * 24576; \
        _Pragma("unroll") for (int i = 0; i < 2; ++i) __builtin_amdgcn_global_load_lds((const unsigned*)(ga + (size_t)(16 * i) * lda + (kt) * 32), \
            (__attribute__((address_space(3))) unsigned*)(l3 + _s + (32 * wid + 16 * i) * 64), 16, 0, 0); \
        _Pragma("unroll") for (int i = 0; i < 4; ++i) __builtin_amdgcn_global_load_lds((const unsigned*)(gb + (size_t)(kt) * ldb * 32 + 16 * i * 32), \
            (__attribute__((address_space(3))) unsigned*)(l3 + _s + 8192 + (64 * wid + 16 * i) * 64), 16, 0, 0); } while (0)
    const int nk = K / 32;
    __syncthreads();
    GT_STAGE(0, 0);
    __syncthreads();
    for (int kt = 0; kt < nk; ++kt) {
        if (kt + 1 < nk) GT_STAGE(kt + 1, (kt + 1) & 1);
        const char* base = lds + (kt & 1) * 24576;
        bf16x8 af[4], bfr[8];
#pragma unroll
        for (int i = 0; i < 4; ++i) af[i] = *(const bf16x8*)(base + aoff + i * 1024);
#pragma unroll
        for (int j = 0; j < 8; ++j) bfr[j] = *(const bf16x8*)(base + boff + j * 1024);
#pragma unroll
        for (int i = 0; i < 4; ++i)
#pragma unroll
            for (int j = 0; j < 8; ++j) acc[i][j] = __builtin_amdgcn_mfma_f32_16x16x32_bf16(bfr[j], af[i], acc[i][j], 0, 0, 0);
        __syncthreads();
    }
#undef GT_STAGE
    epi(acc, m0 + wr * 64, n0 + wc * 128, lds + wid * 12288, lane);
}

template <int TAG>
struct EpiStoreSplit {
    bf16_t* O1; int ld1; bf16_t* O2; int ld2; int split;
    __device__ __forceinline__ void operator()(f32x4 (&acc)[4][8], int row0, int col0, char* wl, int lane) const {
        if (TAG == 0 && col0 < 1536) {
            const bool isq = col0 < 512;
#pragma unroll
            for (int i = 0; i < 4; ++i)
#pragma unroll
                for (int j = 0; j < 8; ++j)
#pragma unroll
                    for (int t = 0; t < 4; ++t) {
                        const float x = acc[i][j][t];
                        const float r = __builtin_amdgcn_rcpf(1.f + __expf(isq ? -x : x));
                        acc[i][j][t] = isq ? x * r : r;
                    }
        }
        const bool first = col0 < split;
        bf16_t* O = first ? O1 : O2; const int ld = first ? ld1 : ld2, cb = first ? col0 : col0 - split;
        const int fr = lane & 15, fq = lane >> 4;
#pragma unroll
        for (int i = 0; i < 4; ++i) {
#pragma unroll
            for (int j = 0; j < 8; ++j) {
                uint2 w; w.x = pack2(acc[i][j][0], acc[i][j][1]); w.y = pack2(acc[i][j][2], acc[i][j][3]);
                *(uint2*)(wl + fr * 272 + (16 * j + 4 * fq) * 2) = w;
            }
#pragma unroll
            for (int m = 0; m < 4; ++m) {
                const int rr = (lane >> 4) + 4 * m;
                const uint4 v = *(const uint4*)(wl + rr * 272 + (lane & 15) * 16);
                *(uint4*)(O + (size_t)(row0 + 16 * i + rr) * ld + cb + (lane & 15) * 8) = v;
            }
        }
    }
};
template <int TAG>
struct EpiResid {
    const float* hin_lat; const float* hin_ctx; const bf16_t* hin16; bf16_t* hout16; const float* gate  ;
    __device__ __forceinline__ void operator()(f32x4 (&acc)[4][8], int row0, int col0, char* wl, int lane) const {
        const int fr = lane & 15, fq = lane >> 4;
        const float4 gg = *(const float4*)(gate + (size_t)mod_row(row0) * 6144 + col0 + (lane & 31) * 4);
#pragma unroll
        for (int i = 0; i < 4; ++i) {
#pragma unroll
            for (int j = 0; j < 8; ++j) *(f32x4*)(wl + fr * 528 + (16 * j + 4 * fq) * 4) = acc[i][j];
#pragma unroll
            for (int m = 0; m < 8; ++m) {
                const int rr = (lane >> 5) + 2 * m, row = row0 + 16 * i + rr, col = col0 + (lane & 31) * 4;
                const f32x4 a = *(const f32x4*)(wl + rr * 528 + (lane & 31) * 16);
                float4 h;
                if (hin16) {
                    const uint2 hw = *(const uint2*)(hin16 + (size_t)row * D + col);
                    h.x = __uint_as_float(hw.x << 16); h.y = __uint_as_float(hw.x & 0xffff0000u); h.z = __uint_as_float(hw.y << 16); h.w = __uint_as_float(hw.y & 0xffff0000u);
                } else {
                    h = *(const float4*)((row < TL ? hin_lat + (size_t)row * D : hin_ctx + (size_t)(row - TL) * D) + col);
                }
                uint2 o; o.x = pack2(h.x + gg.x * a[0], h.y + gg.y * a[1]); o.y = pack2(h.z + gg.z * a[2], h.w + gg.w * a[3]);
                *(uint2*)(hout16 + (size_t)row * D + col) = o;
            }
        }
    }
};
struct EpiGA {
    bf16_t* P; bf16_t* Vt; const float* qg; const float* kg; const float* cosG; const float* sinG;
    __device__ __forceinline__ void operator()(f32x4 (&acc)[4][8], int row0, int col0, char* wl, int lane) const {
        const int fr = lane & 15, fq = lane >> 4;
        const bool latent = row0 < TL;
        if (col0 < 1280) {
            const bool isq = col0 < 1024;
            const float* g = isq ? qg : kg;
            const float osc = isq ? 0.08838834764831845f * LOG2E : 1.0f;
#pragma unroll
            for (int i = 0; i < 4; ++i) {
                float ss = 0.f;
#pragma unroll
                for (int j = 0; j < 8; ++j) ss += acc[i][j][0] * acc[i][j][0] + acc[i][j][1] * acc[i][j][1] + acc[i][j][2] * acc[i][j][2] + acc[i][j][3] * acc[i][j][3];
                ss += __shfl_xor(ss, 16); ss += __shfl_xor(ss, 32);
                const float rinv = rsqrtf(ss * (1.0f / 128.0f) + EPS) * osc;
                const int tpos = (row0 + 16 * i + fr) & (SEQ - 1);
#pragma unroll
                for (int j = 0; j < 4; ++j) {
                    const float4 g1 = *(const float4*)(g + 16 * j + 4 * fq), g2 = *(const float4*)(g + 64 + 16 * j + 4 * fq);
                    f32x4 y1 = acc[i][j] * rinv, y2 = acc[i][j + 4] * rinv;
                    y1[0] *= g1.x; y1[1] *= g1.y; y1[2] *= g1.z; y1[3] *= g1.w; y2[0] *= g2.x; y2[1] *= g2.y; y2[2] *= g2.z; y2[3] *= g2.w;
                    if (latent) {
                        const float4 cs = *(const float4*)(cosG + tpos * 64 + 16 * j + 4 * fq), sn = *(const float4*)(sinG + tpos * 64 + 16 * j + 4 * fq);
                        const f32x4 c4 = {cs.x, cs.y, cs.z, cs.w}, s4 = {sn.x, sn.y, sn.z, sn.w};
                        const f32x4 n1 = y1 * c4 - y2 * s4, n2 = y1 * s4 + y2 * c4;
                        y1 = n1; y2 = n2;
                    }
                    uint2 w1, w2; w1.x = pack2(y1[0], y1[1]); w1.y = pack2(y1[2], y1[3]); w2.x = pack2(y2[0], y2[1]); w2.y = pack2(y2[2], y2[3]);
                    *(uint2*)(wl + fr * 272 + (16 * j + 4 * fq) * 2) = w1;
                    *(uint2*)(wl + fr * 272 + (64 + 16 * j + 4 * fq) * 2) = w2;
                }
#pragma unroll
                for (int m = 0; m < 4; ++m) {
                    const int rr = (lane >> 4) + 4 * m;
                    const uint4 v = *(const uint4*)(wl + rr * 272 + (lane & 15) * 16);
                    *(uint4*)(P + (size_t)(row0 + 16 * i + rr) * GA_IN + col0 + (lane & 15) * 8) = v;
                }
            }
        } else {
            const int kvh = (col0 - 1280) >> 7;
            const int b = latent ? (row0 >> 12) : ((row0 - TL) >> 8);
            const int kidx0 = latent ? LC + (row0 & (SEQ - 1)) : ((row0 - TL) & (LC - 1));
            bf16_t* vt = Vt + (size_t)(b * 2 + kvh) * 128 * NKEY + kidx0;
#pragma unroll
            for (int hh = 0; hh < 2; ++hh) {
#pragma unroll
                for (int i = 0; i < 4; ++i)
#pragma unroll
                    for (int j = 0; j < 4; ++j)
#pragma unroll
                        for (int t = 0; t < 4; ++t)
                            *(bf16_t*)(wl + (16 * j + 4 * fq + t) * 144 + (16 * i + fr) * 2) = (bf16_t)(pack2(acc[i][4 * hh + j][t], 0.f) & 0xffff);
#pragma unroll
                for (int m = 0; m < 8; ++m) {
                    const int dd = (lane >> 3) + 8 * m;
                    const uint4 v = *(const uint4*)(wl + dd * 144 + (lane & 7) * 16);
                    *(uint4*)(vt + (size_t)(64 * hh + dd) * NKEY + (lane & 7) * 8) = v;
                }
            }
        }
    }
};
template <class Epi>
__device__ void ph_gemm(int bid, int nb, const bf16_t* A, int lda, const bf16_t* Bt, int ldb, int M, int N, int K, char* lds, Epi epi, int ncol0 = 0) {
    const int nM = M / 128, nN = N / 256, nwg = nM * nN;
    const bool sw = (nb & 7) == 0;
    for (int L = bid; L < nwg; L += nb) {
        int wg = L;
        if (sw) { const int q = nwg >> 3, r = nwg & 7, xcd = L & 7, off = L >> 3; wg = (xcd < r ? xcd * (q + 1) : r * (q + 1) + (xcd - r) * q) + off; }
        const int nig = 8 * nN, gid = wg / nig, fm = gid * 8, gsz = (nM - fm) < 8 ? (nM - fm) : 8;
        const int pm = fm + (wg % nig) % gsz, pn = (wg % nig) / gsz;
        gemm_tile(A, lda, Bt, ldb, K, pm * 128, ncol0 + pn * 256, lds, epi);
    }
}

typedef short bf16x4 __attribute__((ext_vector_type(4)));
constexpr int HQ_OFF = 0, HK_OFF = 16384, HKT_OFF = 32768, HVT_OFF = 49152, HD_OFF = 57344, HG_LDS = 59392;
__device__ __forceinline__ int hg_row(int b, int dir, int p) {
    if (p < LC) { const int s = dir ? (LC - 1 - p) : p; return TL + b * LC + s; }
    const int t = dir ? (SEQ - 1 - (p - LC)) : (p - LC);
    return b * SEQ + t;
}
__device__ void ph_hgrn(int bid, int nb, const bf16_t* __restrict__ projH, const float* __restrict__ lb, bf16_t* __restrict__ of, bf16_t* __restrict__ ob, char* lds) {
    const int tid = threadIdx.x, lane = tid & 63, w = tid >> 6, fr = lane & 15, fq = lane >> 4;
    for (int it = bid; it < NB * 4 * 2 * 2; it += nb) {
        const int vs = it & 1, dir = (it >> 1) & 1, h = (it >> 2) & 3, b = it >> 4;
        bf16_t* out = dir ? ob : of; const int ldo = dir ? 512 : D;
        const float lb0 = lb[h * 128 + 2 * lane], lb1 = lb[h * 128 + 2 * lane + 1];
        const int fcol = (dir ? 1024 : 512) + h * 128 + 2 * lane, qcol = h * 128 + 2 * lane, vcol = 1536 + h * 128 + vs * 64 + lane;
        f32x4 S[8];
#pragma unroll
        for (int kt = 0; kt < 8; ++kt) S[kt] = (f32x4){0.f, 0.f, 0.f, 0.f};
        unsigned xf[16], xq[16]; bf16_t xv[16];
#define HG_PREFETCH(p0) do { _Pragma("unroll") for (int i = 0; i < 16; ++i) { \
            const size_t rb = (size_t)hg_row(b, dir, (p0) + 16 * w + i) * HGW; \
            xf[i] = *(const unsigned*)(projH + rb + fcol); xq[i] = *(const unsigned*)(projH + rb + qcol); xv[i] = projH[rb + vcol]; } } while (0)
        HG_PREFETCH(0);
        for (int p0 = 0; p0 < NKEY; p0 += 64) {
            __syncthreads();
            {
                float P0 = 1.f, P1 = 1.f, kp0 = 0.f, kp1 = 0.f;
                unsigned kt0[8], kt1[8], vt[8];
#pragma unroll
                for (int i = 0; i < 16; ++i) {
                    const float u0 = __uint_as_float(xf[i] << 16), u1 = __uint_as_float(xf[i] & 0xffff0000u);
                    const float xq0 = __uint_as_float(xq[i] << 16), xq1 = __uint_as_float(xq[i] & 0xffff0000u);
                    const float nf0 = (1.f - lb0) * u0, nf1 = (1.f - lb1) * u1;
                    P0 *= 1.f - nf0; P1 *= 1.f - nf1;
                    const float q0 = xq0 * P0, q1 = xq1 * P1;
                    const float k0 = nf0 * fminf(__builtin_amdgcn_rcpf(P0), 5.0e34f);
                    const float k1 = nf1 * fminf(__builtin_amdgcn_rcpf(P1), 5.0e34f);
                    const int t = 16 * w + i;
                    const int o = t * 256 + (((lane >> 2) ^ (t & 15)) << 4) + (lane & 3) * 4;
                    *(unsigned*)(lds + HQ_OFF + o) = pack2(q0, q1);
                    *(unsigned*)(lds + HK_OFF + o) = pack2(k0, k1);
                    if (i & 1) { kt0[i >> 1] = pack2(kp0, k0); kt1[i >> 1] = pack2(kp1, k1); vt[i >> 1] = (unsigned)xv[i - 1] | ((unsigned)xv[i] << 16); }
                    else { kp0 = k0; kp1 = k1; }
                }
                float2 dd; dd.x = P0; dd.y = P1;
                *(float2*)(lds + HD_OFF + (w * 128 + 2 * lane) * 4) = dd;
                char* kp = lds + HKT_OFF + w * 4096 + (2 * lane) * 32;
                *(uint4*)(kp) = make_uint4(kt0[0], kt0[1], kt0[2], kt0[3]); *(uint4*)(kp + 16) = make_uint4(kt0[4], kt0[5], kt0[6], kt0[7]);
                *(uint4*)(kp + 32) = make_uint4(kt1[0], kt1[1], kt1[2], kt1[3]); *(uint4*)(kp + 48) = make_uint4(kt1[4], kt1[5], kt1[6], kt1[7]);
                char* vp = lds + HVT_OFF + w * 2048 + lane * 32;
                *(uint4*)(vp) = make_uint4(vt[0], vt[1], vt[2], vt[3]); *(uint4*)(vp + 16) = make_uint4(vt[4], vt[5], vt[6], vt[7]);
            }
            if (p0 + 64 < NKEY) HG_PREFETCH(p0 + 64);
            __syncthreads();
#pragma unroll
            for (int I = 0; I < 4; ++I) {
                const int trow = 16 * I + fr;
                f32x4 at = (f32x4){0.f, 0.f, 0.f, 0.f};
#pragma unroll
                for (int ks = 0; ks < 4; ++ks) {
                    const int o = trow * 256 + (((ks * 4 + fq) ^ fr) << 4);
                    const bf16x8 ka = *(const bf16x8*)(lds + HK_OFF + o);
                    const bf16x8 qa = *(const bf16x8*)(lds + HQ_OFF + o);
                    at = __builtin_amdgcn_mfma_f32_16x16x32_bf16(ka, qa, at, 0, 0, 0);
                }
#pragma unroll
                for (int j = 0; j < 4; ++j) if (4 * fq + j > fr) at[j] = 0.f;
                uint2 pa2; pa2.x = pack2(at[0], at[1]); pa2.y = pack2(at[2], at[3]);
                const bf16x4 pA = __builtin_bit_cast(bf16x4, pa2);
                const bf16x4 vfrag = *(const bf16x4*)(lds + HVT_OFF + I * 2048 + (w * 16 + fr) * 32 + fq * 8);
                f32x4 o1 = __builtin_amdgcn_mfma_f32_16x16x16bf16_1k(vfrag, pA, (f32x4){0.f, 0.f, 0.f, 0.f}, 0, 0, 0);
                f32x4 o2 = (f32x4){0.f, 0.f, 0.f, 0.f};
#pragma unroll
                for (int kt = 0; kt < 8; ++kt) {
                    uint2 s2; s2.x = pack2(S[kt][0], S[kt][1]); s2.y = pack2(S[kt][2], S[kt][3]);
                    const bf16x4 sfrag = __builtin_bit_cast(bf16x4, s2);
                    const bf16x4 qfrag = *(const bf16x4*)(lds + HQ_OFF + trow * 256 + (((kt * 2 + (fq >> 1)) ^ fr) << 4) + (fq & 1) * 8);
                    if (kt & 1) o2 = __builtin_amdgcn_mfma_f32_16x16x16bf16_1k(sfrag, qfrag, o2, 0, 0, 0);
                    else o1 = __builtin_amdgcn_mfma_f32_16x16x16bf16_1k(sfrag, qfrag, o1, 0, 0, 0);
                }
#pragma unroll
                for (int kt = 0; kt < 8; ++kt) {
                    const bf16x4 kfrag = *(const bf16x4*)(lds + HKT_OFF + I * 4096 + (kt * 16 + fr) * 32 + fq * 8);
                    const f32x4 d4 = *(const f32x4*)(lds + HD_OFF + (I * 128 + kt * 16 + fq * 4) * 4);
                    S[kt] = __builtin_amdgcn_mfma_f32_16x16x16bf16_1k(kfrag, vfrag, S[kt], 0, 0, 0);
                    S[kt] = S[kt] * d4;
                }
                const size_t orow = (size_t)hg_row(b, dir, p0 + trow);
                uint2 ov; ov.x = pack2(o1[0] + o2[0], o1[1] + o2[1]); ov.y = pack2(o1[2] + o2[2], o1[3] + o2[3]);
                *(uint2*)(out + orow * ldo + h * 128 + vs * 64 + w * 16 + fq * 4) = ov;
            }
        }
#undef HG_PREFETCH
    }
}
__device__ void ph_hgpost(int bid, int nb, const bf16_t* __restrict__ of, const bf16_t* __restrict__ ob, const bf16_t* __restrict__ projH,
                          const float* __restrict__ g, bf16_t* __restrict__ mix) {
    const int lane = threadIdx.x & 63, wid = threadIdx.x >> 6, l16 = lane & 15;
    const float4 g0 = *(const float4*)(g + l16 * 8), g1 = *(const float4*)(g + l16 * 8 + 4);
    const float gw[8] = {g0.x, g0.y, g0.z, g0.w, g1.x, g1.y, g1.z, g1.w};
    for (int it = (bid * 4 + wid) * 4 + (lane >> 4); it < TA * 4; it += nb * 16) {
        const int row = it >> 2, h = it & 3;
        const uint4 a = *(const uint4*)(of + (size_t)row * D + h * 128 + l16 * 8), bb = *(const uint4*)(ob + (size_t)row * 512 + h * 128 + l16 * 8);
        const uint4 gg = *(const uint4*)(projH + (size_t)row * HGW + 2048 + h * 128 + l16 * 8);
        const unsigned aw[4] = {a.x, a.y, a.z, a.w}, bw[4] = {bb.x, bb.y, bb.z, bb.w}, gv[4] = {gg.x, gg.y, gg.z, gg.w};
        float x[8], ss = 0.f;
#pragma unroll
        for (int j = 0; j < 4; ++j) {
            x[2 * j] = __uint_as_float(aw[j] << 16) + __uint_as_float(bw[j] << 16);
            x[2 * j + 1] = __uint_as_float(aw[j] & 0xffff0000u) + __uint_as_float(bw[j] & 0xffff0000u);
            ss += x[2 * j] * x[2 * j] + x[2 * j + 1] * x[2 * j + 1];
        }
        ss += __int_as_float(__builtin_amdgcn_update_dpp(0, __float_as_int(ss), 0xB1, 0xF, 0xF, true));
        ss += __int_as_float(__builtin_amdgcn_update_dpp(0, __float_as_int(ss), 0x4E, 0xF, 0xF, true));
        ss += __int_as_float(__builtin_amdgcn_update_dpp(0, __float_as_int(ss), 0x141, 0xF, 0xF, true));
        ss += __int_as_float(__builtin_amdgcn_update_dpp(0, __float_as_int(ss), 0x140, 0xF, 0xF, true));
        const float rinv = rsqrtf(ss * (1.0f / 128.0f) + EPS);
        unsigned ow[4];
#pragma unroll
        for (int j = 0; j < 4; ++j) {
            const float y0 = x[2 * j] * rinv * gw[2 * j] * siluf_(__uint_as_float(gv[j] << 16));
            const float y1 = x[2 * j + 1] * rinv * gw[2 * j + 1] * siluf_(__uint_as_float(gv[j] & 0xffff0000u));
            ow[j] = pack2(y0, y1);
        }
        *(uint4*)(mix + (size_t)row * D + h * 128 + l16 * 8) = make_uint4(ow[0], ow[1], ow[2], ow[3]);
    }
}

__device__ void ph_prep_swa(int bid, int nb, bf16_t* __restrict__ P, const float* __restrict__ cosS, const float* __restrict__ sinS) {
    const int n = TA * 40;
    for (int idx = bid * blockDim.x + threadIdx.x; idx < n; idx += nb * blockDim.x) {
        const int row = idx / 40, pr = idx - row * 40, head = pr >> 2, d = (pr & 3) * 8;
        bf16_t* p = P + (size_t)row * SWW + head * 64 + d;
        const uint4 a = *(const uint4*)p, b = *(const uint4*)(p + 32);
        const unsigned aw[4] = {a.x, a.y, a.z, a.w}, bw[4] = {b.x, b.y, b.z, b.w};
        float x1[8], x2[8];
#pragma unroll
        for (int j = 0; j < 4; ++j) {
            x1[2 * j] = __uint_as_float(aw[j] << 16); x1[2 * j + 1] = __uint_as_float(aw[j] & 0xffff0000u);
            x2[2 * j] = __uint_as_float(bw[j] << 16); x2[2 * j + 1] = __uint_as_float(bw[j] & 0xffff0000u);
        }
        if (row < TL) {
            const int t = row & (SEQ - 1);
            const float4 c0 = *(const float4*)(cosS + t * 32 + d), c1 = *(const float4*)(cosS + t * 32 + d + 4);
            const float4 s0 = *(const float4*)(sinS + t * 32 + d), s1 = *(const float4*)(sinS + t * 32 + d + 4);
            const float cc[8] = {c0.x, c0.y, c0.z, c0.w, c1.x, c1.y, c1.z, c1.w}, ss[8] = {s0.x, s0.y, s0.z, s0.w, s1.x, s1.y, s1.z, s1.w};
#pragma unroll
            for (int j = 0; j < 8; ++j) { const float y1 = x1[j] * cc[j] - x2[j] * ss[j], y2 = x1[j] * ss[j] + x2[j] * cc[j]; x1[j] = y1; x2[j] = y2; }
        }
        if (head < 8) {
#pragma unroll
            for (int j = 0; j < 8; ++j) { x1[j] *= 0.125f * LOG2E; x2[j] *= 0.125f * LOG2E; }
        }
        uint4 oa, ob;
        oa.x = pack2(x1[0], x1[1]); oa.y = pack2(x1[2], x1[3]); oa.z = pack2(x1[4], x1[5]); oa.w = pack2(x1[6], x1[7]);
        ob.x = pack2(x2[0], x2[1]); ob.y = pack2(x2[2], x2[3]); ob.z = pack2(x2[4], x2[5]); ob.w = pack2(x2[6], x2[7]);
        *(uint4*)p = oa; *(uint4*)(p + 32) = ob;
    }
}
__device__ void ph_prep_ga(int bid, int nb, bf16_t* __restrict__ P, const float* __restrict__ qg, const float* __restrict__ kg,
                           const float* __restrict__ cosG, const float* __restrict__ sinG) {
    const int lane = threadIdx.x & 63, wid = threadIdx.x >> 6;
    for (int it = bid * 4 + wid; it < TA * 10; it += nb * 4) {
        const int row = it / 10, head = it % 10;
        bf16_t* p = P + (size_t)row * GA_IN + head * 128;
        float x1 = bf2f(p[lane]), x2 = bf2f(p[lane + 64]);
        const float ss = wave_sum(x1 * x1 + x2 * x2);
        const float rinv = rsqrtf(ss * (1.0f / 128.0f) + EPS);
        const float* g = head < 8 ? qg : kg;
        x1 = x1 * rinv * g[lane]; x2 = x2 * rinv * g[lane + 64];
        if (row < TL) {
            const int t = row & (SEQ - 1);
            const float c = cosG[t * 64 + lane], s = sinG[t * 64 + lane];
            const float y1 = x1 * c - x2 * s, y2 = x1 * s + x2 * c;
            x1 = y1; x2 = y2;
        }
        if (head < 8) { x1 *= 0.08838834764831845f * LOG2E; x2 *= 0.08838834764831845f * LOG2E; }
        p[lane] = f2bf(x1); p[lane + 64] = f2bf(x2);
    }
}

template <int HD>
__device__ void ph_vt(int bid, int nb, const bf16_t* __restrict__ P, int ldp, int vcol, bf16_t* __restrict__ Vt, bf16_t* lds) {
    constexpr int ND = HD / 64;
    const int tid = threadIdx.x;
    for (int it = bid; it < NB * 2 * ND * (NKEY / 64); it += nb) {
        const int kt = it % (NKEY / 64), r1 = it / (NKEY / 64), dh = r1 % ND, g = r1 / ND, b = g >> 1, kvh = g & 1;
        const int k0 = kt * 64;
        const int row0 = k0 < LC ? TL + b * LC + k0 : b * SEQ + (k0 - LC);
        __syncthreads();
#pragma unroll
        for (int i = 0; i < 2; ++i) {
            const int id = tid + i * 256, kr = id >> 3, c = id & 7;
            const uint4 w = *(const uint4*)(P + (size_t)(row0 + kr) * ldp + vcol + kvh * HD + dh * 64 + c * 8);
            const unsigned ww[4] = {w.x, w.y, w.z, w.w};
#pragma unroll
            for (int j = 0; j < 4; ++j) { lds[kr * 66 + c * 8 + j * 2] = (bf16_t)(ww[j] & 0xffff); lds[kr * 66 + c * 8 + j * 2 + 1] = (bf16_t)(ww[j] >> 16); }
        }
        __syncthreads();
#pragma unroll
        for (int i = 0; i < 2; ++i) {
            const int id = tid + i * 256, d = id >> 3, c = id & 7;
            unsigned o[4];
#pragma unroll
            for (int j = 0; j < 4; ++j) o[j] = (unsigned)lds[(c * 8 + j * 2) * 66 + d] | ((unsigned)lds[(c * 8 + j * 2 + 1) * 66 + d] << 16);
            uint4 w; w.x = o[0]; w.y = o[1]; w.z = o[2]; w.w = o[3];
            *(uint4*)(Vt + (size_t)(g * HD + dh * 64 + d) * NKEY + k0 + c * 8) = w;
        }
    }
}

template <int HD, bool MASK>
__device__ __forceinline__ void flash_item(const bf16_t* __restrict__ Qrow0, int ldq, const bf16_t* __restrict__ Kp, int ldk,
                                           const bf16_t* __restrict__ Vt, int krow_ctx0, int krow_lat0, int nctx_t, int lat_lo, int nlat_t,
                                           int tq0, float m0, float l0, bf16_t* __restrict__ Orow0, int ldo, char* lds) {
    constexpr int NCH = HD / 32;
    constexpr int KB = 64 * HD * 2;
    constexpr int NKK = HD / 16;
    constexpr int NDT = HD / 32;
    const int tid = threadIdx.x, lane = tid & 63, w = tid >> 6, r = lane & 31, h = lane >> 5;
    const int pr = (r & 0x13) | ((r & 4) << 1) | ((r & 8) >> 1);
    bf16x8 qf[NKK];
    {
        const bf16_t* qp = Qrow0 + (size_t)(32 * w + r) * ldq + 8 * h;
#pragma unroll
        for (int kk = 0; kk < NKK; ++kk) qf[kk] = *(const bf16x8*)(qp + 16 * kk);
    }
    f32x16 O[NDT];
#pragma unroll
    for (int dt = 0; dt < NDT; ++dt)
#pragma unroll
        for (int i = 0; i < 16; ++i) O[dt][i] = 0.f;
    float m_run = m0, l_run = (h == 0) ? l0 : 0.f;
    typedef __attribute__((address_space(3))) char las_char;
    las_char* l3 = (las_char*)lds;
    constexpr int KRI = (HD == 128) ? 4 : 8;
    constexpr int NKI = 16 / KRI;
    constexpr int NVI = HD / 32;
    const int krl = (HD == 128) ? (lane >> 4) : (lane >> 3);
    const int kpl = (HD == 128) ? (lane & 15) : (lane & 7);
    const int vrl = lane >> 3, vpl = lane & 7;
    const int kfo = pr * (HD * 2);
    const int kfs = (HD == 128) ? (pr & 15) : ((pr >> 1) & 7);
    const int vfo = KB + r * 128;
    const int vfs = (r >> 1) & 7;
    const int ntile = nctx_t + nlat_t;
#define FA_TILE(t, krow0, kidx0, s0) const int krow0 = (t) < nctx_t ? krow_ctx0 + 64 * (t) : krow_lat0 + lat_lo + 64 * ((t) - nctx_t); \
        const int s0 = (t) < nctx_t ? -(1 << 24) : lat_lo + 64 * ((t) - nctx_t); const int kidx0 = (t) < nctx_t ? 64 * (t) : LC + lat_lo + 64 * ((t) - nctx_t);
#define FA_STAGE(t, buf) do { FA_TILE(t, _kr0, _ki0, _s0) (void)_s0; \
        _Pragma("unroll") for (int i = 0; i < NKI; ++i) { const int _row = 16 * w + KRI * i + krl; \
            const int _c = (HD == 128) ? (kpl ^ (_row & 15)) : (kpl ^ ((_row >> 1) & 7)); \
            __builtin_amdgcn_global_load_lds((const unsigned*)(Kp + (size_t)(_kr0 + _row) * ldk + _c * 8), \
                (__attribute__((address_space(3))) unsigned*)(l3 + (buf) * (2 * KB) + (16 * w + KRI * i) * (HD * 2)), 16, 0, 0); } \
        _Pragma("unroll") for (int i = 0; i < NVI; ++i) { const int _row = (HD / 4) * w + 8 * i + vrl; const int _c = vpl ^ ((_row >> 1) & 7); \
            __builtin_amdgcn_global_load_lds((const unsigned*)(Vt + (size_t)_row * NKEY + _ki0 + _c * 8), \
                (__attribute__((address_space(3))) unsigned*)(l3 + (buf) * (2 * KB) + KB + ((HD / 4) * w + 8 * i) * 128), 16, 0, 0); } } while (0)
    __syncthreads();
    FA_STAGE(0, 0);
    __syncthreads();
    for (int t = 0; t < ntile; ++t) {
        if (t + 1 < ntile) FA_STAGE(t + 1, (t + 1) & 1);
        const char* base = lds + (t & 1) * (2 * KB);
        f32x16 st[2];
        __builtin_amdgcn_s_setprio(1);
#pragma unroll
        for (int rt = 0; rt < 2; ++rt) {
#pragma unroll
            for (int i = 0; i < 16; ++i) st[rt][i] = 0.f;
#pragma unroll
            for (int kk = 0; kk < NKK; ++kk) {
                const bf16x8 kf = *(const bf16x8*)(base + rt * 32 * (HD * 2) + kfo + (((2 * kk + h) ^ kfs) << 4));
                st[rt] = __builtin_amdgcn_mfma_f32_32x32x16_bf16(kf, qf[kk], st[rt], 0, 0, 0);
                if ((kk & 7) == 7) __builtin_amdgcn_sched_barrier(0);
            }
        }
        __builtin_amdgcn_s_setprio(0);
        if (MASK) {
            FA_TILE(t, _kr0, _ki0, s0) (void)_kr0; (void)_ki0;
            if (t >= nctx_t) {
                const int tq = tq0 + 32 * w + r;
#pragma unroll
                for (int rt = 0; rt < 2; ++rt)
#pragma unroll
                    for (int i = 0; i < 16; ++i) {
                        const int s = s0 + 32 * rt + (i & 3) + 4 * ((i >> 2) & 1) + 8 * h + 16 * (i >> 3);
                        const int dlt = tq - s;
                        if (dlt > 128 || dlt < -128) st[rt][i] = -1.0e30f;
                    }
            }
        }
        constexpr float FA_THR = 11.5f;
        float pmax = st[0][0];
#pragma unroll
        for (int rt = 0; rt < 2; ++rt)
#pragma unroll
            for (int i = 0; i < 16; ++i) pmax = fmaxf(pmax, st[rt][i]);
        pmax = fmaxf(pmax, __shfl_xor(pmax, 32));
        float mx = m_run, alpha = 1.0f;
        if (!__all(pmax - m_run <= FA_THR)) {
            mx = fmaxf(m_run, pmax);
            alpha = __builtin_amdgcn_exp2f(m_run - mx);
            m_run = mx;
        }
        float ps = 0.f;
#pragma unroll
        for (int rt = 0; rt < 2; ++rt)
#pragma unroll
            for (int i = 0; i < 16; ++i) { const float p = __builtin_amdgcn_exp2f(st[rt][i] - mx); st[rt][i] = p; ps += p; }
        l_run = l_run * alpha + ps;
        if (!__all(alpha == 1.0f)) {
#pragma unroll
            for (int dt = 0; dt < NDT; ++dt)
#pragma unroll
                for (int i = 0; i < 16; ++i) O[dt][i] *= alpha;
        }
        bf16x8 pf[2][2];
#pragma unroll
        for (int rt = 0; rt < 2; ++rt)
#pragma unroll
            for (int s2 = 0; s2 < 2; ++s2) {
                uint4 pk;
                pk.x = pack2(st[rt][8 * s2 + 0], st[rt][8 * s2 + 1]); pk.y = pack2(st[rt][8 * s2 + 2], st[rt][8 * s2 + 3]);
                pk.z = pack2(st[rt][8 * s2 + 4], st[rt][8 * s2 + 5]); pk.w = pack2(st[rt][8 * s2 + 6], st[rt][8 * s2 + 7]);
                pf[rt][s2] = __builtin_bit_cast(bf16x8, pk);
            }
#pragma unroll
        for (int dt = 0; dt < NDT; ++dt)
#pragma unroll
            for (int rt = 0; rt < 2; ++rt)
#pragma unroll
                for (int s2 = 0; s2 < 2; ++s2) {
                    const bf16x8 vf = *(const bf16x8*)(base + vfo + dt * 4096 + (((4 * rt + 2 * s2 + h) ^ vfs) << 4));
                    O[dt] = __builtin_amdgcn_mfma_f32_32x32x16_bf16(vf, pf[rt][s2], O[dt], 0, 0, 0);
                    if (rt == 1 && s2 == 1) __builtin_amdgcn_sched_barrier(0);
                }
        __syncthreads();
    }
#undef FA_TILE
#undef FA_STAGE
    const float lt = l_run + __shfl_xor(l_run, 32);
    const float inv = 1.0f / lt;
    char* wl = lds + w * (32 * (HD * 2 + 16));
#pragma unroll
    for (int dt = 0; dt < NDT; ++dt)
#pragma unroll
        for (int g = 0; g < 4; ++g) {
            uint2 o2; o2.x = pack2(O[dt][4 * g] * inv, O[dt][4 * g + 1] * inv); o2.y = pack2(O[dt][4 * g + 2] * inv, O[dt][4 * g + 3] * inv);
            *(uint2*)(wl + r * (HD * 2 + 16) + (32 * dt + 8 * g + 4 * h) * 2) = o2;
        }
    constexpr int LPR = HD / 8;
#pragma unroll
    for (int m = 0; m < 32 * LPR / 64; ++m) {
        const int rr = (lane / LPR) + (64 / LPR) * m, ch = lane % LPR;
        const uint4 v = *(const uint4*)(wl + rr * (HD * 2 + 16) + ch * 16);
        *(uint4*)(Orow0 + (size_t)(32 * w + rr) * ldo + ch * 8) = v;
    }
}
__device__ void ph_swa(int bid, int nb, const bf16_t* __restrict__ projS, const bf16_t* __restrict__ Vt, const float* __restrict__ sink,
                       bf16_t* __restrict__ mix, char* lds) {
    const int n_lat = NB * 8 * 32, n_ctx = NB * 8 * 2;
    for (int it = bid; it < n_lat + n_ctx; it += nb) {
        int b, hq, row0, lo, nlat, t0;
        if (it < n_lat) {
            const int qb = it & 31; hq = (it >> 5) & 7; b = it >> 8;
            t0 = qb * 128;
            lo = t0 - 128 < 0 ? 0 : t0 - 128;
            const int hi = t0 + 256 > SEQ ? SEQ : t0 + 256;
            nlat = (hi - lo) / 64; row0 = b * SEQ + t0;
        } else {
            const int i2 = it - n_lat, qb = i2 & 1; hq = (i2 >> 1) & 7; b = i2 >> 4;
            t0 = 0; lo = 0; nlat = 0; row0 = TL + b * LC + qb * 128;
        }
        const int kvh = hq >> 2;
        flash_item<64, true>(projS + (size_t)row0 * SWW + hq * 64, SWW, projS + 512 + kvh * 64, SWW, Vt + (size_t)(b * 2 + kvh) * 64 * NKEY,
                             TL + b * LC, b * SEQ, 4, lo, nlat, t0, sink[hq] * LOG2E, 1.0f, mix + (size_t)row0 * D + 512 + hq * 64, D, lds);
    }
}
__device__ void ph_dense(int bid, int nb, const bf16_t* __restrict__ projG, const bf16_t* __restrict__ Vt, bf16_t* __restrict__ mix, char* lds) {
    const bool sw = (nb & 7) == 0;
    const int nit = NB * 8 * 32;
    for (int j = sw ? (bid >> 3) : bid; j < (sw ? nit / 8 : nit); j += sw ? (nb >> 3) : nb) {
        int g, jj;
        if (sw) { g = (bid & 7) + 8 * (j >> 7); jj = j & 127; } else { g = j >> 7; jj = j & 127; }
        const int b = g >> 1, kvh = g & 1, hq = kvh * 4 + (jj >> 5), qb = jj & 31;
        const int row0 = b * SEQ + qb * 128;
        flash_item<128, false>(projG + (size_t)row0 * GA_IN + hq * 128, GA_IN, projG + 1024 + kvh * 128, GA_IN, Vt + (size_t)(b * 2 + kvh) * 128 * NKEY,
                               TL + b * LC, b * SEQ, 4, 0, SEQ / 64, 0, -1.0e30f, 0.0f, mix + (size_t)row0 * D + hq * 128, D, lds);
    }
}

#define CE(a, b) { const float _h = fmaxf(a, b); b = fminf(a, b); a = _h; }
__device__ __forceinline__ void net_sort16(float (&v)[16]) {
    CE(v[0], v[1]); CE(v[3], v[2]); CE(v[4], v[5]); CE(v[7], v[6]); CE(v[8], v[9]); CE(v[11], v[10]);
    CE(v[12], v[13]); CE(v[15], v[14]); CE(v[0], v[2]); CE(v[1], v[3]); CE(v[6], v[4]); CE(v[7], v[5]);
    CE(v[8], v[10]); CE(v[9], v[11]); CE(v[14], v[12]); CE(v[15], v[13]); CE(v[0], v[1]); CE(v[2], v[3]);
    CE(v[5], v[4]); CE(v[7], v[6]); CE(v[8], v[9]); CE(v[10], v[11]); CE(v[13], v[12]); CE(v[15], v[14]);
    CE(v[0], v[4]); CE(v[1], v[5]); CE(v[2], v[6]); CE(v[3], v[7]); CE(v[12], v[8]); CE(v[13], v[9]);
    CE(v[14], v[10]); CE(v[15], v[11]); CE(v[0], v[2]); CE(v[1], v[3]); CE(v[4], v[6]); CE(v[5], v[7]);
    CE(v[10], v[8]); CE(v[11], v[9]); CE(v[14], v[12]); CE(v[15], v[13]); CE(v[0], v[1]); CE(v[2], v[3]);
    CE(v[4], v[5]); CE(v[6], v[7]); CE(v[9], v[8]); CE(v[11], v[10]); CE(v[13], v[12]); CE(v[15], v[14]);
    CE(v[0], v[8]); CE(v[1], v[9]); CE(v[2], v[10]); CE(v[3], v[11]); CE(v[4], v[12]); CE(v[5], v[13]);
    CE(v[6], v[14]); CE(v[7], v[15]); CE(v[0], v[4]); CE(v[1], v[5]); CE(v[2], v[6]); CE(v[3], v[7]);
    CE(v[8], v[12]); CE(v[9], v[13]); CE(v[10], v[14]); CE(v[11], v[15]); CE(v[0], v[2]); CE(v[1], v[3]);
    CE(v[4], v[6]); CE(v[5], v[7]); CE(v[8], v[10]); CE(v[9], v[11]); CE(v[12], v[14]); CE(v[13], v[15]);
    CE(v[0], v[1]); CE(v[2], v[3]); CE(v[4], v[5]); CE(v[6], v[7]); CE(v[8], v[9]); CE(v[10], v[11]);
    CE(v[12], v[13]); CE(v[14], v[15]);
}
__device__ __forceinline__ void net_clean16(float (&v)[16]) {
    CE(v[0], v[8]); CE(v[1], v[9]); CE(v[2], v[10]); CE(v[3], v[11]); CE(v[4], v[12]); CE(v[5], v[13]);
    CE(v[6], v[14]); CE(v[7], v[15]); CE(v[0], v[4]); CE(v[1], v[5]); CE(v[2], v[6]); CE(v[3], v[7]);
    CE(v[8], v[12]); CE(v[9], v[13]); CE(v[10], v[14]); CE(v[11], v[15]); CE(v[0], v[2]); CE(v[1], v[3]);
    CE(v[4], v[6]); CE(v[5], v[7]); CE(v[8], v[10]); CE(v[9], v[11]); CE(v[12], v[14]); CE(v[13], v[15]);
    CE(v[0], v[1]); CE(v[2], v[3]); CE(v[4], v[5]); CE(v[6], v[7]); CE(v[8], v[9]); CE(v[10], v[11]);
    CE(v[12], v[13]); CE(v[14], v[15]);
}
__device__ __forceinline__ void net_merge16(float (&a)[16], const float (&b)[16]) {
#pragma unroll
    for (int i = 0; i < 16; ++i) a[i] = fmaxf(a[i], b[15 - i]);
    net_clean16(a);
}
#define PEER_CANDS(F) F(0,0,0) F(1,0,1) F(2,0,2) F(3,0,3) F(4,0,4) F(5,0,5) F(6,0,6) F(7,0,7) F(8,0,8) F(9,0,9) F(10,0,10) F(11,0,11) F(12,0,12) F(13,0,13) F(14,0,14) F(15,0,15) F(16,1,1) F(17,1,2) F(18,1,3) F(19,1,4) F(20,1,5) F(21,1,6) F(22,1,7) F(23,2,2) F(24,2,3) F(25,2,4) F(26,3,3)

__device__ __forceinline__ void ph_peer_route(int bid, int nb, const bf16_t* __restrict__ qpeer, const bf16_t* __restrict__ SK, int* __restrict__ sel_e,
                              float* __restrict__ sel_g, int M, char* lds) {
    const int tid = tidx(), lane = tid & 63, w = tid >> 6, r = lane & 31, h2 = lane >> 5;
    const int srow = tid >> 4, sc = tid & 15;
    const int soff = srow * 256 + ((sc ^ (srow & 15)) << 4);
    int hd_loaded = -1;
    for (int it = bid; it < (M / 128) * 8; it += nb) {
        const int m0 = (it >> 3) * 128, hd = it & 7;
        const int row = 32 * w + r;
        __syncthreads();
        if (hd != hd_loaded) {
        hd_loaded = hd;
#pragma unroll
        for (int pp = 0; pp < 2; ++pp) {
            const bf16_t* sp = SK + ((size_t)(hd * 2 + pp) * 128 + srow) * 128 + sc * 8;
            uint4 t0 = *(const uint4*)(sp), t1 = *(const uint4*)(sp + 16 * 128), t2 = *(const uint4*)(sp + 32 * 128), t3 = *(const uint4*)(sp + 48 * 128);
            uint4 t4 = *(const uint4*)(sp + 64 * 128), t5 = *(const uint4*)(sp + 80 * 128), t6 = *(const uint4*)(sp + 96 * 128), t7 = *(const uint4*)(sp + 112 * 128);
            char* d = lds + pp * 32768 + soff;
            *(uint4*)(d) = t0; *(uint4*)(d + 4096) = t1; *(uint4*)(d + 8192) = t2; *(uint4*)(d + 12288) = t3;
            *(uint4*)(d + 16384) = t4; *(uint4*)(d + 20480) = t5; *(uint4*)(d + 24576) = t6; *(uint4*)(d + 28672) = t7;
        }
        }
        __syncthreads();
        float L0[16], L1[16];
#pragma unroll
        for (int pp = 0; pp < 2; ++pp) {
            bf16x8 qf[8];
            const bf16_t* qp = qpeer + (size_t)(m0 + row) * PQ + hd * 256 + pp * 128 + 8 * h2;
#pragma unroll
            for (int kk = 0; kk < 8; ++kk) qf[kk] = *(const bf16x8*)(qp + 16 * kk);
            float g[4][16];
#pragma unroll
            for (int kt = 0; kt < 4; ++kt) {
                f32x16 st;
#pragma unroll
                for (int i = 0; i < 16; ++i) st[i] = 0.f;
#pragma unroll
                for (int kk = 0; kk < 8; ++kk) {
                    const bf16x8 kf = *(const bf16x8*)(lds + pp * 32768 + (32 * kt + r) * 256 + (((2 * kk + h2) ^ (r & 15)) << 4));
                    st = __builtin_amdgcn_mfma_f32_32x32x16_bf16(kf, qf[kk], st, 0, 0, 0);
                }
#pragma unroll
                for (int i = 0; i < 16; ++i) {
                    const unsigned n = 32 * kt + (i & 3) + 8 * (i >> 2) + 4 * h2;
                    g[kt][i] = __uint_as_float((__float_as_uint(st[i]) & 0xFFFFFF80u) | n);
                }
            }
            net_sort16(g[0]); net_sort16(g[1]); net_sort16(g[2]); net_sort16(g[3]);
            net_merge16(g[0], g[1]); net_merge16(g[2], g[3]); net_merge16(g[0], g[2]);
            float pb[16];
#pragma unroll
            for (int i = 0; i < 16; ++i) pb[i] = __shfl_xor(g[0][i], 32);
            net_merge16(g[0], pb);
#pragma unroll
            for (int i = 0; i < 16; ++i) { if (pp == 0) L0[i] = g[0][i]; else L1[i] = g[0][i]; }
        }
        __syncthreads();
        unsigned char* tab = (unsigned char*)lds + 65536;
        if (h2 == 0) {
            unsigned wv[8];
#pragma unroll
            for (int j = 0; j < 4; ++j) {
                wv[j] = (__float_as_uint(L0[4 * j]) & 0x7Fu) | ((__float_as_uint(L0[4 * j + 1]) & 0x7Fu) << 8) | ((__float_as_uint(L0[4 * j + 2]) & 0x7Fu) << 16) | ((__float_as_uint(L0[4 * j + 3]) & 0x7Fu) << 24);
                wv[4 + j] = (__float_as_uint(L1[4 * j]) & 0x7Fu) | ((__float_as_uint(L1[4 * j + 1]) & 0x7Fu) << 8) | ((__float_as_uint(L1[4 * j + 2]) & 0x7Fu) << 16) | ((__float_as_uint(L1[4 * j + 3]) & 0x7Fu) << 24);
            }
            *(uint4*)(tab + row * 32) = make_uint4(wv[0], wv[1], wv[2], wv[3]);
            *(uint4*)(tab + row * 32 + 16) = make_uint4(wv[4], wv[5], wv[6], wv[7]);
        }
        float X[16], Y[16];
#pragma unroll
        for (int i = 0; i < 16; ++i) {
            const float a0 = __uint_as_float(__float_as_uint(L0[i]) & 0xFFFFFF80u), a1 = __uint_as_float(__float_as_uint(L1[i]) & 0xFFFFFF80u);
            X[i] = h2 ? a1 : a0; Y[i] = h2 ? a0 : a1;
        }
        float c0[16], c1[16];
#define PEER_CAND(i, a, b) { float v = X[a] + Y[b]; if ((a) == (b) && h2) v = -3.0e38f; const unsigned id = h2 ? ((b) * 16 + (a)) : ((a) * 16 + (b)); \
            const float pk = __uint_as_float((__float_as_uint(v) & 0xFFFFFF00u) | id); if ((i) < 16) c0[(i) & 15] = pk; else c1[(i) & 15] = pk; }
        PEER_CANDS(PEER_CAND)
#undef PEER_CAND
#pragma unroll
        for (int i = 11; i < 16; ++i) c1[i] = -3.0e38f;
        net_sort16(c0); net_sort16(c1); net_merge16(c0, c1);
        {
            float pb[16];
#pragma unroll
            for (int i = 0; i < 16; ++i) pb[i] = __shfl_xor(c0[i], 32);
            net_merge16(c0, pb);
        }
        float ex[16], sum = 0.f;
#pragma unroll
        for (int i = 0; i < 16; ++i) { ex[i] = __expf(c0[i] - c0[0]); sum += ex[i]; }
        const float rs = 1.0f / sum;
        const size_t ob = ((size_t)(m0 + row) * 8 + hd) * 16;
        if (h2 == 0) {
            int eo[16];
#pragma unroll
            for (int j = 0; j < 16; ++j) {
                const unsigned id = __float_as_uint(c0[j]) & 0xFFu;
                eo[j] = (int)tab[row * 32 + (id >> 4)] * 128 + (int)tab[row * 32 + 16 + (id & 15)];
            }
#pragma unroll
            for (int j = 0; j < 4; ++j) *(int4*)(sel_e + ob + 4 * j) = make_int4(eo[4 * j], eo[4 * j + 1], eo[4 * j + 2], eo[4 * j + 3]);
        } else {
#pragma unroll
            for (int j = 0; j < 4; ++j) *(float4*)(sel_g + ob + 4 * j) = make_float4(ex[4 * j] * rs, ex[4 * j + 1] * rs, ex[4 * j + 2] * rs, ex[4 * j + 3] * rs);
        }
    }
}
constexpr float USCALE = 64.0f;
typedef long i64_t;
__device__ __forceinline__ i64_t mk64(unsigned lo, unsigned hi) { return (i64_t)(((unsigned long long)hi << 32) | (unsigned long long)lo); }
__device__ __forceinline__ float dpp_add_xor1(float v) {
    return v + __int_as_float(__builtin_amdgcn_update_dpp(0, __float_as_int(v), 0xB1, 0xF, 0xF, true));
}
template <class F>
__device__ __forceinline__ void peer_queue_sweep(unsigned* heads, int nunits, unsigned xcc, unsigned* ldsw, F&& body) {
    for (int rr = 0; rr < 8; ++rr) {
        const int s = (int)((xcc + rr) & 7u);
        for (;;) {
            __syncthreads();
            if (tidx() == 0) *ldsw = __hip_atomic_fetch_add(heads + 64 * s, 1u, __ATOMIC_RELAXED, __HIP_MEMORY_SCOPE_AGENT);
            __syncthreads();
            const int u = __builtin_amdgcn_readfirstlane((int)*ldsw);
            if (u >= nunits) break;
            body(__builtin_amdgcn_readfirstlane(s), u);
        }
    }
}
__device__ __forceinline__ float dpp_sum8(float v) {
    v += __int_as_float(__builtin_amdgcn_update_dpp(0, __float_as_int(v), 0xB1, 0xF, 0xF, true));
    v += __int_as_float(__builtin_amdgcn_update_dpp(0, __float_as_int(v), 0x4E, 0xF, 0xF, true));
    v += __int_as_float(__builtin_amdgcn_update_dpp(0, __float_as_int(v), 0x141, 0xF, 0xF, true));
    return v;
}
__device__ __forceinline__ int dpp_isum8(int v) {
    v += __builtin_amdgcn_update_dpp(0, v, 0xB1, 0xF, 0xF, true);
    v += __builtin_amdgcn_update_dpp(0, v, 0x4E, 0xF, 0xF, true);
    v += __builtin_amdgcn_update_dpp(0, v, 0x141, 0xF, 0xF, true);
    return v;
}
__device__ __forceinline__ void ph_peer_dots(unsigned* heads, unsigned xcc, const unsigned char* __restrict__ xq, const float* __restrict__ xs, const unsigned char* __restrict__ U,
                                             const int* __restrict__ sel_e, bf16_t* __restrict__ part, int ntok, unsigned* ldsw) {
    const int lane = tidx() & 63, wid = __builtin_amdgcn_readfirstlane(tidx() >> 6), c = lane & 7, g = lane >> 3;
    peer_queue_sweep(heads, ntok / 64, xcc, ldsw, [&](int s, int u) {
        const unsigned char* Us = U + (size_t)s * NEXP * 128;
        const int row0 = u * 64 + wid * 16;
        int ek[16]; uint4 xw; float sx;
        {
#pragma unroll
            for (int i = 0; i < 4; ++i) {
                const int4 e4 = *(const int4*)(sel_e + (size_t)row0 * 128 + 16 * g + 4 * i);
                ek[4 * i] = e4.x; ek[4 * i + 1] = e4.y; ek[4 * i + 2] = e4.z; ek[4 * i + 3] = e4.w;
            }
            xw = *(const uint4*)(xq + (size_t)row0 * D + s * 128 + c * 16); sx = xs[row0];
        }
#pragma unroll 1
        for (int ti = 0; ti < 16; ++ti) {
            const int row = row0 + ti, rown = row0 + (ti < 15 ? ti + 1 : ti);
            uint4 ur[16];
#pragma unroll
            for (int k = 0; k < 16; ++k) ur[k] = *(const uint4*)(Us + ((unsigned)ek[k] * 128u + (unsigned)c * 16u));
            int ekn[16];
#pragma unroll
            for (int i = 0; i < 4; ++i) {
                const int4 e4 = *(const int4*)(sel_e + (size_t)rown * 128 + 16 * g + 4 * i);
                ekn[4 * i] = e4.x; ekn[4 * i + 1] = e4.y; ekn[4 * i + 2] = e4.z; ekn[4 * i + 3] = e4.w;
            }
            const uint4 xn = *(const uint4*)(xq + (size_t)rown * D + s * 128 + c * 16); const float sxn = xs[rown];
            int keep0 = 0, keep1 = 0;
#pragma unroll
            for (int k = 0; k < 16; ++k) {
                int a = __builtin_amdgcn_sdot4((int)ur[k].x, (int)xw.x, 0, false);
                a = __builtin_amdgcn_sdot4((int)ur[k].y, (int)xw.y, a, false);
                a = __builtin_amdgcn_sdot4((int)ur[k].z, (int)xw.z, a, false);
                a = __builtin_amdgcn_sdot4((int)ur[k].w, (int)xw.w, a, false);
                const int tot = dpp_isum8(a);
                if ((k & 1) == 0) keep0 = (c == (k >> 1)) ? tot : keep0; else keep1 = (c == (k >> 1)) ? tot : keep1;
            }
            const float fs = sx * (USCALE / UQ);
            *(unsigned*)(part + ((size_t)s * ntok + row) * 128 + 16 * g + 2 * c) = pack2((float)keep0 * fs, (float)keep1 * fs);
#pragma unroll
            for (int k = 0; k < 16; ++k) ek[k] = ekn[k];
            xw = xn; sx = sxn;
        }
    });
}
__device__ void ph_peer_weights(int bid, int nb, const bf16_t* __restrict__ part, float* __restrict__ sel_g, int ntok) {
    const size_t n = (size_t)ntok * 128, n4 = n / 4;
    for (size_t i = (size_t)bid * blockDim.x + tidx(); i < n4; i += (size_t)nb * blockDim.x) {
        float a[4] = {0.f, 0.f, 0.f, 0.f};
#pragma unroll
        for (int s = 0; s < 8; ++s) {
            const uint2 w = *(const uint2*)(part + (size_t)s * n + i * 4);
            a[0] += __uint_as_float(w.x << 16); a[1] += __uint_as_float(w.x & 0xffff0000u); a[2] += __uint_as_float(w.y << 16); a[3] += __uint_as_float(w.y & 0xffff0000u);
        }
        float4 gq = ((const float4*)sel_g)[i];
        float o[4] = {gq.x, gq.y, gq.z, gq.w};
#pragma unroll
        for (int j = 0; j < 4; ++j) { const float dot = a[j] * (1.0f / USCALE); o[j] *= 0.5f * dot * (1.0f + erff(dot * 0.70710678118654752f)); }
        ((float4*)sel_g)[i] = make_float4(o[0], o[1], o[2], o[3]);
    }
}
__device__ __forceinline__ void ph_peer_vsum(unsigned* heads, unsigned xcc, const unsigned char* __restrict__ V, const int* __restrict__ sel_e,
                                             const float* __restrict__ sel_w, const float* __restrict__ gate  ,
                                             bf16_t* __restrict__ h16, int ntok, unsigned* ldsw) {
    const int lane = tidx() & 63, wid = __builtin_amdgcn_readfirstlane(tidx() >> 6), c = lane & 7, g = lane >> 3;
    peer_queue_sweep(heads, ntok / 64, xcc, ldsw, [&](int s, int u) {
        const unsigned char* Vs = V + (size_t)s * NEXP * 128;
        const int rbase = u * 64 + wid * 16 + g;
        int ek[16]; float wk[16];
#pragma unroll
        for (int i = 0; i < 4; ++i) {
            const int4 e4 = *(const int4*)(sel_e + (size_t)rbase * 128 + 4 * i);
            const float4 w4 = *(const float4*)(sel_w + (size_t)rbase * 128 + 4 * i);
            ek[4 * i] = e4.x; ek[4 * i + 1] = e4.y; ek[4 * i + 2] = e4.z; ek[4 * i + 3] = e4.w;
            wk[4 * i] = w4.x; wk[4 * i + 1] = w4.y; wk[4 * i + 2] = w4.z; wk[4 * i + 3] = w4.w;
        }
        f32x2 y2[8];
#pragma unroll
        for (int i = 0; i < 8; ++i) y2[i] = (f32x2){0.f, 0.f};
#pragma unroll 1
        for (int q = 0; q < 16; ++q) {
            const int row = rbase + 8 * (q >> 3), qn = q < 15 ? q + 1 : q;
            const size_t offn = (size_t)(rbase + 8 * (qn >> 3)) * 128 + 16 * (qn & 7);
            uint4 vr[16];
#pragma unroll
            for (int k = 0; k < 16; ++k) vr[k] = *(const uint4*)(Vs + ((unsigned)ek[k] * 128u + (unsigned)c * 16u));
            int ekn[16]; float wkn[16];
#pragma unroll
            for (int i = 0; i < 4; ++i) {
                const int4 e4 = *(const int4*)(sel_e + offn + 4 * i);
                const float4 w4 = *(const float4*)(sel_w + offn + 4 * i);
                ekn[4 * i] = e4.x; ekn[4 * i + 1] = e4.y; ekn[4 * i + 2] = e4.z; ekn[4 * i + 3] = e4.w;
                wkn[4 * i] = w4.x; wkn[4 * i + 1] = w4.y; wkn[4 * i + 2] = w4.z; wkn[4 * i + 3] = w4.w;
            }
#pragma unroll
            for (int k = 0; k < 16; ++k) {
                const f32x2 w2 = (f32x2){wk[k], wk[k]};
                const unsigned vw[4] = {vr[k].x, vr[k].y, vr[k].z, vr[k].w};
#pragma unroll
                for (int j = 0; j < 4; ++j) {
                    y2[2 * j] = __builtin_amdgcn_cvt_pk_f32_fp8((int)vw[j], false) * w2 + y2[2 * j];
                    y2[2 * j + 1] = __builtin_amdgcn_cvt_pk_f32_fp8((int)vw[j], true) * w2 + y2[2 * j + 1];
                }
            }
            if ((q & 7) == 7) {
                bf16_t* hp = h16 + (size_t)row * D + s * 128 + c * 16;
                const float* gp = gate + (size_t)mod_row(row) * 6144 + s * 128 + c * 16;
                const uint4 h0 = *(const uint4*)hp, h1 = *(const uint4*)(hp + 8);
                const unsigned hw[8] = {h0.x, h0.y, h0.z, h0.w, h1.x, h1.y, h1.z, h1.w};
                unsigned ow[8];
#pragma unroll
                for (int j = 0; j < 4; ++j) {
                    const float4 g4 = *(const float4*)(gp + 4 * j);
                    ow[2 * j] = pack2(__uint_as_float(hw[2 * j] << 16) + g4.x * y2[2 * j].x, __uint_as_float(hw[2 * j] & 0xffff0000u) + g4.y * y2[2 * j].y);
                    ow[2 * j + 1] = pack2(__uint_as_float(hw[2 * j + 1] << 16) + g4.z * y2[2 * j + 1].x, __uint_as_float(hw[2 * j + 1] & 0xffff0000u) + g4.w * y2[2 * j + 1].y);
                }
                *(uint4*)hp = make_uint4(ow[0], ow[1], ow[2], ow[3]); *(uint4*)(hp + 8) = make_uint4(ow[4], ow[5], ow[6], ow[7]);
#pragma unroll
                for (int i = 0; i < 8; ++i) y2[i] = (f32x2){0.f, 0.f};
            }
#pragma unroll
            for (int k = 0; k < 16; ++k) { ek[k] = ekn[k]; wk[k] = wkn[k]; }
        }
    });
}

__device__ void ph_final(int bid, int nb, const bf16_t* __restrict__ h16, float* __restrict__ out, const float* __restrict__ g) {
    const int lane = tidx() & 63, wid = tidx() >> 6;
    const int nwv = nb * 4, per = (TL + nwv - 1) / nwv, r0 = (bid * 4 + wid) * per, r1 = (r0 + per < TL) ? r0 + per : TL;
    if (r0 >= r1) return;
    float4 gg[4];
#pragma unroll
    for (int i = 0; i < 4; ++i) gg[i] = ((const float4*)g)[i * 64 + lane];
    uint2 wn[4];
#pragma unroll
    for (int i = 0; i < 4; ++i) wn[i] = ((const uint2*)(h16 + (size_t)r0 * D))[i * 64 + lane];
    for (int row = r0; row < r1; ++row) {
        uint2 w[4];
#pragma unroll
        for (int i = 0; i < 4; ++i) w[i] = wn[i];
        const int rn = row + 1 < r1 ? row + 1 : row;
#pragma unroll
        for (int i = 0; i < 4; ++i) wn[i] = ((const uint2*)(h16 + (size_t)rn * D))[i * 64 + lane];
        float4 x[4]; float ss = 0.f;
#pragma unroll
        for (int i = 0; i < 4; ++i) {
            x[i].x = __uint_as_float(w[i].x << 16); x[i].y = __uint_as_float(w[i].x & 0xffff0000u); x[i].z = __uint_as_float(w[i].y << 16); x[i].w = __uint_as_float(w[i].y & 0xffff0000u);
            ss += x[i].x * x[i].x + x[i].y * x[i].y + x[i].z * x[i].z + x[i].w * x[i].w;
        }
        ss = wave_sum(ss);
        const float rinv = rsqrtf(ss * (1.0f / D) + EPS);
        float4* o4 = (float4*)(out + (size_t)row * D);
#pragma unroll
        for (int i = 0; i < 4; ++i) {
            float4 o; o.x = x[i].x * rinv * gg[i].x; o.y = x[i].y * rinv * gg[i].y; o.z = x[i].z * rinv * gg[i].z; o.w = x[i].w * rinv * gg[i].w;
            o4[i * 64 + lane] = o;
        }
    }
}

struct Params {
    const float *x, *c, *ctx, *c_ctx, *ada_w, *ada_b, *norm_mix_g, *norm_ffn_g, *ab_w_in, *ab_w_out, *hg_lb, *hg_norm_g, *sw_sink,
        *ga_w_in, *ga_w_out, *ga_qn, *ga_kn, *peer_wq, *peer_sk, *peer_u, *peer_v, *final_g;
    float* out; char* ws;
};

typedef __attribute__((address_space(1))) char gchar_t;
__device__ __forceinline__ gchar_t* ws_base(char* w) { gchar_t* g = (gchar_t*)w; asm volatile("" : "+s"(g)); return g; }
#define WSP(T, off) ((T*)(ws_base(p.ws) + (off)))

constexpr int XB_XCNT = 0, XB_XSUB = 1024, XB_XGEN = 2048, XB_TOP = 3072, XB_TOPGEN = 3136;
#define gb_state (*(uint4*)(dyn_lds + 65536 + 4096))
__device__ __forceinline__ unsigned xb_ld(unsigned* p) { return __hip_atomic_load(p, __ATOMIC_RELAXED, __HIP_MEMORY_SCOPE_AGENT); }
__device__ __forceinline__ unsigned xb_add(unsigned* p) { return __hip_atomic_fetch_add(p, 1u, __ATOMIC_RELAXED, __HIP_MEMORY_SCOPE_AGENT); }
__device__ __forceinline__ unsigned xcc_id() { return (unsigned)__builtin_amdgcn_s_getreg((3 << 11) | 20) & 0xFu; }
__device__ __forceinline__ void grid_bar_post(unsigned* bar) {
    if (threadIdx.x == 0) { gb_state = make_uint4(0u, 0u, 0u, 0u); (void)xb_add(&bar[XB_XCNT + 64 * xcc_id()]); }
}
__device__ __forceinline__ void grid_bar(unsigned* bar) {
    asm volatile("s_waitcnt vmcnt(0)" ::: "memory");
    __syncthreads();
    if (threadIdx.x == 0) {
        const unsigned x = xcc_id();
        unsigned nloc = gb_state.x, nx = gb_state.y;
        if (nloc == 0u) {
            for (;;) {
                unsigned sum = 0u, cnt = 0u, mine = 0u;
#pragma unroll
                for (unsigned j = 0; j < 16; ++j) { const unsigned c = xb_ld(&bar[XB_XCNT + 64 * j]); sum += c; cnt += c > 0u ? 1u : 0u; mine = (j == x) ? c : mine; }
                if (sum == gridDim.x) { nloc = mine; nx = cnt; break; }
                __builtin_amdgcn_s_sleep(1);
            }
            gb_state.x = nloc; gb_state.y = nx;
        }
        const unsigned old = xb_add(&bar[XB_XSUB + 64 * x]);
        const unsigned gen = old / nloc;
        if (old + 1u == (gen + 1u) * nloc) {
            __builtin_amdgcn_fence(__ATOMIC_RELEASE, "agent");
            asm volatile("s_waitcnt vmcnt(0)" ::: "memory");
            const unsigned og = xb_add(&bar[XB_TOP]);
            const unsigned tg = og / nx;
            if (og + 1u == (tg + 1u) * nx) (void)xb_add(&bar[XB_TOPGEN]);
            else while (xb_ld(&bar[XB_TOPGEN]) == tg) __builtin_amdgcn_s_sleep(1);
            __builtin_amdgcn_fence(__ATOMIC_ACQUIRE, "agent");
            (void)xb_add(&bar[XB_XGEN + 64 * x]);
            asm volatile("s_waitcnt vmcnt(0)" ::: "memory");
        } else {
            while (xb_ld(&bar[XB_XGEN + 64 * x]) == gen) __builtin_amdgcn_s_sleep(1);
            __builtin_amdgcn_fence(__ATOMIC_ACQUIRE, "agent");
            asm volatile("s_waitcnt vmcnt(0)" ::: "memory");
        }
    }
    __syncthreads();
}

__device__ __forceinline__ void sub_bar(unsigned* ctr, unsigned& epoch, unsigned nblk) {
    asm volatile("s_waitcnt vmcnt(0)" ::: "memory");
    __syncthreads();
    epoch += nblk;
    if (threadIdx.x == 0) {
        __builtin_amdgcn_fence(__ATOMIC_RELEASE, "agent");
        asm volatile("s_waitcnt vmcnt(0)" ::: "memory");
        (void)xb_add(ctr);
        while (xb_ld(ctr) < epoch) __builtin_amdgcn_s_sleep(1);
        __builtin_amdgcn_fence(__ATOMIC_ACQUIRE, "agent");
        asm volatile("s_waitcnt vmcnt(0)" ::: "memory");
    }
    __syncthreads();
}

namespace cg = cooperative_groups;
constexpr int MEGA_LDS = 65536 + 4096 + 256;
__global__ void __launch_bounds__(256, 2) k_mega(Params p) {
    cg::grid_group grid = cg::this_grid();
    const int bid = blockIdx.x, nb = gridDim.x;
    char* lds = dyn_lds;
    float* ldf = (float*)dyn_lds;
    grid_bar_post(WSP(unsigned, OFF_BAR));
    ph_mod(bid, nb, p.c, p.c_ctx, p.ada_w, p.ada_b, WSP(float, OFF_MOD), ldf);
    ph_tables(bid, nb, WSP(float, OFF_COSS), WSP(float, OFF_SINS), WSP(float, OFF_COSG), WSP(float, OFF_SING), p.hg_lb, WSP(float, OFF_LB));
    if (p.ws == nullptr) grid.sync();
    grid_bar(WSP(unsigned, OFF_BAR));
    ph_normmod(bid, nb, p.x, p.ctx, p.norm_mix_g, WSP(float, OFF_MOD), 1 * D, 0, WSP(bf16_t, OFF_A), TA);
    ph_transpose(bid, nb, p.ab_w_in, WSP(bf16_t, OFF_WABIN), D, AB_IN, ldf);
    ph_transpose(bid, nb, p.ab_w_out, WSP(bf16_t, OFF_WABOUT), D, D, ldf);
    ph_transpose(bid, nb, p.peer_wq, WSP(bf16_t, OFF_WPQ), D, PQ, ldf);
    ph_cvt(bid, nb, p.peer_sk, WSP(bf16_t, OFF_SK), (size_t)2 * 8 * 2 * 128 * 128);
    grid_bar(WSP(unsigned, OFF_BAR));
    { EpiStoreSplit<0> e{WSP(bf16_t, OFF_PROJH), HGW, WSP(bf16_t, OFF_PROJS), SWW, HGW};
      ph_gemm(bid, nb, WSP(bf16_t, OFF_A), D, WSP(bf16_t, OFF_WABIN), AB_IN, TA, HGW, D, lds, e); }
    grid_bar(WSP(unsigned, OFF_BAR));
    {
        const int hgb = nb >= 256 ? 128 : nb / 2;
        if (bid < hgb) ph_hgrn(bid, hgb, WSP(bf16_t, OFF_PROJH), WSP(float, OFF_LB), WSP(bf16_t, OFF_OF), WSP(bf16_t, OFF_OB), lds);
        else {
            const int sb = bid - hgb, sn = nb - hgb;
            unsigned* sctr = WSP(unsigned, OFF_BAR) + 3328; unsigned sep = 0;
            { EpiStoreSplit<1> e{WSP(bf16_t, OFF_PROJH), HGW, WSP(bf16_t, OFF_PROJS), SWW, HGW};
              ph_gemm(sb, sn, WSP(bf16_t, OFF_A), D, WSP(bf16_t, OFF_WABIN), AB_IN, TA, SWW, D, lds, e, HGW); }
            sub_bar(sctr, sep, (unsigned)sn);
            ph_prep_swa(sb, sn, WSP(bf16_t, OFF_PROJS), WSP(float, OFF_COSS), WSP(float, OFF_SINS));
            ph_vt<64>(sb, sn, WSP(bf16_t, OFF_PROJS), SWW, 640, WSP(bf16_t, OFF_VT64), (bf16_t*)lds);
            sub_bar(sctr, sep, (unsigned)sn);
            ph_swa(sb, sn, WSP(bf16_t, OFF_PROJS), WSP(bf16_t, OFF_VT64), p.sw_sink, WSP(bf16_t, OFF_MIX), lds);
            ph_cvt8i(sb, sn, p.peer_u, WSP(unsigned char, OFF_U16), (size_t)2 * NEXP * D, UQ);
            ph_cvt8(sb, sn, p.peer_v, WSP(unsigned char, OFF_V16), (size_t)2 * NEXP * D, 1.0f);
            ph_transpose(sb, sn, p.ga_w_in, WSP(bf16_t, OFF_WGAIN), D, GA_IN, ldf);
            ph_transpose(sb, sn, p.ga_w_out, WSP(bf16_t, OFF_WGAOUT), D, D, ldf);
            ph_transpose(sb, sn, p.peer_wq + (size_t)D * PQ, WSP(bf16_t, OFF_WPQ) + (size_t)PQ * D, D, PQ, ldf);
        }
    }
    grid_bar(WSP(unsigned, OFF_BAR));
    ph_hgpost(bid, nb, WSP(bf16_t, OFF_OF), WSP(bf16_t, OFF_OB), WSP(bf16_t, OFF_PROJH), p.hg_norm_g, WSP(bf16_t, OFF_MIX));
    grid_bar(WSP(unsigned, OFF_BAR));
    { EpiResid<0> e{p.x, p.ctx, nullptr, WSP(bf16_t, OFF_H16), WSP(float, OFF_MOD) + 2 * D};
      ph_gemm(bid, nb, WSP(bf16_t, OFF_MIX), D, WSP(bf16_t, OFF_WABOUT), D, TA, D, D, lds, e); }
    grid_bar(WSP(unsigned, OFF_BAR));
    ph_normmod16(bid, nb, WSP(bf16_t, OFF_H16), p.norm_ffn_g, WSP(float, OFF_MOD), 4 * D, 3 * D, WSP(bf16_t, OFF_A), TA, WSP(unsigned char, OFF_XQ), WSP(float, OFF_XS));
    grid_bar(WSP(unsigned, OFF_BAR));
    { EpiStoreSplit<2> e{WSP(bf16_t, OFF_QPEER), PQ, WSP(bf16_t, OFF_QPEER), PQ, 1 << 30};
      ph_gemm(bid, nb, WSP(bf16_t, OFF_A), D, WSP(bf16_t, OFF_WPQ), PQ, TA, PQ, D, lds, e); }
    grid_bar(WSP(unsigned, OFF_BAR));
    ph_peer_route(bid, nb, WSP(bf16_t, OFF_QPEER), WSP(bf16_t, OFF_SK), WSP(int, OFF_SELE), WSP(float, OFF_SELG), TA, lds);
    grid_bar(WSP(unsigned, OFF_BAR));
    ph_peer_dots((WSP(unsigned, OFF_BAR) + 4096) + 64 * 0, xcc_id(), WSP(unsigned char, OFF_XQ), WSP(float, OFF_XS), WSP(unsigned char, OFF_U16), WSP(int, OFF_SELE), WSP(bf16_t, OFF_PART), TA, (unsigned*)lds);
    grid_bar(WSP(unsigned, OFF_BAR));
    ph_peer_weights(bid, nb, WSP(bf16_t, OFF_PART), WSP(float, OFF_SELG), TA);
    grid_bar(WSP(unsigned, OFF_BAR));
    ph_peer_vsum((WSP(unsigned, OFF_BAR) + 4096) + 64 * 8, xcc_id(), WSP(unsigned char, OFF_V16), WSP(int, OFF_SELE), WSP(float, OFF_SELG), WSP(float, OFF_MOD) + 5 * D, WSP(bf16_t, OFF_H16), TA, (unsigned*)lds);
    grid_bar(WSP(unsigned, OFF_BAR));
    ph_normmod16(bid, nb, WSP(bf16_t, OFF_H16), p.norm_mix_g + D, (WSP(float, OFF_MOD) + (size_t)9 * 6144), 1 * D, 0, WSP(bf16_t, OFF_A), TA);
    grid_bar(WSP(unsigned, OFF_BAR));
    { EpiGA e{WSP(bf16_t, OFF_PROJ), WSP(bf16_t, OFF_VT), p.ga_qn, p.ga_kn, WSP(float, OFF_COSG), WSP(float, OFF_SING)};
      ph_gemm(bid, nb, WSP(bf16_t, OFF_A), D, WSP(bf16_t, OFF_WGAIN), GA_IN, TA, GA_IN, D, lds, e); }
    grid_bar(WSP(unsigned, OFF_BAR));
    ph_dense(bid, nb, WSP(bf16_t, OFF_PROJ), WSP(bf16_t, OFF_VT), WSP(bf16_t, OFF_MIX), lds);
    grid_bar(WSP(unsigned, OFF_BAR));
    { EpiResid<1> e{nullptr, nullptr, WSP(bf16_t, OFF_H16), WSP(bf16_t, OFF_H16), (WSP(float, OFF_MOD) + (size_t)9 * 6144) + 2 * D};
      ph_gemm(bid, nb, WSP(bf16_t, OFF_MIX), D, WSP(bf16_t, OFF_WGAOUT), D, TL, D, D, lds, e); }
    grid_bar(WSP(unsigned, OFF_BAR));
    ph_normmod16(bid, nb, WSP(bf16_t, OFF_H16), p.norm_ffn_g + D, (WSP(float, OFF_MOD) + (size_t)9 * 6144), 4 * D, 3 * D, WSP(bf16_t, OFF_A), TL, WSP(unsigned char, OFF_XQ), WSP(float, OFF_XS));
    grid_bar(WSP(unsigned, OFF_BAR));
    { EpiStoreSplit<3> e{WSP(bf16_t, OFF_QPEER), PQ, WSP(bf16_t, OFF_QPEER), PQ, 1 << 30};
      ph_gemm(bid, nb, WSP(bf16_t, OFF_A), D, WSP(bf16_t, OFF_WPQ) + (size_t)PQ * D, PQ, TL, PQ, D, lds, e); }
    grid_bar(WSP(unsigned, OFF_BAR));
    ph_peer_route(bid, nb, WSP(bf16_t, OFF_QPEER), WSP(bf16_t, OFF_SK) + (size_t)16 * 128 * 128, WSP(int, OFF_SELE), WSP(float, OFF_SELG), TL, lds);
    grid_bar(WSP(unsigned, OFF_BAR));
    ph_peer_dots((WSP(unsigned, OFF_BAR) + 4096) + 64 * 16, xcc_id(), WSP(unsigned char, OFF_XQ), WSP(float, OFF_XS), WSP(unsigned char, OFF_U16) + (size_t)NEXP * D, WSP(int, OFF_SELE), WSP(bf16_t, OFF_PART), TL, (unsigned*)lds);
    grid_bar(WSP(unsigned, OFF_BAR));
    ph_peer_weights(bid, nb, WSP(bf16_t, OFF_PART), WSP(float, OFF_SELG), TL);
    grid_bar(WSP(unsigned, OFF_BAR));
    ph_peer_vsum((WSP(unsigned, OFF_BAR) + 4096) + 64 * 24, xcc_id(), WSP(unsigned char, OFF_V16) + (size_t)NEXP * D, WSP(int, OFF_SELE), WSP(float, OFF_SELG), (WSP(float, OFF_MOD) + (size_t)9 * 6144) + 5 * D, WSP(bf16_t, OFF_H16), TL, (unsigned*)lds);
    grid_bar(WSP(unsigned, OFF_BAR));
    ph_final(bid, nb, WSP(bf16_t, OFF_H16), p.out, p.final_g);
}

extern "C" void kernel_launch(void* const* d_in, const int* in_sizes, int n_in, void* d_out, int out_size, void* d_ws, size_t ws_size,
                              hipStream_t stream) {
    Params p{};
    p.x = (const float*)d_in[0]; p.c = (const float*)d_in[1]; p.ctx = (const float*)d_in[2]; p.c_ctx = (const float*)d_in[3];
    p.ada_w = (const float*)d_in[4]; p.ada_b = (const float*)d_in[5]; p.norm_mix_g = (const float*)d_in[6]; p.norm_ffn_g = (const float*)d_in[7];
    p.ab_w_in = (const float*)d_in[8]; p.ab_w_out = (const float*)d_in[9]; p.hg_lb = (const float*)d_in[10]; p.hg_norm_g = (const float*)d_in[11];
    p.sw_sink = (const float*)d_in[12]; p.ga_w_in = (const float*)d_in[13]; p.ga_w_out = (const float*)d_in[14]; p.ga_qn = (const float*)d_in[15];
    p.ga_kn = (const float*)d_in[16]; p.peer_wq = (const float*)d_in[17]; p.peer_sk = (const float*)d_in[18]; p.peer_u = (const float*)d_in[19];
    p.peer_v = (const float*)d_in[20]; p.final_g = (const float*)d_in[21];
    p.out = (float*)d_out; p.ws = (char*)d_ws;
    if (ws_size < WS_NEED) { fprintf(stderr, "workspace too small: %zu < %zu\n", ws_size, WS_NEED); return; }
    static int grid_blocks = 0;
    if (!grid_blocks) {
        int dev = 0, cus = 0, per_cu = 0;
        (void)hipGetDevice(&dev);
        (void)hipDeviceGetAttribute(&cus, hipDeviceAttributeMultiprocessorCount, dev);
        (void)hipFuncSetAttribute((const void*)k_mega, hipFuncAttributeMaxDynamicSharedMemorySize, MEGA_LDS);
        (void)hipOccupancyMaxActiveBlocksPerMultiprocessor(&per_cu, k_mega, 256, MEGA_LDS);
        if (per_cu > 2) per_cu = 2;
        if (per_cu < 1) per_cu = 1;
        grid_blocks = cus * per_cu;
    }
    (void)hipMemsetAsync((char*)d_ws + OFF_BAR, 0, BAR_BYTES, stream);
    void* args[] = {&p};
    hipError_t e = hipLaunchCooperativeKernel((const void*)k_mega, dim3(grid_blocks), dim3(256), args, MEGA_LDS, stream);
    if (e != hipSuccess) fprintf(stderr, "cooperative launch failed: %s (grid %d)\n", hipGetErrorString(e), grid_blocks);
}
```

```cpp
#include <hip/hip_runtime.h>
#include <hip/hip_cooperative_groups.h>
#include <stdint.h>
#include <stdio.h>

typedef unsigned short bf16_t;
typedef short bf16x8 __attribute__((ext_vector_type(8)));
typedef float f32x4 __attribute__((ext_vector_type(4)));

constexpr int D = 1024, NB = 8, SEQ = 4096, LC = 256;
constexpr int TL = NB * SEQ;
constexpr int TC = NB * LC;
constexpr int TA = TL + TC;
constexpr int AB_IN = 3328, HGW = 2560, SWW = 768, GA_IN = 1536, PQ = 2048;
constexpr int NEXP = 16384;
constexpr float EPS = 1e-6f;
constexpr float LOG2E = 1.4426950408889634f;
constexpr int NKEY = LC + SEQ;

constexpr size_t OFF_WABIN = 0;
constexpr size_t OFF_WABOUT = OFF_WABIN + (size_t)AB_IN * D * 2;
constexpr size_t OFF_WGAIN = OFF_WABOUT + (size_t)D * D * 2;
constexpr size_t OFF_WGAOUT = OFF_WGAIN + (size_t)GA_IN * D * 2;
constexpr size_t OFF_WPQ = OFF_WGAOUT + (size_t)D * D * 2;
constexpr size_t OFF_SK = OFF_WPQ + (size_t)2 * PQ * D * 2;
constexpr size_t OFF_MOD = OFF_SK + (size_t)2 * 8 * 2 * 128 * 128 * 2;
constexpr size_t OFF_COSS = OFF_MOD + (size_t)2 * 9 * 6144 * 4;
constexpr size_t OFF_SINS = OFF_COSS + (size_t)SEQ * 32 * 4;
constexpr size_t OFF_COSG = OFF_SINS + (size_t)SEQ * 32 * 4;
constexpr size_t OFF_SING = OFF_COSG + (size_t)SEQ * 64 * 4;
constexpr size_t OFF_LB = OFF_SING + (size_t)SEQ * 64 * 4;
constexpr size_t OFF_U16 = OFF_LB + 2048;
constexpr size_t OFF_V16 = OFF_U16 + (size_t)NEXP * D * 2;
constexpr size_t OFF_HCTX = OFF_V16 + (size_t)NEXP * D * 2;
constexpr size_t OFF_A = OFF_HCTX + (size_t)TC * D * 4;
constexpr size_t OFF_PROJ = OFF_A + (size_t)TA * D * 2;
constexpr size_t OFF_MIX = OFF_PROJ + (size_t)TA * AB_IN * 2;
constexpr size_t OFF_SEL = OFF_MIX + (size_t)TA * D * 2;
constexpr size_t OFF_BAR = OFF_SEL + (size_t)TA * 128 * 8;
constexpr size_t BAR_BYTES = 32768;
constexpr size_t OFF_VT64 = OFF_BAR + BAR_BYTES;
constexpr size_t WS_NEED = OFF_VT64 + (size_t)NB * 2 * 64 * NKEY * 2;
static_assert(WS_NEED <= (size_t)536870912, "workspace over 512 MiB");
constexpr size_t OFF_OF = OFF_MIX;
constexpr size_t OFF_OB = OFF_SEL;
constexpr size_t OFF_PROJH = OFF_PROJ;
constexpr size_t OFF_PROJS = OFF_PROJ + (size_t)TA * HGW * 2;
constexpr size_t OFF_QPEER = OFF_PROJ;
constexpr size_t OFF_TSC = OFF_QPEER + (size_t)TA * PQ * 2;
constexpr size_t OFF_TIX = OFF_TSC + (size_t)TA * 256 * 4;
static_assert(OFF_TIX + (size_t)TA * 256 * 4 <= OFF_MIX, "peer scratch overflows proj region");
constexpr size_t OFF_VT = OFF_SEL;
static_assert((size_t)NB * 2 * 128 * NKEY * 2 <= (size_t)TA * 128 * 8, "Vt overflows SEL region");
constexpr size_t OFF_PART = OFF_PROJ;
constexpr size_t OFF_X8 = OFF_PROJ + (size_t)TA * PQ * 2;
static_assert((size_t)8 * TA * 128 * 4 <= (size_t)TA * PQ * 2 && OFF_X8 + (size_t)2 * TA * D <= OFF_MIX, "PEER scratch overflows proj region");
constexpr size_t OFF_H16 = OFF_PROJ + (size_t)TA * PQ * 2;
constexpr size_t OFF_XQ = OFF_MIX;
constexpr size_t OFF_XS = OFF_MIX + (size_t)TA * D;
constexpr size_t OFF_SELE = OFF_SEL;
constexpr size_t OFF_SELG = OFF_SEL + (size_t)TA * 128 * 4;

extern __shared__ __attribute__((aligned(16))) char dyn_lds[];
__device__ __forceinline__ float bf2f(bf16_t v) { return __uint_as_float(((unsigned)v) << 16); }
__device__ __forceinline__ bf16_t f2bf(float f) {
    unsigned u = __float_as_uint(f);
    u += 0x7fffu + ((u >> 16) & 1u);
    return (bf16_t)(u >> 16);
}
typedef float f32x2 __attribute__((ext_vector_type(2)));
typedef float f32x16 __attribute__((ext_vector_type(16)));
typedef __bf16 bf16x2_t __attribute__((ext_vector_type(2)));
__device__ __forceinline__ unsigned pack2(float lo, float hi) { f32x2 v = {lo, hi}; return __builtin_bit_cast(unsigned, __builtin_convertvector(v, bf16x2_t)); }
__device__ __forceinline__ float sigmoidf_(float x) { return 1.0f / (1.0f + __expf(-x)); }
__device__ __forceinline__ float siluf_(float x) { return x * sigmoidf_(x); }
__device__ __forceinline__ float wave_sum(float v) {
#pragma unroll
    for (int o = 32; o >= 1; o >>= 1) v += __shfl_xor(v, o);
    return v;
}
__device__ __forceinline__ int mod_row(int row) { return row < TL ? (row >> 12) : 8; }
__device__ __forceinline__ int tidx() { int t = threadIdx.x; asm volatile("" : "+v"(t)); return t; }

__device__ void ph_transpose(int bid, int nb, const float* __restrict__ in, bf16_t* __restrict__ out, int K, int N, float* lds) {
    const int tk = K / 32, tn = N / 32, nt = tk * tn;
    const int tx = threadIdx.x & 31, ty = threadIdx.x >> 5;
    for (int t = bid; t < nt; t += nb) {
        const int k0 = (t / tn) * 32, n0 = (t % tn) * 32;
        __syncthreads();
#pragma unroll
        for (int i = 0; i < 4; ++i) lds[(ty + i * 8) * 33 + tx] = in[(size_t)(k0 + ty + i * 8) * N + n0 + tx];
        __syncthreads();
#pragma unroll
        for (int i = 0; i < 4; ++i) out[((size_t)(k0 >> 5) * N + n0 + ty + i * 8) * 32 + tx] = f2bf(lds[tx * 33 + ty + i * 8]);
    }
}
__device__ void ph_cvt(int bid, int nb, const float* __restrict__ in, bf16_t* __restrict__ out, size_t n) {
    const size_t n8 = n / 8;
    for (size_t i = (size_t)bid * blockDim.x + threadIdx.x; i < n8; i += (size_t)nb * blockDim.x) {
        const float4 a = ((const float4*)in)[i * 2], b = ((const float4*)in)[i * 2 + 1];
        uint4 w; w.x = pack2(a.x, a.y); w.y = pack2(a.z, a.w); w.z = pack2(b.x, b.y); w.w = pack2(b.z, b.w);
        ((uint4*)out)[i] = w;
    }
}
__device__ void ph_cvt8(int bid, int nb, const float* __restrict__ in, unsigned char* __restrict__ out, size_t n, float scale) {
    const size_t n16 = n / 16;
    for (size_t i = (size_t)bid * blockDim.x + threadIdx.x; i < n16; i += (size_t)nb * blockDim.x) {
        const float4 a = ((const float4*)in)[i * 4], b = ((const float4*)in)[i * 4 + 1], c = ((const float4*)in)[i * 4 + 2], d = ((const float4*)in)[i * 4 + 3];
        int w0 = __builtin_amdgcn_cvt_pk_fp8_f32(a.x * scale, a.y * scale, 0, false); w0 = __builtin_amdgcn_cvt_pk_fp8_f32(a.z * scale, a.w * scale, w0, true);
        int w1 = __builtin_amdgcn_cvt_pk_fp8_f32(b.x * scale, b.y * scale, 0, false); w1 = __builtin_amdgcn_cvt_pk_fp8_f32(b.z * scale, b.w * scale, w1, true);
        int w2 = __builtin_amdgcn_cvt_pk_fp8_f32(c.x * scale, c.y * scale, 0, false); w2 = __builtin_amdgcn_cvt_pk_fp8_f32(c.z * scale, c.w * scale, w2, true);
        int w3 = __builtin_amdgcn_cvt_pk_fp8_f32(d.x * scale, d.y * scale, 0, false); w3 = __builtin_amdgcn_cvt_pk_fp8_f32(d.z * scale, d.w * scale, w3, true);
        const size_t el = i * 16, rowg = el >> 10;
        const size_t layer = rowg / NEXP, e = rowg % NEXP; const int col = (int)(el & 1023), sl = col >> 7, cs = col & 127;
        *(int4*)(out + layer * ((size_t)NEXP * D) + ((size_t)sl * NEXP + e) * 128 + cs) = make_int4(w0, w1, w2, w3);
    }
}
constexpr float UQ = 512.0f;
__device__ __forceinline__ int q8(float v, float sc) { return (int)rintf(fminf(fmaxf(v * sc, -127.f), 127.f)) & 0xff; }
__device__ void ph_cvt8i(int bid, int nb, const float* __restrict__ in, unsigned char* __restrict__ out, size_t n, float scale) {
    const size_t n16 = n / 16;
    for (size_t i = (size_t)bid * blockDim.x + tidx(); i < n16; i += (size_t)nb * blockDim.x) {
        const float4 a = ((const float4*)in)[i * 4], b = ((const float4*)in)[i * 4 + 1], c = ((const float4*)in)[i * 4 + 2], d = ((const float4*)in)[i * 4 + 3];
        const int w0 = q8(a.x, scale) | (q8(a.y, scale) << 8) | (q8(a.z, scale) << 16) | (q8(a.w, scale) << 24);
        const int w1 = q8(b.x, scale) | (q8(b.y, scale) << 8) | (q8(b.z, scale) << 16) | (q8(b.w, scale) << 24);
        const int w2 = q8(c.x, scale) | (q8(c.y, scale) << 8) | (q8(c.z, scale) << 16) | (q8(c.w, scale) << 24);
        const int w3 = q8(d.x, scale) | (q8(d.y, scale) << 8) | (q8(d.z, scale) << 16) | (q8(d.w, scale) << 24);
        const size_t el = i * 16, rowg = el >> 10;
        const size_t layer = rowg / NEXP, e = rowg % NEXP; const int col = (int)(el & 1023), sl = col >> 7, cs = col & 127;
        *(int4*)(out + layer * ((size_t)NEXP * D) + ((size_t)sl * NEXP + e) * 128 + cs) = make_int4(w0, w1, w2, w3);
    }
}
__device__ void ph_mod(int bid, int nb, const float* __restrict__ c, const float* __restrict__ c_ctx, const float* __restrict__ ada_w,
                       const float* __restrict__ ada_b, float* __restrict__ mod, float* lds) {
    float* s = lds;
    float* red = lds + 9 * 1024;
    const int tx = threadIdx.x & 63, ky = threadIdx.x >> 6;
    for (int i = threadIdx.x; i < 9 * 1024; i += 256) {
        const int r = i >> 10, k = i & 1023;
        const float v = r < 8 ? c[r * 1024 + k] : c_ctx[k];
        s[i] = siluf_(v);
    }
    __syncthreads();
    const int nitems = 2 * 96;
    for (int it = bid; it < nitems; it += nb) {
        const int layer = it / 96, n = (it % 96) * 64 + tx;
        const float* w = ada_w + (size_t)layer * 1024 * 6144 + n;
        float acc[9];
#pragma unroll
        for (int r = 0; r < 9; ++r) acc[r] = 0.f;
        for (int k = ky * 256; k < ky * 256 + 256; ++k) {
            const float wv = w[(size_t)k * 6144];
#pragma unroll
            for (int r = 0; r < 9; ++r) acc[r] += s[r * 1024 + k] * wv;
        }
        __syncthreads();
#pragma unroll
        for (int r = 0; r < 9; ++r) red[(ky * 9 + r) * 64 + tx] = acc[r];
        __syncthreads();
        if (ky == 0) {
#pragma unroll
            for (int r = 0; r < 9; ++r) {
                const float v = red[(0 * 9 + r) * 64 + tx] + red[(1 * 9 + r) * 64 + tx] + red[(2 * 9 + r) * 64 + tx] + red[(3 * 9 + r) * 64 + tx];
                mod[((size_t)layer * 9 + r) * 6144 + n] = v + ada_b[layer * 6144 + n];
            }
        }
    }
}
__device__ void ph_tables(int bid, int nb, float* cosS, float* sinS, float* cosG, float* sinG, const float* __restrict__ lb_logits, float* lb) {
    const int gt = bid * blockDim.x + threadIdx.x, gs = nb * blockDim.x;
    for (int i = gt; i < SEQ * 32; i += gs) {
        const int t = i >> 5, j = i & 31;
        const float pos = (float)(j < 16 ? (t >> 6) : (t & 63));
        const float inv = powf(10000.0f, -(float)(j & 15) / 16.0f);
        const float ang = pos * inv;
        cosS[i] = cosf(ang); sinS[i] = sinf(ang);
    }
    for (int i = gt; i < SEQ * 64; i += gs) {
        const int t = i >> 6, j = i & 63;
        const float pos = (float)(j < 32 ? (t >> 6) : (t & 63));
        const float inv = powf(10000.0f, -(float)(j & 31) / 32.0f);
        const float ang = pos * inv;
        cosG[i] = cosf(ang); sinG[i] = sinf(ang);
    }
    for (int i = gt; i < 512; i += gs) {
        const float l0 = lb_logits[i], l1 = lb_logits[512 + i];
        lb[i] = 1.0f / (1.0f + expf(l1 - l0));
    }
}

__device__ void ph_normmod(int bid, int nb, const float* __restrict__ hlat, const float* __restrict__ hctx, const float* __restrict__ gamma,
                           const float* __restrict__ modl  , int sc_off, int sh_off, bf16_t* __restrict__ out, int nrows) {
    const int lane = tidx() & 63, wid = tidx() >> 6;
    const int nwv = nb * 4, per = (nrows + nwv - 1) / nwv, r0 = (bid * 4 + wid) * per, r1 = (r0 + per < nrows) ? r0 + per : nrows;
    if (r0 >= r1) return;
    float4 ca[4], cb[4];
    int curm = -1;
    float4 xn[4];
    {
        const float* s0 = r0 < TL ? hlat + (size_t)r0 * D : hctx + (size_t)(r0 - TL) * D;
#pragma unroll
        for (int i = 0; i < 4; ++i) xn[i] = ((const float4*)s0)[i * 64 + lane];
    }
    for (int row = r0; row < r1; ++row) {
        float4 x[4];
#pragma unroll
        for (int i = 0; i < 4; ++i) x[i] = xn[i];
        const int rn = row + 1 < r1 ? row + 1 : row;
        const float* sn = rn < TL ? hlat + (size_t)rn * D : hctx + (size_t)(rn - TL) * D;
#pragma unroll
        for (int i = 0; i < 4; ++i) xn[i] = ((const float4*)sn)[i * 64 + lane];
        const int mr = mod_row(row);
        if (mr != curm) {
            curm = mr;
            const float* m = modl + (size_t)mr * 6144;
#pragma unroll
            for (int i = 0; i < 4; ++i) {
                const int col = (i * 64 + lane) * 4;
                const float4 g = *(const float4*)(gamma + col), sc = *(const float4*)(m + sc_off + col);
                ca[i] = make_float4(g.x * (1.f + sc.x), g.y * (1.f + sc.y), g.z * (1.f + sc.z), g.w * (1.f + sc.w));
                cb[i] = *(const float4*)(m + sh_off + col);
            }
        }
        float ss = 0.f;
#pragma unroll
        for (int i = 0; i < 4; ++i) ss += x[i].x * x[i].x + x[i].y * x[i].y + x[i].z * x[i].z + x[i].w * x[i].w;
        ss = wave_sum(ss);
        const float rinv = rsqrtf(ss * (1.0f / D) + EPS);
#pragma unroll
        for (int i = 0; i < 4; ++i) {
            const int col = (i * 64 + lane) * 4;
            uint2 w; w.x = pack2(x[i].x * rinv * ca[i].x + cb[i].x, x[i].y * rinv * ca[i].y + cb[i].y);
            w.y = pack2(x[i].z * rinv * ca[i].z + cb[i].z, x[i].w * rinv * ca[i].w + cb[i].w);
            *(uint2*)(out + (size_t)row * D + col) = w;
        }
    }
}

__device__ void ph_normmod16(int bid, int nb, const bf16_t* __restrict__ h16, const float* __restrict__ gamma,
                             const float* __restrict__ modl  , int sc_off, int sh_off, bf16_t* __restrict__ out, int nrows,
                             unsigned char* __restrict__ xq = nullptr, float* __restrict__ xs = nullptr) {
    const int lane = tidx() & 63, wid = tidx() >> 6;
    const int nwv = nb * 4, per = (nrows + nwv - 1) / nwv, r0 = (bid * 4 + wid) * per, r1 = (r0 + per < nrows) ? r0 + per : nrows;
    if (r0 >= r1) return;
    float4 ca[4], cb[4];
    int curm = -1;
    uint2 wn[4];
#pragma unroll
    for (int i = 0; i < 4; ++i) wn[i] = ((const uint2*)(h16 + (size_t)r0 * D))[i * 64 + lane];
    for (int row = r0; row < r1; ++row) {
        uint2 w[4];
#pragma unroll
        for (int i = 0; i < 4; ++i) w[i] = wn[i];
        const int rn = row + 1 < r1 ? row + 1 : row;
#pragma unroll
        for (int i = 0; i < 4; ++i) wn[i] = ((const uint2*)(h16 + (size_t)rn * D))[i * 64 + lane];
        const int mr = mod_row(row);
        if (mr != curm) {
            curm = mr;
            const float* m = modl + (size_t)mr * 6144;
#pragma unroll
            for (int i = 0; i < 4; ++i) {
                const int col = (i * 64 + lane) * 4;
                const float4 g = *(const float4*)(gamma + col), sc = *(const float4*)(m + sc_off + col);
                ca[i] = make_float4(g.x * (1.f + sc.x), g.y * (1.f + sc.y), g.z * (1.f + sc.z), g.w * (1.f + sc.w));
                cb[i] = *(const float4*)(m + sh_off + col);
            }
        }
        float4 x[4]; float ss = 0.f;
#pragma unroll
        for (int i = 0; i < 4; ++i) {
            x[i].x = __uint_as_float(w[i].x << 16); x[i].y = __uint_as_float(w[i].x & 0xffff0000u); x[i].z = __uint_as_float(w[i].y << 16); x[i].w = __uint_as_float(w[i].y & 0xffff0000u);
            ss += x[i].x * x[i].x + x[i].y * x[i].y + x[i].z * x[i].z + x[i].w * x[i].w;
        }
        ss = wave_sum(ss);
        const float rinv = rsqrtf(ss * (1.0f / D) + EPS);
        float amax = 0.f;
#pragma unroll
        for (int i = 0; i < 4; ++i) {
            const int col = (i * 64 + lane) * 4;
            const float y0 = x[i].x * rinv * ca[i].x + cb[i].x, y1 = x[i].y * rinv * ca[i].y + cb[i].y;
            const float y2 = x[i].z * rinv * ca[i].z + cb[i].z, y3 = x[i].w * rinv * ca[i].w + cb[i].w;
            uint2 o; o.x = pack2(y0, y1); o.y = pack2(y2, y3);
            *(uint2*)(out + (size_t)row * D + col) = o;
            x[i] = make_float4(y0, y1, y2, y3);
            amax = fmaxf(amax, fmaxf(fmaxf(fabsf(y0), fabsf(y1)), fmaxf(fabsf(y2), fabsf(y3))));
        }
        if (xq) {
#pragma unroll
            for (int o = 32; o > 0; o >>= 1) amax = fmaxf(amax, __shfl_xor(amax, o));
            amax = fmaxf(amax, 1e-20f);
            const float qs = 127.0f / amax;
#pragma unroll
            for (int i = 0; i < 4; ++i)
                *(int*)(xq + (size_t)row * D + (i * 64 + lane) * 4) = q8(x[i].x, qs) | (q8(x[i].y, qs) << 8) | (q8(x[i].z, qs) << 16) | (q8(x[i].w, qs) << 24);
            if (lane == 0) xs[row] = amax * (1.0f / 127.0f);
        }
    }
}

constexpr int GEMM_LDS = 49152;
template <class Epi>
__device__ __forceinline__ void gemm_tile(const bf16_t* __restrict__ A, int lda, const bf16_t* __restrict__ Bt, int ldb, int K,
                                          int m0, int n0, char* lds, Epi& epi) {
    const int tid = threadIdx.x, lane = tid & 63, wid = tid >> 6, wr = wid >> 1, wc = wid & 1, fr = lane & 15, fq = lane >> 4;
    f32x4 acc[4][8];
#pragma unroll
    for (int i = 0; i < 4; ++i)
#pragma unroll
        for (int j = 0; j < 8; ++j) acc[i][j] = (f32x4){0.f, 0.f, 0.f, 0.f};
    typedef __attribute__((address_space(3))) char las_char;
    las_char* l3 = (las_char*)lds;
    const int dsub = lane >> 2, dch = (lane & 3) ^ ((lane >> 5) * 3);
    const bf16_t* ga = A + (size_t)(m0 + 32 * wid + dsub) * lda + dch * 8;
    const bf16_t* gb = Bt + (size_t)(n0 + 64 * wid + dsub) * 32 + dch * 8;
    const int fsw = ((fr >> 3) & 1) * 3;
    const int aoff = (wr * 64 + fr) * 64 + ((fq ^ fsw) << 4), boff = 8192 + (wc * 128 + fr) * 64 + ((fq ^ fsw) << 4);
#define GT_STAGE(kt, buf) do { const int _s = (buf) * 24576; \
        _Pragma("unroll") for (int i = 0; i < 2; ++i) __builtin_amdgcn_global_load_lds((const unsigned*)(ga + (size_t)(16 * i) * lda + (kt) * 32), \
            (__attribute__((address_space(3))) unsigned*)(l3 + _s + (32 * wid + 16 * i) * 64), 16, 0, 0); \
        { const unsigned* _gp = (const unsigned*)(gb + (size_t)(kt) * ldb * 32); \
          __attribute__((address_space(3))) unsigned* _lp = (__attribute__((address_space(3))) unsigned*)(l3 + _s + 8192 + (64 * wid) * 64); \
          __builtin_amdgcn_global_load_lds(_gp, _lp, 16, 0, 0); __builtin_amdgcn_global_load_lds(_gp, _lp, 16, 1024, 0); \
          __builtin_amdgcn_global_load_lds(_gp, _lp, 16, 2048, 0); __builtin_amdgcn_global_load_lds(_gp, _lp, 16, 3072, 0); } } while (0)
    const int nk = K / 32;
    __syncthreads();
    GT_STAGE(0, 0);
    __syncthreads();
    for (int kt = 0; kt < nk; ++kt) {
        if (kt + 1 < nk) GT_STAGE(kt + 1, (kt + 1) & 1);
        const char* base = lds + (kt & 1) * 24576;
        bf16x8 af[4], bfr[8];
#pragma unroll
        for (int i = 0; i < 4; ++i) af[i] = *(const bf16x8*)(base + aoff + i * 1024);
#pragma unroll
        for (int j = 0; j < 8; ++j) bfr[j] = *(const bf16x8*)(base + boff + j * 1024);
#pragma unroll
        for (int i = 0; i < 4; ++i)
#pragma unroll
            for (int j = 0; j < 8; ++j) acc[i][j] = __builtin_amdgcn_mfma_f32_16x16x32_bf16(bfr[j], af[i], acc[i][j], 0, 0, 0);
        __syncthreads();
    }
#undef GT_STAGE
    epi(acc, m0 + wr * 64, n0 + wc * 128, lds + wid * 12288, lane);
}

template <int TAG>
struct EpiStoreSplit {
    bf16_t* O1; int ld1; bf16_t* O2; int ld2; int split;
    __device__ __forceinline__ void operator()(f32x4 (&acc)[4][8], int row0, int col0, char* wl, int lane) const {
        if (TAG == 0 && col0 < 1536) {
            const bool isq = col0 < 512;
#pragma unroll
            for (int i = 0; i < 4; ++i)
#pragma unroll
                for (int j = 0; j < 8; ++j)
#pragma unroll
                    for (int t = 0; t < 4; ++t) {
                        const float x = acc[i][j][t];
                        const float r = __builtin_amdgcn_rcpf(1.f + __expf(isq ? -x : x));
                        acc[i][j][t] = isq ? x * r : r;
                    }
        }
        const bool first = col0 < split;
        bf16_t* O = first ? O1 : O2; const int ld = first ? ld1 : ld2, cb = first ? col0 : col0 - split;
        const int fr = lane & 15, fq = lane >> 4;
#pragma unroll
        for (int i = 0; i < 4; ++i) {
#pragma unroll
            for (int j = 0; j < 8; ++j) {
                uint2 w; w.x = pack2(acc[i][j][0], acc[i][j][1]); w.y = pack2(acc[i][j][2], acc[i][j][3]);
                *(uint2*)(wl + fr * 272 + (16 * j + 4 * fq) * 2) = w;
            }
#pragma unroll
            for (int m = 0; m < 4; ++m) {
                const int rr = (lane >> 4) + 4 * m;
                const uint4 v = *(const uint4*)(wl + rr * 272 + (lane & 15) * 16);
                *(uint4*)(O + (size_t)(row0 + 16 * i + rr) * ld + cb + (lane & 15) * 8) = v;
            }
        }
    }
};
template <int TAG>
struct EpiResid {
    const float* hin_lat; const float* hin_ctx; const bf16_t* hin16; bf16_t* hout16; const float* gate  ;
    __device__ __forceinline__ void operator()(f32x4 (&acc)[4][8], int row0, int col0, char* wl, int lane) const {
        const int fr = lane & 15, fq = lane >> 4;
        const float4 gg = *(const float4*)(gate + (size_t)mod_row(row0) * 6144 + col0 + (lane & 31) * 4);
#pragma unroll
        for (int i = 0; i < 4; ++i) {
#pragma unroll
            for (int j = 0; j < 8; ++j) *(f32x4*)(wl + fr * 528 + (16 * j + 4 * fq) * 4) = acc[i][j];
#pragma unroll
            for (int m = 0; m < 8; ++m) {
                const int rr = (lane >> 5) + 2 * m, row = row0 + 16 * i + rr, col = col0 + (lane & 31) * 4;
                const f32x4 a = *(const f32x4*)(wl + rr * 528 + (lane & 31) * 16);
                float4 h;
                if (hin16) {
                    const uint2 hw = *(const uint2*)(hin16 + (size_t)row * D + col);
                    h.x = __uint_as_float(hw.x << 16); h.y = __uint_as_float(hw.x & 0xffff0000u); h.z = __uint_as_float(hw.y << 16); h.w = __uint_as_float(hw.y & 0xffff0000u);
                } else {
                    h = *(const float4*)((row < TL ? hin_lat + (size_t)row * D : hin_ctx + (size_t)(row - TL) * D) + col);
                }
                uint2 o; o.x = pack2(h.x + gg.x * a[0], h.y + gg.y * a[1]); o.y = pack2(h.z + gg.z * a[2], h.w + gg.w * a[3]);
                *(uint2*)(hout16 + (size_t)row * D + col) = o;
            }
        }
    }
};
struct EpiGA {
    bf16_t* P; bf16_t* Vt; const float* qg; const float* kg; const float* cosG; const float* sinG;
    __device__ __forceinline__ void operator()(f32x4 (&acc)[4][8], int row0, int col0, char* wl, int lane) const {
        const int fr = lane & 15, fq = lane >> 4;
        const bool latent = row0 < TL;
        if (col0 < 1280) {
            const bool isq = col0 < 1024;
            const float* g = isq ? qg : kg;
            const float osc = isq ? 0.08838834764831845f * LOG2E : 1.0f;
#pragma unroll
            for (int i = 0; i < 4; ++i) {
                float ss = 0.f;
#pragma unroll
                for (int j = 0; j < 8; ++j) ss += acc[i][j][0] * acc[i][j][0] + acc[i][j][1] * acc[i][j][1] + acc[i][j][2] * acc[i][j][2] + acc[i][j][3] * acc[i][j][3];
                ss += __shfl_xor(ss, 16); ss += __shfl_xor(ss, 32);
                const float rinv = rsqrtf(ss * (1.0f / 128.0f) + EPS) * osc;
                const int tpos = (row0 + 16 * i + fr) & (SEQ - 1);
#pragma unroll
                for (int j = 0; j < 4; ++j) {
                    const float4 g1 = *(const float4*)(g + 16 * j + 4 * fq), g2 = *(const float4*)(g + 64 + 16 * j + 4 * fq);
                    f32x4 y1 = acc[i][j] * rinv, y2 = acc[i][j + 4] * rinv;
                    y1[0] *= g1.x; y1[1] *= g1.y; y1[2] *= g1.z; y1[3] *= g1.w; y2[0] *= g2.x; y2[1] *= g2.y; y2[2] *= g2.z; y2[3] *= g2.w;
                    if (latent) {
                        const float4 cs = *(const float4*)(cosG + tpos * 64 + 16 * j + 4 * fq), sn = *(const float4*)(sinG + tpos * 64 + 16 * j + 4 * fq);
                        const f32x4 c4 = {cs.x, cs.y, cs.z, cs.w}, s4 = {sn.x, sn.y, sn.z, sn.w};
                        const f32x4 n1 = y1 * c4 - y2 * s4, n2 = y1 * s4 + y2 * c4;
                        y1 = n1; y2 = n2;
                    }
                    uint2 w1, w2; w1.x = pack2(y1[0], y1[1]); w1.y = pack2(y1[2], y1[3]); w2.x = pack2(y2[0], y2[1]); w2.y = pack2(y2[2], y2[3]);
                    *(uint2*)(wl + fr * 272 + (16 * j + 4 * fq) * 2) = w1;
                    *(uint2*)(wl + fr * 272 + (64 + 16 * j + 4 * fq) * 2) = w2;
                }
#pragma unroll
                for (int m = 0; m < 4; ++m) {
                    const int rr = (lane >> 4) + 4 * m;
                    const uint4 v = *(const uint4*)(wl + rr * 272 + (lane & 15) * 16);
                    *(uint4*)(P + (size_t)(row0 + 16 * i + rr) * GA_IN + col0 + (lane & 15) * 8) = v;
                }
            }
        } else {
            const int kvh = (col0 - 1280) >> 7;
            const int b = latent ? (row0 >> 12) : ((row0 - TL) >> 8);
            const int kidx0 = latent ? LC + (row0 & (SEQ - 1)) : ((row0 - TL) & (LC - 1));
            bf16_t* vt = Vt + (size_t)(b * 2 + kvh) * 128 * NKEY + kidx0;
#pragma unroll
            for (int hh = 0; hh < 2; ++hh) {
#pragma unroll
                for (int i = 0; i < 4; ++i)
#pragma unroll
                    for (int j = 0; j < 4; ++j)
#pragma unroll
                        for (int t = 0; t < 4; ++t)
                            *(bf16_t*)(wl + (16 * j + 4 * fq + t) * 144 + (16 * i + fr) * 2) = (bf16_t)(pack2(acc[i][4 * hh + j][t], 0.f) & 0xffff);
#pragma unroll
                for (int m = 0; m < 8; ++m) {
                    const int dd = (lane >> 3) + 8 * m;
                    const uint4 v = *(const uint4*)(wl + dd * 144 + (lane & 7) * 16);
                    *(uint4*)(vt + (size_t)(64 * hh + dd) * NKEY + (lane & 7) * 8) = v;
                }
            }
        }
    }
};
template <class Epi>
__device__ void ph_gemm(int bid, int nb, const bf16_t* A, int lda, const bf16_t* Bt, int ldb, int M, int N, int K, char* lds, Epi epi, int ncol0 = 0) {
    const int nM = M / 128, nN = N / 256, nwg = nM * nN;
    const bool sw = (nb & 7) == 0;
    for (int L = bid; L < nwg; L += nb) {
        int wg = L;
        if (sw) { const int q = nwg >> 3, r = nwg & 7, xcd = L & 7, off = L >> 3; wg = (xcd < r ? xcd * (q + 1) : r * (q + 1) + (xcd - r) * q) + off; }
        const int nig = 8 * nN, gid = wg / nig, fm = gid * 8, gsz = (nM - fm) < 8 ? (nM - fm) : 8;
        const int pm = fm + (wg % nig) % gsz, pn = (wg % nig) / gsz;
        gemm_tile(A, lda, Bt, ldb, K, pm * 128, ncol0 + pn * 256, lds, epi);
    }
}

typedef short bf16x4 __attribute__((ext_vector_type(4)));
constexpr int HQ_OFF = 0, HK_OFF = 16384, HKT_OFF = 32768, HVT_OFF = 49152, HD_OFF = 57344, HG_LDS = 59392;
__device__ __forceinline__ int hg_row(int b, int dir, int p) {
    if (p < LC) { const int s = dir ? (LC - 1 - p) : p; return TL + b * LC + s; }
    const int t = dir ? (SEQ - 1 - (p - LC)) : (p - LC);
    return b * SEQ + t;
}
__device__ void ph_hgrn(int bid, int nb, const bf16_t* __restrict__ projH, const float* __restrict__ lb, bf16_t* __restrict__ of, bf16_t* __restrict__ ob, char* lds) {
    const int tid = threadIdx.x, lane = tid & 63, w = tid >> 6, fr = lane & 15, fq = lane >> 4;
    for (int it = bid; it < NB * 4 * 2 * 2; it += nb) {
        const int vs = it & 1, dir = (it >> 1) & 1, h = (it >> 2) & 3, b = it >> 4;
        bf16_t* out = dir ? ob : of; const int ldo = dir ? 512 : D;
        const float lb0 = lb[h * 128 + 2 * lane], lb1 = lb[h * 128 + 2 * lane + 1];
        const int fcol = (dir ? 1024 : 512) + h * 128 + 2 * lane, qcol = h * 128 + 2 * lane, vcol = 1536 + h * 128 + vs * 64 + lane;
        f32x4 S[8];
#pragma unroll
        for (int kt = 0; kt < 8; ++kt) S[kt] = (f32x4){0.f, 0.f, 0.f, 0.f};
        unsigned xf[16], xq[16]; bf16_t xv[16];
#define HG_PREFETCH(p0) do { _Pragma("unroll") for (int i = 0; i < 16; ++i) { \
            const size_t rb = (size_t)hg_row(b, dir, (p0) + 16 * w + i) * HGW; \
            xf[i] = *(const unsigned*)(projH + rb + fcol); xq[i] = *(const unsigned*)(projH + rb + qcol); xv[i] = projH[rb + vcol]; } } while (0)
        HG_PREFETCH(0);
        for (int p0 = 0; p0 < NKEY; p0 += 64) {
            __syncthreads();
            {
                float P0 = 1.f, P1 = 1.f, kp0 = 0.f, kp1 = 0.f;
                unsigned kt0[8], kt1[8], vt[8];
#pragma unroll
                for (int i = 0; i < 16; ++i) {
                    const float u0 = __uint_as_float(xf[i] << 16), u1 = __uint_as_float(xf[i] & 0xffff0000u);
                    const float xq0 = __uint_as_float(xq[i] << 16), xq1 = __uint_as_float(xq[i] & 0xffff0000u);
                    const float nf0 = (1.f - lb0) * u0, nf1 = (1.f - lb1) * u1;
                    P0 *= 1.f - nf0; P1 *= 1.f - nf1;
                    const float q0 = xq0 * P0, q1 = xq1 * P1;
                    const float k0 = nf0 * fminf(__builtin_amdgcn_rcpf(P0), 5.0e34f);
                    const float k1 = nf1 * fminf(__builtin_amdgcn_rcpf(P1), 5.0e34f);
                    const int t = 16 * w + i;
                    const int o = t * 256 + (((lane >> 2) ^ (t & 15)) << 4) + (lane & 3) * 4;
                    *(unsigned*)(lds + HQ_OFF + o) = pack2(q0, q1);
                    *(unsigned*)(lds + HK_OFF + o) = pack2(k0, k1);
                    if (i & 1) { kt0[i >> 1] = pack2(kp0, k0); kt1[i >> 1] = pack2(kp1, k1); vt[i >> 1] = (unsigned)xv[i - 1] | ((unsigned)xv[i] << 16); }
                    else { kp0 = k0; kp1 = k1; }
                }
                float2 dd; dd.x = P0; dd.y = P1;
                *(float2*)(lds + HD_OFF + (w * 128 + 2 * lane) * 4) = dd;
                char* kp = lds + HKT_OFF + w * 4096 + (2 * lane) * 32;
                *(uint4*)(kp) = make_uint4(kt0[0], kt0[1], kt0[2], kt0[3]); *(uint4*)(kp + 16) = make_uint4(kt0[4], kt0[5], kt0[6], kt0[7]);
                *(uint4*)(kp + 32) = make_uint4(kt1[0], kt1[1], kt1[2], kt1[3]); *(uint4*)(kp + 48) = make_uint4(kt1[4], kt1[5], kt1[6], kt1[7]);
                char* vp = lds + HVT_OFF + w * 2048 + lane * 32;
                *(uint4*)(vp) = make_uint4(vt[0], vt[1], vt[2], vt[3]); *(uint4*)(vp + 16) = make_uint4(vt[4], vt[5], vt[6], vt[7]);
            }
            if (p0 + 64 < NKEY) HG_PREFETCH(p0 + 64);
            __syncthreads();
#pragma unroll
            for (int I = 0; I < 4; ++I) {
                const int trow = 16 * I + fr;
                f32x4 at = (f32x4){0.f, 0.f, 0.f, 0.f};
#pragma unroll
                for (int ks = 0; ks < 4; ++ks) {
                    const int o = trow * 256 + (((ks * 4 + fq) ^ fr) << 4);
                    const bf16x8 ka = *(const bf16x8*)(lds + HK_OFF + o);
                    const bf16x8 qa = *(const bf16x8*)(lds + HQ_OFF + o);
                    at = __builtin_amdgcn_mfma_f32_16x16x32_bf16(ka, qa, at, 0, 0, 0);
                }
#pragma unroll
                for (int j = 0; j < 4; ++j) if (4 * fq + j > fr) at[j] = 0.f;
                uint2 pa2; pa2.x = pack2(at[0], at[1]); pa2.y = pack2(at[2], at[3]);
                const bf16x4 pA = __builtin_bit_cast(bf16x4, pa2);
                const bf16x4 vfrag = *(const bf16x4*)(lds + HVT_OFF + I * 2048 + (w * 16 + fr) * 32 + fq * 8);
                f32x4 o1 = __builtin_amdgcn_mfma_f32_16x16x16bf16_1k(vfrag, pA, (f32x4){0.f, 0.f, 0.f, 0.f}, 0, 0, 0);
                f32x4 o2 = (f32x4){0.f, 0.f, 0.f, 0.f};
#pragma unroll
                for (int kt = 0; kt < 8; ++kt) {
                    uint2 s2; s2.x = pack2(S[kt][0], S[kt][1]); s2.y = pack2(S[kt][2], S[kt][3]);
                    const bf16x4 sfrag = __builtin_bit_cast(bf16x4, s2);
                    const bf16x4 qfrag = *(const bf16x4*)(lds + HQ_OFF + trow * 256 + (((kt * 2 + (fq >> 1)) ^ fr) << 4) + (fq & 1) * 8);
                    if (kt & 1) o2 = __builtin_amdgcn_mfma_f32_16x16x16bf16_1k(sfrag, qfrag, o2, 0, 0, 0);
                    else o1 = __builtin_amdgcn_mfma_f32_16x16x16bf16_1k(sfrag, qfrag, o1, 0, 0, 0);
                }
#pragma unroll
                for (int kt = 0; kt < 8; ++kt) {
                    const bf16x4 kfrag = *(const bf16x4*)(lds + HKT_OFF + I * 4096 + (kt * 16 + fr) * 32 + fq * 8);
                    const f32x4 d4 = *(const f32x4*)(lds + HD_OFF + (I * 128 + kt * 16 + fq * 4) * 4);
                    S[kt] = __builtin_amdgcn_mfma_f32_16x16x16bf16_1k(kfrag, vfrag, S[kt], 0, 0, 0);
                    S[kt] = S[kt] * d4;
                }
                const size_t orow = (size_t)hg_row(b, dir, p0 + trow);
                uint2 ov; ov.x = pack2(o1[0] + o2[0], o1[1] + o2[1]); ov.y = pack2(o1[2] + o2[2], o1[3] + o2[3]);
                *(uint2*)(out + orow * ldo + h * 128 + vs * 64 + w * 16 + fq * 4) = ov;
            }
        }
#undef HG_PREFETCH
    }
}
__device__ void ph_hgpost(int bid, int nb, const bf16_t* __restrict__ of, const bf16_t* __restrict__ ob, const bf16_t* __restrict__ projH,
                          const float* __restrict__ g, bf16_t* __restrict__ mix) {
    const int lane = threadIdx.x & 63, wid = threadIdx.x >> 6, l16 = lane & 15;
    const float4 g0 = *(const float4*)(g + l16 * 8), g1 = *(const float4*)(g + l16 * 8 + 4);
    const float gw[8] = {g0.x, g0.y, g0.z, g0.w, g1.x, g1.y, g1.z, g1.w};
    for (int it = (bid * 4 + wid) * 4 + (lane >> 4); it < TA * 4; it += nb * 16) {
        const int row = it >> 2, h = it & 3;
        const uint4 a = *(const uint4*)(of + (size_t)row * D + h * 128 + l16 * 8), bb = *(const uint4*)(ob + (size_t)row * 512 + h * 128 + l16 * 8);
        const uint4 gg = *(const uint4*)(projH + (size_t)row * HGW + 2048 + h * 128 + l16 * 8);
        const unsigned aw[4] = {a.x, a.y, a.z, a.w}, bw[4] = {bb.x, bb.y, bb.z, bb.w}, gv[4] = {gg.x, gg.y, gg.z, gg.w};
        float x[8], ss = 0.f;
#pragma unroll
        for (int j = 0; j < 4; ++j) {
            x[2 * j] = __uint_as_float(aw[j] << 16) + __uint_as_float(bw[j] << 16);
            x[2 * j + 1] = __uint_as_float(aw[j] & 0xffff0000u) + __uint_as_float(bw[j] & 0xffff0000u);
            ss += x[2 * j] * x[2 * j] + x[2 * j + 1] * x[2 * j + 1];
        }
        ss += __int_as_float(__builtin_amdgcn_update_dpp(0, __float_as_int(ss), 0xB1, 0xF, 0xF, true));
        ss += __int_as_float(__builtin_amdgcn_update_dpp(0, __float_as_int(ss), 0x4E, 0xF, 0xF, true));
        ss += __int_as_float(__builtin_amdgcn_update_dpp(0, __float_as_int(ss), 0x141, 0xF, 0xF, true));
        ss += __int_as_float(__builtin_amdgcn_update_dpp(0, __float_as_int(ss), 0x140, 0xF, 0xF, true));
        const float rinv = rsqrtf(ss * (1.0f / 128.0f) + EPS);
        unsigned ow[4];
#pragma unroll
        for (int j = 0; j < 4; ++j) {
            const float y0 = x[2 * j] * rinv * gw[2 * j] * siluf_(__uint_as_float(gv[j] << 16));
            const float y1 = x[2 * j + 1] * rinv * gw[2 * j + 1] * siluf_(__uint_as_float(gv[j] & 0xffff0000u));
            ow[j] = pack2(y0, y1);
        }
        *(uint4*)(mix + (size_t)row * D + h * 128 + l16 * 8) = make_uint4(ow[0], ow[1], ow[2], ow[3]);
    }
}

__device__ void ph_prep_swa(int bid, int nb, bf16_t* __restrict__ P, const float* __restrict__ cosS, const float* __restrict__ sinS) {
    const int n = TA * 40;
    for (int idx = bid * blockDim.x + threadIdx.x; idx < n; idx += nb * blockDim.x) {
        const int row = idx / 40, pr = idx - row * 40, head = pr >> 2, d = (pr & 3) * 8;
        bf16_t* p = P + (size_t)row * SWW + head * 64 + d;
        const uint4 a = *(const uint4*)p, b = *(const uint4*)(p + 32);
        const unsigned aw[4] = {a.x, a.y, a.z, a.w}, bw[4] = {b.x, b.y, b.z, b.w};
        float x1[8], x2[8];
#pragma unroll
        for (int j = 0; j < 4; ++j) {
            x1[2 * j] = __uint_as_float(aw[j] << 16); x1[2 * j + 1] = __uint_as_float(aw[j] & 0xffff0000u);
            x2[2 * j] = __uint_as_float(bw[j] << 16); x2[2 * j + 1] = __uint_as_float(bw[j] & 0xffff0000u);
        }
        if (row < TL) {
            const int t = row & (SEQ - 1);
            const float4 c0 = *(const float4*)(cosS + t * 32 + d), c1 = *(const float4*)(cosS + t * 32 + d + 4);
            const float4 s0 = *(const float4*)(sinS + t * 32 + d), s1 = *(const float4*)(sinS + t * 32 + d + 4);
            const float cc[8] = {c0.x, c0.y, c0.z, c0.w, c1.x, c1.y, c1.z, c1.w}, ss[8] = {s0.x, s0.y, s0.z, s0.w, s1.x, s1.y, s1.z, s1.w};
#pragma unroll
            for (int j = 0; j < 8; ++j) { const float y1 = x1[j] * cc[j] - x2[j] * ss[j], y2 = x1[j] * ss[j] + x2[j] * cc[j]; x1[j] = y1; x2[j] = y2; }
        }
        if (head < 8) {
#pragma unroll
            for (int j = 0; j < 8; ++j) { x1[j] *= 0.125f * LOG2E; x2[j] *= 0.125f * LOG2E; }
        }
        uint4 oa, ob;
        oa.x = pack2(x1[0], x1[1]); oa.y = pack2(x1[2], x1[3]); oa.z = pack2(x1[4], x1[5]); oa.w = pack2(x1[6], x1[7]);
        ob.x = pack2(x2[0], x2[1]); ob.y = pack2(x2[2], x2[3]); ob.z = pack2(x2[4], x2[5]); ob.w = pack2(x2[6], x2[7]);
        *(uint4*)p = oa; *(uint4*)(p + 32) = ob;
    }
}
__device__ void ph_prep_ga(int bid, int nb, bf16_t* __restrict__ P, const float* __restrict__ qg, const float* __restrict__ kg,
                           const float* __restrict__ cosG, const float* __restrict__ sinG) {
    const int lane = threadIdx.x & 63, wid = threadIdx.x >> 6;
    for (int it = bid * 4 + wid; it < TA * 10; it += nb * 4) {
        const int row = it / 10, head = it % 10;
        bf16_t* p = P + (size_t)row * GA_IN + head * 128;
        float x1 = bf2f(p[lane]), x2 = bf2f(p[lane + 64]);
        const float ss = wave_sum(x1 * x1 + x2 * x2);
        const float rinv = rsqrtf(ss * (1.0f / 128.0f) + EPS);
        const float* g = head < 8 ? qg : kg;
        x1 = x1 * rinv * g[lane]; x2 = x2 * rinv * g[lane + 64];
        if (row < TL) {
            const int t = row & (SEQ - 1);
            const float c = cosG[t * 64 + lane], s = sinG[t * 64 + lane];
            const float y1 = x1 * c - x2 * s, y2 = x1 * s + x2 * c;
            x1 = y1; x2 = y2;
        }
        if (head < 8) { x1 *= 0.08838834764831845f * LOG2E; x2 *= 0.08838834764831845f * LOG2E; }
        p[lane] = f2bf(x1); p[lane + 64] = f2bf(x2);
    }
}

template <int HD>
__device__ void ph_vt(int bid, int nb, const bf16_t* __restrict__ P, int ldp, int vcol, bf16_t* __restrict__ Vt, bf16_t* lds) {
    constexpr int ND = HD / 64;
    const int tid = threadIdx.x;
    for (int it = bid; it < NB * 2 * ND * (NKEY / 64); it += nb) {
        const int kt = it % (NKEY / 64), r1 = it / (NKEY / 64), dh = r1 % ND, g = r1 / ND, b = g >> 1, kvh = g & 1;
        const int k0 = kt * 64;
        const int row0 = k0 < LC ? TL + b * LC + k0 : b * SEQ + (k0 - LC);
        __syncthreads();
#pragma unroll
        for (int i = 0; i < 2; ++i) {
            const int id = tid + i * 256, kr = id >> 3, c = id & 7;
            const uint4 w = *(const uint4*)(P + (size_t)(row0 + kr) * ldp + vcol + kvh * HD + dh * 64 + c * 8);
            const unsigned ww[4] = {w.x, w.y, w.z, w.w};
#pragma unroll
            for (int j = 0; j < 4; ++j) { lds[kr * 66 + c * 8 + j * 2] = (bf16_t)(ww[j] & 0xffff); lds[kr * 66 + c * 8 + j * 2 + 1] = (bf16_t)(ww[j] >> 16); }
        }
        __syncthreads();
#pragma unroll
        for (int i = 0; i < 2; ++i) {
            const int id = tid + i * 256, d = id >> 3, c = id & 7;
            unsigned o[4];
#pragma unroll
            for (int j = 0; j < 4; ++j) o[j] = (unsigned)lds[(c * 8 + j * 2) * 66 + d] | ((unsigned)lds[(c * 8 + j * 2 + 1) * 66 + d] << 16);
            uint4 w; w.x = o[0]; w.y = o[1]; w.z = o[2]; w.w = o[3];
            *(uint4*)(Vt + (size_t)(g * HD + dh * 64 + d) * NKEY + k0 + c * 8) = w;
        }
    }
}

template <int HD, bool MASK>
__device__ __forceinline__ void flash_item(const bf16_t* __restrict__ Qrow0, int ldq, const bf16_t* __restrict__ Kp, int ldk,
                                           const bf16_t* __restrict__ Vt, int krow_ctx0, int krow_lat0, int nctx_t, int lat_lo, int nlat_t,
                                           int tq0, float m0, float l0, bf16_t* __restrict__ Orow0, int ldo, char* lds) {
    constexpr int NCH = HD / 32;
    constexpr int KB = 64 * HD * 2;
    constexpr int NKK = HD / 16;
    constexpr int NDT = HD / 32;
    const int tid = threadIdx.x, lane = tid & 63, w = tid >> 6, r = lane & 31, h = lane >> 5;
    const int pr = (r & 0x13) | ((r & 4) << 1) | ((r & 8) >> 1);
    bf16x8 qf[NKK];
    {
        const bf16_t* qp = Qrow0 + (size_t)(32 * w + r) * ldq + 8 * h;
#pragma unroll
        for (int kk = 0; kk < NKK; ++kk) qf[kk] = *(const bf16x8*)(qp + 16 * kk);
    }
    f32x16 O[NDT];
#pragma unroll
    for (int dt = 0; dt < NDT; ++dt)
#pragma unroll
        for (int i = 0; i < 16; ++i) O[dt][i] = 0.f;
    float m_run = m0, l_run = (h == 0) ? l0 : 0.f;
    typedef __attribute__((address_space(3))) char las_char;
    las_char* l3 = (las_char*)lds;
    constexpr int KRI = (HD == 128) ? 4 : 8;
    constexpr int NKI = 16 / KRI;
    constexpr int NVI = HD / 32;
    const int krl = (HD == 128) ? (lane >> 4) : (lane >> 3);
    const int kpl = (HD == 128) ? (lane & 15) : (lane & 7);
    const int vrl = lane >> 3, vpl = lane & 7;
    const int kfo = pr * (HD * 2);
    const int kfs = (HD == 128) ? (pr & 15) : ((pr >> 1) & 7);
    const int vfo = KB + r * 128;
    const int vfs = (r >> 1) & 7;
    const int ntile = nctx_t + nlat_t;
#define FA_TILE(t, krow0, kidx0, s0) const int krow0 = (t) < nctx_t ? krow_ctx0 + 64 * (t) : krow_lat0 + lat_lo + 64 * ((t) - nctx_t); \
        const int s0 = (t) < nctx_t ? -(1 << 24) : lat_lo + 64 * ((t) - nctx_t); const int kidx0 = (t) < nctx_t ? 64 * (t) : LC + lat_lo + 64 * ((t) - nctx_t);
#define FA_STAGE(t, buf) do { FA_TILE(t, _kr0, _ki0, _s0) (void)_s0; \
        _Pragma("unroll") for (int i = 0; i < NKI; ++i) { const int _row = 16 * w + KRI * i + krl; \
            const int _c = (HD == 128) ? (kpl ^ (_row & 15)) : (kpl ^ ((_row >> 1) & 7)); \
            __builtin_amdgcn_global_load_lds((const unsigned*)(Kp + (size_t)(_kr0 + _row) * ldk + _c * 8), \
                (__attribute__((address_space(3))) unsigned*)(l3 + (buf) * (2 * KB) + (16 * w + KRI * i) * (HD * 2)), 16, 0, 0); } \
        _Pragma("unroll") for (int i = 0; i < NVI; ++i) { const int _row = (HD / 4) * w + 8 * i + vrl; const int _c = vpl ^ ((_row >> 1) & 7); \
            __builtin_amdgcn_global_load_lds((const unsigned*)(Vt + (size_t)_row * NKEY + _ki0 + _c * 8), \
                (__attribute__((address_space(3))) unsigned*)(l3 + (buf) * (2 * KB) + KB + ((HD / 4) * w + 8 * i) * 128), 16, 0, 0); } } while (0)
    __syncthreads();
    FA_STAGE(0, 0);
    __syncthreads();
    for (int t = 0; t < ntile; ++t) {
        if (t + 1 < ntile) FA_STAGE(t + 1, (t + 1) & 1);
        const char* base = lds + (t & 1) * (2 * KB);
        f32x16 st[2];
        __builtin_amdgcn_s_setprio(1);
#pragma unroll
        for (int rt = 0; rt < 2; ++rt) {
#pragma unroll
            for (int i = 0; i < 16; ++i) st[rt][i] = 0.f;
#pragma unroll
            for (int kk = 0; kk < NKK; ++kk) {
                const bf16x8 kf = *(const bf16x8*)(base + rt * 32 * (HD * 2) + kfo + (((2 * kk + h) ^ kfs) << 4));
                st[rt] = __builtin_amdgcn_mfma_f32_32x32x16_bf16(kf, qf[kk], st[rt], 0, 0, 0);
                if ((kk & 7) == 7) __builtin_amdgcn_sched_barrier(0);
            }
        }
        __builtin_amdgcn_s_setprio(0);
        if (MASK) {
            FA_TILE(t, _kr0, _ki0, s0) (void)_kr0; (void)_ki0;
            if (t >= nctx_t) {
                const int tq = tq0 + 32 * w + r;
#pragma unroll
                for (int rt = 0; rt < 2; ++rt)
#pragma unroll
                    for (int i = 0; i < 16; ++i) {
                        const int s = s0 + 32 * rt + (i & 3) + 4 * ((i >> 2) & 1) + 8 * h + 16 * (i >> 3);
                        const int dlt = tq - s;
                        if (dlt > 128 || dlt < -128) st[rt][i] = -1.0e30f;
                    }
            }
        }
        constexpr float FA_THR = 11.5f;
        float pmax = st[0][0];
#pragma unroll
        for (int rt = 0; rt < 2; ++rt)
#pragma unroll
            for (int i = 0; i < 16; ++i) pmax = fmaxf(pmax, st[rt][i]);
        pmax = fmaxf(pmax, __shfl_xor(pmax, 32));
        float mx = m_run, alpha = 1.0f;
        if (!__all(pmax - m_run <= FA_THR)) {
            mx = fmaxf(m_run, pmax);
            alpha = __builtin_amdgcn_exp2f(m_run - mx);
            m_run = mx;
        }
        float ps = 0.f;
#pragma unroll
        for (int rt = 0; rt < 2; ++rt)
#pragma unroll
            for (int i = 0; i < 16; ++i) { const float p = __builtin_amdgcn_exp2f(st[rt][i] - mx); st[rt][i] = p; ps += p; }
        l_run = l_run * alpha + ps;
        if (!__all(alpha == 1.0f)) {
#pragma unroll
            for (int dt = 0; dt < NDT; ++dt)
#pragma unroll
                for (int i = 0; i < 16; ++i) O[dt][i] *= alpha;
        }
        bf16x8 pf[2][2];
#pragma unroll
        for (int rt = 0; rt < 2; ++rt)
#pragma unroll
            for (int s2 = 0; s2 < 2; ++s2) {
                uint4 pk;
                pk.x = pack2(st[rt][8 * s2 + 0], st[rt][8 * s2 + 1]); pk.y = pack2(st[rt][8 * s2 + 2], st[rt][8 * s2 + 3]);
                pk.z = pack2(st[rt][8 * s2 + 4], st[rt][8 * s2 + 5]); pk.w = pack2(st[rt][8 * s2 + 6], st[rt][8 * s2 + 7]);
                pf[rt][s2] = __builtin_bit_cast(bf16x8, pk);
            }
#pragma unroll
        for (int dt = 0; dt < NDT; ++dt)
#pragma unroll
            for (int rt = 0; rt < 2; ++rt)
#pragma unroll
                for (int s2 = 0; s2 < 2; ++s2) {
                    const bf16x8 vf = *(const bf16x8*)(base + vfo + dt * 4096 + (((4 * rt + 2 * s2 + h) ^ vfs) << 4));
                    O[dt] = __builtin_amdgcn_mfma_f32_32x32x16_bf16(vf, pf[rt][s2], O[dt], 0, 0, 0);
                    if (rt == 1 && s2 == 1) __builtin_amdgcn_sched_barrier(0);
                }
        __syncthreads();
    }
#undef FA_TILE
#undef FA_STAGE
    const float lt = l_run + __shfl_xor(l_run, 32);
    const float inv = 1.0f / lt;
    char* wl = lds + w * (32 * (HD * 2 + 16));
#pragma unroll
    for (int dt = 0; dt < NDT; ++dt)
#pragma unroll
        for (int g = 0; g < 4; ++g) {
            uint2 o2; o2.x = pack2(O[dt][4 * g] * inv, O[dt][4 * g + 1] * inv); o2.y = pack2(O[dt][4 * g + 2] * inv, O[dt][4 * g + 3] * inv);
            *(uint2*)(wl + r * (HD * 2 + 16) + (32 * dt + 8 * g + 4 * h) * 2) = o2;
        }
    constexpr int LPR = HD / 8;
#pragma unroll
    for (int m = 0; m < 32 * LPR / 64; ++m) {
        const int rr = (lane / LPR) + (64 / LPR) * m, ch = lane % LPR;
        const uint4 v = *(const uint4*)(wl + rr * (HD * 2 + 16) + ch * 16);
        *(uint4*)(Orow0 + (size_t)(32 * w + rr) * ldo + ch * 8) = v;
    }
}
__device__ void ph_swa(int bid, int nb, const bf16_t* __restrict__ projS, const bf16_t* __restrict__ Vt, const float* __restrict__ sink,
                       bf16_t* __restrict__ mix, char* lds) {
    const int n_lat = NB * 8 * 32, n_ctx = NB * 8 * 2;
    for (int it = bid; it < n_lat + n_ctx; it += nb) {
        int b, hq, row0, lo, nlat, t0;
        if (it < n_lat) {
            const int qb = it & 31; hq = (it >> 5) & 7; b = it >> 8;
            t0 = qb * 128;
            lo = t0 - 128 < 0 ? 0 : t0 - 128;
            const int hi = t0 + 256 > SEQ ? SEQ : t0 + 256;
            nlat = (hi - lo) / 64; row0 = b * SEQ + t0;
        } else {
            const int i2 = it - n_lat, qb = i2 & 1; hq = (i2 >> 1) & 7; b = i2 >> 4;
            t0 = 0; lo = 0; nlat = 0; row0 = TL + b * LC + qb * 128;
        }
        const int kvh = hq >> 2;
        flash_item<64, true>(projS + (size_t)row0 * SWW + hq * 64, SWW, projS + 512 + kvh * 64, SWW, Vt + (size_t)(b * 2 + kvh) * 64 * NKEY,
                             TL + b * LC, b * SEQ, 4, lo, nlat, t0, sink[hq] * LOG2E, 1.0f, mix + (size_t)row0 * D + 512 + hq * 64, D, lds);
    }
}
__device__ void ph_dense(int bid, int nb, const bf16_t* __restrict__ projG, const bf16_t* __restrict__ Vt, bf16_t* __restrict__ mix, char* lds) {
    const bool sw = (nb & 7) == 0;
    const int nit = NB * 8 * 32;
    for (int j = sw ? (bid >> 3) : bid; j < (sw ? nit / 8 : nit); j += sw ? (nb >> 3) : nb) {
        int g, jj;
        if (sw) { g = (bid & 7) + 8 * (j >> 7); jj = j & 127; } else { g = j >> 7; jj = j & 127; }
        const int b = g >> 1, kvh = g & 1, hq = kvh * 4 + (jj >> 5), qb = jj & 31;
        const int row0 = b * SEQ + qb * 128;
        flash_item<128, false>(projG + (size_t)row0 * GA_IN + hq * 128, GA_IN, projG + 1024 + kvh * 128, GA_IN, Vt + (size_t)(b * 2 + kvh) * 128 * NKEY,
                               TL + b * LC, b * SEQ, 4, 0, SEQ / 64, 0, -1.0e30f, 0.0f, mix + (size_t)row0 * D + hq * 128, D, lds);
    }
}

#define CE(a, b) { const float _h = fmaxf(a, b); b = fminf(a, b); a = _h; }
__device__ __forceinline__ void net_sort16(float (&v)[16]) {
    CE(v[0], v[1]); CE(v[3], v[2]); CE(v[4], v[5]); CE(v[7], v[6]); CE(v[8], v[9]); CE(v[11], v[10]);
    CE(v[12], v[13]); CE(v[15], v[14]); CE(v[0], v[2]); CE(v[1], v[3]); CE(v[6], v[4]); CE(v[7], v[5]);
    CE(v[8], v[10]); CE(v[9], v[11]); CE(v[14], v[12]); CE(v[15], v[13]); CE(v[0], v[1]); CE(v[2], v[3]);
    CE(v[5], v[4]); CE(v[7], v[6]); CE(v[8], v[9]); CE(v[10], v[11]); CE(v[13], v[12]); CE(v[15], v[14]);
    CE(v[0], v[4]); CE(v[1], v[5]); CE(v[2], v[6]); CE(v[3], v[7]); CE(v[12], v[8]); CE(v[13], v[9]);
    CE(v[14], v[10]); CE(v[15], v[11]); CE(v[0], v[2]); CE(v[1], v[3]); CE(v[4], v[6]); CE(v[5], v[7]);
    CE(v[10], v[8]); CE(v[11], v[9]); CE(v[14], v[12]); CE(v[15], v[13]); CE(v[0], v[1]); CE(v[2], v[3]);
    CE(v[4], v[5]); CE(v[6], v[7]); CE(v[9], v[8]); CE(v[11], v[10]); CE(v[13], v[12]); CE(v[15], v[14]);
    CE(v[0], v[8]); CE(v[1], v[9]); CE(v[2], v[10]); CE(v[3], v[11]); CE(v[4], v[12]); CE(v[5], v[13]);
    CE(v[6], v[14]); CE(v[7], v[15]); CE(v[0], v[4]); CE(v[1], v[5]); CE(v[2], v[6]); CE(v[3], v[7]);
    CE(v[8], v[12]); CE(v[9], v[13]); CE(v[10], v[14]); CE(v[11], v[15]); CE(v[0], v[2]); CE(v[1], v[3]);
    CE(v[4], v[6]); CE(v[5], v[7]); CE(v[8], v[10]); CE(v[9], v[11]); CE(v[12], v[14]); CE(v[13], v[15]);
    CE(v[0], v[1]); CE(v[2], v[3]); CE(v[4], v[5]); CE(v[6], v[7]); CE(v[8], v[9]); CE(v[10], v[11]);
    CE(v[12], v[13]); CE(v[14], v[15]);
}
__device__ __forceinline__ void net_clean16(float (&v)[16]) {
    CE(v[0], v[8]); CE(v[1], v[9]); CE(v[2], v[10]); CE(v[3], v[11]); CE(v[4], v[12]); CE(v[5], v[13]);
    CE(v[6], v[14]); CE(v[7], v[15]); CE(v[0], v[4]); CE(v[1], v[5]); CE(v[2], v[6]); CE(v[3], v[7]);
    CE(v[8], v[12]); CE(v[9], v[13]); CE(v[10], v[14]); CE(v[11], v[15]); CE(v[0], v[2]); CE(v[1], v[3]);
    CE(v[4], v[6]); CE(v[5], v[7]); CE(v[8], v[10]); CE(v[9], v[11]); CE(v[12], v[14]); CE(v[13], v[15]);
    CE(v[0], v[1]); CE(v[2], v[3]); CE(v[4], v[5]); CE(v[6], v[7]); CE(v[8], v[9]); CE(v[10], v[11]);
    CE(v[12], v[13]); CE(v[14], v[15]);
}
__device__ __forceinline__ void net_merge16(float (&a)[16], const float (&b)[16]) {
#pragma unroll
    for (int i = 0; i < 16; ++i) a[i] = fmaxf(a[i], b[15 - i]);
    net_clean16(a);
}
#define PEER_CANDS(F) F(0,0,0) F(1,0,1) F(2,0,2) F(3,0,3) F(4,0,4) F(5,0,5) F(6,0,6) F(7,0,7) F(8,0,8) F(9,0,9) F(10,0,10) F(11,0,11) F(12,0,12) F(13,0,13) F(14,0,14) F(15,0,15) F(16,1,1) F(17,1,2) F(18,1,3) F(19,1,4) F(20,1,5) F(21,1,6) F(22,1,7) F(23,2,2) F(24,2,3) F(25,2,4) F(26,3,3)

__device__ __forceinline__ void ph_peer_route(int bid, int nb, const bf16_t* __restrict__ qpeer, const bf16_t* __restrict__ SK, int* __restrict__ sel_e,
                              float* __restrict__ sel_g, int M, char* lds) {
    const int tid = tidx(), lane = tid & 63, w = tid >> 6, r = lane & 31, h2 = lane >> 5;
    const int srow = tid >> 4, sc = tid & 15;
    const int soff = srow * 256 + ((sc ^ (srow & 15)) << 4);
    int hd_loaded = -1;
    for (int it = bid; it < (M / 128) * 8; it += nb) {
        const int m0 = (it >> 3) * 128, hd = it & 7;
        const int row = 32 * w + r;
        __syncthreads();
        if (hd != hd_loaded) {
        hd_loaded = hd;
#pragma unroll
        for (int pp = 0; pp < 2; ++pp) {
            const bf16_t* sp = SK + ((size_t)(hd * 2 + pp) * 128 + srow) * 128 + sc * 8;
            uint4 t0 = *(const uint4*)(sp), t1 = *(const uint4*)(sp + 16 * 128), t2 = *(const uint4*)(sp + 32 * 128), t3 = *(const uint4*)(sp + 48 * 128);
            uint4 t4 = *(const uint4*)(sp + 64 * 128), t5 = *(const uint4*)(sp + 80 * 128), t6 = *(const uint4*)(sp + 96 * 128), t7 = *(const uint4*)(sp + 112 * 128);
            char* d = lds + pp * 32768 + soff;
            *(uint4*)(d) = t0; *(uint4*)(d + 4096) = t1; *(uint4*)(d + 8192) = t2; *(uint4*)(d + 12288) = t3;
            *(uint4*)(d + 16384) = t4; *(uint4*)(d + 20480) = t5; *(uint4*)(d + 24576) = t6; *(uint4*)(d + 28672) = t7;
        }
        }
        __syncthreads();
        float L0[16], L1[16];
#pragma unroll
        for (int pp = 0; pp < 2; ++pp) {
            bf16x8 qf[8];
            const bf16_t* qp = qpeer + (size_t)(m0 + row) * PQ + hd * 256 + pp * 128 + 8 * h2;
#pragma unroll
            for (int kk = 0; kk < 8; ++kk) qf[kk] = *(const bf16x8*)(qp + 16 * kk);
            float g[4][16];
#pragma unroll
            for (int kt = 0; kt < 4; ++kt) {
                f32x16 st;
#pragma unroll
                for (int i = 0; i < 16; ++i) st[i] = 0.f;
#pragma unroll
                for (int kk = 0; kk < 8; ++kk) {
                    const bf16x8 kf = *(const bf16x8*)(lds + pp * 32768 + (32 * kt + r) * 256 + (((2 * kk + h2) ^ (r & 15)) << 4));
                    st = __builtin_amdgcn_mfma_f32_32x32x16_bf16(kf, qf[kk], st, 0, 0, 0);
                }
#pragma unroll
                for (int i = 0; i < 16; ++i) {
                    const unsigned n = 32 * kt + (i & 3) + 8 * (i >> 2) + 4 * h2;
                    g[kt][i] = __uint_as_float((__float_as_uint(st[i]) & 0xFFFFFF80u) | n);
                }
            }
            net_sort16(g[0]); net_sort16(g[1]); net_sort16(g[2]); net_sort16(g[3]);
            net_merge16(g[0], g[1]); net_merge16(g[2], g[3]); net_merge16(g[0], g[2]);
            float pb[16];
#pragma unroll
            for (int i = 0; i < 16; ++i) pb[i] = __shfl_xor(g[0][i], 32);
            net_merge16(g[0], pb);
#pragma unroll
            for (int i = 0; i < 16; ++i) { if (pp == 0) L0[i] = g[0][i]; else L1[i] = g[0][i]; }
        }
        __syncthreads();
        unsigned char* tab = (unsigned char*)lds + 65536;
        if (h2 == 0) {
            unsigned wv[8];
#pragma unroll
            for (int j = 0; j < 4; ++j) {
                wv[j] = (__float_as_uint(L0[4 * j]) & 0x7Fu) | ((__float_as_uint(L0[4 * j + 1]) & 0x7Fu) << 8) | ((__float_as_uint(L0[4 * j + 2]) & 0x7Fu) << 16) | ((__float_as_uint(L0[4 * j + 3]) & 0x7Fu) << 24);
                wv[4 + j] = (__float_as_uint(L1[4 * j]) & 0x7Fu) | ((__float_as_uint(L1[4 * j + 1]) & 0x7Fu) << 8) | ((__float_as_uint(L1[4 * j + 2]) & 0x7Fu) << 16) | ((__float_as_uint(L1[4 * j + 3]) & 0x7Fu) << 24);
            }
            *(uint4*)(tab + row * 32) = make_uint4(wv[0], wv[1], wv[2], wv[3]);
            *(uint4*)(tab + row * 32 + 16) = make_uint4(wv[4], wv[5], wv[6], wv[7]);
        }
        float X[16], Y[16];
#pragma unroll
        for (int i = 0; i < 16; ++i) {
            const float a0 = __uint_as_float(__float_as_uint(L0[i]) & 0xFFFFFF80u), a1 = __uint_as_float(__float_as_uint(L1[i]) & 0xFFFFFF80u);
            X[i] = h2 ? a1 : a0; Y[i] = h2 ? a0 : a1;
        }
        float c0[16], c1[16];
#define PEER_CAND(i, a, b) { float v = X[a] + Y[b]; if ((a) == (b) && h2) v = -3.0e38f; const unsigned id = h2 ? ((b) * 16 + (a)) : ((a) * 16 + (b)); \
            const float pk = __uint_as_float((__float_as_uint(v) & 0xFFFFFF00u) | id); if ((i) < 16) c0[(i) & 15] = pk; else c1[(i) & 15] = pk; }
        PEER_CANDS(PEER_CAND)
#undef PEER_CAND
#pragma unroll
        for (int i = 11; i < 16; ++i) c1[i] = -3.0e38f;
        net_sort16(c0); net_sort16(c1); net_merge16(c0, c1);
        {
            float pb[16];
#pragma unroll
            for (int i = 0; i < 16; ++i) pb[i] = __shfl_xor(c0[i], 32);
            net_merge16(c0, pb);
        }
        float ex[16], sum = 0.f;
#pragma unroll
        for (int i = 0; i < 16; ++i) { ex[i] = __expf(c0[i] - c0[0]); sum += ex[i]; }
        const float rs = 1.0f / sum;
        const size_t ob = ((size_t)(m0 + row) * 8 + hd) * 16;
        if (h2 == 0) {
            int eo[16];
#pragma unroll
            for (int j = 0; j < 16; ++j) {
                const unsigned id = __float_as_uint(c0[j]) & 0xFFu;
                eo[j] = (int)tab[row * 32 + (id >> 4)] * 128 + (int)tab[row * 32 + 16 + (id & 15)];
            }
#pragma unroll
            for (int j = 0; j < 4; ++j) *(int4*)(sel_e + ob + 4 * j) = make_int4(eo[4 * j], eo[4 * j + 1], eo[4 * j + 2], eo[4 * j + 3]);
        } else {
#pragma unroll
            for (int j = 0; j < 4; ++j) *(float4*)(sel_g + ob + 4 * j) = make_float4(ex[4 * j] * rs, ex[4 * j + 1] * rs, ex[4 * j + 2] * rs, ex[4 * j + 3] * rs);
        }
    }
}
constexpr float USCALE = 64.0f;
typedef long i64_t;
__device__ __forceinline__ i64_t mk64(unsigned lo, unsigned hi) { return (i64_t)(((unsigned long long)hi << 32) | (unsigned long long)lo); }
__device__ __forceinline__ float dpp_add_xor1(float v) {
    return v + __int_as_float(__builtin_amdgcn_update_dpp(0, __float_as_int(v), 0xB1, 0xF, 0xF, true));
}
template <class F>
__device__ __forceinline__ void peer_queue_sweep(unsigned* heads, int nunits, unsigned xcc, unsigned* ldsw, F&& body) {
    for (int rr = 0; rr < 8; ++rr) {
        const int s = (int)((xcc + rr) & 7u);
        for (;;) {
            __syncthreads();
            if (tidx() == 0) *ldsw = __hip_atomic_fetch_add(heads + 64 * s, 1u, __ATOMIC_RELAXED, __HIP_MEMORY_SCOPE_AGENT);
            __syncthreads();
            const int u = __builtin_amdgcn_readfirstlane((int)*ldsw);
            if (u >= nunits) break;
            body(__builtin_amdgcn_readfirstlane(s), u);
        }
    }
}
__device__ __forceinline__ float dpp_sum8(float v) {
    v += __int_as_float(__builtin_amdgcn_update_dpp(0, __float_as_int(v), 0xB1, 0xF, 0xF, true));
    v += __int_as_float(__builtin_amdgcn_update_dpp(0, __float_as_int(v), 0x4E, 0xF, 0xF, true));
    v += __int_as_float(__builtin_amdgcn_update_dpp(0, __float_as_int(v), 0x141, 0xF, 0xF, true));
    return v;
}
__device__ __forceinline__ int dpp_isum8(int v) {
    v += __builtin_amdgcn_update_dpp(0, v, 0xB1, 0xF, 0xF, true);
    v += __builtin_amdgcn_update_dpp(0, v, 0x4E, 0xF, 0xF, true);
    v += __builtin_amdgcn_update_dpp(0, v, 0x141, 0xF, 0xF, true);
    return v;
}
__device__ __forceinline__ void ph_peer_dots(unsigned* heads, unsigned xcc, const unsigned char* __restrict__ xq, const float* __restrict__ xs, const unsigned char* __restrict__ U,
                                             const int* __restrict__ sel_e, bf16_t* __restrict__ part, int ntok, unsigned* ldsw) {
    const int lane = tidx() & 63, wid = __builtin_amdgcn_readfirstlane(tidx() >> 6), c = lane & 7, g = lane >> 3;
    peer_queue_sweep(heads, ntok / 64, xcc, ldsw, [&](int s, int u) {
        const unsigned char* Us = U + (size_t)s * NEXP * 128;
        const int row0 = u * 64 + wid * 16;
        int ek[16]; uint4 xw; float sx;
        {
#pragma unroll
            for (int i = 0; i < 4; ++i) {
                const int4 e4 = *(const int4*)(sel_e + (size_t)row0 * 128 + 16 * g + 4 * i);
                ek[4 * i] = e4.x; ek[4 * i + 1] = e4.y; ek[4 * i + 2] = e4.z; ek[4 * i + 3] = e4.w;
            }
            xw = *(const uint4*)(xq + (size_t)row0 * D + s * 128 + c * 16); sx = xs[row0];
        }
#pragma unroll 1
        for (int ti = 0; ti < 16; ++ti) {
            const int row = row0 + ti, rown = row0 + (ti < 15 ? ti + 1 : ti);
            uint4 ur[16];
#pragma unroll
            for (int k = 0; k < 16; ++k) ur[k] = *(const uint4*)(Us + ((unsigned)ek[k] * 128u + (unsigned)c * 16u));
            int ekn[16];
#pragma unroll
            for (int i = 0; i < 4; ++i) {
                const int4 e4 = *(const int4*)(sel_e + (size_t)rown * 128 + 16 * g + 4 * i);
                ekn[4 * i] = e4.x; ekn[4 * i + 1] = e4.y; ekn[4 * i + 2] = e4.z; ekn[4 * i + 3] = e4.w;
            }
            const uint4 xn = *(const uint4*)(xq + (size_t)rown * D + s * 128 + c * 16); const float sxn = xs[rown];
            int keep0 = 0, keep1 = 0;
#pragma unroll
            for (int k = 0; k < 16; ++k) {
                int a = __builtin_amdgcn_sdot4((int)ur[k].x, (int)xw.x, 0, false);
                a = __builtin_amdgcn_sdot4((int)ur[k].y, (int)xw.y, a, false);
                a = __builtin_amdgcn_sdot4((int)ur[k].z, (int)xw.z, a, false);
                a = __builtin_amdgcn_sdot4((int)ur[k].w, (int)xw.w, a, false);
                const int tot = dpp_isum8(a);
                if ((k & 1) == 0) keep0 = (c == (k >> 1)) ? tot : keep0; else keep1 = (c == (k >> 1)) ? tot : keep1;
            }
            const float fs = sx * (USCALE / UQ);
            *(unsigned*)(part + ((size_t)s * ntok + row) * 128 + 16 * g + 2 * c) = pack2((float)keep0 * fs, (float)keep1 * fs);
#pragma unroll
            for (int k = 0; k < 16; ++k) ek[k] = ekn[k];
            xw = xn; sx = sxn;
        }
    });
}
__device__ void ph_peer_weights(int bid, int nb, const bf16_t* __restrict__ part, float* __restrict__ sel_g, int ntok) {
    const size_t n = (size_t)ntok * 128, n4 = n / 4;
    for (size_t i = (size_t)bid * blockDim.x + tidx(); i < n4; i += (size_t)nb * blockDim.x) {
        float a[4] = {0.f, 0.f, 0.f, 0.f};
#pragma unroll
        for (int s = 0; s < 8; ++s) {
            const uint2 w = *(const uint2*)(part + (size_t)s * n + i * 4);
            a[0] += __uint_as_float(w.x << 16); a[1] += __uint_as_float(w.x & 0xffff0000u); a[2] += __uint_as_float(w.y << 16); a[3] += __uint_as_float(w.y & 0xffff0000u);
        }
        float4 gq = ((const float4*)sel_g)[i];
        float o[4] = {gq.x, gq.y, gq.z, gq.w};
#pragma unroll
        for (int j = 0; j < 4; ++j) { const float dot = a[j] * (1.0f / USCALE); o[j] *= 0.5f * dot * (1.0f + erff(dot * 0.70710678118654752f)); }
        ((float4*)sel_g)[i] = make_float4(o[0], o[1], o[2], o[3]);
    }
}
__device__ __forceinline__ void ph_peer_vsum(unsigned* heads, unsigned xcc, const unsigned char* __restrict__ V, const int* __restrict__ sel_e,
                                             const float* __restrict__ sel_w, const float* __restrict__ gate  ,
                                             bf16_t* __restrict__ h16, int ntok, unsigned* ldsw) {
    const int lane = tidx() & 63, wid = __builtin_amdgcn_readfirstlane(tidx() >> 6), c = lane & 7, g = lane >> 3;
    peer_queue_sweep(heads, ntok / 64, xcc, ldsw, [&](int s, int u) {
        const unsigned char* Vs = V + (size_t)s * NEXP * 128;
        const int rbase = u * 64 + wid * 16 + g;
        int ek[16]; float wk[16];
#pragma unroll
        for (int i = 0; i < 4; ++i) {
            const int4 e4 = *(const int4*)(sel_e + (size_t)rbase * 128 + 4 * i);
            const float4 w4 = *(const float4*)(sel_w + (size_t)rbase * 128 + 4 * i);
            ek[4 * i] = e4.x; ek[4 * i + 1] = e4.y; ek[4 * i + 2] = e4.z; ek[4 * i + 3] = e4.w;
            wk[4 * i] = w4.x; wk[4 * i + 1] = w4.y; wk[4 * i + 2] = w4.z; wk[4 * i + 3] = w4.w;
        }
        f32x2 y2[8];
#pragma unroll
        for (int i = 0; i < 8; ++i) y2[i] = (f32x2){0.f, 0.f};
#pragma unroll 1
        for (int q = 0; q < 16; ++q) {
            const int row = rbase + 8 * (q >> 3), qn = q < 15 ? q + 1 : q;
            const size_t offn = (size_t)(rbase + 8 * (qn >> 3)) * 128 + 16 * (qn & 7);
            uint4 vr[16];
#pragma unroll
            for (int k = 0; k < 16; ++k) vr[k] = *(const uint4*)(Vs + ((unsigned)ek[k] * 128u + (unsigned)c * 16u));
            int ekn[16]; float wkn[16];
#pragma unroll
            for (int i = 0; i < 4; ++i) {
                const int4 e4 = *(const int4*)(sel_e + offn + 4 * i);
                const float4 w4 = *(const float4*)(sel_w + offn + 4 * i);
                ekn[4 * i] = e4.x; ekn[4 * i + 1] = e4.y; ekn[4 * i + 2] = e4.z; ekn[4 * i + 3] = e4.w;
                wkn[4 * i] = w4.x; wkn[4 * i + 1] = w4.y; wkn[4 * i + 2] = w4.z; wkn[4 * i + 3] = w4.w;
            }
#pragma unroll
            for (int k = 0; k < 16; ++k) {
                const f32x2 w2 = (f32x2){wk[k], wk[k]};
                const unsigned vw[4] = {vr[k].x, vr[k].y, vr[k].z, vr[k].w};
#pragma unroll
                for (int j = 0; j < 4; ++j) {
                    y2[2 * j] = __builtin_amdgcn_cvt_pk_f32_fp8((int)vw[j], false) * w2 + y2[2 * j];
                    y2[2 * j + 1] = __builtin_amdgcn_cvt_pk_f32_fp8((int)vw[j], true) * w2 + y2[2 * j + 1];
                }
            }
            if ((q & 7) == 7) {
                bf16_t* hp = h16 + (size_t)row * D + s * 128 + c * 16;
                const float* gp = gate + (size_t)mod_row(row) * 6144 + s * 128 + c * 16;
                const uint4 h0 = *(const uint4*)hp, h1 = *(const uint4*)(hp + 8);
                const unsigned hw[8] = {h0.x, h0.y, h0.z, h0.w, h1.x, h1.y, h1.z, h1.w};
                unsigned ow[8];
#pragma unroll
                for (int j = 0; j < 4; ++j) {
                    const float4 g4 = *(const float4*)(gp + 4 * j);
                    ow[2 * j] = pack2(__uint_as_float(hw[2 * j] << 16) + g4.x * y2[2 * j].x, __uint_as_float(hw[2 * j] & 0xffff0000u) + g4.y * y2[2 * j].y);
                    ow[2 * j + 1] = pack2(__uint_as_float(hw[2 * j + 1] << 16) + g4.z * y2[2 * j + 1].x, __uint_as_float(hw[2 * j + 1] & 0xffff0000u) + g4.w * y2[2 * j + 1].y);
                }
                *(uint4*)hp = make_uint4(ow[0], ow[1], ow[2], ow[3]); *(uint4*)(hp + 8) = make_uint4(ow[4], ow[5], ow[6], ow[7]);
#pragma unroll
                for (int i = 0; i < 8; ++i) y2[i] = (f32x2){0.f, 0.f};
            }
#pragma unroll
            for (int k = 0; k < 16; ++k) { ek[k] = ekn[k]; wk[k] = wkn[k]; }
        }
    });
}

__device__ void ph_final(int bid, int nb, const bf16_t* __restrict__ h16, float* __restrict__ out, const float* __restrict__ g) {
    const int lane = tidx() & 63, wid = tidx() >> 6;
    const int nwv = nb * 4, per = (TL + nwv - 1) / nwv, r0 = (bid * 4 + wid) * per, r1 = (r0 + per < TL) ? r0 + per : TL;
    if (r0 >= r1) return;
    float4 gg[4];
#pragma unroll
    for (int i = 0; i < 4; ++i) gg[i] = ((const float4*)g)[i * 64 + lane];
    uint2 wn[4];
#pragma unroll
    for (int i = 0; i < 4; ++i) wn[i] = ((const uint2*)(h16 + (size_t)r0 * D))[i * 64 + lane];
    for (int row = r0; row < r1; ++row) {
        uint2 w[4];
#pragma unroll
        for (int i = 0; i < 4; ++i) w[i] = wn[i];
        const int rn = row + 1 < r1 ? row + 1 : row;
#pragma unroll
        for (int i = 0; i < 4; ++i) wn[i] = ((const uint2*)(h16 + (size_t)rn * D))[i * 64 + lane];
        float4 x[4]; float ss = 0.f;
#pragma unroll
        for (int i = 0; i < 4; ++i) {
            x[i].x = __uint_as_float(w[i].x << 16); x[i].y = __uint_as_float(w[i].x & 0xffff0000u); x[i].z = __uint_as_float(w[i].y << 16); x[i].w = __uint_as_float(w[i].y & 0xffff0000u);
            ss += x[i].x * x[i].x + x[i].y * x[i].y + x[i].z * x[i].z + x[i].w * x[i].w;
        }
        ss = wave_sum(ss);
        const float rinv = rsqrtf(ss * (1.0f / D) + EPS);
        float4* o4 = (float4*)(out + (size_t)row * D);
#pragma unroll
        for (int i = 0; i < 4; ++i) {
            float4 o; o.x = x[i].x * rinv * gg[i].x; o.y = x[i].y * rinv * gg[i].y; o.z = x[i].z * rinv * gg[i].z; o.w = x[i].w * rinv * gg[i].w;
            o4[i * 64 + lane] = o;
        }
    }
}

struct Params {
    const float *x, *c, *ctx, *c_ctx, *ada_w, *ada_b, *norm_mix_g, *norm_ffn_g, *ab_w_in, *ab_w_out, *hg_lb, *hg_norm_g, *sw_sink,
        *ga_w_in, *ga_w_out, *ga_qn, *ga_kn, *peer_wq, *peer_sk, *peer_u, *peer_v, *final_g;
    float* out; char* ws;
};

typedef __attribute__((address_space(1))) char gchar_t;
__device__ __forceinline__ gchar_t* ws_base(char* w) { gchar_t* g = (gchar_t*)w; asm volatile("" : "+s"(g)); return g; }
#define WSP(T, off) ((T*)(ws_base(p.ws) + (off)))

constexpr int XB_XCNT = 0, XB_XSUB = 1024, XB_XGEN = 2048, XB_TOP = 3072, XB_TOPGEN = 3136;
#define gb_state (*(uint4*)(dyn_lds + 65536 + 4096))
__device__ __forceinline__ unsigned xb_ld(unsigned* p) { return __hip_atomic_load(p, __ATOMIC_RELAXED, __HIP_MEMORY_SCOPE_AGENT); }
__device__ __forceinline__ unsigned xb_add(unsigned* p) { return __hip_atomic_fetch_add(p, 1u, __ATOMIC_RELAXED, __HIP_MEMORY_SCOPE_AGENT); }
__device__ __forceinline__ unsigned xcc_id() { return (unsigned)__builtin_amdgcn_s_getreg((3 << 11) | 20) & 0xFu; }
__device__ __forceinline__ void grid_bar_post(unsigned* bar) {
    if (threadIdx.x == 0) { gb_state = make_uint4(0u, 0u, 0u, 0u); (void)xb_add(&bar[XB_XCNT + 64 * xcc_id()]); }
}
__device__ __forceinline__ void grid_bar(unsigned* bar) {
    asm volatile("s_waitcnt vmcnt(0)" ::: "memory");
    __syncthreads();
    if (threadIdx.x == 0) {
        const unsigned x = xcc_id();
        unsigned nloc = gb_state.x, nx = gb_state.y;
        if (nloc == 0u) {
            for (;;) {
                unsigned sum = 0u, cnt = 0u, mine = 0u;
#pragma unroll
                for (unsigned j = 0; j < 16; ++j) { const unsigned c = xb_ld(&bar[XB_XCNT + 64 * j]); sum += c; cnt += c > 0u ? 1u : 0u; mine = (j == x) ? c : mine; }
                if (sum == gridDim.x) { nloc = mine; nx = cnt; break; }
                __builtin_amdgcn_s_sleep(1);
            }
            gb_state.x = nloc; gb_state.y = nx;
        }
        const unsigned old = xb_add(&bar[XB_XSUB + 64 * x]);
        const unsigned gen = old / nloc;
        if (old + 1u == (gen + 1u) * nloc) {
            __builtin_amdgcn_fence(__ATOMIC_RELEASE, "agent");
            asm volatile("s_waitcnt vmcnt(0)" ::: "memory");
            const unsigned og = xb_add(&bar[XB_TOP]);
            const unsigned tg = og / nx;
            if (og + 1u == (tg + 1u) * nx) (void)xb_add(&bar[XB_TOPGEN]);
            else while (xb_ld(&bar[XB_TOPGEN]) == tg) __builtin_amdgcn_s_sleep(1);
            __builtin_amdgcn_fence(__ATOMIC_ACQUIRE, "agent");
            (void)xb_add(&bar[XB_XGEN + 64 * x]);
            asm volatile("s_waitcnt vmcnt(0)" ::: "memory");
        } else {
            while (xb_ld(&bar[XB_XGEN + 64 * x]) == gen) __builtin_amdgcn_s_sleep(1);
            __builtin_amdgcn_fence(__ATOMIC_ACQUIRE, "agent");
            asm volatile("s_waitcnt vmcnt(0)" ::: "memory");
        }
    }
    __syncthreads();
}

__device__ __forceinline__ void sub_bar(unsigned* ctr, unsigned& epoch, unsigned nblk) {
    asm volatile("s_waitcnt vmcnt(0)" ::: "memory");
    __syncthreads();
    epoch += nblk;
    if (threadIdx.x == 0) {
        __builtin_amdgcn_fence(__ATOMIC_RELEASE, "agent");
        asm volatile("s_waitcnt vmcnt(0)" ::: "memory");
        (void)xb_add(ctr);
        while (xb_ld(ctr) < epoch) __builtin_amdgcn_s_sleep(1);
        __builtin_amdgcn_fence(__ATOMIC_ACQUIRE, "agent");
        asm volatile("s_waitcnt vmcnt(0)" ::: "memory");
    }
    __syncthreads();
}

namespace cg = cooperative_groups;
constexpr int MEGA_LDS = 65536 + 4096 + 256;
__global__ void __launch_bounds__(256, 2) k_mega(Params p) {
    cg::grid_group grid = cg::this_grid();
    const int bid = blockIdx.x, nb = gridDim.x;
    char* lds = dyn_lds;
    float* ldf = (float*)dyn_lds;
    grid_bar_post(WSP(unsigned, OFF_BAR));
    ph_mod(bid, nb, p.c, p.c_ctx, p.ada_w, p.ada_b, WSP(float, OFF_MOD), ldf);
    ph_tables(bid, nb, WSP(float, OFF_COSS), WSP(float, OFF_SINS), WSP(float, OFF_COSG), WSP(float, OFF_SING), p.hg_lb, WSP(float, OFF_LB));
    if (p.ws == nullptr) grid.sync();
    grid_bar(WSP(unsigned, OFF_BAR));
    ph_normmod(bid, nb, p.x, p.ctx, p.norm_mix_g, WSP(float, OFF_MOD), 1 * D, 0, WSP(bf16_t, OFF_A), TA);
    ph_transpose(bid, nb, p.ab_w_in, WSP(bf16_t, OFF_WABIN), D, AB_IN, ldf);
    ph_transpose(bid, nb, p.ab_w_out, WSP(bf16_t, OFF_WABOUT), D, D, ldf);
    ph_transpose(bid, nb, p.peer_wq, WSP(bf16_t, OFF_WPQ), D, PQ, ldf);
    ph_cvt(bid, nb, p.peer_sk, WSP(bf16_t, OFF_SK), (size_t)2 * 8 * 2 * 128 * 128);
    grid_bar(WSP(unsigned, OFF_BAR));
    { EpiStoreSplit<0> e{WSP(bf16_t, OFF_PROJH), HGW, WSP(bf16_t, OFF_PROJS), SWW, HGW};
      ph_gemm(bid, nb, WSP(bf16_t, OFF_A), D, WSP(bf16_t, OFF_WABIN), AB_IN, TA, HGW, D, lds, e); }
    grid_bar(WSP(unsigned, OFF_BAR));
    {
        const int hgb = nb >= 256 ? 128 : nb / 2;
        if (bid < hgb) ph_hgrn(bid, hgb, WSP(bf16_t, OFF_PROJH), WSP(float, OFF_LB), WSP(bf16_t, OFF_OF), WSP(bf16_t, OFF_OB), lds);
        else {
            const int sb = bid - hgb, sn = nb - hgb;
            unsigned* sctr = WSP(unsigned, OFF_BAR) + 3328; unsigned sep = 0;
            { EpiStoreSplit<1> e{WSP(bf16_t, OFF_PROJH), HGW, WSP(bf16_t, OFF_PROJS), SWW, HGW};
              ph_gemm(sb, sn, WSP(bf16_t, OFF_A), D, WSP(bf16_t, OFF_WABIN), AB_IN, TA, SWW, D, lds, e, HGW); }
            sub_bar(sctr, sep, (unsigned)sn);
            ph_prep_swa(sb, sn, WSP(bf16_t, OFF_PROJS), WSP(float, OFF_COSS), WSP(float, OFF_SINS));
            ph_vt<64>(sb, sn, WSP(bf16_t, OFF_PROJS), SWW, 640, WSP(bf16_t, OFF_VT64), (bf16_t*)lds);
            sub_bar(sctr, sep, (unsigned)sn);
            ph_swa(sb, sn, WSP(bf16_t, OFF_PROJS), WSP(bf16_t, OFF_VT64), p.sw_sink, WSP(bf16_t, OFF_MIX), lds);
            ph_cvt8i(sb, sn, p.peer_u, WSP(unsigned char, OFF_U16), (size_t)2 * NEXP * D, UQ);
            ph_cvt8(sb, sn, p.peer_v, WSP(unsigned char, OFF_V16), (size_t)2 * NEXP * D, 1.0f);
            ph_transpose(sb, sn, p.ga_w_in, WSP(bf16_t, OFF_WGAIN), D, GA_IN, ldf);
            ph_transpose(sb, sn, p.ga_w_out, WSP(bf16_t, OFF_WGAOUT), D, D, ldf);
            ph_transpose(sb, sn, p.peer_wq + (size_t)D * PQ, WSP(bf16_t, OFF_WPQ) + (size_t)PQ * D, D, PQ, ldf);
        }
    }
    grid_bar(WSP(unsigned, OFF_BAR));
    ph_hgpost(bid, nb, WSP(bf16_t, OFF_OF), WSP(bf16_t, OFF_OB), WSP(bf16_t, OFF_PROJH), p.hg_norm_g, WSP(bf16_t, OFF_MIX));
    grid_bar(WSP(unsigned, OFF_BAR));
    { EpiResid<0> e{p.x, p.ctx, nullptr, WSP(bf16_t, OFF_H16), WSP(float, OFF_MOD) + 2 * D};
      ph_gemm(bid, nb, WSP(bf16_t, OFF_MIX), D, WSP(bf16_t, OFF_WABOUT), D, TA, D, D, lds, e); }
    grid_bar(WSP(unsigned, OFF_BAR));
    ph_normmod16(bid, nb, WSP(bf16_t, OFF_H16), p.norm_ffn_g, WSP(float, OFF_MOD), 4 * D, 3 * D, WSP(bf16_t, OFF_A), TA, WSP(unsigned char, OFF_XQ), WSP(float, OFF_XS));
    grid_bar(WSP(unsigned, OFF_BAR));
    { EpiStoreSplit<2> e{WSP(bf16_t, OFF_QPEER), PQ, WSP(bf16_t, OFF_QPEER), PQ, 1 << 30};
      ph_gemm(bid, nb, WSP(bf16_t, OFF_A), D, WSP(bf16_t, OFF_WPQ), PQ, TA, PQ, D, lds, e); }
    grid_bar(WSP(unsigned, OFF_BAR));
    ph_peer_route(bid, nb, WSP(bf16_t, OFF_QPEER), WSP(bf16_t, OFF_SK), WSP(int, OFF_SELE), WSP(float, OFF_SELG), TA, lds);
    grid_bar(WSP(unsigned, OFF_BAR));
    ph_peer_dots((WSP(unsigned, OFF_BAR) + 4096) + 64 * 0, xcc_id(), WSP(unsigned char, OFF_XQ), WSP(float, OFF_XS), WSP(unsigned char, OFF_U16), WSP(int, OFF_SELE), WSP(bf16_t, OFF_PART), TA, (unsigned*)lds);
    grid_bar(WSP(unsigned, OFF_BAR));
    ph_peer_weights(bid, nb, WSP(bf16_t, OFF_PART), WSP(float, OFF_SELG), TA);
    grid_bar(WSP(unsigned, OFF_BAR));
    ph_peer_vsum((WSP(unsigned, OFF_BAR) + 4096) + 64 * 8, xcc_id(), WSP(unsigned char, OFF_V16), WSP(int, OFF_SELE), WSP(float, OFF_SELG), WSP(float, OFF_MOD) + 5 * D, WSP(bf16_t, OFF_H16), TA, (unsigned*)lds);
    grid_bar(WSP(unsigned, OFF_BAR));
    ph_normmod16(bid, nb, WSP(bf16_t, OFF_H16), p.norm_mix_g + D, (WSP(float, OFF_MOD) + (size_t)9 * 6144), 1 * D, 0, WSP(bf16_t, OFF_A), TA);
    grid_bar(WSP(unsigned, OFF_BAR));
    { EpiGA e{WSP(bf16_t, OFF_PROJ), WSP(bf16_t, OFF_VT), p.ga_qn, p.ga_kn, WSP(float, OFF_COSG), WSP(float, OFF_SING)};
      ph_gemm(bid, nb, WSP(bf16_t, OFF_A), D, WSP(bf16_t, OFF_WGAIN), GA_IN, TA, GA_IN, D, lds, e); }
    grid_bar(WSP(unsigned, OFF_BAR));
    ph_dense(bid, nb, WSP(bf16_t, OFF_PROJ), WSP(bf16_t, OFF_VT), WSP(bf16_t, OFF_MIX), lds);
    grid_bar(WSP(unsigned, OFF_BAR));
    { EpiResid<1> e{nullptr, nullptr, WSP(bf16_t, OFF_H16), WSP(bf16_t, OFF_H16), (WSP(float, OFF_MOD) + (size_t)9 * 6144) + 2 * D};
      ph_gemm(bid, nb, WSP(bf16_t, OFF_MIX), D, WSP(bf16_t, OFF_WGAOUT), D, TL, D, D, lds, e); }
    grid_bar(WSP(unsigned, OFF_BAR));
    ph_normmod16(bid, nb, WSP(bf16_t, OFF_H16), p.norm_ffn_g + D, (WSP(float, OFF_MOD) + (size_t)9 * 6144), 4 * D, 3 * D, WSP(bf16_t, OFF_A), TL, WSP(unsigned char, OFF_XQ), WSP(float, OFF_XS));
    grid_bar(WSP(unsigned, OFF_BAR));
    { EpiStoreSplit<3> e{WSP(bf16_t, OFF_QPEER), PQ, WSP(bf16_t, OFF_QPEER), PQ, 1 << 30};
      ph_gemm(bid, nb, WSP(bf16_t, OFF_A), D, WSP(bf16_t, OFF_WPQ) + (size_t)PQ * D, PQ, TL, PQ, D, lds, e); }
    grid_bar(WSP(unsigned, OFF_BAR));
    ph_peer_route(bid, nb, WSP(bf16_t, OFF_QPEER), WSP(bf16_t, OFF_SK) + (size_t)16 * 128 * 128, WSP(int, OFF_SELE), WSP(float, OFF_SELG), TL, lds);
    grid_bar(WSP(unsigned, OFF_BAR));
    ph_peer_dots((WSP(unsigned, OFF_BAR) + 4096) + 64 * 16, xcc_id(), WSP(unsigned char, OFF_XQ), WSP(float, OFF_XS), WSP(unsigned char, OFF_U16) + (size_t)NEXP * D, WSP(int, OFF_SELE), WSP(bf16_t, OFF_PART), TL, (unsigned*)lds);
    grid_bar(WSP(unsigned, OFF_BAR));
    ph_peer_weights(bid, nb, WSP(bf16_t, OFF_PART), WSP(float, OFF_SELG), TL);
    grid_bar(WSP(unsigned, OFF_BAR));
    ph_peer_vsum((WSP(unsigned, OFF_BAR) + 4096) + 64 * 24, xcc_id(), WSP(unsigned char, OFF_V16) + (size_t)NEXP * D, WSP(int, OFF_SELE), WSP(float, OFF_SELG), (WSP(float, OFF_MOD) + (size_t)9 * 6144) + 5 * D, WSP(bf16_t, OFF_H16), TL, (unsigned*)lds);
    grid_bar(WSP(unsigned, OFF_BAR));
    ph_final(bid, nb, WSP(bf16_t, OFF_H16), p.out, p.final_g);
}

extern "C" void kernel_launch(void* const* d_in, const int* in_sizes, int n_in, void* d_out, int out_size, void* d_ws, size_t ws_size,
                              hipStream_t stream) {
    Params p{};
    p.x = (const float*)d_in[0]; p.c = (const float*)d_in[1]; p.ctx = (const float*)d_in[2]; p.c_ctx = (const float*)d_in[3];
    p.ada_w = (const float*)d_in[4]; p.ada_b = (const float*)d_in[5]; p.norm_mix_g = (const float*)d_in[6]; p.norm_ffn_g = (const float*)d_in[7];
    p.ab_w_in = (const float*)d_in[8]; p.ab_w_out = (const float*)d_in[9]; p.hg_lb = (const float*)d_in[10]; p.hg_norm_g = (const float*)d_in[11];
    p.sw_sink = (const float*)d_in[12]; p.ga_w_in = (const float*)d_in[13]; p.ga_w_out = (const float*)d_in[14]; p.ga_qn = (const float*)d_in[15];
    p.ga_kn = (const float*)d_in[16]; p.peer_wq = (const float*)d_in[17]; p.peer_sk = (const float*)d_in[18]; p.peer_u = (const float*)d_in[19];
    p.peer_v = (const float*)d_in[20]; p.final_g = (const float*)d_in[21];
    p.out = (float*)d_out; p.ws = (char*)d_ws;
    if (ws_size < WS_NEED) { fprintf(stderr, "workspace too small: %zu < %zu\n", ws_size, WS_NEED); return; }
    static int grid_blocks = 0;
    if (!grid_blocks) {
        int dev = 0, cus = 0, per_cu = 0;
        (void)hipGetDevice(&dev);
        (void)hipDeviceGetAttribute(&cus, hipDeviceAttributeMultiprocessorCount, dev);
        (void)hipFuncSetAttribute((const void*)k_mega, hipFuncAttributeMaxDynamicSharedMemorySize, MEGA_LDS);
        (void)hipOccupancyMaxActiveBlocksPerMultiprocessor(&per_cu, k_mega, 256, MEGA_LDS);
        if (per_cu > 2) per_cu = 2;
        if (per_cu < 1) per_cu = 1;
        grid_blocks = cus * per_cu;
    }
    (void)hipMemsetAsync((char*)d_ws + OFF_BAR, 0, BAR_BYTES, stream);
    void* args[] = {&p};
    hipError_t e = hipLaunchCooperativeKernel((const void*)k_mega, dim3(grid_blocks), dim3(256), args, MEGA_LDS, stream);
    if (e != hipSuccess) fprintf(stderr, "cooperative launch failed: %s (grid %d)\n", hipGetErrorString(e), grid_blocks);
}
```

```cpp
#include <hip/hip_runtime.h>
#include <hip/hip_cooperative_groups.h>
#include <stdint.h>
#include <stdio.h>

typedef unsigned short bf16_t;
typedef short bf16x8 __attribute__((ext_vector_type(8)));
typedef float f32x4 __attribute__((ext_vector_type(4)));

constexpr int D = 1024, NB = 8, SEQ = 4096, LC = 256;
constexpr int TL = NB * SEQ;
constexpr int TC = NB * LC;
constexpr int TA = TL + TC;
constexpr int AB_IN = 3328, HGW = 2560, SWW = 768, GA_IN = 1536, PQ = 2048;
constexpr int NEXP = 16384;
constexpr float EPS = 1e-6f;
constexpr float LOG2E = 1.4426950408889634f;
constexpr int NKEY = LC + SEQ;

constexpr size_t OFF_WABIN = 0;
constexpr size_t OFF_WABOUT = OFF_WABIN + (size_t)AB_IN * D * 2;
constexpr size_t OFF_WGAIN = OFF_WABOUT + (size_t)D * D * 2;
constexpr size_t OFF_WGAOUT = OFF_WGAIN + (size_t)GA_IN * D * 2;
constexpr size_t OFF_WPQ = OFF_WGAOUT + (size_t)D * D * 2;
constexpr size_t OFF_SK = OFF_WPQ + (size_t)2 * PQ * D * 2;
constexpr size_t OFF_MOD = OFF_SK + (size_t)2 * 8 * 2 * 128 * 128 * 2;
constexpr size_t OFF_COSS = OFF_MOD + (size_t)2 * 9 * 6144 * 4;
constexpr size_t OFF_SINS = OFF_COSS + (size_t)SEQ * 32 * 4;
constexpr size_t OFF_COSG = OFF_SINS + (size_t)SEQ * 32 * 4;
constexpr size_t OFF_SING = OFF_COSG + (size_t)SEQ * 64 * 4;
constexpr size_t OFF_LB = OFF_SING + (size_t)SEQ * 64 * 4;
constexpr size_t OFF_U16 = OFF_LB + 2048;
constexpr size_t OFF_V16 = OFF_U16 + (size_t)NEXP * D * 2;
constexpr size_t OFF_HCTX = OFF_V16 + (size_t)NEXP * D * 2;
constexpr size_t OFF_A = OFF_HCTX + (size_t)TC * D * 4;
constexpr size_t OFF_PROJ = OFF_A + (size_t)TA * D * 2;
constexpr size_t OFF_MIX = OFF_PROJ + (size_t)TA * AB_IN * 2;
constexpr size_t OFF_SEL = OFF_MIX + (size_t)TA * D * 2;
constexpr size_t OFF_BAR = OFF_SEL + (size_t)TA * 128 * 8;
constexpr size_t BAR_BYTES = 32768;
constexpr size_t OFF_VT64 = OFF_BAR + BAR_BYTES;
constexpr size_t WS_NEED = OFF_VT64 + (size_t)NB * 2 * 64 * NKEY * 2;
static_assert(WS_NEED <= (size_t)536870912, "workspace over 512 MiB");
constexpr size_t OFF_OF = OFF_MIX;
constexpr size_t OFF_OB = OFF_SEL;
constexpr size_t OFF_PROJH = OFF_PROJ;
constexpr size_t OFF_PROJS = OFF_PROJ + (size_t)TA * HGW * 2;
constexpr size_t OFF_QPEER = OFF_PROJ;
constexpr size_t OFF_TSC = OFF_QPEER + (size_t)TA * PQ * 2;
constexpr size_t OFF_TIX = OFF_TSC + (size_t)TA * 256 * 4;
static_assert(OFF_TIX + (size_t)TA * 256 * 4 <= OFF_MIX, "peer scratch overflows proj region");
constexpr size_t OFF_VT = OFF_SEL;
static_assert((size_t)NB * 2 * 128 * NKEY * 2 <= (size_t)TA * 128 * 8, "Vt overflows SEL region");
constexpr size_t OFF_PART = OFF_PROJ;
constexpr size_t OFF_X8 = OFF_PROJ + (size_t)TA * PQ * 2;
static_assert((size_t)8 * TA * 128 * 4 <= (size_t)TA * PQ * 2 && OFF_X8 + (size_t)2 * TA * D <= OFF_MIX, "PEER scratch overflows proj region");
constexpr size_t OFF_H16 = OFF_PROJ + (size_t)TA * PQ * 2;
constexpr size_t OFF_XQ = OFF_MIX;
constexpr size_t OFF_XS = OFF_MIX + (size_t)TA * D;
constexpr size_t OFF_SELE = OFF_SEL;
constexpr size_t OFF_SELG = OFF_SEL + (size_t)TA * 128 * 4;

extern __shared__ __attribute__((aligned(16))) char dyn_lds[];
__device__ __forceinline__ float bf2f(bf16_t v) { return __uint_as_float(((unsigned)v) << 16); }
__device__ __forceinline__ bf16_t f2bf(float f) {
    unsigned u = __float_as_uint(f);
    u += 0x7fffu + ((u >> 16) & 1u);
    return (bf16_t)(u >> 16);
}
typedef float f32x2 __attribute__((ext_vector_type(2)));
typedef float f32x16 __attribute__((ext_vector_type(16)));
typedef __bf16 bf16x2_t __attribute__((ext_vector_type(2)));
__device__ __forceinline__ unsigned pack2(float lo, float hi) { f32x2 v = {lo, hi}; return __builtin_bit_cast(unsigned, __builtin_convertvector(v, bf16x2_t)); }
__device__ __forceinline__ float sigmoidf_(float x) { return 1.0f / (1.0f + __expf(-x)); }
__device__ __forceinline__ float siluf_(float x) { return x * sigmoidf_(x); }
__device__ __forceinline__ float wave_sum(float v) {
#pragma unroll
    for (int o = 32; o >= 1; o >>= 1) v += __shfl_xor(v, o);
    return v;
}
__device__ __forceinline__ int mod_row(int row) { return row < TL ? (row >> 12) : 8; }
__device__ __forceinline__ int tidx() { int t = threadIdx.x; asm volatile("" : "+v"(t)); return t; }

__device__ void ph_transpose(int bid, int nb, const float* __restrict__ in, bf16_t* __restrict__ out, int K, int N, float* lds) {
    const int tk = K / 32, tn = N / 32, nt = tk * tn;
    const int tx = threadIdx.x & 31, ty = threadIdx.x >> 5;
    for (int t = bid; t < nt; t += nb) {
        const int k0 = (t / tn) * 32, n0 = (t % tn) * 32;
        __syncthreads();
#pragma unroll
        for (int i = 0; i < 4; ++i) lds[(ty + i * 8) * 33 + tx] = in[(size_t)(k0 + ty + i * 8) * N + n0 + tx];
        __syncthreads();
#pragma unroll
        for (int i = 0; i < 4; ++i) out[((size_t)(k0 >> 5) * N + n0 + ty + i * 8) * 32 + tx] = f2bf(lds[tx * 33 + ty + i * 8]);
    }
}
__device__ void ph_cvt(int bid, int nb, const float* __restrict__ in, bf16_t* __restrict__ out, size_t n) {
    const size_t n8 = n / 8;
    for (size_t i = (size_t)bid * blockDim.x + threadIdx.x; i < n8; i += (size_t)nb * blockDim.x) {
        const float4 a = ((const float4*)in)[i * 2], b = ((const float4*)in)[i * 2 + 1];
        uint4 w; w.x = pack2(a.x, a.y); w.y = pack2(a.z, a.w); w.z = pack2(b.x, b.y); w.w = pack2(b.z, b.w);
        ((uint4*)out)[i] = w;
    }
}
__device__ void ph_cvt8(int bid, int nb, const float* __restrict__ in, unsigned char* __restrict__ out, size_t n, float scale) {
    const size_t n16 = n / 16;
    for (size_t i = (size_t)bid * blockDim.x + threadIdx.x; i < n16; i += (size_t)nb * blockDim.x) {
        const float4 a = ((const float4*)in)[i * 4], b = ((const float4*)in)[i * 4 + 1], c = ((const float4*)in)[i * 4 + 2], d = ((const float4*)in)[i * 4 + 3];
        int w0 = __builtin_amdgcn_cvt_pk_fp8_f32(a.x * scale, a.y * scale, 0, false); w0 = __builtin_amdgcn_cvt_pk_fp8_f32(a.z * scale, a.w * scale, w0, true);
        int w1 = __builtin_amdgcn_cvt_pk_fp8_f32(b.x * scale, b.y * scale, 0, false); w1 = __builtin_amdgcn_cvt_pk_fp8_f32(b.z * scale, b.w * scale, w1, true);
        int w2 = __builtin_amdgcn_cvt_pk_fp8_f32(c.x * scale, c.y * scale, 0, false); w2 = __builtin_amdgcn_cvt_pk_fp8_f32(c.z * scale, c.w * scale, w2, true);
        int w3 = __builtin_amdgcn_cvt_pk_fp8_f32(d.x * scale, d.y * scale, 0, false); w3 = __builtin_amdgcn_cvt_pk_fp8_f32(d.z * scale, d.w * scale, w3, true);
        const size_t el = i * 16, rowg = el >> 10;
        const size_t layer = rowg / NEXP, e = rowg % NEXP; const int col = (int)(el & 1023), sl = col >> 7, cs = col & 127;
        *(int4*)(out + layer * ((size_t)NEXP * D) + ((size_t)sl * NEXP + e) * 128 + cs) = make_int4(w0, w1, w2, w3);
    }
}
constexpr float UQ = 512.0f;
__device__ __forceinline__ int q8(float v, float sc) { return (int)rintf(fminf(fmaxf(v * sc, -127.f), 127.f)) & 0xff; }
__device__ void ph_cvt8i(int bid, int nb, const float* __restrict__ in, unsigned char* __restrict__ out, size_t n, float scale) {
    const size_t n16 = n / 16;
    for (size_t i = (size_t)bid * blockDim.x + tidx(); i < n16; i += (size_t)nb * blockDim.x) {
        const float4 a = ((const float4*)in)[i * 4], b = ((const float4*)in)[i * 4 + 1], c = ((const float4*)in)[i * 4 + 2], d = ((const float4*)in)[i * 4 + 3];
        const int w0 = q8(a.x, scale) | (q8(a.y, scale) << 8) | (q8(a.z, scale) << 16) | (q8(a.w, scale) << 24);
        const int w1 = q8(b.x, scale) | (q8(b.y, scale) << 8) | (q8(b.z, scale) << 16) | (q8(b.w, scale) << 24);
        const int w2 = q8(c.x, scale) | (q8(c.y, scale) << 8) | (q8(c.z, scale) << 16) | (q8(c.w, scale) << 24);
        const int w3 = q8(d.x, scale) | (q8(d.y, scale) << 8) | (q8(d.z, scale) << 16) | (q8(d.w, scale) << 24);
        const size_t el = i * 16, rowg = el >> 10;
        const size_t layer = rowg / NEXP, e = rowg % NEXP; const int col = (int)(el & 1023), sl = col >> 7, cs = col & 127;
        *(int4*)(out + layer * ((size_t)NEXP * D) + ((size_t)sl * NEXP + e) * 128 + cs) = make_int4(w0, w1, w2, w3);
    }
}
__device__ void ph_mod(int bid, int nb, const float* __restrict__ c, const float* __restrict__ c_ctx, const float* __restrict__ ada_w,
                       const float* __restrict__ ada_b, float* __restrict__ mod, float* lds) {
    float* s = lds;
    float* red = lds + 9 * 1024;
    const int tx = threadIdx.x & 63, ky = threadIdx.x >> 6;
    for (int i = threadIdx.x; i < 9 * 1024; i += 256) {
        const int r = i >> 10, k = i & 1023;
        const float v = r < 8 ? c[r * 1024 + k] : c_ctx[k];
        s[i] = siluf_(v);
    }
    __syncthreads();
    const int nitems = 2 * 96;
    for (int it = bid; it < nitems; it += nb) {
        const int layer = it / 96, n = (it % 96) * 64 + tx;
        const float* w = ada_w + (size_t)layer * 1024 * 6144 + n;
        float acc[9];
#pragma unroll
        for (int r = 0; r < 9; ++r) acc[r] = 0.f;
        for (int k = ky * 256; k < ky * 256 + 256; ++k) {
            const float wv = w[(size_t)k * 6144];
#pragma unroll
            for (int r = 0; r < 9; ++r) acc[r] += s[r * 1024 + k] * wv;
        }
        __syncthreads();
#pragma unroll
        for (int r = 0; r < 9; ++r) red[(ky * 9 + r) * 64 + tx] = acc[r];
        __syncthreads();
        if (ky == 0) {
#pragma unroll
            for (int r = 0; r < 9; ++r) {
                const float v = red[(0 * 9 + r) * 64 + tx] + red[(1 * 9 + r) * 64 + tx] + red[(2 * 9 + r) * 64 + tx] + red[(3 * 9 + r) * 64 + tx];
                mod[((size_t)layer * 9 + r) * 6144 + n] = v + ada_b[layer * 6144 + n];
            }
        }
    }
}
__device__ void ph_tables(int bid, int nb, float* cosS, float* sinS, float* cosG, float* sinG, const float* __restrict__ lb_logits, float* lb) {
    const int gt = bid * blockDim.x + threadIdx.x, gs = nb * blockDim.x;
    for (int i = gt; i < SEQ * 32; i += gs) {
        const int t = i >> 5, j = i & 31;
        const float pos = (float)(j < 16 ? (t >> 6) : (t & 63));
        const float inv = powf(10000.0f, -(float)(j & 15) / 16.0f);
        const float ang = pos * inv;
        cosS[i] = cosf(ang); sinS[i] = sinf(ang);
    }
    for (int i = gt; i < SEQ * 64; i += gs) {
        const int t = i >> 6, j = i & 63;
        const float pos = (float)(j < 32 ? (t >> 6) : (t & 63));
        const float inv = powf(10000.0f, -(float)(j & 31) / 32.0f);
        const float ang = pos * inv;
        cosG[i] = cosf(ang); sinG[i] = sinf(ang);
    }
    for (int i = gt; i < 512; i += gs) {
        const float l0 = lb_logits[i], l1 = lb_logits[512 + i];
        lb[i] = 1.0f / (1.0f + expf(l1 - l0));
    }
}

__device__ void ph_normmod(int bid, int nb, const float* __restrict__ hlat, const float* __restrict__ hctx, const float* __restrict__ gamma,
                           const float* __restrict__ modl  , int sc_off, int sh_off, bf16_t* __restrict__ out, int nrows) {
    const int lane = tidx() & 63, wid = tidx() >> 6;
    const int nwv = nb * 4, per = (nrows + nwv - 1) / nwv, r0 = (bid * 4 + wid) * per, r1 = (r0 + per < nrows) ? r0 + per : nrows;
    if (r0 >= r1) return;
    float4 ca[4], cb[4];
    int curm = -1;
    float4 xn[4];
    {
        const float* s0 = r0 < TL ? hlat + (size_t)r0 * D : hctx + (size_t)(r0 - TL) * D;
#pragma unroll
        for (int i = 0; i < 4; ++i) xn[i] = ((const float4*)s0)[i * 64 + lane];
    }
    for (int row = r0; row < r1; ++row) {
        float4 x[4];
#pragma unroll
        for (int i = 0; i < 4; ++i) x[i] = xn[i];
        const int rn = row + 1 < r1 ? row + 1 : row;
        const float* sn = rn < TL ? hlat + (size_t)rn * D : hctx + (size_t)(rn - TL) * D;
#pragma unroll
        for (int i = 0; i < 4; ++i) xn[i] = ((const float4*)sn)[i * 64 + lane];
        const int mr = mod_row(row);
        if (mr != curm) {
            curm = mr;
            const float* m = modl + (size_t)mr * 6144;
#pragma unroll
            for (int i = 0; i < 4; ++i) {
                const int col = (i * 64 + lane) * 4;
                const float4 g = *(const float4*)(gamma + col), sc = *(const float4*)(m + sc_off + col);
                ca[i] = make_float4(g.x * (1.f + sc.x), g.y * (1.f + sc.y), g.z * (1.f + sc.z), g.w * (1.f + sc.w));
                cb[i] = *(const float4*)(m + sh_off + col);
            }
        }
        float ss = 0.f;
#pragma unroll
        for (int i = 0; i < 4; ++i) ss += x[i].x * x[i].x + x[i].y * x[i].y + x[i].z * x[i].z + x[i].w * x[i].w;
        ss = wave_sum(ss);
        const float rinv = rsqrtf(ss * (1.0f / D) + EPS);
#pragma unroll
        for (int i = 0; i < 4; ++i) {
            const int col = (i * 64 + lane) * 4;
            uint2 w; w.x = pack2(x[i].x * rinv * ca[i].x + cb[i].x, x[i].y * rinv * ca[i].y + cb[i].y);
            w.y = pack2(x[i].z * rinv * ca[i].z + cb[i].z, x[i].w * rinv * ca[i].w + cb[i].w);
            *(uint2*)(out + ((size_t)(col >> 5) * TA + row) * 32 + (col & 31)) = w;
        }
    }
}

__device__ void ph_normmod16(int bid, int nb, const bf16_t* __restrict__ h16, const float* __restrict__ gamma,
                             const float* __restrict__ modl  , int sc_off, int sh_off, bf16_t* __restrict__ out, int nrows,
                             unsigned char* __restrict__ xq = nullptr, float* __restrict__ xs = nullptr) {
    const int lane = tidx() & 63, wid = tidx() >> 6;
    const int nwv = nb * 4, per = (nrows + nwv - 1) / nwv, r0 = (bid * 4 + wid) * per, r1 = (r0 + per < nrows) ? r0 + per : nrows;
    if (r0 >= r1) return;
    float4 ca[4], cb[4];
    int curm = -1;
    uint2 wn[4];
#pragma unroll
    for (int i = 0; i < 4; ++i) wn[i] = ((const uint2*)(h16 + (size_t)r0 * D))[i * 64 + lane];
    for (int row = r0; row < r1; ++row) {
        uint2 w[4];
#pragma unroll
        for (int i = 0; i < 4; ++i) w[i] = wn[i];
        const int rn = row + 1 < r1 ? row + 1 : row;
#pragma unroll
        for (int i = 0; i < 4; ++i) wn[i] = ((const uint2*)(h16 + (size_t)rn * D))[i * 64 + lane];
        const int mr = mod_row(row);
        if (mr != curm) {
            curm = mr;
            const float* m = modl + (size_t)mr * 6144;
#pragma unroll
            for (int i = 0; i < 4; ++i) {
                const int col = (i * 64 + lane) * 4;
                const float4 g = *(const float4*)(gamma + col), sc = *(const float4*)(m + sc_off + col);
                ca[i] = make_float4(g.x * (1.f + sc.x), g.y * (1.f + sc.y), g.z * (1.f + sc.z), g.w * (1.f + sc.w));
                cb[i] = *(const float4*)(m + sh_off + col);
            }
        }
        float4 x[4]; float ss = 0.f;
#pragma unroll
        for (int i = 0; i < 4; ++i) {
            x[i].x = __uint_as_float(w[i].x << 16); x[i].y = __uint_as_float(w[i].x & 0xffff0000u); x[i].z = __uint_as_float(w[i].y << 16); x[i].w = __uint_as_float(w[i].y & 0xffff0000u);
            ss += x[i].x * x[i].x + x[i].y * x[i].y + x[i].z * x[i].z + x[i].w * x[i].w;
        }
        ss = wave_sum(ss);
        const float rinv = rsqrtf(ss * (1.0f / D) + EPS);
        float amax = 0.f;
#pragma unroll
        for (int i = 0; i < 4; ++i) {
            const int col = (i * 64 + lane) * 4;
            const float y0 = x[i].x * rinv * ca[i].x + cb[i].x, y1 = x[i].y * rinv * ca[i].y + cb[i].y;
            const float y2 = x[i].z * rinv * ca[i].z + cb[i].z, y3 = x[i].w * rinv * ca[i].w + cb[i].w;
            uint2 o; o.x = pack2(y0, y1); o.y = pack2(y2, y3);
            *(uint2*)(out + ((size_t)(col >> 5) * TA + row) * 32 + (col & 31)) = o;
            x[i] = make_float4(y0, y1, y2, y3);
            amax = fmaxf(amax, fmaxf(fmaxf(fabsf(y0), fabsf(y1)), fmaxf(fabsf(y2), fabsf(y3))));
        }
        if (xq) {
#pragma unroll
            for (int o = 32; o > 0; o >>= 1) amax = fmaxf(amax, __shfl_xor(amax, o));
            amax = fmaxf(amax, 1e-20f);
            const float qs = 127.0f / amax;
#pragma unroll
            for (int i = 0; i < 4; ++i)
                *(int*)(xq + (size_t)row * D + (i * 64 + lane) * 4) = q8(x[i].x, qs) | (q8(x[i].y, qs) << 8) | (q8(x[i].z, qs) << 16) | (q8(x[i].w, qs) << 24);
            if (lane == 0) xs[row] = amax * (1.0f / 127.0f);
        }
    }
}

constexpr int GEMM_LDS = 49152;
template <class Epi>
__device__ __forceinline__ void gemm_tile(const bf16_t* __restrict__ A, int lda, const bf16_t* __restrict__ Bt, int ldb, int K,
                                          int m0, int n0, char* lds, Epi& epi) {
    const int tid = threadIdx.x, lane = tid & 63, wid = tid >> 6, wr = wid >> 1, wc = wid & 1, fr = lane & 15, fq = lane >> 4;
    f32x4 acc[4][8];
#pragma unroll
    for (int i = 0; i < 4; ++i)
#pragma unroll
        for (int j = 0; j < 8; ++j) acc[i][j] = (f32x4){0.f, 0.f, 0.f, 0.f};
    typedef __attribute__((address_space(3))) char las_char;
    las_char* l3 = (las_char*)lds;
    const int dsub = lane >> 2, dch = (lane & 3) ^ ((lane >> 5) * 3);
    const bf16_t* ga = A + (size_t)(m0 + 32 * wid + dsub) * (Epi::ABLK ? 32 : lda) + dch * 8;
    const bf16_t* gb = Bt + (size_t)(n0 + 64 * wid + dsub) * 32 + dch * 8;
    const int fsw = ((fr >> 3) & 1) * 3;
    const int aoff = (wr * 64 + fr) * 64 + ((fq ^ fsw) << 4), boff = 8192 + (wc * 128 + fr) * 64 + ((fq ^ fsw) << 4);
#define GT_STAGE(kt, buf) do { const int _s = (buf) * 24576; \
        if (Epi::ABLK) { const unsigned* _ap = (const unsigned*)(ga + (size_t)(kt) * lda * 32); \
          __attribute__((address_space(3))) unsigned* _al = (__attribute__((address_space(3))) unsigned*)(l3 + _s + (32 * wid) * 64); \
          __builtin_amdgcn_global_load_lds(_ap, _al, 16, 0, 0); __builtin_amdgcn_global_load_lds(_ap, _al, 16, 1024, 0); } \
        else { _Pragma("unroll") for (int i = 0; i < 2; ++i) __builtin_amdgcn_global_load_lds((const unsigned*)(ga + (size_t)(16 * i) * lda + (kt) * 32), \
            (__attribute__((address_space(3))) unsigned*)(l3 + _s + (32 * wid + 16 * i) * 64), 16, 0, 0); } \
        { const unsigned* _gp = (const unsigned*)(gb + (size_t)(kt) * ldb * 32); \
          __attribute__((address_space(3))) unsigned* _lp = (__attribute__((address_space(3))) unsigned*)(l3 + _s + 8192 + (64 * wid) * 64); \
          __builtin_amdgcn_global_load_lds(_gp, _lp, 16, 0, 0); __builtin_amdgcn_global_load_lds(_gp, _lp, 16, 1024, 0); \
          __builtin_amdgcn_global_load_lds(_gp, _lp, 16, 2048, 0); __builtin_amdgcn_global_load_lds(_gp, _lp, 16, 3072, 0); } } while (0)
    const int nk = K / 32;
    __syncthreads();
    GT_STAGE(0, 0);
    __syncthreads();
    for (int kt = 0; kt < nk; ++kt) {
        if (kt + 1 < nk) GT_STAGE(kt + 1, (kt + 1) & 1);
        const char* base = lds + (kt & 1) * 24576;
        bf16x8 af[4], bfr[8];
#pragma unroll
        for (int i = 0; i < 4; ++i) af[i] = *(const bf16x8*)(base + aoff + i * 1024);
#pragma unroll
        for (int j = 0; j < 8; ++j) bfr[j] = *(const bf16x8*)(base + boff + j * 1024);
#pragma unroll
        for (int i = 0; i < 4; ++i)
#pragma unroll
            for (int j = 0; j < 8; ++j) acc[i][j] = __builtin_amdgcn_mfma_f32_16x16x32_bf16(bfr[j], af[i], acc[i][j], 0, 0, 0);
        __syncthreads();
    }
#undef GT_STAGE
    epi(acc, m0 + wr * 64, n0 + wc * 128, lds + wid * 12288, lane);
}

template <int TAG>
struct EpiStoreSplit {
    static constexpr bool ABLK = true;
    bf16_t* O1; int ld1; bf16_t* O2; int ld2; int split;
    __device__ __forceinline__ void operator()(f32x4 (&acc)[4][8], int row0, int col0, char* wl, int lane) const {
        if (TAG == 0 && col0 < 1536) {
            const bool isq = col0 < 512;
#pragma unroll
            for (int i = 0; i < 4; ++i)
#pragma unroll
                for (int j = 0; j < 8; ++j)
#pragma unroll
                    for (int t = 0; t < 4; ++t) {
                        const float x = acc[i][j][t];
                        const float r = __builtin_amdgcn_rcpf(1.f + __expf(isq ? -x : x));
                        acc[i][j][t] = isq ? x * r : r;
                    }
        }
        const bool first = col0 < split;
        bf16_t* O = first ? O1 : O2; const int ld = first ? ld1 : ld2, cb = first ? col0 : col0 - split;
        const int fr = lane & 15, fq = lane >> 4;
#pragma unroll
        for (int i = 0; i < 4; ++i) {
#pragma unroll
            for (int j = 0; j < 8; ++j) {
                uint2 w; w.x = pack2(acc[i][j][0], acc[i][j][1]); w.y = pack2(acc[i][j][2], acc[i][j][3]);
                *(uint2*)(wl + fr * 272 + (16 * j + 4 * fq) * 2) = w;
            }
#pragma unroll
            for (int m = 0; m < 4; ++m) {
                const int rr = (lane >> 4) + 4 * m;
                const uint4 v = *(const uint4*)(wl + rr * 272 + (lane & 15) * 16);
                *(uint4*)(O + (size_t)(row0 + 16 * i + rr) * ld + cb + (lane & 15) * 8) = v;
            }
        }
    }
};
template <int TAG>
struct EpiResid {
    static constexpr bool ABLK = false;
    const float* hin_lat; const float* hin_ctx; const bf16_t* hin16; bf16_t* hout16; const float* gate  ;
    __device__ __forceinline__ void operator()(f32x4 (&acc)[4][8], int row0, int col0, char* wl, int lane) const {
        const int fr = lane & 15, fq = lane >> 4;
        const float4 gg = *(const float4*)(gate + (size_t)mod_row(row0) * 6144 + col0 + (lane & 31) * 4);
#pragma unroll
        for (int i = 0; i < 4; ++i) {
#pragma unroll
            for (int j = 0; j < 8; ++j) *(f32x4*)(wl + fr * 528 + (16 * j + 4 * fq) * 4) = acc[i][j];
#pragma unroll
            for (int m = 0; m < 8; ++m) {
                const int rr = (lane >> 5) + 2 * m, row = row0 + 16 * i + rr, col = col0 + (lane & 31) * 4;
                const f32x4 a = *(const f32x4*)(wl + rr * 528 + (lane & 31) * 16);
                float4 h;
                if (hin16) {
                    const uint2 hw = *(const uint2*)(hin16 + (size_t)row * D + col);
                    h.x = __uint_as_float(hw.x << 16); h.y = __uint_as_float(hw.x & 0xffff0000u); h.z = __uint_as_float(hw.y << 16); h.w = __uint_as_float(hw.y & 0xffff0000u);
                } else {
                    h = *(const float4*)((row < TL ? hin_lat + (size_t)row * D : hin_ctx + (size_t)(row - TL) * D) + col);
                }
                uint2 o; o.x = pack2(h.x + gg.x * a[0], h.y + gg.y * a[1]); o.y = pack2(h.z + gg.z * a[2], h.w + gg.w * a[3]);
                *(uint2*)(hout16 + (size_t)row * D + col) = o;
            }
        }
    }
};
struct EpiGA {
    static constexpr bool ABLK = true;
    bf16_t* P; bf16_t* Vt; const float* qg; const float* kg; const float* cosG; const float* sinG;
    __device__ __forceinline__ void operator()(f32x4 (&acc)[4][8], int row0, int col0, char* wl, int lane) const {
        const int fr = lane & 15, fq = lane >> 4;
        const bool latent = row0 < TL;
        if (col0 < 1280) {
            const bool isq = col0 < 1024;
            const float* g = isq ? qg : kg;
            const float osc = isq ? 0.08838834764831845f * LOG2E : 1.0f;
#pragma unroll
            for (int i = 0; i < 4; ++i) {
                float ss = 0.f;
#pragma unroll
                for (int j = 0; j < 8; ++j) ss += acc[i][j][0] * acc[i][j][0] + acc[i][j][1] * acc[i][j][1] + acc[i][j][2] * acc[i][j][2] + acc[i][j][3] * acc[i][j][3];
                ss += __shfl_xor(ss, 16); ss += __shfl_xor(ss, 32);
                const float rinv = rsqrtf(ss * (1.0f / 128.0f) + EPS) * osc;
                const int tpos = (row0 + 16 * i + fr) & (SEQ - 1);
#pragma unroll
                for (int j = 0; j < 4; ++j) {
                    const float4 g1 = *(const float4*)(g + 16 * j + 4 * fq), g2 = *(const float4*)(g + 64 + 16 * j + 4 * fq);
                    f32x4 y1 = acc[i][j] * rinv, y2 = acc[i][j + 4] * rinv;
                    y1[0] *= g1.x; y1[1] *= g1.y; y1[2] *= g1.z; y1[3] *= g1.w; y2[0] *= g2.x; y2[1] *= g2.y; y2[2] *= g2.z; y2[3] *= g2.w;
                    if (latent) {
                        const float4 cs = *(const float4*)(cosG + tpos * 64 + 16 * j + 4 * fq), sn = *(const float4*)(sinG + tpos * 64 + 16 * j + 4 * fq);
                        const f32x4 c4 = {cs.x, cs.y, cs.z, cs.w}, s4 = {sn.x, sn.y, sn.z, sn.w};
                        const f32x4 n1 = y1 * c4 - y2 * s4, n2 = y1 * s4 + y2 * c4;
                        y1 = n1; y2 = n2;
                    }
                    uint2 w1, w2; w1.x = pack2(y1[0], y1[1]); w1.y = pack2(y1[2], y1[3]); w2.x = pack2(y2[0], y2[1]); w2.y = pack2(y2[2], y2[3]);
                    *(uint2*)(wl + fr * 272 + (16 * j + 4 * fq) * 2) = w1;
                    *(uint2*)(wl + fr * 272 + (64 + 16 * j + 4 * fq) * 2) = w2;
                }
#pragma unroll
                for (int m = 0; m < 4; ++m) {
                    const int rr = (lane >> 4) + 4 * m;
                    const uint4 v = *(const uint4*)(wl + rr * 272 + (lane & 15) * 16);
                    *(uint4*)(P + (size_t)(row0 + 16 * i + rr) * GA_IN + col0 + (lane & 15) * 8) = v;
                }
            }
        } else {
            const int kvh = (col0 - 1280) >> 7;
            const int b = latent ? (row0 >> 12) : ((row0 - TL) >> 8);
            const int kidx0 = latent ? LC + (row0 & (SEQ - 1)) : ((row0 - TL) & (LC - 1));
            bf16_t* vt = Vt + (size_t)(b * 2 + kvh) * 128 * NKEY + kidx0;
#pragma unroll
            for (int hh = 0; hh < 2; ++hh) {
#pragma unroll
                for (int i = 0; i < 4; ++i)
#pragma unroll
                    for (int j = 0; j < 4; ++j)
#pragma unroll
                        for (int t = 0; t < 4; ++t)
                            *(bf16_t*)(wl + (16 * j + 4 * fq + t) * 144 + (16 * i + fr) * 2) = (bf16_t)(pack2(acc[i][4 * hh + j][t], 0.f) & 0xffff);
#pragma unroll
                for (int m = 0; m < 8; ++m) {
                    const int dd = (lane >> 3) + 8 * m;
                    const uint4 v = *(const uint4*)(wl + dd * 144 + (lane & 7) * 16);
                    *(uint4*)(vt + (size_t)(64 * hh + dd) * NKEY + (lane & 7) * 8) = v;
                }
            }
        }
    }
};
template <class Epi>
__device__ void ph_gemm(int bid, int nb, const bf16_t* A, int lda, const bf16_t* Bt, int ldb, int M, int N, int K, char* lds, Epi epi, int ncol0 = 0) {
    const int nM = M / 128, nN = N / 256, nwg = nM * nN;
    const bool sw = (nb & 7) == 0;
    for (int L = bid; L < nwg; L += nb) {
        int wg = L;
        if (sw) { const int q = nwg >> 3, r = nwg & 7, xcd = L & 7, off = L >> 3; wg = (xcd < r ? xcd * (q + 1) : r * (q + 1) + (xcd - r) * q) + off; }
        const int nig = 8 * nN, gid = wg / nig, fm = gid * 8, gsz = (nM - fm) < 8 ? (nM - fm) : 8;
        const int pm = fm + (wg % nig) % gsz, pn = (wg % nig) / gsz;
        gemm_tile(A, lda, Bt, ldb, K, pm * 128, ncol0 + pn * 256, lds, epi);
    }
}

typedef short bf16x4 __attribute__((ext_vector_type(4)));
constexpr int HQ_OFF = 0, HK_OFF = 16384, HKT_OFF = 32768, HVT_OFF = 49152, HD_OFF = 57344, HG_LDS = 59392;
__device__ __forceinline__ int hg_row(int b, int dir, int p) {
    if (p < LC) { const int s = dir ? (LC - 1 - p) : p; return TL + b * LC + s; }
    const int t = dir ? (SEQ - 1 - (p - LC)) : (p - LC);
    return b * SEQ + t;
}
__device__ void ph_hgrn(int bid, int nb, const bf16_t* __restrict__ projH, const float* __restrict__ lb, bf16_t* __restrict__ of, bf16_t* __restrict__ ob, char* lds) {
    const int tid = threadIdx.x, lane = tid & 63, w = tid >> 6, fr = lane & 15, fq = lane >> 4;
    for (int it = bid; it < NB * 4 * 2 * 2; it += nb) {
        const int vs = it & 1, dir = (it >> 1) & 1, h = (it >> 2) & 3, b = it >> 4;
        bf16_t* out = dir ? ob : of; const int ldo = dir ? 512 : D;
        const float lb0 = lb[h * 128 + 2 * lane], lb1 = lb[h * 128 + 2 * lane + 1];
        const int fcol = (dir ? 1024 : 512) + h * 128 + 2 * lane, qcol = h * 128 + 2 * lane, vcol = 1536 + h * 128 + vs * 64 + lane;
        f32x4 S[8];
#pragma unroll
        for (int kt = 0; kt < 8; ++kt) S[kt] = (f32x4){0.f, 0.f, 0.f, 0.f};
        unsigned xf[16], xq[16]; bf16_t xv[16];
#define HG_PREFETCH(p0) do { _Pragma("unroll") for (int i = 0; i < 16; ++i) { \
            const size_t rb = (size_t)hg_row(b, dir, (p0) + 16 * w + i) * HGW; \
            xf[i] = *(const unsigned*)(projH + rb + fcol); xq[i] = *(const unsigned*)(projH + rb + qcol); xv[i] = projH[rb + vcol]; } } while (0)
        HG_PREFETCH(0);
        for (int p0 = 0; p0 < NKEY; p0 += 64) {
            __syncthreads();
            {
                float P0 = 1.f, P1 = 1.f, kp0 = 0.f, kp1 = 0.f;
                unsigned kt0[8], kt1[8], vt[8];
#pragma unroll
                for (int i = 0; i < 16; ++i) {
                    const float u0 = __uint_as_float(xf[i] << 16), u1 = __uint_as_float(xf[i] & 0xffff0000u);
                    const float xq0 = __uint_as_float(xq[i] << 16), xq1 = __uint_as_float(xq[i] & 0xffff0000u);
                    const float nf0 = (1.f - lb0) * u0, nf1 = (1.f - lb1) * u1;
                    P0 *= 1.f - nf0; P1 *= 1.f - nf1;
                    const float q0 = xq0 * P0, q1 = xq1 * P1;
                    const float k0 = nf0 * fminf(__builtin_amdgcn_rcpf(P0), 5.0e34f);
                    const float k1 = nf1 * fminf(__builtin_amdgcn_rcpf(P1), 5.0e34f);
                    const int t = 16 * w + i;
                    const int o = t * 256 + (((lane >> 2) ^ (t & 15)) << 4) + (lane & 3) * 4;
                    *(unsigned*)(lds + HQ_OFF + o) = pack2(q0, q1);
                    *(unsigned*)(lds + HK_OFF + o) = pack2(k0, k1);
                    if (i & 1) { kt0[i >> 1] = pack2(kp0, k0); kt1[i >> 1] = pack2(kp1, k1); vt[i >> 1] = (unsigned)xv[i - 1] | ((unsigned)xv[i] << 16); }
                    else { kp0 = k0; kp1 = k1; }
                }
                float2 dd; dd.x = P0; dd.y = P1;
                *(float2*)(lds + HD_OFF + (w * 128 + 2 * lane) * 4) = dd;
                char* kp = lds + HKT_OFF + w * 4096 + (2 * lane) * 32;
                *(uint4*)(kp) = make_uint4(kt0[0], kt0[1], kt0[2], kt0[3]); *(uint4*)(kp + 16) = make_uint4(kt0[4], kt0[5], kt0[6], kt0[7]);
                *(uint4*)(kp + 32) = make_uint4(kt1[0], kt1[1], kt1[2], kt1[3]); *(uint4*)(kp + 48) = make_uint4(kt1[4], kt1[5], kt1[6], kt1[7]);
                char* vp = lds + HVT_OFF + w * 2048 + lane * 32;
                *(uint4*)(vp) = make_uint4(vt[0], vt[1], vt[2], vt[3]); *(uint4*)(vp + 16) = make_uint4(vt[4], vt[5], vt[6], vt[7]);
            }
            if (p0 + 64 < NKEY) HG_PREFETCH(p0 + 64);
            __syncthreads();
#pragma unroll
            for (int I = 0; I < 4; ++I) {
                const int trow = 16 * I + fr;
                f32x4 at = (f32x4){0.f, 0.f, 0.f, 0.f};
#pragma unroll
                for (int ks = 0; ks < 4; ++ks) {
                    const int o = trow * 256 + (((ks * 4 + fq) ^ fr) << 4);
                    const bf16x8 ka = *(const bf16x8*)(lds + HK_OFF + o);
                    const bf16x8 qa = *(const bf16x8*)(lds + HQ_OFF + o);
                    at = __builtin_amdgcn_mfma_f32_16x16x32_bf16(ka, qa, at, 0, 0, 0);
                }
#pragma unroll
                for (int j = 0; j < 4; ++j) if (4 * fq + j > fr) at[j] = 0.f;
                uint2 pa2; pa2.x = pack2(at[0], at[1]); pa2.y = pack2(at[2], at[3]);
                const bf16x4 pA = __builtin_bit_cast(bf16x4, pa2);
                const bf16x4 vfrag = *(const bf16x4*)(lds + HVT_OFF + I * 2048 + (w * 16 + fr) * 32 + fq * 8);
                f32x4 o1 = __builtin_amdgcn_mfma_f32_16x16x16bf16_1k(vfrag, pA, (f32x4){0.f, 0.f, 0.f, 0.f}, 0, 0, 0);
                f32x4 o2 = (f32x4){0.f, 0.f, 0.f, 0.f};
#pragma unroll
                for (int kt = 0; kt < 8; ++kt) {
                    uint2 s2; s2.x = pack2(S[kt][0], S[kt][1]); s2.y = pack2(S[kt][2], S[kt][3]);
                    const bf16x4 sfrag = __builtin_bit_cast(bf16x4, s2);
                    const bf16x4 qfrag = *(const bf16x4*)(lds + HQ_OFF + trow * 256 + (((kt * 2 + (fq >> 1)) ^ fr) << 4) + (fq & 1) * 8);
                    if (kt & 1) o2 = __builtin_amdgcn_mfma_f32_16x16x16bf16_1k(sfrag, qfrag, o2, 0, 0, 0);
                    else o1 = __builtin_amdgcn_mfma_f32_16x16x16bf16_1k(sfrag, qfrag, o1, 0, 0, 0);
                }
#pragma unroll
                for (int kt = 0; kt < 8; ++kt) {
                    const bf16x4 kfrag = *(const bf16x4*)(lds + HKT_OFF + I * 4096 + (kt * 16 + fr) * 32 + fq * 8);
                    const f32x4 d4 = *(const f32x4*)(lds + HD_OFF + (I * 128 + kt * 16 + fq * 4) * 4);
                    S[kt] = __builtin_amdgcn_mfma_f32_16x16x16bf16_1k(kfrag, vfrag, S[kt], 0, 0, 0);
                    S[kt] = S[kt] * d4;
                }
                const size_t orow = (size_t)hg_row(b, dir, p0 + trow);
                uint2 ov; ov.x = pack2(o1[0] + o2[0], o1[1] + o2[1]); ov.y = pack2(o1[2] + o2[2], o1[3] + o2[3]);
                *(uint2*)(out + orow * ldo + h * 128 + vs * 64 + w * 16 + fq * 4) = ov;
            }
        }
#undef HG_PREFETCH
    }
}
__device__ void ph_hgpost(int bid, int nb, const bf16_t* __restrict__ of, const bf16_t* __restrict__ ob, const bf16_t* __restrict__ projH,
                          const float* __restrict__ g, bf16_t* __restrict__ mix) {
    const int lane = threadIdx.x & 63, wid = threadIdx.x >> 6, l16 = lane & 15;
    const float4 g0 = *(const float4*)(g + l16 * 8), g1 = *(const float4*)(g + l16 * 8 + 4);
    const float gw[8] = {g0.x, g0.y, g0.z, g0.w, g1.x, g1.y, g1.z, g1.w};
    for (int it = (bid * 4 + wid) * 4 + (lane >> 4); it < TA * 4; it += nb * 16) {
        const int row = it >> 2, h = it & 3;
        const uint4 a = *(const uint4*)(of + (size_t)row * D + h * 128 + l16 * 8), bb = *(const uint4*)(ob + (size_t)row * 512 + h * 128 + l16 * 8);
        const uint4 gg = *(const uint4*)(projH + (size_t)row * HGW + 2048 + h * 128 + l16 * 8);
        const unsigned aw[4] = {a.x, a.y, a.z, a.w}, bw[4] = {bb.x, bb.y, bb.z, bb.w}, gv[4] = {gg.x, gg.y, gg.z, gg.w};
        float x[8], ss = 0.f;
#pragma unroll
        for (int j = 0; j < 4; ++j) {
            x[2 * j] = __uint_as_float(aw[j] << 16) + __uint_as_float(bw[j] << 16);
            x[2 * j + 1] = __uint_as_float(aw[j] & 0xffff0000u) + __uint_as_float(bw[j] & 0xffff0000u);
            ss += x[2 * j] * x[2 * j] + x[2 * j + 1] * x[2 * j + 1];
        }
        ss += __int_as_float(__builtin_amdgcn_update_dpp(0, __float_as_int(ss), 0xB1, 0xF, 0xF, true));
        ss += __int_as_float(__builtin_amdgcn_update_dpp(0, __float_as_int(ss), 0x4E, 0xF, 0xF, true));
        ss += __int_as_float(__builtin_amdgcn_update_dpp(0, __float_as_int(ss), 0x141, 0xF, 0xF, true));
        ss += __int_as_float(__builtin_amdgcn_update_dpp(0, __float_as_int(ss), 0x140, 0xF, 0xF, true));
        const float rinv = rsqrtf(ss * (1.0f / 128.0f) + EPS);
        unsigned ow[4];
#pragma unroll
        for (int j = 0; j < 4; ++j) {
            const float y0 = x[2 * j] * rinv * gw[2 * j] * siluf_(__uint_as_float(gv[j] << 16));
            const float y1 = x[2 * j + 1] * rinv * gw[2 * j + 1] * siluf_(__uint_as_float(gv[j] & 0xffff0000u));
            ow[j] = pack2(y0, y1);
        }
        *(uint4*)(mix + (size_t)row * D + h * 128 + l16 * 8) = make_uint4(ow[0], ow[1], ow[2], ow[3]);
    }
}

__device__ void ph_prep_swa(int bid, int nb, bf16_t* __restrict__ P, const float* __restrict__ cosS, const float* __restrict__ sinS) {
    const int n = TA * 40;
    for (int idx = bid * blockDim.x + threadIdx.x; idx < n; idx += nb * blockDim.x) {
        const int row = idx / 40, pr = idx - row * 40, head = pr >> 2, d = (pr & 3) * 8;
        bf16_t* p = P + (size_t)row * SWW + head * 64 + d;
        const uint4 a = *(const uint4*)p, b = *(const uint4*)(p + 32);
        const unsigned aw[4] = {a.x, a.y, a.z, a.w}, bw[4] = {b.x, b.y, b.z, b.w};
        float x1[8], x2[8];
#pragma unroll
        for (int j = 0; j < 4; ++j) {
            x1[2 * j] = __uint_as_float(aw[j] << 16); x1[2 * j + 1] = __uint_as_float(aw[j] & 0xffff0000u);
            x2[2 * j] = __uint_as_float(bw[j] << 16); x2[2 * j + 1] = __uint_as_float(bw[j] & 0xffff0000u);
        }
        if (row < TL) {
            const int t = row & (SEQ - 1);
            const float4 c0 = *(const float4*)(cosS + t * 32 + d), c1 = *(const float4*)(cosS + t * 32 + d + 4);
            const float4 s0 = *(const float4*)(sinS + t * 32 + d), s1 = *(const float4*)(sinS + t * 32 + d + 4);
            const float cc[8] = {c0.x, c0.y, c0.z, c0.w, c1.x, c1.y, c1.z, c1.w}, ss[8] = {s0.x, s0.y, s0.z, s0.w, s1.x, s1.y, s1.z, s1.w};
#pragma unroll
            for (int j = 0; j < 8; ++j) { const float y1 = x1[j] * cc[j] - x2[j] * ss[j], y2 = x1[j] * ss[j] + x2[j] * cc[j]; x1[j] = y1; x2[j] = y2; }
        }
        if (head < 8) {
#pragma unroll
            for (int j = 0; j < 8; ++j) { x1[j] *= 0.125f * LOG2E; x2[j] *= 0.125f * LOG2E; }
        }
        uint4 oa, ob;
        oa.x = pack2(x1[0], x1[1]); oa.y = pack2(x1[2], x1[3]); oa.z = pack2(x1[4], x1[5]); oa.w = pack2(x1[6], x1[7]);
        ob.x = pack2(x2[0], x2[1]); ob.y = pack2(x2[2], x2[3]); ob.z = pack2(x2[4], x2[5]); ob.w = pack2(x2[6], x2[7]);
        *(uint4*)p = oa; *(uint4*)(p + 32) = ob;
    }
}
__device__ void ph_prep_ga(int bid, int nb, bf16_t* __restrict__ P, const float* __restrict__ qg, const float* __restrict__ kg,
                           const float* __restrict__ cosG, const float* __restrict__ sinG) {
    const int lane = threadIdx.x & 63, wid = threadIdx.x >> 6;
    for (int it = bid * 4 + wid; it < TA * 10; it += nb * 4) {
        const int row = it / 10, head = it % 10;
        bf16_t* p = P + (size_t)row * GA_IN + head * 128;
        float x1 = bf2f(p[lane]), x2 = bf2f(p[lane + 64]);
        const float ss = wave_sum(x1 * x1 + x2 * x2);
        const float rinv = rsqrtf(ss * (1.0f / 128.0f) + EPS);
        const float* g = head < 8 ? qg : kg;
        x1 = x1 * rinv * g[lane]; x2 = x2 * rinv * g[lane + 64];
        if (row < TL) {
            const int t = row & (SEQ - 1);
            const float c = cosG[t * 64 + lane], s = sinG[t * 64 + lane];
            const float y1 = x1 * c - x2 * s, y2 = x1 * s + x2 * c;
            x1 = y1; x2 = y2;
        }
        if (head < 8) { x1 *= 0.08838834764831845f * LOG2E; x2 *= 0.08838834764831845f * LOG2E; }
        p[lane] = f2bf(x1); p[lane + 64] = f2bf(x2);
    }
}

template <int HD>
__device__ void ph_vt(int bid, int nb, const bf16_t* __restrict__ P, int ldp, int vcol, bf16_t* __restrict__ Vt, bf16_t* lds) {
    constexpr int ND = HD / 64;
    const int tid = threadIdx.x;
    for (int it = bid; it < NB * 2 * ND * (NKEY / 64); it += nb) {
        const int kt = it % (NKEY / 64), r1 = it / (NKEY / 64), dh = r1 % ND, g = r1 / ND, b = g >> 1, kvh = g & 1;
        const int k0 = kt * 64;
        const int row0 = k0 < LC ? TL + b * LC + k0 : b * SEQ + (k0 - LC);
        __syncthreads();
#pragma unroll
        for (int i = 0; i < 2; ++i) {
            const int id = tid + i * 256, kr = id >> 3, c = id & 7;
            const uint4 w = *(const uint4*)(P + (size_t)(row0 + kr) * ldp + vcol + kvh * HD + dh * 64 + c * 8);
            const unsigned ww[4] = {w.x, w.y, w.z, w.w};
#pragma unroll
            for (int j = 0; j < 4; ++j) { lds[kr * 66 + c * 8 + j * 2] = (bf16_t)(ww[j] & 0xffff); lds[kr * 66 + c * 8 + j * 2 + 1] = (bf16_t)(ww[j] >> 16); }
        }
        __syncthreads();
#pragma unroll
        for (int i = 0; i < 2; ++i) {
            const int id = tid + i * 256, d = id >> 3, c = id & 7;
            unsigned o[4];
#pragma unroll
            for (int j = 0; j < 4; ++j) o[j] = (unsigned)lds[(c * 8 + j * 2) * 66 + d] | ((unsigned)lds[(c * 8 + j * 2 + 1) * 66 + d] << 16);
            uint4 w; w.x = o[0]; w.y = o[1]; w.z = o[2]; w.w = o[3];
            *(uint4*)(Vt + (size_t)(g * HD + dh * 64 + d) * NKEY + k0 + c * 8) = w;
        }
    }
}

template <int HD, bool MASK>
__device__ __forceinline__ void flash_item(const bf16_t* __restrict__ Qrow0, int ldq, const bf16_t* __restrict__ Kp, int ldk,
                                           const bf16_t* __restrict__ Vt, int krow_ctx0, int krow_lat0, int nctx_t, int lat_lo, int nlat_t,
                                           int tq0, float m0, float l0, bf16_t* __restrict__ Orow0, int ldo, char* lds) {
    constexpr int NCH = HD / 32;
    constexpr int KB = 64 * HD * 2;
    constexpr int NKK = HD / 16;
    constexpr int NDT = HD / 32;
    const int tid = threadIdx.x, lane = tid & 63, w = tid >> 6, r = lane & 31, h = lane >> 5;
    const int pr = (r & 0x13) | ((r & 4) << 1) | ((r & 8) >> 1);
    bf16x8 qf[NKK];
    {
        const bf16_t* qp = Qrow0 + (size_t)(32 * w + r) * ldq + 8 * h;
#pragma unroll
        for (int kk = 0; kk < NKK; ++kk) qf[kk] = *(const bf16x8*)(qp + 16 * kk);
    }
    f32x16 O[NDT];
#pragma unroll
    for (int dt = 0; dt < NDT; ++dt)
#pragma unroll
        for (int i = 0; i < 16; ++i) O[dt][i] = 0.f;
    float m_run = m0, l_run = (h == 0) ? l0 : 0.f;
    typedef __attribute__((address_space(3))) char las_char;
    las_char* l3 = (las_char*)lds;
    constexpr int KRI = (HD == 128) ? 4 : 8;
    constexpr int NKI = 16 / KRI;
    constexpr int NVI = HD / 32;
    const int krl = (HD == 128) ? (lane >> 4) : (lane >> 3);
    const int kpl = (HD == 128) ? (lane & 15) : (lane & 7);
    const int vrl = lane >> 3, vpl = lane & 7;
    const int kfo = pr * (HD * 2);
    const int kfs = (HD == 128) ? (pr & 15) : ((pr >> 1) & 7);
    const int vfo = KB + r * 128;
    const int vfs = (r >> 1) & 7;
    const int ntile = nctx_t + nlat_t;
#define FA_TILE(t, krow0, kidx0, s0) const int krow0 = (t) < nctx_t ? krow_ctx0 + 64 * (t) : krow_lat0 + lat_lo + 64 * ((t) - nctx_t); \
        const int s0 = (t) < nctx_t ? -(1 << 24) : lat_lo + 64 * ((t) - nctx_t); const int kidx0 = (t) < nctx_t ? 64 * (t) : LC + lat_lo + 64 * ((t) - nctx_t);
#define FA_STAGE(t, buf) do { FA_TILE(t, _kr0, _ki0, _s0) (void)_s0; \
        _Pragma("unroll") for (int i = 0; i < NKI; ++i) { const int _row = 16 * w + KRI * i + krl; \
            const int _c = (HD == 128) ? (kpl ^ (_row & 15)) : (kpl ^ ((_row >> 1) & 7)); \
            __builtin_amdgcn_global_load_lds((const unsigned*)(Kp + (size_t)(_kr0 + _row) * ldk + _c * 8), \
                (__attribute__((address_space(3))) unsigned*)(l3 + (buf) * (2 * KB) + (16 * w + KRI * i) * (HD * 2)), 16, 0, 0); } \
        _Pragma("unroll") for (int i = 0; i < NVI; ++i) { const int _row = (HD / 4) * w + 8 * i + vrl; const int _c = vpl ^ ((_row >> 1) & 7); \
            __builtin_amdgcn_global_load_lds((const unsigned*)(Vt + (size_t)_row * NKEY + _ki0 + _c * 8), \
                (__attribute__((address_space(3))) unsigned*)(l3 + (buf) * (2 * KB) + KB + ((HD / 4) * w + 8 * i) * 128), 16, 0, 0); } } while (0)
    __syncthreads();
    FA_STAGE(0, 0);
    __syncthreads();
    for (int t = 0; t < ntile; ++t) {
        if (t + 1 < ntile) FA_STAGE(t + 1, (t + 1) & 1);
        const char* base = lds + (t & 1) * (2 * KB);
        f32x16 st[2];
        __builtin_amdgcn_s_setprio(1);
#pragma unroll
        for (int rt = 0; rt < 2; ++rt) {
#pragma unroll
            for (int i = 0; i < 16; ++i) st[rt][i] = 0.f;
#pragma unroll
            for (int kk = 0; kk < NKK; ++kk) {
                const bf16x8 kf = *(const bf16x8*)(base + rt * 32 * (HD * 2) + kfo + (((2 * kk + h) ^ kfs) << 4));
                st[rt] = __builtin_amdgcn_mfma_f32_32x32x16_bf16(kf, qf[kk], st[rt], 0, 0, 0);
                if ((kk & 7) == 7) __builtin_amdgcn_sched_barrier(0);
            }
        }
        __builtin_amdgcn_s_setprio(0);
        if (MASK) {
            FA_TILE(t, _kr0, _ki0, s0) (void)_kr0; (void)_ki0;
            if (t >= nctx_t) {
                const int tq = tq0 + 32 * w + r;
#pragma unroll
                for (int rt = 0; rt < 2; ++rt)
#pragma unroll
                    for (int i = 0; i < 16; ++i) {
                        const int s = s0 + 32 * rt + (i & 3) + 4 * ((i >> 2) & 1) + 8 * h + 16 * (i >> 3);
                        const int dlt = tq - s;
                        if (dlt > 128 || dlt < -128) st[rt][i] = -1.0e30f;
                    }
            }
        }
        constexpr float FA_THR = 11.5f;
        float pmax = st[0][0];
#pragma unroll
        for (int rt = 0; rt < 2; ++rt)
#pragma unroll
            for (int i = 0; i < 16; ++i) pmax = fmaxf(pmax, st[rt][i]);
        pmax = fmaxf(pmax, __shfl_xor(pmax, 32));
        float mx = m_run, alpha = 1.0f;
        if (!__all(pmax - m_run <= FA_THR)) {
            mx = fmaxf(m_run, pmax);
            alpha = __builtin_amdgcn_exp2f(m_run - mx);
            m_run = mx;
        }
        float ps = 0.f;
#pragma unroll
        for (int rt = 0; rt < 2; ++rt)
#pragma unroll
            for (int i = 0; i < 16; ++i) { const float p = __builtin_amdgcn_exp2f(st[rt][i] - mx); st[rt][i] = p; ps += p; }
        l_run = l_run * alpha + ps;
        if (!__all(alpha == 1.0f)) {
#pragma unroll
            for (int dt = 0; dt < NDT; ++dt)
#pragma unroll
                for (int i = 0; i < 16; ++i) O[dt][i] *= alpha;
        }
        bf16x8 pf[2][2];
#pragma unroll
        for (int rt = 0; rt < 2; ++rt)
#pragma unroll
            for (int s2 = 0; s2 < 2; ++s2) {
                uint4 pk;
                pk.x = pack2(st[rt][8 * s2 + 0], st[rt][8 * s2 + 1]); pk.y = pack2(st[rt][8 * s2 + 2], st[rt][8 * s2 + 3]);
                pk.z = pack2(st[rt][8 * s2 + 4], st[rt][8 * s2 + 5]); pk.w = pack2(st[rt][8 * s2 + 6], st[rt][8 * s2 + 7]);
                pf[rt][s2] = __builtin_bit_cast(bf16x8, pk);
            }
#pragma unroll
        for (int dt = 0; dt < NDT; ++dt)
#pragma unroll
            for (int rt = 0; rt < 2; ++rt)
#pragma unroll
                for (int s2 = 0; s2 < 2; ++s2) {
                    const bf16x8 vf = *(const bf16x8*)(base + vfo + dt * 4096 + (((4 * rt + 2 * s2 + h) ^ vfs) << 4));
                    O[dt] = __builtin_amdgcn_mfma_f32_32x32x16_bf16(vf, pf[rt][s2], O[dt], 0, 0, 0);
                    if (rt == 1 && s2 == 1) __builtin_amdgcn_sched_barrier(0);
                }
        __syncthreads();
    }
#undef FA_TILE
#undef FA_STAGE
    const float lt = l_run + __shfl_xor(l_run, 32);
    const float inv = 1.0f / lt;
    char* wl = lds + w * (32 * (HD * 2 + 16));
#pragma unroll
    for (int dt = 0; dt < NDT; ++dt)
#pragma unroll
        for (int g = 0; g < 4; ++g) {
            uint2 o2; o2.x = pack2(O[dt][4 * g] * inv, O[dt][4 * g + 1] * inv); o2.y = pack2(O[dt][4 * g + 2] * inv, O[dt][4 * g + 3] * inv);
            *(uint2*)(wl + r * (HD * 2 + 16) + (32 * dt + 8 * g + 4 * h) * 2) = o2;
        }
    constexpr int LPR = HD / 8;
#pragma unroll
    for (int m = 0; m < 32 * LPR / 64; ++m) {
        const int rr = (lane / LPR) + (64 / LPR) * m, ch = lane % LPR;
        const uint4 v = *(const uint4*)(wl + rr * (HD * 2 + 16) + ch * 16);
        *(uint4*)(Orow0 + (size_t)(32 * w + rr) * ldo + ch * 8) = v;
    }
}
__device__ void ph_swa(int bid, int nb, const bf16_t* __restrict__ projS, const bf16_t* __restrict__ Vt, const float* __restrict__ sink,
                       bf16_t* __restrict__ mix, char* lds) {
    const int n_lat = NB * 8 * 32, n_ctx = NB * 8 * 2;
    for (int it = bid; it < n_lat + n_ctx; it += nb) {
        int b, hq, row0, lo, nlat, t0;
        if (it < n_lat) {
            const int qb = it & 31; hq = (it >> 5) & 7; b = it >> 8;
            t0 = qb * 128;
            lo = t0 - 128 < 0 ? 0 : t0 - 128;
            const int hi = t0 + 256 > SEQ ? SEQ : t0 + 256;
            nlat = (hi - lo) / 64; row0 = b * SEQ + t0;
        } else {
            const int i2 = it - n_lat, qb = i2 & 1; hq = (i2 >> 1) & 7; b = i2 >> 4;
            t0 = 0; lo = 0; nlat = 0; row0 = TL + b * LC + qb * 128;
        }
        const int kvh = hq >> 2;
        flash_item<64, true>(projS + (size_t)row0 * SWW + hq * 64, SWW, projS + 512 + kvh * 64, SWW, Vt + (size_t)(b * 2 + kvh) * 64 * NKEY,
                             TL + b * LC, b * SEQ, 4, lo, nlat, t0, sink[hq] * LOG2E, 1.0f, mix + (size_t)row0 * D + 512 + hq * 64, D, lds);
    }
}
__device__ void ph_dense(int bid, int nb, const bf16_t* __restrict__ projG, const bf16_t* __restrict__ Vt, bf16_t* __restrict__ mix, char* lds) {
    const bool sw = (nb & 7) == 0;
    const int nit = NB * 8 * 32;
    for (int j = sw ? (bid >> 3) : bid; j < (sw ? nit / 8 : nit); j += sw ? (nb >> 3) : nb) {
        int g, jj;
        if (sw) { g = (bid & 7) + 8 * (j >> 7); jj = j & 127; } else { g = j >> 7; jj = j & 127; }
        const int b = g >> 1, kvh = g & 1, hq = kvh * 4 + (jj >> 5), qb = jj & 31;
        const int row0 = b * SEQ + qb * 128;
        flash_item<128, false>(projG + (size_t)row0 * GA_IN + hq * 128, GA_IN, projG + 1024 + kvh * 128, GA_IN, Vt + (size_t)(b * 2 + kvh) * 128 * NKEY,
                               TL + b * LC, b * SEQ, 4, 0, SEQ / 64, 0, -1.0e30f, 0.0f, mix + (size_t)row0 * D + hq * 128, D, lds);
    }
}

#define CE(a, b) { const float _h = fmaxf(a, b); b = fminf(a, b); a = _h; }
__device__ __forceinline__ void net_sort16(float (&v)[16]) {
    CE(v[0], v[1]); CE(v[3], v[2]); CE(v[4], v[5]); CE(v[7], v[6]); CE(v[8], v[9]); CE(v[11], v[10]);
    CE(v[12], v[13]); CE(v[15], v[14]); CE(v[0], v[2]); CE(v[1], v[3]); CE(v[6], v[4]); CE(v[7], v[5]);
    CE(v[8], v[10]); CE(v[9], v[11]); CE(v[14], v[12]); CE(v[15], v[13]); CE(v[0], v[1]); CE(v[2], v[3]);
    CE(v[5], v[4]); CE(v[7], v[6]); CE(v[8], v[9]); CE(v[10], v[11]); CE(v[13], v[12]); CE(v[15], v[14]);
    CE(v[0], v[4]); CE(v[1], v[5]); CE(v[2], v[6]); CE(v[3], v[7]); CE(v[12], v[8]); CE(v[13], v[9]);
    CE(v[14], v[10]); CE(v[15], v[11]); CE(v[0], v[2]); CE(v[1], v[3]); CE(v[4], v[6]); CE(v[5], v[7]);
    CE(v[10], v[8]); CE(v[11], v[9]); CE(v[14], v[12]); CE(v[15], v[13]); CE(v[0], v[1]); CE(v[2], v[3]);
    CE(v[4], v[5]); CE(v[6], v[7]); CE(v[9], v[8]); CE(v[11], v[10]); CE(v[13], v[12]); CE(v[15], v[14]);
    CE(v[0], v[8]); CE(v[1], v[9]); CE(v[2], v[10]); CE(v[3], v[11]); CE(v[4], v[12]); CE(v[5], v[13]);
    CE(v[6], v[14]); CE(v[7], v[15]); CE(v[0], v[4]); CE(v[1], v[5]); CE(v[2], v[6]); CE(v[3], v[7]);
    CE(v[8], v[12]); CE(v[9], v[13]); CE(v[10], v[14]); CE(v[11], v[15]); CE(v[0], v[2]); CE(v[1], v[3]);
    CE(v[4], v[6]); CE(v[5], v[7]); CE(v[8], v[10]); CE(v[9], v[11]); CE(v[12], v[14]); CE(v[13], v[15]);
    CE(v[0], v[1]); CE(v[2], v[3]); CE(v[4], v[5]); CE(v[6], v[7]); CE(v[8], v[9]); CE(v[10], v[11]);
    CE(v[12], v[13]); CE(v[14], v[15]);
}
__device__ __forceinline__ void net_clean16(float (&v)[16]) {
    CE(v[0], v[8]); CE(v[1], v[9]); CE(v[2], v[10]); CE(v[3], v[11]); CE(v[4], v[12]); CE(v[5], v[13]);
    CE(v[6], v[14]); CE(v[7], v[15]); CE(v[0], v[4]); CE(v[1], v[5]); CE(v[2], v[6]); CE(v[3], v[7]);
    CE(v[8], v[12]); CE(v[9], v[13]); CE(v[10], v[14]); CE(v[11], v[15]); CE(v[0], v[2]); CE(v[1], v[3]);
    CE(v[4], v[6]); CE(v[5], v[7]); CE(v[8], v[10]); CE(v[9], v[11]); CE(v[12], v[14]); CE(v[13], v[15]);
    CE(v[0], v[1]); CE(v[2], v[3]); CE(v[4], v[5]); CE(v[6], v[7]); CE(v[8], v[9]); CE(v[10], v[11]);
    CE(v[12], v[13]); CE(v[14], v[15]);
}
__device__ __forceinline__ void net_merge16(float (&a)[16], const float (&b)[16]) {
#pragma unroll
    for (int i = 0; i < 16; ++i) a[i] = fmaxf(a[i], b[15 - i]);
    net_clean16(a);
}
#define PEER_CANDS(F) F(0,0,0) F(1,0,1) F(2,0,2) F(3,0,3) F(4,0,4) F(5,0,5) F(6,0,6) F(7,0,7) F(8,0,8) F(9,0,9) F(10,0,10) F(11,0,11) F(12,0,12) F(13,0,13) F(14,0,14) F(15,0,15) F(16,1,1) F(17,1,2) F(18,1,3) F(19,1,4) F(20,1,5) F(21,1,6) F(22,1,7) F(23,2,2) F(24,2,3) F(25,2,4) F(26,3,3)

__device__ __forceinline__ void ph_peer_route(int bid, int nb, const bf16_t* __restrict__ qpeer, const bf16_t* __restrict__ SK, int* __restrict__ sel_e,
                              float* __restrict__ sel_g, int M, char* lds) {
    const int tid = tidx(), lane = tid & 63, w = tid >> 6, r = lane & 31, h2 = lane >> 5;
    const int srow = tid >> 4, sc = tid & 15;
    const int soff = srow * 256 + ((sc ^ (srow & 15)) << 4);
    int hd_loaded = -1;
    for (int it = bid; it < (M / 128) * 8; it += nb) {
        const int m0 = (it >> 3) * 128, hd = it & 7;
        const int row = 32 * w + r;
        __syncthreads();
        if (hd != hd_loaded) {
        hd_loaded = hd;
#pragma unroll
        for (int pp = 0; pp < 2; ++pp) {
            const bf16_t* sp = SK + ((size_t)(hd * 2 + pp) * 128 + srow) * 128 + sc * 8;
            uint4 t0 = *(const uint4*)(sp), t1 = *(const uint4*)(sp + 16 * 128), t2 = *(const uint4*)(sp + 32 * 128), t3 = *(const uint4*)(sp + 48 * 128);
            uint4 t4 = *(const uint4*)(sp + 64 * 128), t5 = *(const uint4*)(sp + 80 * 128), t6 = *(const uint4*)(sp + 96 * 128), t7 = *(const uint4*)(sp + 112 * 128);
            char* d = lds + pp * 32768 + soff;
            *(uint4*)(d) = t0; *(uint4*)(d + 4096) = t1; *(uint4*)(d + 8192) = t2; *(uint4*)(d + 12288) = t3;
            *(uint4*)(d + 16384) = t4; *(uint4*)(d + 20480) = t5; *(uint4*)(d + 24576) = t6; *(uint4*)(d + 28672) = t7;
        }
        }
        __syncthreads();
        float L0[16], L1[16];
#pragma unroll
        for (int pp = 0; pp < 2; ++pp) {
            bf16x8 qf[8];
            const bf16_t* qp = qpeer + (size_t)(m0 + row) * PQ + hd * 256 + pp * 128 + 8 * h2;
#pragma unroll
            for (int kk = 0; kk < 8; ++kk) qf[kk] = *(const bf16x8*)(qp + 16 * kk);
            float g[4][16];
#pragma unroll
            for (int kt = 0; kt < 4; ++kt) {
                f32x16 st;
#pragma unroll
                for (int i = 0; i < 16; ++i) st[i] = 0.f;
#pragma unroll
                for (int kk = 0; kk < 8; ++kk) {
                    const bf16x8 kf = *(const bf16x8*)(lds + pp * 32768 + (32 * kt + r) * 256 + (((2 * kk + h2) ^ (r & 15)) << 4));
                    st = __builtin_amdgcn_mfma_f32_32x32x16_bf16(kf, qf[kk], st, 0, 0, 0);
                }
#pragma unroll
                for (int i = 0; i < 16; ++i) {
                    const unsigned n = 32 * kt + (i & 3) + 8 * (i >> 2) + 4 * h2;
                    g[kt][i] = __uint_as_float((__float_as_uint(st[i]) & 0xFFFFFF80u) | n);
                }
            }
            net_sort16(g[0]); net_sort16(g[1]); net_sort16(g[2]); net_sort16(g[3]);
            net_merge16(g[0], g[1]); net_merge16(g[2], g[3]); net_merge16(g[0], g[2]);
            float pb[16];
#pragma unroll
            for (int i = 0; i < 16; ++i) pb[i] = __shfl_xor(g[0][i], 32);
            net_merge16(g[0], pb);
#pragma unroll
            for (int i = 0; i < 16; ++i) { if (pp == 0) L0[i] = g[0][i]; else L1[i] = g[0][i]; }
        }
        __syncthreads();
        unsigned char* tab = (unsigned char*)lds + 65536;
        if (h2 == 0) {
            unsigned wv[8];
#pragma unroll
            for (int j = 0; j < 4; ++j) {
                wv[j] = (__float_as_uint(L0[4 * j]) & 0x7Fu) | ((__float_as_uint(L0[4 * j + 1]) & 0x7Fu) << 8) | ((__float_as_uint(L0[4 * j + 2]) & 0x7Fu) << 16) | ((__float_as_uint(L0[4 * j + 3]) & 0x7Fu) << 24);
                wv[4 + j] = (__float_as_uint(L1[4 * j]) & 0x7Fu) | ((__float_as_uint(L1[4 * j + 1]) & 0x7Fu) << 8) | ((__float_as_uint(L1[4 * j + 2]) & 0x7Fu) << 16) | ((__float_as_uint(L1[4 * j + 3]) & 0x7Fu) << 24);
            }
            *(uint4*)(tab + row * 32) = make_uint4(wv[0], wv[1], wv[2], wv[3]);
            *(uint4*)(tab + row * 32 + 16) = make_uint4(wv[4], wv[5], wv[6], wv[7]);
        }
        float X[16], Y[16];
#pragma unroll
        for (int i = 0; i < 16; ++i) {
            const float a0 = __uint_as_float(__float_as_uint(L0[i]) & 0xFFFFFF80u), a1 = __uint_as_float(__float_as_uint(L1[i]) & 0xFFFFFF80u);
            X[i] = h2 ? a1 : a0; Y[i] = h2 ? a0 : a1;
        }
        float c0[16], c1[16];
#define PEER_CAND(i, a, b) { float v = X[a] + Y[b]; if ((a) == (b) && h2) v = -3.0e38f; const unsigned id = h2 ? ((b) * 16 + (a)) : ((a) * 16 + (b)); \
            const float pk = __uint_as_float((__float_as_uint(v) & 0xFFFFFF00u) | id); if ((i) < 16) c0[(i) & 15] = pk; else c1[(i) & 15] = pk; }
        PEER_CANDS(PEER_CAND)
#undef PEER_CAND
#pragma unroll
        for (int i = 11; i < 16; ++i) c1[i] = -3.0e38f;
        net_sort16(c0); net_sort16(c1); net_merge16(c0, c1);
        {
            float pb[16];
#pragma unroll
            for (int i = 0; i < 16; ++i) pb[i] = __shfl_xor(c0[i], 32);
            net_merge16(c0, pb);
        }
        float ex[16], sum = 0.f;
#pragma unroll
        for (int i = 0; i < 16; ++i) { ex[i] = __expf(c0[i] - c0[0]); sum += ex[i]; }
        const float rs = 1.0f / sum;
        const size_t ob = ((size_t)(m0 + row) * 8 + hd) * 16;
        if (h2 == 0) {
            int eo[16];
#pragma unroll
            for (int j = 0; j < 16; ++j) {
                const unsigned id = __float_as_uint(c0[j]) & 0xFFu;
                eo[j] = (int)tab[row * 32 + (id >> 4)] * 128 + (int)tab[row * 32 + 16 + (id & 15)];
            }
#pragma unroll
            for (int j = 0; j < 4; ++j) *(int4*)(sel_e + ob + 4 * j) = make_int4(eo[4 * j], eo[4 * j + 1], eo[4 * j + 2], eo[4 * j + 3]);
        } else {
#pragma unroll
            for (int j = 0; j < 4; ++j) *(float4*)(sel_g + ob + 4 * j) = make_float4(ex[4 * j] * rs, ex[4 * j + 1] * rs, ex[4 * j + 2] * rs, ex[4 * j + 3] * rs);
        }
    }
}
constexpr float USCALE = 64.0f;
typedef long i64_t;
__device__ __forceinline__ i64_t mk64(unsigned lo, unsigned hi) { return (i64_t)(((unsigned long long)hi << 32) | (unsigned long long)lo); }
__device__ __forceinline__ float dpp_add_xor1(float v) {
    return v + __int_as_float(__builtin_amdgcn_update_dpp(0, __float_as_int(v), 0xB1, 0xF, 0xF, true));
}
template <class F>
__device__ __forceinline__ void peer_queue_sweep(unsigned* heads, int nunits, unsigned xcc, unsigned* ldsw, F&& body) {
    for (int rr = 0; rr < 8; ++rr) {
        const int s = (int)((xcc + rr) & 7u);
        for (;;) {
            __syncthreads();
            if (tidx() == 0) *ldsw = __hip_atomic_fetch_add(heads + 64 * s, 1u, __ATOMIC_RELAXED, __HIP_MEMORY_SCOPE_AGENT);
            __syncthreads();
            const int u = __builtin_amdgcn_readfirstlane((int)*ldsw);
            if (u >= nunits) break;
            body(__builtin_amdgcn_readfirstlane(s), u);
        }
    }
}
__device__ __forceinline__ float dpp_sum8(float v) {
    v += __int_as_float(__builtin_amdgcn_update_dpp(0, __float_as_int(v), 0xB1, 0xF, 0xF, true));
    v += __int_as_float(__builtin_amdgcn_update_dpp(0, __float_as_int(v), 0x4E, 0xF, 0xF, true));
    v += __int_as_float(__builtin_amdgcn_update_dpp(0, __float_as_int(v), 0x141, 0xF, 0xF, true));
    return v;
}
__device__ __forceinline__ int dpp_isum8(int v) {
    v += __builtin_amdgcn_update_dpp(0, v, 0xB1, 0xF, 0xF, true);
    v += __builtin_amdgcn_update_dpp(0, v, 0x4E, 0xF, 0xF, true);
    v += __builtin_amdgcn_update_dpp(0, v, 0x141, 0xF, 0xF, true);
    return v;
}
__device__ __forceinline__ void ph_peer_dots(unsigned* heads, unsigned xcc, const unsigned char* __restrict__ xq, const float* __restrict__ xs, const unsigned char* __restrict__ U,
                                             const int* __restrict__ sel_e, bf16_t* __restrict__ part, int ntok, unsigned* ldsw) {
    const int lane = tidx() & 63, wid = __builtin_amdgcn_readfirstlane(tidx() >> 6), c = lane & 7, g = lane >> 3;
    peer_queue_sweep(heads, ntok / 64, xcc, ldsw, [&](int s, int u) {
        const unsigned char* Us = U + (size_t)s * NEXP * 128;
        const int row0 = u * 64 + wid * 16;
        int ek[16]; uint4 xw; float sx;
        {
#pragma unroll
            for (int i = 0; i < 4; ++i) {
                const int4 e4 = *(const int4*)(sel_e + (size_t)row0 * 128 + 16 * g + 4 * i);
                ek[4 * i] = e4.x; ek[4 * i + 1] = e4.y; ek[4 * i + 2] = e4.z; ek[4 * i + 3] = e4.w;
            }
            xw = *(const uint4*)(xq + (size_t)row0 * D + s * 128 + c * 16); sx = xs[row0];
        }
#pragma unroll 1
        for (int ti = 0; ti < 16; ++ti) {
            const int row = row0 + ti, rown = row0 + (ti < 15 ? ti + 1 : ti);
            uint4 ur[16];
#pragma unroll
            for (int k = 0; k < 16; ++k) ur[k] = *(const uint4*)(Us + ((unsigned)ek[k] * 128u + (unsigned)c * 16u));
            int ekn[16];
#pragma unroll
            for (int i = 0; i < 4; ++i) {
                const int4 e4 = *(const int4*)(sel_e + (size_t)rown * 128 + 16 * g + 4 * i);
                ekn[4 * i] = e4.x; ekn[4 * i + 1] = e4.y; ekn[4 * i + 2] = e4.z; ekn[4 * i + 3] = e4.w;
            }
            const uint4 xn = *(const uint4*)(xq + (size_t)rown * D + s * 128 + c * 16); const float sxn = xs[rown];
            int keep0 = 0, keep1 = 0;
#pragma unroll
            for (int k = 0; k < 16; ++k) {
                int a = __builtin_amdgcn_sdot4((int)ur[k].x, (int)xw.x, 0, false);
                a = __builtin_amdgcn_sdot4((int)ur[k].y, (int)xw.y, a, false);
                a = __builtin_amdgcn_sdot4((int)ur[k].z, (int)xw.z, a, false);
                a = __builtin_amdgcn_sdot4((int)ur[k].w, (int)xw.w, a, false);
                const int tot = dpp_isum8(a);
                if ((k & 1) == 0) keep0 = (c == (k >> 1)) ? tot : keep0; else keep1 = (c == (k >> 1)) ? tot : keep1;
            }
            const float fs = sx * (USCALE / UQ);
            *(unsigned*)(part + ((size_t)s * ntok + row) * 128 + 16 * g + 2 * c) = pack2((float)keep0 * fs, (float)keep1 * fs);
#pragma unroll
            for (int k = 0; k < 16; ++k) ek[k] = ekn[k];
            xw = xn; sx = sxn;
        }
    });
}
__device__ void ph_peer_weights(int bid, int nb, const bf16_t* __restrict__ part, float* __restrict__ sel_g, int ntok) {
    const size_t n = (size_t)ntok * 128, n4 = n / 4;
    for (size_t i = (size_t)bid * blockDim.x + tidx(); i < n4; i += (size_t)nb * blockDim.x) {
        float a[4] = {0.f, 0.f, 0.f, 0.f};
#pragma unroll
        for (int s = 0; s < 8; ++s) {
            const uint2 w = *(const uint2*)(part + (size_t)s * n + i * 4);
            a[0] += __uint_as_float(w.x << 16); a[1] += __uint_as_float(w.x & 0xffff0000u); a[2] += __uint_as_float(w.y << 16); a[3] += __uint_as_float(w.y & 0xffff0000u);
        }
        float4 gq = ((const float4*)sel_g)[i];
        float o[4] = {gq.x, gq.y, gq.z, gq.w};
#pragma unroll
        for (int j = 0; j < 4; ++j) { const float dot = a[j] * (1.0f / USCALE); o[j] *= 0.5f * dot * (1.0f + erff(dot * 0.70710678118654752f)); }
        ((float4*)sel_g)[i] = make_float4(o[0], o[1], o[2], o[3]);
    }
}
__device__ __forceinline__ void ph_peer_vsum(unsigned* heads, unsigned xcc, const unsigned char* __restrict__ V, const int* __restrict__ sel_e,
                                             const float* __restrict__ sel_w, const float* __restrict__ gate  ,
                                             bf16_t* __restrict__ h16, int ntok, unsigned* ldsw) {
    const int lane = tidx() & 63, wid = __builtin_amdgcn_readfirstlane(tidx() >> 6), c = lane & 7, g = lane >> 3;
    peer_queue_sweep(heads, ntok / 64, xcc, ldsw, [&](int s, int u) {
        const unsigned char* Vs = V + (size_t)s * NEXP * 128;
        const int rbase = u * 64 + wid * 16 + g;
        int ek[16]; float wk[16];
#pragma unroll
        for (int i = 0; i < 4; ++i) {
            const int4 e4 = *(const int4*)(sel_e + (size_t)rbase * 128 + 4 * i);
            const float4 w4 = *(const float4*)(sel_w + (size_t)rbase * 128 + 4 * i);
            ek[4 * i] = e4.x; ek[4 * i + 1] = e4.y; ek[4 * i + 2] = e4.z; ek[4 * i + 3] = e4.w;
            wk[4 * i] = w4.x; wk[4 * i + 1] = w4.y; wk[4 * i + 2] = w4.z; wk[4 * i + 3] = w4.w;
        }
        f32x2 y2[8];
#pragma unroll
        for (int i = 0; i < 8; ++i) y2[i] = (f32x2){0.f, 0.f};
#pragma unroll 1
        for (int q = 0; q < 16; ++q) {
            const int row = rbase + 8 * (q >> 3), qn = q < 15 ? q + 1 : q;
            const size_t offn = (size_t)(rbase + 8 * (qn >> 3)) * 128 + 16 * (qn & 7);
            uint4 vr[16];
#pragma unroll
            for (int k = 0; k < 16; ++k) vr[k] = *(const uint4*)(Vs + ((unsigned)ek[k] * 128u + (unsigned)c * 16u));
            int ekn[16]; float wkn[16];
#pragma unroll
            for (int i = 0; i < 4; ++i) {
                const int4 e4 = *(const int4*)(sel_e + offn + 4 * i);
                const float4 w4 = *(const float4*)(sel_w + offn + 4 * i);
                ekn[4 * i] = e4.x; ekn[4 * i + 1] = e4.y; ekn[4 * i + 2] = e4.z; ekn[4 * i + 3] = e4.w;
                wkn[4 * i] = w4.x; wkn[4 * i + 1] = w4.y; wkn[4 * i + 2] = w4.z; wkn[4 * i + 3] = w4.w;
            }
#pragma unroll
            for (int k = 0; k < 16; ++k) {
                const f32x2 w2 = (f32x2){wk[k], wk[k]};
                const unsigned vw[4] = {vr[k].x, vr[k].y, vr[k].z, vr[k].w};
#pragma unroll
                for (int j = 0; j < 4; ++j) {
                    y2[2 * j] = __builtin_amdgcn_cvt_pk_f32_fp8((int)vw[j], false) * w2 + y2[2 * j];
                    y2[2 * j + 1] = __builtin_amdgcn_cvt_pk_f32_fp8((int)vw[j], true) * w2 + y2[2 * j + 1];
                }
            }
            if ((q & 7) == 7) {
                bf16_t* hp = h16 + (size_t)row * D + s * 128 + c * 16;
                const float* gp = gate + (size_t)mod_row(row) * 6144 + s * 128 + c * 16;
                const uint4 h0 = *(const uint4*)hp, h1 = *(const uint4*)(hp + 8);
                const unsigned hw[8] = {h0.x, h0.y, h0.z, h0.w, h1.x, h1.y, h1.z, h1.w};
                unsigned ow[8];
#pragma unroll
                for (int j = 0; j < 4; ++j) {
                    const float4 g4 = *(const float4*)(gp + 4 * j);
                    ow[2 * j] = pack2(__uint_as_float(hw[2 * j] << 16) + g4.x * y2[2 * j].x, __uint_as_float(hw[2 * j] & 0xffff0000u) + g4.y * y2[2 * j].y);
                    ow[2 * j + 1] = pack2(__uint_as_float(hw[2 * j + 1] << 16) + g4.z * y2[2 * j + 1].x, __uint_as_float(hw[2 * j + 1] & 0xffff0000u) + g4.w * y2[2 * j + 1].y);
                }
                *(uint4*)hp = make_uint4(ow[0], ow[1], ow[2], ow[3]); *(uint4*)(hp + 8) = make_uint4(ow[4], ow[5], ow[6], ow[7]);
#pragma unroll
                for (int i = 0; i < 8; ++i) y2[i] = (f32x2){0.f, 0.f};
            }
#pragma unroll
            for (int k = 0; k < 16; ++k) { ek[k] = ekn[k]; wk[k] = wkn[k]; }
        }
    });
}

__device__ void ph_final(int bid, int nb, const bf16_t* __restrict__ h16, float* __restrict__ out, const float* __restrict__ g) {
    const int lane = tidx() & 63, wid = tidx() >> 6;
    const int nwv = nb * 4, per = (TL + nwv - 1) / nwv, r0 = (bid * 4 + wid) * per, r1 = (r0 + per < TL) ? r0 + per : TL;
    if (r0 >= r1) return;
    float4 gg[4];
#pragma unroll
    for (int i = 0; i < 4; ++i) gg[i] = ((const float4*)g)[i * 64 + lane];
    uint2 wn[4];
#pragma unroll
    for (int i = 0; i < 4; ++i) wn[i] = ((const uint2*)(h16 + (size_t)r0 * D))[i * 64 + lane];
    for (int row = r0; row < r1; ++row) {
        uint2 w[4];
#pragma unroll
        for (int i = 0; i < 4; ++i) w[i] = wn[i];
        const int rn = row + 1 < r1 ? row + 1 : row;
#pragma unroll
        for (int i = 0; i < 4; ++i) wn[i] = ((const uint2*)(h16 + (size_t)rn * D))[i * 64 + lane];
        float4 x[4]; float ss = 0.f;
#pragma unroll
        for (int i = 0; i < 4; ++i) {
            x[i].x = __uint_as_float(w[i].x << 16); x[i].y = __uint_as_float(w[i].x & 0xffff0000u); x[i].z = __uint_as_float(w[i].y << 16); x[i].w = __uint_as_float(w[i].y & 0xffff0000u);
            ss += x[i].x * x[i].x + x[i].y * x[i].y + x[i].z * x[i].z + x[i].w * x[i].w;
        }
        ss = wave_sum(ss);
        const float rinv = rsqrtf(ss * (1.0f / D) + EPS);
        float4* o4 = (float4*)(out + (size_t)row * D);
#pragma unroll
        for (int i = 0; i < 4; ++i) {
            float4 o; o.x = x[i].x * rinv * gg[i].x; o.y = x[i].y * rinv * gg[i].y; o.z = x[i].z * rinv * gg[i].z; o.w = x[i].w * rinv * gg[i].w;
            o4[i * 64 + lane] = o;
        }
    }
}

struct Params {
    const float *x, *c, *ctx, *c_ctx, *ada_w, *ada_b, *norm_mix_g, *norm_ffn_g, *ab_w_in, *ab_w_out, *hg_lb, *hg_norm_g, *sw_sink,
        *ga_w_in, *ga_w_out, *ga_qn, *ga_kn, *peer_wq, *peer_sk, *peer_u, *peer_v, *final_g;
    float* out; char* ws;
};

typedef __attribute__((address_space(1))) char gchar_t;
__device__ __forceinline__ gchar_t* ws_base(char* w) { gchar_t* g = (gchar_t*)w; asm volatile("" : "+s"(g)); return g; }
#define WSP(T, off) ((T*)(ws_base(p.ws) + (off)))

constexpr int XB_XCNT = 0, XB_XSUB = 1024, XB_XGEN = 2048, XB_TOP = 3072, XB_TOPGEN = 3136;
#define gb_state (*(uint4*)(dyn_lds + 65536 + 4096))
__device__ __forceinline__ unsigned xb_ld(unsigned* p) { return __hip_atomic_load(p, __ATOMIC_RELAXED, __HIP_MEMORY_SCOPE_AGENT); }
__device__ __forceinline__ unsigned xb_add(unsigned* p) { return __hip_atomic_fetch_add(p, 1u, __ATOMIC_RELAXED, __HIP_MEMORY_SCOPE_AGENT); }
__device__ __forceinline__ unsigned xcc_id() { return (unsigned)__builtin_amdgcn_s_getreg((3 << 11) | 20) & 0xFu; }
__device__ __forceinline__ void grid_bar_post(unsigned* bar) {
    if (threadIdx.x == 0) { gb_state = make_uint4(0u, 0u, 0u, 0u); (void)xb_add(&bar[XB_XCNT + 64 * xcc_id()]); }
}
__device__ __forceinline__ void grid_bar(unsigned* bar) {
    asm volatile("s_waitcnt vmcnt(0)" ::: "memory");
    __syncthreads();
    if (threadIdx.x == 0) {
        const unsigned x = xcc_id();
        unsigned nloc = gb_state.x, nx = gb_state.y;
        if (nloc == 0u) {
            for (;;) {
                unsigned sum = 0u, cnt = 0u, mine = 0u;
#pragma unroll
                for (unsigned j = 0; j < 16; ++j) { const unsigned c = xb_ld(&bar[XB_XCNT + 64 * j]); sum += c; cnt += c > 0u ? 1u : 0u; mine = (j == x) ? c : mine; }
                if (sum == gridDim.x) { nloc = mine; nx = cnt; break; }
                __builtin_amdgcn_s_sleep(1);
            }
            gb_state.x = nloc; gb_state.y = nx;
        }
        const unsigned old = xb_add(&bar[XB_XSUB + 64 * x]);
        const unsigned gen = old / nloc;
        if (old + 1u == (gen + 1u) * nloc) {
            __builtin_amdgcn_fence(__ATOMIC_RELEASE, "agent");
            asm volatile("s_waitcnt vmcnt(0)" ::: "memory");
            const unsigned og = xb_add(&bar[XB_TOP]);
            const unsigned tg = og / nx;
            if (og + 1u == (tg + 1u) * nx) (void)xb_add(&bar[XB_TOPGEN]);
            else while (xb_ld(&bar[XB_TOPGEN]) == tg) __builtin_amdgcn_s_sleep(1);
            __builtin_amdgcn_fence(__ATOMIC_ACQUIRE, "agent");
            (void)xb_add(&bar[XB_XGEN + 64 * x]);
            asm volatile("s_waitcnt vmcnt(0)" ::: "memory");
        } else {
            while (xb_ld(&bar[XB_XGEN + 64 * x]) == gen) __builtin_amdgcn_s_sleep(1);
            __builtin_amdgcn_fence(__ATOMIC_ACQUIRE, "agent");
            asm volatile("s_waitcnt vmcnt(0)" ::: "memory");
        }
    }
    __syncthreads();
}

__device__ __forceinline__ void sub_bar(unsigned* ctr, unsigned& epoch, unsigned nblk) {
    asm volatile("s_waitcnt vmcnt(0)" ::: "memory");
    __syncthreads();
    epoch += nblk;
    if (threadIdx.x == 0) {
        __builtin_amdgcn_fence(__ATOMIC_RELEASE, "agent");
        asm volatile("s_waitcnt vmcnt(0)" ::: "memory");
        (void)xb_add(ctr);
        while (xb_ld(ctr) < epoch) __builtin_amdgcn_s_sleep(1);
        __builtin_amdgcn_fence(__ATOMIC_ACQUIRE, "agent");
        asm volatile("s_waitcnt vmcnt(0)" ::: "memory");
    }
    __syncthreads();
}

namespace cg = cooperative_groups;
constexpr int MEGA_LDS = 65536 + 4096 + 256;
__global__ void __launch_bounds__(256, 2) k_mega(Params p) {
    cg::grid_group grid = cg::this_grid();
    const int bid = blockIdx.x, nb = gridDim.x;
    char* lds = dyn_lds;
    float* ldf = (float*)dyn_lds;
    grid_bar_post(WSP(unsigned, OFF_BAR));
    ph_mod(bid, nb, p.c, p.c_ctx, p.ada_w, p.ada_b, WSP(float, OFF_MOD), ldf);
    ph_tables(bid, nb, WSP(float, OFF_COSS), WSP(float, OFF_SINS), WSP(float, OFF_COSG), WSP(float, OFF_SING), p.hg_lb, WSP(float, OFF_LB));
    if (p.ws == nullptr) grid.sync();
    grid_bar(WSP(unsigned, OFF_BAR));
    ph_normmod(bid, nb, p.x, p.ctx, p.norm_mix_g, WSP(float, OFF_MOD), 1 * D, 0, WSP(bf16_t, OFF_A), TA);
    ph_transpose(bid, nb, p.ab_w_in, WSP(bf16_t, OFF_WABIN), D, AB_IN, ldf);
    ph_transpose(bid, nb, p.ab_w_out, WSP(bf16_t, OFF_WABOUT), D, D, ldf);
    ph_transpose(bid, nb, p.peer_wq, WSP(bf16_t, OFF_WPQ), D, PQ, ldf);
    ph_cvt(bid, nb, p.peer_sk, WSP(bf16_t, OFF_SK), (size_t)2 * 8 * 2 * 128 * 128);
    grid_bar(WSP(unsigned, OFF_BAR));
    { EpiStoreSplit<0> e{WSP(bf16_t, OFF_PROJH), HGW, WSP(bf16_t, OFF_PROJS), SWW, HGW};
      ph_gemm(bid, nb, WSP(bf16_t, OFF_A), TA, WSP(bf16_t, OFF_WABIN), AB_IN, TA, HGW, D, lds, e); }
    grid_bar(WSP(unsigned, OFF_BAR));
    {
        const int hgb = nb >= 256 ? 128 : nb / 2;
        if (bid < hgb) ph_hgrn(bid, hgb, WSP(bf16_t, OFF_PROJH), WSP(float, OFF_LB), WSP(bf16_t, OFF_OF), WSP(bf16_t, OFF_OB), lds);
        else {
            const int sb = bid - hgb, sn = nb - hgb;
            unsigned* sctr = WSP(unsigned, OFF_BAR) + 3328; unsigned sep = 0;
            { EpiStoreSplit<1> e{WSP(bf16_t, OFF_PROJH), HGW, WSP(bf16_t, OFF_PROJS), SWW, HGW};
              ph_gemm(sb, sn, WSP(bf16_t, OFF_A), TA, WSP(bf16_t, OFF_WABIN), AB_IN, TA, SWW, D, lds, e, HGW); }
            sub_bar(sctr, sep, (unsigned)sn);
            ph_prep_swa(sb, sn, WSP(bf16_t, OFF_PROJS), WSP(float, OFF_COSS), WSP(float, OFF_SINS));
            ph_vt<64>(sb, sn, WSP(bf16_t, OFF_PROJS), SWW, 640, WSP(bf16_t, OFF_VT64), (bf16_t*)lds);
            sub_bar(sctr, sep, (unsigned)sn);
            ph_swa(sb, sn, WSP(bf16_t, OFF_PROJS), WSP(bf16_t, OFF_VT64), p.sw_sink, WSP(bf16_t, OFF_MIX), lds);
            ph_cvt8i(sb, sn, p.peer_u, WSP(unsigned char, OFF_U16), (size_t)2 * NEXP * D, UQ);
            ph_cvt8(sb, sn, p.peer_v, WSP(unsigned char, OFF_V16), (size_t)2 * NEXP * D, 1.0f);
            ph_transpose(sb, sn, p.ga_w_in, WSP(bf16_t, OFF_WGAIN), D, GA_IN, ldf);
            ph_transpose(sb, sn, p.ga_w_out, WSP(bf16_t, OFF_WGAOUT), D, D, ldf);
            ph_transpose(sb, sn, p.peer_wq + (size_t)D * PQ, WSP(bf16_t, OFF_WPQ) + (size_t)PQ * D, D, PQ, ldf);
        }
    }
    grid_bar(WSP(unsigned, OFF_BAR));
    ph_hgpost(bid, nb, WSP(bf16_t, OFF_OF), WSP(bf16_t, OFF_OB), WSP(bf16_t, OFF_PROJH), p.hg_norm_g, WSP(bf16_t, OFF_MIX));
    grid_bar(WSP(unsigned, OFF_BAR));
    { EpiResid<0> e{p.x, p.ctx, nullptr, WSP(bf16_t, OFF_H16), WSP(float, OFF_MOD) + 2 * D};
      ph_gemm(bid, nb, WSP(bf16_t, OFF_MIX), D, WSP(bf16_t, OFF_WABOUT), D, TA, D, D, lds, e); }
    grid_bar(WSP(unsigned, OFF_BAR));
    ph_normmod16(bid, nb, WSP(bf16_t, OFF_H16), p.norm_ffn_g, WSP(float, OFF_MOD), 4 * D, 3 * D, WSP(bf16_t, OFF_A), TA, WSP(unsigned char, OFF_XQ), WSP(float, OFF_XS));
    grid_bar(WSP(unsigned, OFF_BAR));
    { EpiStoreSplit<2> e{WSP(bf16_t, OFF_QPEER), PQ, WSP(bf16_t, OFF_QPEER), PQ, 1 << 30};
      ph_gemm(bid, nb, WSP(bf16_t, OFF_A), TA, WSP(bf16_t, OFF_WPQ), PQ, TA, PQ, D, lds, e); }
    grid_bar(WSP(unsigned, OFF_BAR));
    ph_peer_route(bid, nb, WSP(bf16_t, OFF_QPEER), WSP(bf16_t, OFF_SK), WSP(int, OFF_SELE), WSP(float, OFF_SELG), TA, lds);
    grid_bar(WSP(unsigned, OFF_BAR));
    ph_peer_dots((WSP(unsigned, OFF_BAR) + 4096) + 64 * 0, xcc_id(), WSP(unsigned char, OFF_XQ), WSP(float, OFF_XS), WSP(unsigned char, OFF_U16), WSP(int, OFF_SELE), WSP(bf16_t, OFF_PART), TA, (unsigned*)lds);
    grid_bar(WSP(unsigned, OFF_BAR));
    ph_peer_weights(bid, nb, WSP(bf16_t, OFF_PART), WSP(float, OFF_SELG), TA);
    grid_bar(WSP(unsigned, OFF_BAR));
    ph_peer_vsum((WSP(unsigned, OFF_BAR) + 4096) + 64 * 8, xcc_id(), WSP(unsigned char, OFF_V16), WSP(int, OFF_SELE), WSP(float, OFF_SELG), WSP(float, OFF_MOD) + 5 * D, WSP(bf16_t, OFF_H16), TA, (unsigned*)lds);
    grid_bar(WSP(unsigned, OFF_BAR));
    ph_normmod16(bid, nb, WSP(bf16_t, OFF_H16), p.norm_mix_g + D, (WSP(float, OFF_MOD) + (size_t)9 * 6144), 1 * D, 0, WSP(bf16_t, OFF_A), TA);
    grid_bar(WSP(unsigned, OFF_BAR));
    { EpiGA e{WSP(bf16_t, OFF_PROJ), WSP(bf16_t, OFF_VT), p.ga_qn, p.ga_kn, WSP(float, OFF_COSG), WSP(float, OFF_SING)};
      ph_gemm(bid, nb, WSP(bf16_t, OFF_A), TA, WSP(bf16_t, OFF_WGAIN), GA_IN, TA, GA_IN, D, lds, e); }
    grid_bar(WSP(unsigned, OFF_BAR));
    ph_dense(bid, nb, WSP(bf16_t, OFF_PROJ), WSP(bf16_t, OFF_VT), WSP(bf16_t, OFF_MIX), lds);
    grid_bar(WSP(unsigned, OFF_BAR));
    { EpiResid<1> e{nullptr, nullptr, WSP(bf16_t, OFF_H16), WSP(bf16_t, OFF_H16), (WSP(float, OFF_MOD) + (size_t)9 * 6144) + 2 * D};
      ph_gemm(bid, nb, WSP(bf16_t, OFF_MIX), D, WSP(bf16_t, OFF_WGAOUT), D, TL, D, D, lds, e); }
    grid_bar(WSP(unsigned, OFF_BAR));
    ph_normmod16(bid, nb, WSP(bf16_t, OFF_H16), p.norm_ffn_g + D, (WSP(float, OFF_MOD) + (size_t)9 * 6144), 4 * D, 3 * D, WSP(bf16_t, OFF_A), TL, WSP(unsigned char, OFF_XQ), WSP(float, OFF_XS));
    grid_bar(WSP(unsigned, OFF_BAR));
    { EpiStoreSplit<3> e{WSP(bf16_t, OFF_QPEER), PQ, WSP(bf16_t, OFF_QPEER), PQ, 1 << 30};
      ph_gemm(bid, nb, WSP(bf16_t, OFF_A), TA, WSP(bf16_t, OFF_WPQ) + (size_t)PQ * D, PQ, TL, PQ, D, lds, e); }
    grid_bar(WSP(unsigned, OFF_BAR));
    ph_peer_route(bid, nb, WSP(bf16_t, OFF_QPEER), WSP(bf16_t, OFF_SK) + (size_t)16 * 128 * 128, WSP(int, OFF_SELE), WSP(float, OFF_SELG), TL, lds);
    grid_bar(WSP(unsigned, OFF_BAR));
    ph_peer_dots((WSP(unsigned, OFF_BAR) + 4096) + 64 * 16, xcc_id(), WSP(unsigned char, OFF_XQ), WSP(float, OFF_XS), WSP(unsigned char, OFF_U16) + (size_t)NEXP * D, WSP(int, OFF_SELE), WSP(bf16_t, OFF_PART), TL, (unsigned*)lds);
    grid_bar(WSP(unsigned, OFF_BAR));
    ph_peer_weights(bid, nb, WSP(bf16_t, OFF_PART), WSP(float, OFF_SELG), TL);
    grid_bar(WSP(unsigned, OFF_BAR));
    ph_peer_vsum((WSP(unsigned, OFF_BAR) + 4096) + 64 * 24, xcc_id(), WSP(unsigned char, OFF_V16) + (size_t)NEXP * D, WSP(int, OFF_SELE), WSP(float, OFF_SELG), (WSP(float, OFF_MOD) + (size_t)9 * 6144) + 5 * D, WSP(bf16_t, OFF_H16), TL, (unsigned*)lds);
    grid_bar(WSP(unsigned, OFF_BAR));
    ph_final(bid, nb, WSP(bf16_t, OFF_H16), p.out, p.final_g);
}

extern "C" void kernel_launch(void* const* d_in, const int* in_sizes, int n_in, void* d_out, int out_size, void* d_ws, size_t ws_size,
                              hipStream_t stream) {
    Params p{};
    p.x = (const float*)d_in[0]; p.c = (const float*)d_in[1]; p.ctx = (const float*)d_in[2]; p.c_ctx = (const float*)d_in[3];
    p.ada_w = (const float*)d_in[4]; p.ada_b = (const float*)d_in[5]; p.norm_mix_g = (const float*)d_in[6]; p.norm_ffn_g = (const float*)d_in[7];
    p.ab_w_in = (const float*)d_in[8]; p.ab_w_out = (const float*)d_in[9]; p.hg_lb = (const float*)d_in[10]; p.hg_norm_g = (const float*)d_in[11];
    p.sw_sink = (const float*)d_in[12]; p.ga_w_in = (const float*)d_in[13]; p.ga_w_out = (const float*)d_in[14]; p.ga_qn = (const float*)d_in[15];
    p.ga_kn = (const float*)d_in[16]; p.peer_wq = (const float*)d_in[17]; p.peer_sk = (const float*)d_in[18]; p.peer_u = (const float*)d_in[19];
    p.peer_v = (const float*)d_in[20]; p.final_g = (const float*)d_in[21];
    p.out = (float*)d_out; p.ws = (char*)d_ws;
    if (ws_size < WS_NEED) { fprintf(stderr, "workspace too small: %zu < %zu\n", ws_size, WS_NEED); return; }
    static int grid_blocks = 0;
    if (!grid_blocks) {
        int dev = 0, cus = 0, per_cu = 0;
        (void)hipGetDevice(&dev);
        (void)hipDeviceGetAttribute(&cus, hipDeviceAttributeMultiprocessorCount, dev);
        (void)hipFuncSetAttribute((const void*)k_mega, hipFuncAttributeMaxDynamicSharedMemorySize, MEGA_LDS);
        (void)hipOccupancyMaxActiveBlocksPerMultiprocessor(&per_cu, k_mega, 256, MEGA_LDS);
        if (per_cu > 2) per_cu = 2;
        if (per_cu < 1) per_cu = 1;
        grid_blocks = cus * per_cu;
    }
    (void)hipMemsetAsync((char*)d_ws + OFF_BAR, 0, BAR_BYTES, stream);
    void* args[] = {&p};
    hipError_t e = hipLaunchCooperativeKernel((const void*)k_mega, dim3(grid_blocks), dim3(256), args, MEGA_LDS, stream);
    if (e != hipSuccess) fprintf(stderr, "cooperative launch failed: %s (grid %d)\n", hipGetErrorString(e), grid_blocks);
}
```

```cpp
#include <hip/hip_runtime.h>
#include <hip/hip_cooperative_groups.h>
#include <stdint.h>
#include <stdio.h>

typedef unsigned short bf16_t;
typedef short bf16x8 __attribute__((ext_vector_type(8)));
typedef float f32x4 __attribute__((ext_vector_type(4)));

constexpr int D = 1024, NB = 8, SEQ = 4096, LC = 256;
constexpr int TL = NB * SEQ;
constexpr int TC = NB * LC;
constexpr int TA = TL + TC;
constexpr int AB_IN = 3328, HGW = 2560, SWW = 768, GA_IN = 1536, PQ = 2048;
constexpr int NEXP = 16384;
constexpr float EPS = 1e-6f;
constexpr float LOG2E = 1.4426950408889634f;
constexpr int NKEY = LC + SEQ;

constexpr size_t OFF_WABIN = 0;
constexpr size_t OFF_WABOUT = OFF_WABIN + (size_t)AB_IN * D * 2;
constexpr size_t OFF_WGAIN = OFF_WABOUT + (size_t)D * D * 2;
constexpr size_t OFF_WGAOUT = OFF_WGAIN + (size_t)GA_IN * D * 2;
constexpr size_t OFF_WPQ = OFF_WGAOUT + (size_t)D * D * 2;
constexpr size_t OFF_SK = OFF_WPQ + (size_t)2 * PQ * D * 2;
constexpr size_t OFF_MOD = OFF_SK + (size_t)2 * 8 * 2 * 128 * 128 * 2;
constexpr size_t OFF_COSS = OFF_MOD + (size_t)2 * 9 * 6144 * 4;
constexpr size_t OFF_SINS = OFF_COSS + (size_t)SEQ * 32 * 4;
constexpr size_t OFF_COSG = OFF_SINS + (size_t)SEQ * 32 * 4;
constexpr size_t OFF_SING = OFF_COSG + (size_t)SEQ * 64 * 4;
constexpr size_t OFF_LB = OFF_SING + (size_t)SEQ * 64 * 4;
constexpr size_t OFF_U16 = OFF_LB + 2048;
constexpr size_t OFF_V16 = OFF_U16 + (size_t)NEXP * D * 2;
constexpr size_t OFF_HCTX = OFF_V16 + (size_t)NEXP * D * 2;
constexpr size_t OFF_A = OFF_HCTX + (size_t)TC * D * 4;
constexpr size_t OFF_PROJ = OFF_A + (size_t)TA * D * 2;
constexpr size_t OFF_MIX = OFF_PROJ + (size_t)TA * AB_IN * 2;
constexpr size_t OFF_SEL = OFF_MIX + (size_t)TA * D * 2;
constexpr size_t OFF_BAR = OFF_SEL + (size_t)TA * 128 * 8;
constexpr size_t BAR_BYTES = 32768;
constexpr size_t OFF_VT64 = OFF_BAR + BAR_BYTES;
constexpr size_t WS_NEED = OFF_VT64 + (size_t)NB * 2 * 64 * NKEY * 2;
static_assert(WS_NEED <= (size_t)536870912, "workspace over 512 MiB");
constexpr size_t OFF_OF = OFF_MIX;
constexpr size_t OFF_OB = OFF_SEL;
constexpr size_t OFF_PROJH = OFF_PROJ;
constexpr size_t OFF_PROJS = OFF_PROJ + (size_t)TA * HGW * 2;
constexpr size_t OFF_QPEER = OFF_PROJ;
constexpr size_t OFF_TSC = OFF_QPEER + (size_t)TA * PQ * 2;
constexpr size_t OFF_TIX = OFF_TSC + (size_t)TA * 256 * 4;
static_assert(OFF_TIX + (size_t)TA * 256 * 4 <= OFF_MIX, "peer scratch overflows proj region");
constexpr size_t OFF_VT = OFF_SEL;
static_assert((size_t)NB * 2 * 128 * NKEY * 2 <= (size_t)TA * 128 * 8, "Vt overflows SEL region");
constexpr size_t OFF_PART = OFF_PROJ;
constexpr size_t OFF_X8 = OFF_PROJ + (size_t)TA * PQ * 2;
static_assert((size_t)8 * TA * 128 * 4 <= (size_t)TA * PQ * 2 && OFF_X8 + (size_t)2 * TA * D <= OFF_MIX, "PEER scratch overflows proj region");
constexpr size_t OFF_H16 = OFF_PROJ + (size_t)TA * PQ * 2;
constexpr size_t OFF_XQ = OFF_MIX;
constexpr size_t OFF_XS = OFF_MIX + (size_t)TA * D;
constexpr size_t OFF_SELE = OFF_SEL;
constexpr size_t OFF_SELW = OFF_SEL + (size_t)TA * 128 * 2;
constexpr size_t OFF_SELG = OFF_SEL + (size_t)TA * 128 * 4;

extern __shared__ __attribute__((aligned(16))) char dyn_lds[];
__device__ __forceinline__ float bf2f(bf16_t v) { return __uint_as_float(((unsigned)v) << 16); }
__device__ __forceinline__ bf16_t f2bf(float f) {
    unsigned u = __float_as_uint(f);
    u += 0x7fffu + ((u >> 16) & 1u);
    return (bf16_t)(u >> 16);
}
typedef float f32x2 __attribute__((ext_vector_type(2)));
typedef float f32x16 __attribute__((ext_vector_type(16)));
typedef __bf16 bf16x2_t __attribute__((ext_vector_type(2)));
__device__ __forceinline__ unsigned pack2(float lo, float hi) { f32x2 v = {lo, hi}; return __builtin_bit_cast(unsigned, __builtin_convertvector(v, bf16x2_t)); }
__device__ __forceinline__ float sigmoidf_(float x) { return 1.0f / (1.0f + __expf(-x)); }
__device__ __forceinline__ float siluf_(float x) { return x * sigmoidf_(x); }
__device__ __forceinline__ float wave_sum(float v) {
#pragma unroll
    for (int o = 32; o >= 1; o >>= 1) v += __shfl_xor(v, o);
    return v;
}
__device__ __forceinline__ int mod_row(int row) { return row < TL ? (row >> 12) : 8; }
__device__ __forceinline__ int tidx() { int t = threadIdx.x; asm volatile("" : "+v"(t)); return t; }

__device__ void ph_transpose(int bid, int nb, const float* __restrict__ in, bf16_t* __restrict__ out, int K, int N, float* lds) {
    const int tk = K / 32, tn = N / 32, nt = tk * tn;
    const int tx = threadIdx.x & 31, ty = threadIdx.x >> 5;
    for (int t = bid; t < nt; t += nb) {
        const int k0 = (t / tn) * 32, n0 = (t % tn) * 32;
        __syncthreads();
#pragma unroll
        for (int i = 0; i < 4; ++i) lds[(ty + i * 8) * 33 + tx] = in[(size_t)(k0 + ty + i * 8) * N + n0 + tx];
        __syncthreads();
        {
            const int n = tidx() >> 3, kq = (tidx() & 7) * 4;
            uint2 w; w.x = pack2(lds[(kq + 0) * 33 + n], lds[(kq + 1) * 33 + n]); w.y = pack2(lds[(kq + 2) * 33 + n], lds[(kq + 3) * 33 + n]);
            *(uint2*)(out + ((size_t)(k0 >> 5) * N + n0 + n) * 32 + kq) = w;
        }
    }
}
__device__ void ph_cvt(int bid, int nb, const float* __restrict__ in, bf16_t* __restrict__ out, size_t n) {
    const size_t n8 = n / 8;
    for (size_t i = (size_t)bid * blockDim.x + threadIdx.x; i < n8; i += (size_t)nb * blockDim.x) {
        const float4 a = ((const float4*)in)[i * 2], b = ((const float4*)in)[i * 2 + 1];
        uint4 w; w.x = pack2(a.x, a.y); w.y = pack2(a.z, a.w); w.z = pack2(b.x, b.y); w.w = pack2(b.z, b.w);
        ((uint4*)out)[i] = w;
    }
}
__device__ void ph_cvt8(int bid, int nb, const float* __restrict__ in, unsigned char* __restrict__ out, size_t n, float scale) {
    const size_t n16 = n / 16;
    for (size_t i = (size_t)bid * blockDim.x + threadIdx.x; i < n16; i += (size_t)nb * blockDim.x) {
        const float4 a = ((const float4*)in)[i * 4], b = ((const float4*)in)[i * 4 + 1], c = ((const float4*)in)[i * 4 + 2], d = ((const float4*)in)[i * 4 + 3];
        int w0 = __builtin_amdgcn_cvt_pk_fp8_f32(a.x * scale, a.y * scale, 0, false); w0 = __builtin_amdgcn_cvt_pk_fp8_f32(a.z * scale, a.w * scale, w0, true);
        int w1 = __builtin_amdgcn_cvt_pk_fp8_f32(b.x * scale, b.y * scale, 0, false); w1 = __builtin_amdgcn_cvt_pk_fp8_f32(b.z * scale, b.w * scale, w1, true);
        int w2 = __builtin_amdgcn_cvt_pk_fp8_f32(c.x * scale, c.y * scale, 0, false); w2 = __builtin_amdgcn_cvt_pk_fp8_f32(c.z * scale, c.w * scale, w2, true);
        int w3 = __builtin_amdgcn_cvt_pk_fp8_f32(d.x * scale, d.y * scale, 0, false); w3 = __builtin_amdgcn_cvt_pk_fp8_f32(d.z * scale, d.w * scale, w3, true);
        const size_t el = i * 16, rowg = el >> 10;
        const size_t layer = rowg / NEXP, e = rowg % NEXP; const int col = (int)(el & 1023), sl = col >> 7, cs = col & 127;
        *(int4*)(out + layer * ((size_t)NEXP * D) + ((size_t)sl * NEXP + e) * 128 + cs) = make_int4(w0, w1, w2, w3);
    }
}
constexpr float UQ = 512.0f;
__device__ __forceinline__ int q8(float v, float sc) { return (int)rintf(fminf(fmaxf(v * sc, -127.f), 127.f)) & 0xff; }
__device__ void ph_cvt8i(int bid, int nb, const float* __restrict__ in, unsigned char* __restrict__ out, size_t n, float scale) {
    const size_t n16 = n / 16;
    for (size_t i = (size_t)bid * blockDim.x + tidx(); i < n16; i += (size_t)nb * blockDim.x) {
        const float4 a = ((const float4*)in)[i * 4], b = ((const float4*)in)[i * 4 + 1], c = ((const float4*)in)[i * 4 + 2], d = ((const float4*)in)[i * 4 + 3];
        const int w0 = q8(a.x, scale) | (q8(a.y, scale) << 8) | (q8(a.z, scale) << 16) | (q8(a.w, scale) << 24);
        const int w1 = q8(b.x, scale) | (q8(b.y, scale) << 8) | (q8(b.z, scale) << 16) | (q8(b.w, scale) << 24);
        const int w2 = q8(c.x, scale) | (q8(c.y, scale) << 8) | (q8(c.z, scale) << 16) | (q8(c.w, scale) << 24);
        const int w3 = q8(d.x, scale) | (q8(d.y, scale) << 8) | (q8(d.z, scale) << 16) | (q8(d.w, scale) << 24);
        const size_t el = i * 16, rowg = el >> 10;
        const size_t layer = rowg / NEXP, e = rowg % NEXP; const int col = (int)(el & 1023), sl = col >> 7, cs = col & 127;
        *(int4*)(out + layer * ((size_t)NEXP * D) + ((size_t)sl * NEXP + e) * 128 + cs) = make_int4(w0, w1, w2, w3);
    }
}
__device__ void ph_mod(int bid, int nb, const float* __restrict__ c, const float* __restrict__ c_ctx, const float* __restrict__ ada_w,
                       const float* __restrict__ ada_b, float* __restrict__ mod, float* lds) {
    float* s = lds;
    float* red = lds + 9 * 1024;
    const int tx = threadIdx.x & 63, ky = threadIdx.x >> 6;
    for (int i = threadIdx.x; i < 9 * 1024; i += 256) {
        const int r = i >> 10, k = i & 1023;
        const float v = r < 8 ? c[r * 1024 + k] : c_ctx[k];
        s[i] = siluf_(v);
    }
    __syncthreads();
    const int nitems = 2 * 192, cx = tx & 31, kh = tx >> 5;
    for (int it = bid; it < nitems; it += nb) {
        const int layer = it / 192, n = (it % 192) * 32 + cx;
        const float* w = ada_w + (size_t)layer * 1024 * 6144 + n;
        float acc[9];
#pragma unroll
        for (int r = 0; r < 9; ++r) acc[r] = 0.f;
        const int kb = ky * 256 + kh * 128;
#pragma unroll 16
        for (int k = kb; k < kb + 128; ++k) {
            const float wv = w[(size_t)k * 6144];
#pragma unroll
            for (int r = 0; r < 9; ++r) acc[r] += s[r * 1024 + k] * wv;
        }
        __syncthreads();
#pragma unroll
        for (int r = 0; r < 9; ++r) red[(ky * 9 + r) * 64 + tx] = acc[r];
        __syncthreads();
        if (ky == 0 && kh == 0) {
#pragma unroll
            for (int r = 0; r < 9; ++r) {
                float v = 0.f;
#pragma unroll
                for (int q = 0; q < 4; ++q) v += red[(q * 9 + r) * 64 + cx] + red[(q * 9 + r) * 64 + 32 + cx];
                mod[((size_t)layer * 9 + r) * 6144 + n] = v + ada_b[layer * 6144 + n];
            }
        }
    }
}
__device__ void ph_tables(int bid, int nb, float* cosS, float* sinS, float* cosG, float* sinG, const float* __restrict__ lb_logits, float* lb) {
    const int gt = bid * blockDim.x + threadIdx.x, gs = nb * blockDim.x;
    for (int i = gt; i < SEQ * 32; i += gs) {
        const int t = i >> 5, j = i & 31;
        const float pos = (float)(j < 16 ? (t >> 6) : (t & 63));
        const float inv = powf(10000.0f, -(float)(j & 15) / 16.0f);
        const float ang = pos * inv;
        cosS[i] = cosf(ang); sinS[i] = sinf(ang);
    }
    for (int i = gt; i < SEQ * 64; i += gs) {
        const int t = i >> 6, j = i & 63;
        const float pos = (float)(j < 32 ? (t >> 6) : (t & 63));
        const float inv = powf(10000.0f, -(float)(j & 31) / 32.0f);
        const float ang = pos * inv;
        cosG[i] = cosf(ang); sinG[i] = sinf(ang);
    }
    for (int i = gt; i < 512; i += gs) {
        const float l0 = lb_logits[i], l1 = lb_logits[512 + i];
        lb[i] = 1.0f / (1.0f + expf(l1 - l0));
    }
}

__device__ void ph_normmod(int bid, int nb, const float* __restrict__ hlat, const float* __restrict__ hctx, const float* __restrict__ gamma,
                           const float* __restrict__ modl  , int sc_off, int sh_off, bf16_t* __restrict__ out, int nrows) {
    const int lane = tidx() & 63, wid = tidx() >> 6;
    const int nwv = nb * 4, per = (nrows + nwv - 1) / nwv, r0 = (bid * 4 + wid) * per, r1 = (r0 + per < nrows) ? r0 + per : nrows;
    if (r0 >= r1) return;
    float4 ca[4], cb[4];
    int curm = -1;
    float4 xn[4];
    {
        const float* s0 = r0 < TL ? hlat + (size_t)r0 * D : hctx + (size_t)(r0 - TL) * D;
#pragma unroll
        for (int i = 0; i < 4; ++i) xn[i] = ((const float4*)s0)[i * 64 + lane];
    }
    for (int row = r0; row < r1; ++row) {
        float4 x[4];
#pragma unroll
        for (int i = 0; i < 4; ++i) x[i] = xn[i];
        const int rn = row + 1 < r1 ? row + 1 : row;
        const float* sn = rn < TL ? hlat + (size_t)rn * D : hctx + (size_t)(rn - TL) * D;
#pragma unroll
        for (int i = 0; i < 4; ++i) xn[i] = ((const float4*)sn)[i * 64 + lane];
        const int mr = mod_row(row);
        if (mr != curm) {
            curm = mr;
            const float* m = modl + (size_t)mr * 6144;
#pragma unroll
            for (int i = 0; i < 4; ++i) {
                const int col = (i * 64 + lane) * 4;
                const float4 g = *(const float4*)(gamma + col), sc = *(const float4*)(m + sc_off + col);
                ca[i] = make_float4(g.x * (1.f + sc.x), g.y * (1.f + sc.y), g.z * (1.f + sc.z), g.w * (1.f + sc.w));
                cb[i] = *(const float4*)(m + sh_off + col);
            }
        }
        float ss = 0.f;
#pragma unroll
        for (int i = 0; i < 4; ++i) ss += x[i].x * x[i].x + x[i].y * x[i].y + x[i].z * x[i].z + x[i].w * x[i].w;
        ss = wave_sum(ss);
        const float rinv = rsqrtf(ss * (1.0f / D) + EPS);
#pragma unroll
        for (int i = 0; i < 4; ++i) {
            const int col = (i * 64 + lane) * 4;
            uint2 w; w.x = pack2(x[i].x * rinv * ca[i].x + cb[i].x, x[i].y * rinv * ca[i].y + cb[i].y);
            w.y = pack2(x[i].z * rinv * ca[i].z + cb[i].z, x[i].w * rinv * ca[i].w + cb[i].w);
            *(uint2*)(out + ((size_t)(col >> 5) * TA + row) * 32 + (col & 31)) = w;
        }
    }
}

__device__ void ph_normmod16(int bid, int nb, const bf16_t* __restrict__ h16, const float* __restrict__ gamma,
                             const float* __restrict__ modl  , int sc_off, int sh_off, bf16_t* __restrict__ out, int nrows,
                             unsigned char* __restrict__ xq = nullptr, float* __restrict__ xs = nullptr) {
    const int lane = tidx() & 63, wid = tidx() >> 6;
    const int nwv = nb * 4, per = (nrows + nwv - 1) / nwv, r0 = (bid * 4 + wid) * per, r1 = (r0 + per < nrows) ? r0 + per : nrows;
    if (r0 >= r1) return;
    float4 ca[4], cb[4];
    int curm = -1;
    uint2 wn[4];
#pragma unroll
    for (int i = 0; i < 4; ++i) wn[i] = ((const uint2*)(h16 + (size_t)r0 * D))[i * 64 + lane];
    for (int row = r0; row < r1; ++row) {
        uint2 w[4];
#pragma unroll
        for (int i = 0; i < 4; ++i) w[i] = wn[i];
        const int rn = row + 1 < r1 ? row + 1 : row;
#pragma unroll
        for (int i = 0; i < 4; ++i) wn[i] = ((const uint2*)(h16 + (size_t)rn * D))[i * 64 + lane];
        const int mr = mod_row(row);
        if (mr != curm) {
            curm = mr;
            const float* m = modl + (size_t)mr * 6144;
#pragma unroll
            for (int i = 0; i < 4; ++i) {
                const int col = (i * 64 + lane) * 4;
                const float4 g = *(const float4*)(gamma + col), sc = *(const float4*)(m + sc_off + col);
                ca[i] = make_float4(g.x * (1.f + sc.x), g.y * (1.f + sc.y), g.z * (1.f + sc.z), g.w * (1.f + sc.w));
                cb[i] = *(const float4*)(m + sh_off + col);
            }
        }
        float4 x[4]; float ss = 0.f;
#pragma unroll
        for (int i = 0; i < 4; ++i) {
            x[i].x = __uint_as_float(w[i].x << 16); x[i].y = __uint_as_float(w[i].x & 0xffff0000u); x[i].z = __uint_as_float(w[i].y << 16); x[i].w = __uint_as_float(w[i].y & 0xffff0000u);
            ss += x[i].x * x[i].x + x[i].y * x[i].y + x[i].z * x[i].z + x[i].w * x[i].w;
        }
        ss = wave_sum(ss);
        const float rinv = rsqrtf(ss * (1.0f / D) + EPS);
        float amax = 0.f;
#pragma unroll
        for (int i = 0; i < 4; ++i) {
            const int col = (i * 64 + lane) * 4;
            const float y0 = x[i].x * rinv * ca[i].x + cb[i].x, y1 = x[i].y * rinv * ca[i].y + cb[i].y;
            const float y2 = x[i].z * rinv * ca[i].z + cb[i].z, y3 = x[i].w * rinv * ca[i].w + cb[i].w;
            uint2 o; o.x = pack2(y0, y1); o.y = pack2(y2, y3);
            *(uint2*)(out + ((size_t)(col >> 5) * TA + row) * 32 + (col & 31)) = o;
            x[i] = make_float4(y0, y1, y2, y3);
            amax = fmaxf(amax, fmaxf(fmaxf(fabsf(y0), fabsf(y1)), fmaxf(fabsf(y2), fabsf(y3))));
        }
        if (xq) {
#pragma unroll
            for (int o = 32; o > 0; o >>= 1) amax = fmaxf(amax, __shfl_xor(amax, o));
            amax = fmaxf(amax, 1e-20f);
            const float qs = 127.0f / amax;
#pragma unroll
            for (int i = 0; i < 4; ++i)
                *(int*)(xq + (size_t)row * D + (i * 64 + lane) * 4) = q8(x[i].x, qs) | (q8(x[i].y, qs) << 8) | (q8(x[i].z, qs) << 16) | (q8(x[i].w, qs) << 24);
            if (lane == 0) xs[row] = amax * (1.0f / 127.0f);
        }
    }
}

constexpr int GEMM_LDS = 49152;
template <class Epi>
__device__ __forceinline__ void gemm_tile(const bf16_t* __restrict__ A, int lda, const bf16_t* __restrict__ Bt, int ldb, int K,
                                          int m0, int n0, char* lds, Epi& epi) {
    const int tid = threadIdx.x, lane = tid & 63, wid = __builtin_amdgcn_readfirstlane(tid >> 6), wr = wid >> 1, wc = wid & 1, fr = lane & 15, fq = lane >> 4;
    f32x4 acc[4][8];
#pragma unroll
    for (int i = 0; i < 4; ++i)
#pragma unroll
        for (int j = 0; j < 8; ++j) acc[i][j] = (f32x4){0.f, 0.f, 0.f, 0.f};
    typedef __attribute__((address_space(3))) char las_char;
    las_char* l3 = (las_char*)lds;
    const int dsub = lane >> 2, dch = (lane & 3) ^ ((lane >> 5) * 3);
    const bf16_t* ga = A + (size_t)(m0 + 32 * wid + dsub) * (Epi::ABLK ? 32 : lda) + dch * 8;
    const bf16_t* gb = Bt + (size_t)(n0 + 64 * wid + dsub) * 32 + dch * 8;
    const int fsw = ((fr >> 3) & 1) * 3;
    const int aoff = (wr * 64 + fr) * 64 + ((fq ^ fsw) << 4), boff = 8192 + (wc * 128 + fr) * 64 + ((fq ^ fsw) << 4);
#define GT_STAGE(kt, buf) do { const int _s = (buf) * 24576; \
        if (Epi::ABLK) { const unsigned* _ap = (const unsigned*)(ga + (size_t)(kt) * lda * 32); \
          __attribute__((address_space(3))) unsigned* _al = (__attribute__((address_space(3))) unsigned*)(l3 + _s + (32 * wid) * 64); \
          __builtin_amdgcn_global_load_lds(_ap, _al, 16, 0, 0); __builtin_amdgcn_global_load_lds(_ap, _al, 16, 1024, 0); } \
        else { _Pragma("unroll") for (int i = 0; i < 2; ++i) __builtin_amdgcn_global_load_lds((const unsigned*)(ga + (size_t)(16 * i) * lda + (kt) * 32), \
            (__attribute__((address_space(3))) unsigned*)(l3 + _s + (32 * wid + 16 * i) * 64), 16, 0, 0); } \
        { const unsigned* _gp = (const unsigned*)(gb + (size_t)(kt) * ldb * 32); \
          __attribute__((address_space(3))) unsigned* _lp = (__attribute__((address_space(3))) unsigned*)(l3 + _s + 8192 + (64 * wid) * 64); \
          __builtin_amdgcn_global_load_lds(_gp, _lp, 16, 0, 0); __builtin_amdgcn_global_load_lds(_gp, _lp, 16, 1024, 0); \
          __builtin_amdgcn_global_load_lds(_gp, _lp, 16, 2048, 0); __builtin_amdgcn_global_load_lds(_gp, _lp, 16, 3072, 0); } } while (0)
    const int nk = K / 32;
    __syncthreads();
    GT_STAGE(0, 0);
    __syncthreads();
    for (int kt = 0; kt < nk; ++kt) {
        if (kt + 1 < nk) GT_STAGE(kt + 1, (kt + 1) & 1);
        const char* base = lds + (kt & 1) * 24576;
        bf16x8 af[4], bfr[8];
#pragma unroll
        for (int i = 0; i < 4; ++i) af[i] = *(const bf16x8*)(base + aoff + i * 1024);
#pragma unroll
        for (int j = 0; j < 8; ++j) bfr[j] = *(const bf16x8*)(base + boff + j * 1024);
#pragma unroll
        for (int i = 0; i < 4; ++i)
#pragma unroll
            for (int j = 0; j < 8; ++j) acc[i][j] = __builtin_amdgcn_mfma_f32_16x16x32_bf16(bfr[j], af[i], acc[i][j], 0, 0, 0);
        __builtin_amdgcn_sched_barrier(0);
        __syncthreads();
    }
#undef GT_STAGE
    epi(acc, m0 + wr * 64, n0 + wc * 128, lds + wid * 12288, lane);
}

template <int TAG>
struct EpiStoreSplit {
    static constexpr bool ABLK = true;
    bf16_t* O1; int ld1; bf16_t* O2; int ld2; int split;
    __device__ __forceinline__ void operator()(f32x4 (&acc)[4][8], int row0, int col0, char* wl, int lane) const {
        if (TAG == 0 && col0 < 1536) {
            const bool isq = col0 < 512;
#pragma unroll
            for (int i = 0; i < 4; ++i)
#pragma unroll
                for (int j = 0; j < 8; ++j)
#pragma unroll
                    for (int t = 0; t < 4; ++t) {
                        const float x = acc[i][j][t];
                        const float r = __builtin_amdgcn_rcpf(1.f + __expf(isq ? -x : x));
                        acc[i][j][t] = isq ? x * r : r;
                    }
        }
        const bool first = col0 < split;
        bf16_t* O = first ? O1 : O2; const int ld = first ? ld1 : ld2, cb = first ? col0 : col0 - split;
        const int fr = lane & 15, fq = lane >> 4;
#pragma unroll
        for (int i = 0; i < 4; ++i) {
#pragma unroll
            for (int j = 0; j < 8; ++j) {
                uint2 w; w.x = pack2(acc[i][j][0], acc[i][j][1]); w.y = pack2(acc[i][j][2], acc[i][j][3]);
                *(uint2*)(wl + fr * 272 + (16 * j + 4 * fq) * 2) = w;
            }
#pragma unroll
            for (int m = 0; m < 4; ++m) {
                const int rr = (lane >> 4) + 4 * m;
                const uint4 v = *(const uint4*)(wl + rr * 272 + (lane & 15) * 16);
                *(uint4*)(O + (size_t)(row0 + 16 * i + rr) * ld + cb + (lane & 15) * 8) = v;
            }
        }
    }
};
template <int TAG>
struct EpiResid {
    static constexpr bool ABLK = false;
    const float* hin_lat; const float* hin_ctx; const bf16_t* hin16; bf16_t* hout16; const float* gate  ;
    __device__ __forceinline__ void operator()(f32x4 (&acc)[4][8], int row0, int col0, char* wl, int lane) const {
        const int fr = lane & 15, fq = lane >> 4;
        const float4 gg = *(const float4*)(gate + (size_t)mod_row(row0) * 6144 + col0 + (lane & 31) * 4);
#pragma unroll
        for (int i = 0; i < 4; ++i) {
#pragma unroll
            for (int j = 0; j < 8; ++j) *(f32x4*)(wl + fr * 528 + (16 * j + 4 * fq) * 4) = acc[i][j];
#pragma unroll
            for (int m = 0; m < 8; ++m) {
                const int rr = (lane >> 5) + 2 * m, row = row0 + 16 * i + rr, col = col0 + (lane & 31) * 4;
                const f32x4 a = *(const f32x4*)(wl + rr * 528 + (lane & 31) * 16);
                float4 h;
                if (hin16) {
                    const uint2 hw = *(const uint2*)(hin16 + (size_t)row * D + col);
                    h.x = __uint_as_float(hw.x << 16); h.y = __uint_as_float(hw.x & 0xffff0000u); h.z = __uint_as_float(hw.y << 16); h.w = __uint_as_float(hw.y & 0xffff0000u);
                } else {
                    h = *(const float4*)((row < TL ? hin_lat + (size_t)row * D : hin_ctx + (size_t)(row - TL) * D) + col);
                }
                uint2 o; o.x = pack2(h.x + gg.x * a[0], h.y + gg.y * a[1]); o.y = pack2(h.z + gg.z * a[2], h.w + gg.w * a[3]);
                *(uint2*)(hout16 + (size_t)row * D + col) = o;
            }
        }
    }
};
struct EpiGA {
    static constexpr bool ABLK = true;
    bf16_t* P; bf16_t* Vt; const float* qg; const float* kg; const float* cosG; const float* sinG;
    __device__ __forceinline__ void operator()(f32x4 (&acc)[4][8], int row0, int col0, char* wl, int lane) const {
        const int fr = lane & 15, fq = lane >> 4;
        const bool latent = row0 < TL;
        if (col0 < 1280) {
            const bool isq = col0 < 1024;
            const float* g = isq ? qg : kg;
            const float osc = isq ? 0.08838834764831845f * LOG2E : 1.0f;
#pragma unroll
            for (int i = 0; i < 4; ++i) {
                float ss = 0.f;
#pragma unroll
                for (int j = 0; j < 8; ++j) ss += acc[i][j][0] * acc[i][j][0] + acc[i][j][1] * acc[i][j][1] + acc[i][j][2] * acc[i][j][2] + acc[i][j][3] * acc[i][j][3];
                ss += __shfl_xor(ss, 16); ss += __shfl_xor(ss, 32);
                const float rinv = rsqrtf(ss * (1.0f / 128.0f) + EPS) * osc;
                const int tpos = (row0 + 16 * i + fr) & (SEQ - 1);
#pragma unroll
                for (int j = 0; j < 4; ++j) {
                    const float4 g1 = *(const float4*)(g + 16 * j + 4 * fq), g2 = *(const float4*)(g + 64 + 16 * j + 4 * fq);
                    f32x4 y1 = acc[i][j] * rinv, y2 = acc[i][j + 4] * rinv;
                    y1[0] *= g1.x; y1[1] *= g1.y; y1[2] *= g1.z; y1[3] *= g1.w; y2[0] *= g2.x; y2[1] *= g2.y; y2[2] *= g2.z; y2[3] *= g2.w;
                    if (latent) {
                        const float4 cs = *(const float4*)(cosG + tpos * 64 + 16 * j + 4 * fq), sn = *(const float4*)(sinG + tpos * 64 + 16 * j + 4 * fq);
                        const f32x4 c4 = {cs.x, cs.y, cs.z, cs.w}, s4 = {sn.x, sn.y, sn.z, sn.w};
                        const f32x4 n1 = y1 * c4 - y2 * s4, n2 = y1 * s4 + y2 * c4;
                        y1 = n1; y2 = n2;
                    }
                    uint2 w1, w2; w1.x = pack2(y1[0], y1[1]); w1.y = pack2(y1[2], y1[3]); w2.x = pack2(y2[0], y2[1]); w2.y = pack2(y2[2], y2[3]);
                    *(uint2*)(wl + fr * 272 + (16 * j + 4 * fq) * 2) = w1;
                    *(uint2*)(wl + fr * 272 + (64 + 16 * j + 4 * fq) * 2) = w2;
                }
#pragma unroll
                for (int m = 0; m < 4; ++m) {
                    const int rr = (lane >> 4) + 4 * m;
                    const uint4 v = *(const uint4*)(wl + rr * 272 + (lane & 15) * 16);
                    *(uint4*)(P + (size_t)(row0 + 16 * i + rr) * GA_IN + col0 + (lane & 15) * 8) = v;
                }
            }
        } else {
            const int kvh = (col0 - 1280) >> 7;
            const int b = latent ? (row0 >> 12) : ((row0 - TL) >> 8);
            const int kidx0 = latent ? LC + (row0 & (SEQ - 1)) : ((row0 - TL) & (LC - 1));
            bf16_t* vt = Vt + (size_t)(b * 2 + kvh) * 128 * NKEY + kidx0;
#pragma unroll
            for (int hh = 0; hh < 2; ++hh) {
#pragma unroll
                for (int i = 0; i < 4; ++i)
#pragma unroll
                    for (int j = 0; j < 4; ++j)
#pragma unroll
                        for (int t = 0; t < 4; ++t)
                            *(bf16_t*)(wl + (16 * j + 4 * fq + t) * 144 + (16 * i + fr) * 2) = (bf16_t)(pack2(acc[i][4 * hh + j][t], 0.f) & 0xffff);
#pragma unroll
                for (int m = 0; m < 8; ++m) {
                    const int dd = (lane >> 3) + 8 * m;
                    const uint4 v = *(const uint4*)(wl + dd * 144 + (lane & 7) * 16);
                    *(uint4*)(vt + (size_t)(64 * hh + dd) * NKEY + (lane & 7) * 8) = v;
                }
            }
        }
    }
};
template <class Epi>
__device__ void ph_gemm(int bid, int nb, const bf16_t* A, int lda, const bf16_t* Bt, int ldb, int M, int N, int K, char* lds, Epi epi, int ncol0 = 0) {
    const int nM = M / 128, nN = N / 256, nwg = nM * nN;
    const bool sw = (nb & 7) == 0;
    for (int L = bid; L < nwg; L += nb) {
        int wg = L;
        if (sw) { const int q = nwg >> 3, r = nwg & 7, xcd = L & 7, off = L >> 3; wg = (xcd < r ? xcd * (q + 1) : r * (q + 1) + (xcd - r) * q) + off; }
        const int nig = 8 * nN, gid = wg / nig, fm = gid * 8, gsz = (nM - fm) < 8 ? (nM - fm) : 8;
        const int pm = fm + (wg % nig) % gsz, pn = (wg % nig) / gsz;
        gemm_tile(A, lda, Bt, ldb, K, pm * 128, ncol0 + pn * 256, lds, epi);
    }
}

typedef short bf16x4 __attribute__((ext_vector_type(4)));
constexpr int HQ_OFF = 0, HK_OFF = 16384, HKT_OFF = 32768, HVT_OFF = 49152, HD_OFF = 57344, HG_LDS = 59392;
__device__ __forceinline__ int hg_row(int b, int dir, int p) {
    const int s = dir ? (LC - 1 - p) : p, t = dir ? (SEQ - 1 - (p - LC)) : (p - LC);
    return p < LC ? TL + b * LC + s : b * SEQ + t;
}
__device__ void ph_hgrn(int bid, int nb, const bf16_t* __restrict__ projH, const float* __restrict__ lb, bf16_t* __restrict__ of, bf16_t* __restrict__ ob, char* lds) {
    const int tid = threadIdx.x, lane = tid & 63, w = __builtin_amdgcn_readfirstlane(tid >> 6), fr = lane & 15, fq = lane >> 4;
    for (int it = bid; it < NB * 4 * 2 * 2; it += nb) {
        const int vs = it & 1, dir = (it >> 1) & 1, h = (it >> 2) & 3, b = it >> 4;
        bf16_t* out = dir ? ob : of; const int ldo = dir ? 512 : D;
        const float lb0 = lb[h * 128 + 2 * lane], lb1 = lb[h * 128 + 2 * lane + 1];
        const int fcol = (dir ? 1024 : 512) + h * 128 + 2 * lane, qcol = h * 128 + 2 * lane, vcol = 1536 + h * 128 + vs * 64 + lane;
        f32x4 S[8];
#pragma unroll
        for (int kt = 0; kt < 8; ++kt) S[kt] = (f32x4){0.f, 0.f, 0.f, 0.f};
        unsigned xf[16], xq[16]; bf16_t xv[16];
        const int sg = dir ? -1 : 1;
#define HG_PREFETCH(p0) do { const int _r0 = hg_row(b, dir, (p0) + 16 * w); \
        _Pragma("unroll") for (int i = 0; i < 16; ++i) xv[i] = projH[(size_t)(_r0 + sg * i) * HGW + vcol];        \
        _Pragma("unroll") for (int i = 0; i < 16; ++i) { const size_t rb = (size_t)(_r0 + sg * i) * HGW; \
            xf[i] = *(const unsigned*)(projH + rb + fcol); xq[i] = *(const unsigned*)(projH + rb + qcol); } } while (0)
        HG_PREFETCH(0);
        for (int p0 = 0; p0 < NKEY; p0 += 64) {
            __syncthreads();
            {
                float P0 = 1.f, P1 = 1.f, kp0 = 0.f, kp1 = 0.f;
                unsigned kt0[8], kt1[8], vt[8];
#pragma unroll
                for (int i = 0; i < 16; ++i) {
                    const float u0 = __uint_as_float(xf[i] << 16), u1 = __uint_as_float(xf[i] & 0xffff0000u);
                    const float xq0 = __uint_as_float(xq[i] << 16), xq1 = __uint_as_float(xq[i] & 0xffff0000u);
                    const float nf0 = (1.f - lb0) * u0, nf1 = (1.f - lb1) * u1;
                    P0 *= 1.f - nf0; P1 *= 1.f - nf1;
                    const float q0 = xq0 * P0, q1 = xq1 * P1;
                    const float k0 = nf0 * fminf(__builtin_amdgcn_rcpf(P0), 5.0e34f);
                    const float k1 = nf1 * fminf(__builtin_amdgcn_rcpf(P1), 5.0e34f);
                    const int t = 16 * w + i;
                    const int o = t * 256 + (((lane >> 2) ^ (t & 15)) << 4) + (lane & 3) * 4;
                    *(unsigned*)(lds + HQ_OFF + o) = pack2(q0, q1);
                    *(unsigned*)(lds + HK_OFF + o) = pack2(k0, k1);
                    if (i & 1) { kt0[i >> 1] = pack2(kp0, k0); kt1[i >> 1] = pack2(kp1, k1); vt[i >> 1] = (unsigned)xv[i - 1] | ((unsigned)xv[i] << 16); }
                    else { kp0 = k0; kp1 = k1; }
                }
                float2 dd; dd.x = P0; dd.y = P1;
                *(float2*)(lds + HD_OFF + (w * 128 + 2 * lane) * 4) = dd;
                char* kp = lds + HKT_OFF + w * 4096 + (2 * lane) * 32;
                *(uint4*)(kp) = make_uint4(kt0[0], kt0[1], kt0[2], kt0[3]); *(uint4*)(kp + 16) = make_uint4(kt0[4], kt0[5], kt0[6], kt0[7]);
                *(uint4*)(kp + 32) = make_uint4(kt1[0], kt1[1], kt1[2], kt1[3]); *(uint4*)(kp + 48) = make_uint4(kt1[4], kt1[5], kt1[6], kt1[7]);
                char* vp = lds + HVT_OFF + w * 2048 + lane * 32;
                *(uint4*)(vp) = make_uint4(vt[0], vt[1], vt[2], vt[3]); *(uint4*)(vp + 16) = make_uint4(vt[4], vt[5], vt[6], vt[7]);
            }
            if (p0 + 64 < NKEY) HG_PREFETCH(p0 + 64);
            __syncthreads();
#pragma unroll
            for (int I = 0; I < 4; ++I) {
                const int trow = 16 * I + fr;
                f32x4 at = (f32x4){0.f, 0.f, 0.f, 0.f};
#pragma unroll
                for (int ks = 0; ks < 4; ++ks) {
                    const int o = trow * 256 + (((ks * 4 + fq) ^ fr) << 4);
                    const bf16x8 ka = *(const bf16x8*)(lds + HK_OFF + o);
                    const bf16x8 qa = *(const bf16x8*)(lds + HQ_OFF + o);
                    at = __builtin_amdgcn_mfma_f32_16x16x32_bf16(ka, qa, at, 0, 0, 0);
                }
#pragma unroll
                for (int j = 0; j < 4; ++j) if (4 * fq + j > fr) at[j] = 0.f;
                uint2 pa2; pa2.x = pack2(at[0], at[1]); pa2.y = pack2(at[2], at[3]);
                const bf16x4 pA = __builtin_bit_cast(bf16x4, pa2);
                const bf16x4 vfrag = *(const bf16x4*)(lds + HVT_OFF + I * 2048 + (w * 16 + fr) * 32 + fq * 8);
                f32x4 o1 = __builtin_amdgcn_mfma_f32_16x16x16bf16_1k(vfrag, pA, (f32x4){0.f, 0.f, 0.f, 0.f}, 0, 0, 0);
                f32x4 o2 = (f32x4){0.f, 0.f, 0.f, 0.f};
#pragma unroll
                for (int kt = 0; kt < 8; ++kt) {
                    uint2 s2; s2.x = pack2(S[kt][0], S[kt][1]); s2.y = pack2(S[kt][2], S[kt][3]);
                    const bf16x4 sfrag = __builtin_bit_cast(bf16x4, s2);
                    const bf16x4 qfrag = *(const bf16x4*)(lds + HQ_OFF + trow * 256 + (((kt * 2 + (fq >> 1)) ^ fr) << 4) + (fq & 1) * 8);
                    if (kt & 1) o2 = __builtin_amdgcn_mfma_f32_16x16x16bf16_1k(sfrag, qfrag, o2, 0, 0, 0);
                    else o1 = __builtin_amdgcn_mfma_f32_16x16x16bf16_1k(sfrag, qfrag, o1, 0, 0, 0);
                }
#pragma unroll
                for (int kt = 0; kt < 8; ++kt) {
                    const bf16x4 kfrag = *(const bf16x4*)(lds + HKT_OFF + I * 4096 + (kt * 16 + fr) * 32 + fq * 8);
                    const f32x4 d4 = *(const f32x4*)(lds + HD_OFF + (I * 128 + kt * 16 + fq * 4) * 4);
                    S[kt] = __builtin_amdgcn_mfma_f32_16x16x16bf16_1k(kfrag, vfrag, S[kt], 0, 0, 0);
                    S[kt] = S[kt] * d4;
                }
                const size_t orow = (size_t)(hg_row(b, dir, p0) + sg * trow);
                uint2 ov; ov.x = pack2(o1[0] + o2[0], o1[1] + o2[1]); ov.y = pack2(o1[2] + o2[2], o1[3] + o2[3]);
                *(uint2*)(out + orow * ldo + h * 128 + vs * 64 + w * 16 + fq * 4) = ov;
            }
        }
#undef HG_PREFETCH
    }
}
__device__ void ph_hgpost(int bid, int nb, const bf16_t* __restrict__ of, const bf16_t* __restrict__ ob, const bf16_t* __restrict__ projH,
                          const float* __restrict__ g, bf16_t* __restrict__ mix) {
    const int lane = threadIdx.x & 63, wid = threadIdx.x >> 6, l16 = lane & 15;
    const float4 g0 = *(const float4*)(g + l16 * 8), g1 = *(const float4*)(g + l16 * 8 + 4);
    const float gw[8] = {g0.x, g0.y, g0.z, g0.w, g1.x, g1.y, g1.z, g1.w};
    for (int it = (bid * 4 + wid) * 4 + (lane >> 4); it < TA * 4; it += nb * 16) {
        const int row = it >> 2, h = it & 3;
        const uint4 a = *(const uint4*)(of + (size_t)row * D + h * 128 + l16 * 8), bb = *(const uint4*)(ob + (size_t)row * 512 + h * 128 + l16 * 8);
        const uint4 gg = *(const uint4*)(projH + (size_t)row * HGW + 2048 + h * 128 + l16 * 8);
        const unsigned aw[4] = {a.x, a.y, a.z, a.w}, bw[4] = {bb.x, bb.y, bb.z, bb.w}, gv[4] = {gg.x, gg.y, gg.z, gg.w};
        float x[8], ss = 0.f;
#pragma unroll
        for (int j = 0; j < 4; ++j) {
            x[2 * j] = __uint_as_float(aw[j] << 16) + __uint_as_float(bw[j] << 16);
            x[2 * j + 1] = __uint_as_float(aw[j] & 0xffff0000u) + __uint_as_float(bw[j] & 0xffff0000u);
            ss += x[2 * j] * x[2 * j] + x[2 * j + 1] * x[2 * j + 1];
        }
        ss += __int_as_float(__builtin_amdgcn_update_dpp(0, __float_as_int(ss), 0xB1, 0xF, 0xF, true));
        ss += __int_as_float(__builtin_amdgcn_update_dpp(0, __float_as_int(ss), 0x4E, 0xF, 0xF, true));
        ss += __int_as_float(__builtin_amdgcn_update_dpp(0, __float_as_int(ss), 0x141, 0xF, 0xF, true));
        ss += __int_as_float(__builtin_amdgcn_update_dpp(0, __float_as_int(ss), 0x140, 0xF, 0xF, true));
        const float rinv = rsqrtf(ss * (1.0f / 128.0f) + EPS);
        unsigned ow[4];
#pragma unroll
        for (int j = 0; j < 4; ++j) {
            const float y0 = x[2 * j] * rinv * gw[2 * j] * siluf_(__uint_as_float(gv[j] << 16));
            const float y1 = x[2 * j + 1] * rinv * gw[2 * j + 1] * siluf_(__uint_as_float(gv[j] & 0xffff0000u));
            ow[j] = pack2(y0, y1);
        }
        *(uint4*)(mix + (size_t)row * D + h * 128 + l16 * 8) = make_uint4(ow[0], ow[1], ow[2], ow[3]);
    }
}

__device__ void ph_prep_swa(int bid, int nb, bf16_t* __restrict__ P, const float* __restrict__ cosS, const float* __restrict__ sinS) {
    const int n = TA * 40;
    for (int idx = bid * blockDim.x + threadIdx.x; idx < n; idx += nb * blockDim.x) {
        const int row = idx / 40, pr = idx - row * 40, head = pr >> 2, d = (pr & 3) * 8;
        bf16_t* p = P + (size_t)row * SWW + head * 64 + d;
        const uint4 a = *(const uint4*)p, b = *(const uint4*)(p + 32);
        const unsigned aw[4] = {a.x, a.y, a.z, a.w}, bw[4] = {b.x, b.y, b.z, b.w};
        float x1[8], x2[8];
#pragma unroll
        for (int j = 0; j < 4; ++j) {
            x1[2 * j] = __uint_as_float(aw[j] << 16); x1[2 * j + 1] = __uint_as_float(aw[j] & 0xffff0000u);
            x2[2 * j] = __uint_as_float(bw[j] << 16); x2[2 * j + 1] = __uint_as_float(bw[j] & 0xffff0000u);
        }
        if (row < TL) {
            const int t = row & (SEQ - 1);
            const float4 c0 = *(const float4*)(cosS + t * 32 + d), c1 = *(const float4*)(cosS + t * 32 + d + 4);
            const float4 s0 = *(const float4*)(sinS + t * 32 + d), s1 = *(const float4*)(sinS + t * 32 + d + 4);
            const float cc[8] = {c0.x, c0.y, c0.z, c0.w, c1.x, c1.y, c1.z, c1.w}, ss[8] = {s0.x, s0.y, s0.z, s0.w, s1.x, s1.y, s1.z, s1.w};
#pragma unroll
            for (int j = 0; j < 8; ++j) { const float y1 = x1[j] * cc[j] - x2[j] * ss[j], y2 = x1[j] * ss[j] + x2[j] * cc[j]; x1[j] = y1; x2[j] = y2; }
        }
        if (head < 8) {
#pragma unroll
            for (int j = 0; j < 8; ++j) { x1[j] *= 0.125f * LOG2E; x2[j] *= 0.125f * LOG2E; }
        }
        uint4 oa, ob;
        oa.x = pack2(x1[0], x1[1]); oa.y = pack2(x1[2], x1[3]); oa.z = pack2(x1[4], x1[5]); oa.w = pack2(x1[6], x1[7]);
        ob.x = pack2(x2[0], x2[1]); ob.y = pack2(x2[2], x2[3]); ob.z = pack2(x2[4], x2[5]); ob.w = pack2(x2[6], x2[7]);
        *(uint4*)p = oa; *(uint4*)(p + 32) = ob;
    }
}
__device__ void ph_prep_ga(int bid, int nb, bf16_t* __restrict__ P, const float* __restrict__ qg, const float* __restrict__ kg,
                           const float* __restrict__ cosG, const float* __restrict__ sinG) {
    const int lane = threadIdx.x & 63, wid = threadIdx.x >> 6;
    for (int it = bid * 4 + wid; it < TA * 10; it += nb * 4) {
        const int row = it / 10, head = it % 10;
        bf16_t* p = P + (size_t)row * GA_IN + head * 128;
        float x1 = bf2f(p[lane]), x2 = bf2f(p[lane + 64]);
        const float ss = wave_sum(x1 * x1 + x2 * x2);
        const float rinv = rsqrtf(ss * (1.0f / 128.0f) + EPS);
        const float* g = head < 8 ? qg : kg;
        x1 = x1 * rinv * g[lane]; x2 = x2 * rinv * g[lane + 64];
        if (row < TL) {
            const int t = row & (SEQ - 1);
            const float c = cosG[t * 64 + lane], s = sinG[t * 64 + lane];
            const float y1 = x1 * c - x2 * s, y2 = x1 * s + x2 * c;
            x1 = y1; x2 = y2;
        }
        if (head < 8) { x1 *= 0.08838834764831845f * LOG2E; x2 *= 0.08838834764831845f * LOG2E; }
        p[lane] = f2bf(x1); p[lane + 64] = f2bf(x2);
    }
}

template <int HD>
__device__ void ph_vt(int bid, int nb, const bf16_t* __restrict__ P, int ldp, int vcol, bf16_t* __restrict__ Vt, bf16_t* lds) {
    constexpr int ND = HD / 64;
    const int tid = threadIdx.x;
    for (int it = bid; it < NB * 2 * ND * (NKEY / 64); it += nb) {
        const int kt = it % (NKEY / 64), r1 = it / (NKEY / 64), dh = r1 % ND, g = r1 / ND, b = g >> 1, kvh = g & 1;
        const int k0 = kt * 64;
        const int row0 = k0 < LC ? TL + b * LC + k0 : b * SEQ + (k0 - LC);
        __syncthreads();
#pragma unroll
        for (int i = 0; i < 2; ++i) {
            const int id = tid + i * 256, kr = id >> 3, c = id & 7;
            const uint4 w = *(const uint4*)(P + (size_t)(row0 + kr) * ldp + vcol + kvh * HD + dh * 64 + c * 8);
            const unsigned ww[4] = {w.x, w.y, w.z, w.w};
#pragma unroll
            for (int j = 0; j < 4; ++j) { lds[kr * 66 + c * 8 + j * 2] = (bf16_t)(ww[j] & 0xffff); lds[kr * 66 + c * 8 + j * 2 + 1] = (bf16_t)(ww[j] >> 16); }
        }
        __syncthreads();
#pragma unroll
        for (int i = 0; i < 2; ++i) {
            const int id = tid + i * 256, d = id >> 3, c = id & 7;
            unsigned o[4];
#pragma unroll
            for (int j = 0; j < 4; ++j) o[j] = (unsigned)lds[(c * 8 + j * 2) * 66 + d] | ((unsigned)lds[(c * 8 + j * 2 + 1) * 66 + d] << 16);
            uint4 w; w.x = o[0]; w.y = o[1]; w.z = o[2]; w.w = o[3];
            *(uint4*)(Vt + (size_t)(g * HD + dh * 64 + d) * NKEY + k0 + c * 8) = w;
        }
    }
}

template <int HD, bool MASK>
__device__ __forceinline__ void flash_item(const bf16_t* __restrict__ Qrow0, int ldq, const bf16_t* __restrict__ Kp, int ldk,
                                           const bf16_t* __restrict__ Vt, int krow_ctx0, int krow_lat0, int nctx_t, int lat_lo, int nlat_t,
                                           int tq0, float m0, float l0, bf16_t* __restrict__ Orow0, int ldo, char* lds) {
    constexpr int NCH = HD / 32;
    constexpr int KB = 64 * HD * 2;
    constexpr int NKK = HD / 16;
    constexpr int NDT = HD / 32;
    const int tid = threadIdx.x, lane = tid & 63, w = __builtin_amdgcn_readfirstlane(tid >> 6), r = lane & 31, h = lane >> 5;
    const int pr = (r & 0x13) | ((r & 4) << 1) | ((r & 8) >> 1);
    bf16x8 qf[NKK];
    {
        const bf16_t* qp = Qrow0 + (size_t)(32 * w + r) * ldq + 8 * h;
#pragma unroll
        for (int kk = 0; kk < NKK; ++kk) qf[kk] = *(const bf16x8*)(qp + 16 * kk);
    }
    f32x16 O[NDT];
#pragma unroll
    for (int dt = 0; dt < NDT; ++dt)
#pragma unroll
        for (int i = 0; i < 16; ++i) O[dt][i] = 0.f;
    float m_run = m0, l_run = (h == 0) ? l0 : 0.f;
    typedef __attribute__((address_space(3))) char las_char;
    las_char* l3 = (las_char*)lds;
    constexpr int KRI = (HD == 128) ? 4 : 8;
    constexpr int NKI = 16 / KRI;
    constexpr int NVI = HD / 32;
    const int krl = (HD == 128) ? (lane >> 4) : (lane >> 3);
    const int kpl = (HD == 128) ? (lane & 15) : (lane & 7);
    const int vrl = lane >> 3, vpl = lane & 7;
    const int kfo = pr * (HD * 2);
    const int kfs = (HD == 128) ? (pr & 15) : ((pr >> 1) & 7);
    const int vfo = KB + r * 128;
    const int vfs = (r >> 1) & 7;
    const int ntile = nctx_t + nlat_t;
#define FA_TILE(t, krow0, kidx0, s0) const int krow0 = (t) < nctx_t ? krow_ctx0 + 64 * (t) : krow_lat0 + lat_lo + 64 * ((t) - nctx_t); \
        const int s0 = (t) < nctx_t ? -(1 << 24) : lat_lo + 64 * ((t) - nctx_t); const int kidx0 = (t) < nctx_t ? 64 * (t) : LC + lat_lo + 64 * ((t) - nctx_t);
    const unsigned kro = (unsigned)(16 * w + krl) * (unsigned)ldk * 2u, kc0 = (HD == 128) ? (unsigned)(kpl ^ krl) : (unsigned)(kpl ^ (krl >> 1));
    const unsigned vro = (unsigned)((HD / 4) * w + vrl) * (unsigned)(NKEY * 2), vc0 = (unsigned)(vpl ^ (vrl >> 1));
#define FA_STAGE(t, buf) do { FA_TILE(t, _kr0, _ki0, _s0) (void)_s0; \
        const char* _kb = (const char*)Kp + (size_t)_kr0 * (size_t)ldk * 2; const char* _vb = (const char*)(Vt + _ki0); \
        _Pragma("unroll") for (int i = 0; i < NKI; ++i) { \
            __builtin_amdgcn_global_load_lds((const unsigned*)(_kb + (kro + (unsigned)(KRI * i) * (unsigned)ldk * 2u + ((kc0 ^ (unsigned)(4 * i)) << 4))), \
                (__attribute__((address_space(3))) unsigned*)(l3 + (buf) * (2 * KB) + (16 * w + KRI * i) * (HD * 2)), 16, 0, 0); } \
        _Pragma("unroll") for (int i = 0; i < NVI; ++i) { \
            __builtin_amdgcn_global_load_lds((const unsigned*)(_vb + (vro + (unsigned)(8 * i) * (unsigned)(NKEY * 2) + ((vc0 ^ (unsigned)(4 * (i & 1))) << 4))), \
                (__attribute__((address_space(3))) unsigned*)(l3 + (buf) * (2 * KB) + KB + ((HD / 4) * w + 8 * i) * 128), 16, 0, 0); } } while (0)
    __syncthreads();
    FA_STAGE(0, 0);
    __syncthreads();
    for (int t = 0; t < ntile; ++t) {
        if (t + 1 < ntile) FA_STAGE(t + 1, (t + 1) & 1);
        const char* base = lds + (t & 1) * (2 * KB);
        f32x16 st[2];
        __builtin_amdgcn_s_setprio(1);
#pragma unroll
        for (int rt = 0; rt < 2; ++rt) {
#pragma unroll
            for (int i = 0; i < 16; ++i) st[rt][i] = 0.f;
#pragma unroll
            for (int kk = 0; kk < NKK; ++kk) {
                const bf16x8 kf = *(const bf16x8*)(base + rt * 32 * (HD * 2) + kfo + (((2 * kk + h) ^ kfs) << 4));
                st[rt] = __builtin_amdgcn_mfma_f32_32x32x16_bf16(kf, qf[kk], st[rt], 0, 0, 0);
                if ((kk & 7) == 7) __builtin_amdgcn_sched_barrier(0);
            }
        }
        __builtin_amdgcn_s_setprio(0);
        if (MASK) {
            FA_TILE(t, _kr0, _ki0, s0) (void)_kr0; (void)_ki0;
            if (t >= nctx_t) {
                const int tq = tq0 + 32 * w + r;
#pragma unroll
                for (int rt = 0; rt < 2; ++rt)
#pragma unroll
                    for (int i = 0; i < 16; ++i) {
                        const int s = s0 + 32 * rt + (i & 3) + 4 * ((i >> 2) & 1) + 8 * h + 16 * (i >> 3);
                        const int dlt = tq - s;
                        if (dlt > 128 || dlt < -128) st[rt][i] = -1.0e30f;
                    }
            }
        }
        constexpr float FA_THR = 11.5f;
        float pm0 = st[0][0], pm1 = st[0][8], pm2 = st[1][0], pm3 = st[1][8];
#pragma unroll
        for (int i = 1; i < 8; i += 2) {
            pm0 = fmaxf(fmaxf(pm0, st[0][i]), st[0][i + 1 < 8 ? i + 1 : i]);
            pm1 = fmaxf(fmaxf(pm1, st[0][8 + i]), st[0][8 + (i + 1 < 8 ? i + 1 : i)]);
            pm2 = fmaxf(fmaxf(pm2, st[1][i]), st[1][i + 1 < 8 ? i + 1 : i]);
            pm3 = fmaxf(fmaxf(pm3, st[1][8 + i]), st[1][8 + (i + 1 < 8 ? i + 1 : i)]);
        }
        float pmax = fmaxf(fmaxf(pm0, pm1), fmaxf(pm2, pm3));
        pmax = fmaxf(pmax, __shfl_xor(pmax, 32));
        float mx = m_run, alpha = 1.0f;
        if (!__all(pmax - m_run <= FA_THR)) {
            mx = fmaxf(m_run, pmax);
            alpha = __builtin_amdgcn_exp2f(m_run - mx);
            m_run = mx;
        }
        float ps0 = 0.f, ps1 = 0.f, ps2 = 0.f, ps3 = 0.f;
#pragma unroll
        for (int rt = 0; rt < 2; ++rt)
#pragma unroll
            for (int i = 0; i < 16; i += 4) {
                const float p0 = __builtin_amdgcn_exp2f(st[rt][i] - mx), p1 = __builtin_amdgcn_exp2f(st[rt][i + 1] - mx);
                const float p2 = __builtin_amdgcn_exp2f(st[rt][i + 2] - mx), p3 = __builtin_amdgcn_exp2f(st[rt][i + 3] - mx);
                st[rt][i] = p0; st[rt][i + 1] = p1; st[rt][i + 2] = p2; st[rt][i + 3] = p3;
                ps0 += p0; ps1 += p1; ps2 += p2; ps3 += p3;
            }
        const float ps = (ps0 + ps1) + (ps2 + ps3);
        l_run = l_run * alpha + ps;
        if (!__all(alpha == 1.0f)) {
#pragma unroll
            for (int dt = 0; dt < NDT; ++dt)
#pragma unroll
                for (int i = 0; i < 16; ++i) O[dt][i] *= alpha;
        }
        bf16x8 pf[2][2];
#pragma unroll
        for (int rt = 0; rt < 2; ++rt)
#pragma unroll
            for (int s2 = 0; s2 < 2; ++s2) {
                uint4 pk;
                pk.x = pack2(st[rt][8 * s2 + 0], st[rt][8 * s2 + 1]); pk.y = pack2(st[rt][8 * s2 + 2], st[rt][8 * s2 + 3]);
                pk.z = pack2(st[rt][8 * s2 + 4], st[rt][8 * s2 + 5]); pk.w = pack2(st[rt][8 * s2 + 6], st[rt][8 * s2 + 7]);
                pf[rt][s2] = __builtin_bit_cast(bf16x8, pk);
            }
#pragma unroll
        for (int dt = 0; dt < NDT; ++dt)
#pragma unroll
            for (int rt = 0; rt < 2; ++rt)
#pragma unroll
                for (int s2 = 0; s2 < 2; ++s2) {
                    const bf16x8 vf = *(const bf16x8*)(base + vfo + dt * 4096 + (((4 * rt + 2 * s2 + h) ^ vfs) << 4));
                    O[dt] = __builtin_amdgcn_mfma_f32_32x32x16_bf16(vf, pf[rt][s2], O[dt], 0, 0, 0);
                    if (rt == 1 && s2 == 1) __builtin_amdgcn_sched_barrier(0);
                }
        __syncthreads();
    }
#undef FA_TILE
#undef FA_STAGE
    const float lt = l_run + __shfl_xor(l_run, 32);
    const float inv = 1.0f / lt;
    char* wl = lds + w * (32 * (HD * 2 + 16));
#pragma unroll
    for (int dt = 0; dt < NDT; ++dt)
#pragma unroll
        for (int g = 0; g < 4; ++g) {
            uint2 o2; o2.x = pack2(O[dt][4 * g] * inv, O[dt][4 * g + 1] * inv); o2.y = pack2(O[dt][4 * g + 2] * inv, O[dt][4 * g + 3] * inv);
            *(uint2*)(wl + r * (HD * 2 + 16) + (32 * dt + 8 * g + 4 * h) * 2) = o2;
        }
    constexpr int LPR = HD / 8;
#pragma unroll
    for (int m = 0; m < 32 * LPR / 64; ++m) {
        const int rr = (lane / LPR) + (64 / LPR) * m, ch = lane % LPR;
        const uint4 v = *(const uint4*)(wl + rr * (HD * 2 + 16) + ch * 16);
        *(uint4*)(Orow0 + (size_t)(32 * w + rr) * ldo + ch * 8) = v;
    }
}
__device__ void ph_swa(int bid, int nb, const bf16_t* __restrict__ projS, const bf16_t* __restrict__ Vt, const float* __restrict__ sink,
                       bf16_t* __restrict__ mix, char* lds) {
    const int n_lat = NB * 8 * 32, n_ctx = NB * 8 * 2;
    for (int it = bid; it < n_lat + n_ctx; it += nb) {
        int b, hq, row0, lo, nlat, t0;
        if (it < n_lat) {
            const int qb = it & 31; hq = (it >> 5) & 7; b = it >> 8;
            t0 = qb * 128;
            lo = t0 - 128 < 0 ? 0 : t0 - 128;
            const int hi = t0 + 256 > SEQ ? SEQ : t0 + 256;
            nlat = (hi - lo) / 64; row0 = b * SEQ + t0;
        } else {
            const int i2 = it - n_lat, qb = i2 & 1; hq = (i2 >> 1) & 7; b = i2 >> 4;
            t0 = 0; lo = 0; nlat = 0; row0 = TL + b * LC + qb * 128;
        }
        const int kvh = hq >> 2;
        flash_item<64, true>(projS + (size_t)row0 * SWW + hq * 64, SWW, projS + 512 + kvh * 64, SWW, Vt + (size_t)(b * 2 + kvh) * 64 * NKEY,
                             TL + b * LC, b * SEQ, 4, lo, nlat, t0, sink[hq] * LOG2E, 1.0f, mix + (size_t)row0 * D + 512 + hq * 64, D, lds);
    }
}
__device__ void ph_dense(int bid, int nb, const bf16_t* __restrict__ projG, const bf16_t* __restrict__ Vt, bf16_t* __restrict__ mix, char* lds) {
    const bool sw = (nb & 7) == 0;
    const int nit = NB * 8 * 32;
    for (int j = sw ? (bid >> 3) : bid; j < (sw ? nit / 8 : nit); j += sw ? (nb >> 3) : nb) {
        int g, jj;
        if (sw) { g = (bid & 7) + 8 * (j >> 7); jj = j & 127; } else { g = j >> 7; jj = j & 127; }
        const int b = g >> 1, kvh = g & 1, hq = kvh * 4 + (jj >> 5), qb = jj & 31;
        const int row0 = b * SEQ + qb * 128;
        flash_item<128, false>(projG + (size_t)row0 * GA_IN + hq * 128, GA_IN, projG + 1024 + kvh * 128, GA_IN, Vt + (size_t)(b * 2 + kvh) * 128 * NKEY,
                               TL + b * LC, b * SEQ, 4, 0, SEQ / 64, 0, -1.0e30f, 0.0f, mix + (size_t)row0 * D + hq * 128, D, lds);
    }
}

#define CE(a, b) { const float _h = fmaxf(a, b); b = fminf(a, b); a = _h; }
__device__ __forceinline__ void net_sort16(float (&v)[16]) {
    CE(v[0], v[1]); CE(v[3], v[2]); CE(v[4], v[5]); CE(v[7], v[6]); CE(v[8], v[9]); CE(v[11], v[10]);
    CE(v[12], v[13]); CE(v[15], v[14]); CE(v[0], v[2]); CE(v[1], v[3]); CE(v[6], v[4]); CE(v[7], v[5]);
    CE(v[8], v[10]); CE(v[9], v[11]); CE(v[14], v[12]); CE(v[15], v[13]); CE(v[0], v[1]); CE(v[2], v[3]);
    CE(v[5], v[4]); CE(v[7], v[6]); CE(v[8], v[9]); CE(v[10], v[11]); CE(v[13], v[12]); CE(v[15], v[14]);
    CE(v[0], v[4]); CE(v[1], v[5]); CE(v[2], v[6]); CE(v[3], v[7]); CE(v[12], v[8]); CE(v[13], v[9]);
    CE(v[14], v[10]); CE(v[15], v[11]); CE(v[0], v[2]); CE(v[1], v[3]); CE(v[4], v[6]); CE(v[5], v[7]);
    CE(v[10], v[8]); CE(v[11], v[9]); CE(v[14], v[12]); CE(v[15], v[13]); CE(v[0], v[1]); CE(v[2], v[3]);
    CE(v[4], v[5]); CE(v[6], v[7]); CE(v[9], v[8]); CE(v[11], v[10]); CE(v[13], v[12]); CE(v[15], v[14]);
    CE(v[0], v[8]); CE(v[1], v[9]); CE(v[2], v[10]); CE(v[3], v[11]); CE(v[4], v[12]); CE(v[5], v[13]);
    CE(v[6], v[14]); CE(v[7], v[15]); CE(v[0], v[4]); CE(v[1], v[5]); CE(v[2], v[6]); CE(v[3], v[7]);
    CE(v[8], v[12]); CE(v[9], v[13]); CE(v[10], v[14]); CE(v[11], v[15]); CE(v[0], v[2]); CE(v[1], v[3]);
    CE(v[4], v[6]); CE(v[5], v[7]); CE(v[8], v[10]); CE(v[9], v[11]); CE(v[12], v[14]); CE(v[13], v[15]);
    CE(v[0], v[1]); CE(v[2], v[3]); CE(v[4], v[5]); CE(v[6], v[7]); CE(v[8], v[9]); CE(v[10], v[11]);
    CE(v[12], v[13]); CE(v[14], v[15]);
}
__device__ __forceinline__ void net_clean16(float (&v)[16]) {
    CE(v[0], v[8]); CE(v[1], v[9]); CE(v[2], v[10]); CE(v[3], v[11]); CE(v[4], v[12]); CE(v[5], v[13]);
    CE(v[6], v[14]); CE(v[7], v[15]); CE(v[0], v[4]); CE(v[1], v[5]); CE(v[2], v[6]); CE(v[3], v[7]);
    CE(v[8], v[12]); CE(v[9], v[13]); CE(v[10], v[14]); CE(v[11], v[15]); CE(v[0], v[2]); CE(v[1], v[3]);
    CE(v[4], v[6]); CE(v[5], v[7]); CE(v[8], v[10]); CE(v[9], v[11]); CE(v[12], v[14]); CE(v[13], v[15]);
    CE(v[0], v[1]); CE(v[2], v[3]); CE(v[4], v[5]); CE(v[6], v[7]); CE(v[8], v[9]); CE(v[10], v[11]);
    CE(v[12], v[13]); CE(v[14], v[15]);
}
__device__ __forceinline__ void net_merge16(float (&a)[16], const float (&b)[16]) {
#pragma unroll
    for (int i = 0; i < 16; ++i) a[i] = fmaxf(a[i], b[15 - i]);
    net_clean16(a);
}
#define PEER_CANDS(F) F(0,0,0) F(1,0,1) F(2,0,2) F(3,0,3) F(4,0,4) F(5,0,5) F(6,0,6) F(7,0,7) F(8,0,8) F(9,0,9) F(10,0,10) F(11,0,11) F(12,0,12) F(13,0,13) F(14,0,14) F(15,0,15) F(16,1,1) F(17,1,2) F(18,1,3) F(19,1,4) F(20,1,5) F(21,1,6) F(22,1,7) F(23,2,2) F(24,2,3) F(25,2,4) F(26,3,3)

__device__ __forceinline__ void ph_peer_route(int bid, int nb, const bf16_t* __restrict__ qpeer, const bf16_t* __restrict__ SK, unsigned short* __restrict__ sel_e,
                              float* __restrict__ sel_g, int M, char* lds) {
    const int tid = tidx(), lane = tid & 63, w = tid >> 6, r = lane & 31, h2 = lane >> 5;
    const int srow = tid >> 4, sc = tid & 15;
    const int soff = srow * 256 + ((sc ^ (srow & 15)) << 4);
    int hd_loaded = -1;
    for (int it = bid; it < (M / 128) * 8; it += nb) {
        const int m0 = (it >> 3) * 128, hd = it & 7;
        const int row = 32 * w + r;
        __syncthreads();
        if (hd != hd_loaded) {
        hd_loaded = hd;
#pragma unroll
        for (int pp = 0; pp < 2; ++pp) {
            const bf16_t* sp = SK + ((size_t)(hd * 2 + pp) * 128 + srow) * 128 + sc * 8;
            uint4 t0 = *(const uint4*)(sp), t1 = *(const uint4*)(sp + 16 * 128), t2 = *(const uint4*)(sp + 32 * 128), t3 = *(const uint4*)(sp + 48 * 128);
            uint4 t4 = *(const uint4*)(sp + 64 * 128), t5 = *(const uint4*)(sp + 80 * 128), t6 = *(const uint4*)(sp + 96 * 128), t7 = *(const uint4*)(sp + 112 * 128);
            char* d = lds + pp * 32768 + soff;
            *(uint4*)(d) = t0; *(uint4*)(d + 4096) = t1; *(uint4*)(d + 8192) = t2; *(uint4*)(d + 12288) = t3;
            *(uint4*)(d + 16384) = t4; *(uint4*)(d + 20480) = t5; *(uint4*)(d + 24576) = t6; *(uint4*)(d + 28672) = t7;
        }
        }
        __syncthreads();
        float L0[16], L1[16];
#pragma unroll
        for (int pp = 0; pp < 2; ++pp) {
            bf16x8 qf[8];
            const bf16_t* qp = qpeer + (size_t)(m0 + row) * PQ + hd * 256 + pp * 128 + 8 * h2;
#pragma unroll
            for (int kk = 0; kk < 8; ++kk) qf[kk] = *(const bf16x8*)(qp + 16 * kk);
            float g[4][16];
#pragma unroll
            for (int kt = 0; kt < 4; ++kt) {
                f32x16 st;
#pragma unroll
                for (int i = 0; i < 16; ++i) st[i] = 0.f;
#pragma unroll
                for (int kk = 0; kk < 8; ++kk) {
                    const bf16x8 kf = *(const bf16x8*)(lds + pp * 32768 + (32 * kt + r) * 256 + (((2 * kk + h2) ^ (r & 15)) << 4));
                    st = __builtin_amdgcn_mfma_f32_32x32x16_bf16(kf, qf[kk], st, 0, 0, 0);
                }
#pragma unroll
                for (int i = 0; i < 16; ++i) {
                    const unsigned n = 32 * kt + (i & 3) + 8 * (i >> 2) + 4 * h2;
                    g[kt][i] = __uint_as_float((__float_as_uint(st[i]) & 0xFFFFFF80u) | n);
                }
            }
            net_sort16(g[0]); net_sort16(g[1]); net_sort16(g[2]); net_sort16(g[3]);
            net_merge16(g[0], g[1]); net_merge16(g[2], g[3]); net_merge16(g[0], g[2]);
            float pb[16];
#pragma unroll
            for (int i = 0; i < 16; ++i) pb[i] = __shfl_xor(g[0][i], 32);
            net_merge16(g[0], pb);
#pragma unroll
            for (int i = 0; i < 16; ++i) { if (pp == 0) L0[i] = g[0][i]; else L1[i] = g[0][i]; }
        }
        __syncthreads();
        unsigned char* tab = (unsigned char*)lds + 65536;
        if (h2 == 0) {
            unsigned wv[8];
#pragma unroll
            for (int j = 0; j < 4; ++j) {
                wv[j] = (__float_as_uint(L0[4 * j]) & 0x7Fu) | ((__float_as_uint(L0[4 * j + 1]) & 0x7Fu) << 8) | ((__float_as_uint(L0[4 * j + 2]) & 0x7Fu) << 16) | ((__float_as_uint(L0[4 * j + 3]) & 0x7Fu) << 24);
                wv[4 + j] = (__float_as_uint(L1[4 * j]) & 0x7Fu) | ((__float_as_uint(L1[4 * j + 1]) & 0x7Fu) << 8) | ((__float_as_uint(L1[4 * j + 2]) & 0x7Fu) << 16) | ((__float_as_uint(L1[4 * j + 3]) & 0x7Fu) << 24);
            }
            *(uint4*)(tab + row * 32) = make_uint4(wv[0], wv[1], wv[2], wv[3]);
            *(uint4*)(tab + row * 32 + 16) = make_uint4(wv[4], wv[5], wv[6], wv[7]);
        }
        float X[16], Y[16];
#pragma unroll
        for (int i = 0; i < 16; ++i) {
            const float a0 = __uint_as_float(__float_as_uint(L0[i]) & 0xFFFFFF80u), a1 = __uint_as_float(__float_as_uint(L1[i]) & 0xFFFFFF80u);
            X[i] = h2 ? a1 : a0; Y[i] = h2 ? a0 : a1;
        }
        float c0[16], c1[16];
#define PEER_CAND(i, a, b) { float v = X[a] + Y[b]; if ((a) == (b) && h2) v = -3.0e38f; const unsigned id = h2 ? ((b) * 16 + (a)) : ((a) * 16 + (b)); \
            const float pk = __uint_as_float((__float_as_uint(v) & 0xFFFFFF00u) | id); if ((i) < 16) c0[(i) & 15] = pk; else c1[(i) & 15] = pk; }
        PEER_CANDS(PEER_CAND)
#undef PEER_CAND
#pragma unroll
        for (int i = 11; i < 16; ++i) c1[i] = -3.0e38f;
        net_sort16(c0); net_sort16(c1); net_merge16(c0, c1);
        {
            float pb[16];
#pragma unroll
            for (int i = 0; i < 16; ++i) pb[i] = __shfl_xor(c0[i], 32);
            net_merge16(c0, pb);
        }
        float ex[16], sum = 0.f;
#pragma unroll
        for (int i = 0; i < 16; ++i) { ex[i] = __expf(c0[i] - c0[0]); sum += ex[i]; }
        const float rs = 1.0f / sum;
        const size_t ob = ((size_t)(m0 + row) * 8 + hd) * 16;
        if (h2 == 0) {
            int eo[16];
#pragma unroll
            for (int j = 0; j < 16; ++j) {
                const unsigned id = __float_as_uint(c0[j]) & 0xFFu;
                eo[j] = (int)tab[row * 32 + (id >> 4)] * 128 + (int)tab[row * 32 + 16 + (id & 15)];
            }
#pragma unroll
            for (int j = 0; j < 2; ++j) *(uint4*)(sel_e + ob + 8 * j) = make_uint4((unsigned)eo[8 * j] | ((unsigned)eo[8 * j + 1] << 16), (unsigned)eo[8 * j + 2] | ((unsigned)eo[8 * j + 3] << 16),
                                                                        (unsigned)eo[8 * j + 4] | ((unsigned)eo[8 * j + 5] << 16), (unsigned)eo[8 * j + 6] | ((unsigned)eo[8 * j + 7] << 16));
        } else {
#pragma unroll
            for (int j = 0; j < 4; ++j) *(float4*)(sel_g + ob + 4 * j) = make_float4(ex[4 * j] * rs, ex[4 * j + 1] * rs, ex[4 * j + 2] * rs, ex[4 * j + 3] * rs);
        }
    }
}
constexpr float USCALE = 64.0f;
typedef long i64_t;
__device__ __forceinline__ i64_t mk64(unsigned lo, unsigned hi) { return (i64_t)(((unsigned long long)hi << 32) | (unsigned long long)lo); }
__device__ __forceinline__ float dpp_add_xor1(float v) {
    return v + __int_as_float(__builtin_amdgcn_update_dpp(0, __float_as_int(v), 0xB1, 0xF, 0xF, true));
}
template <class F>
__device__ __forceinline__ void peer_queue_sweep(unsigned* heads, int nunits, unsigned xcc, unsigned* ldsw, F&& body) {
    unsigned it = 0u;
    __syncthreads();
    for (int rr = 0; rr < 8; ++rr) {
        const int s = (int)((xcc + rr) & 7u);
        for (;;) {
            if (tidx() == 0) ldsw[it & 1u] = __hip_atomic_fetch_add(heads + 64 * s, 1u, __ATOMIC_RELAXED, __HIP_MEMORY_SCOPE_AGENT);
            __syncthreads();
            const int u = __builtin_amdgcn_readfirstlane((int)ldsw[it & 1u]);
            ++it;
            if (u >= nunits) break;
            body(__builtin_amdgcn_readfirstlane(s), u);
        }
    }
}
__device__ __forceinline__ float dpp_sum8(float v) {
    v += __int_as_float(__builtin_amdgcn_update_dpp(0, __float_as_int(v), 0xB1, 0xF, 0xF, true));
    v += __int_as_float(__builtin_amdgcn_update_dpp(0, __float_as_int(v), 0x4E, 0xF, 0xF, true));
    v += __int_as_float(__builtin_amdgcn_update_dpp(0, __float_as_int(v), 0x141, 0xF, 0xF, true));
    return v;
}
__device__ __forceinline__ int dpp_isum8(int v) {
    v += __builtin_amdgcn_update_dpp(0, v, 0xB1, 0xF, 0xF, true);
    v += __builtin_amdgcn_update_dpp(0, v, 0x4E, 0xF, 0xF, true);
    v += __builtin_amdgcn_update_dpp(0, v, 0x141, 0xF, 0xF, true);
    return v;
}
__device__ __forceinline__ void ph_peer_dots(unsigned* heads, unsigned xcc, const unsigned char* __restrict__ xq, const float* __restrict__ xs, const unsigned char* __restrict__ U,
                                             const unsigned short* __restrict__ sel_e, bf16_t* __restrict__ part, int ntok, unsigned* ldsw) {
    const int lane = tidx() & 63, wid = __builtin_amdgcn_readfirstlane(tidx() >> 6), c = lane & 7, g = lane >> 3;
    peer_queue_sweep(heads, ntok / 64, xcc, ldsw, [&](int s, int u) {
        const unsigned char* Us = U + (size_t)s * NEXP * 128;
        const int row0 = u * 64 + wid * 16;
        int ek[16]; uint4 xw; float sx;
        {
#pragma unroll
            for (int i = 0; i < 2; ++i) {
                const uint4 e4 = *(const uint4*)(sel_e + (size_t)row0 * 128 + 16 * g + 8 * i);
                const unsigned ew[4] = {e4.x, e4.y, e4.z, e4.w};
#pragma unroll
                for (int j = 0; j < 4; ++j) { ek[8 * i + 2 * j] = (int)(ew[j] & 0xffffu); ek[8 * i + 2 * j + 1] = (int)(ew[j] >> 16); }
            }
            xw = *(const uint4*)(xq + (size_t)row0 * D + s * 128 + c * 16); sx = xs[row0];
        }
#pragma unroll 1
        for (int ti = 0; ti < 16; ++ti) {
            const int row = row0 + ti, rown = row0 + (ti < 15 ? ti + 1 : ti);
            uint4 ur[16];
#pragma unroll
            for (int k = 0; k < 16; ++k) ur[k] = *(const uint4*)(Us + ((unsigned)ek[k] * 128u + (unsigned)c * 16u));
            int ekn[16];
#pragma unroll
            for (int i = 0; i < 2; ++i) {
                const uint4 e4 = *(const uint4*)(sel_e + (size_t)rown * 128 + 16 * g + 8 * i);
                const unsigned ew[4] = {e4.x, e4.y, e4.z, e4.w};
#pragma unroll
                for (int j = 0; j < 4; ++j) { ekn[8 * i + 2 * j] = (int)(ew[j] & 0xffffu); ekn[8 * i + 2 * j + 1] = (int)(ew[j] >> 16); }
            }
            const uint4 xn = *(const uint4*)(xq + (size_t)rown * D + s * 128 + c * 16); const float sxn = xs[rown];
            int keep0 = 0, keep1 = 0;
#pragma unroll
            for (int k = 0; k < 16; ++k) {
                int a = __builtin_amdgcn_sdot4((int)ur[k].x, (int)xw.x, 0, false);
                a = __builtin_amdgcn_sdot4((int)ur[k].y, (int)xw.y, a, false);
                a = __builtin_amdgcn_sdot4((int)ur[k].z, (int)xw.z, a, false);
                a = __builtin_amdgcn_sdot4((int)ur[k].w, (int)xw.w, a, false);
                const int tot = dpp_isum8(a);
                if ((k & 1) == 0) keep0 = (c == (k >> 1)) ? tot : keep0; else keep1 = (c == (k >> 1)) ? tot : keep1;
            }
            const float fs = sx * (USCALE / UQ);
            *(unsigned*)(part + ((size_t)s * ntok + row) * 128 + 16 * g + 2 * c) = pack2((float)keep0 * fs, (float)keep1 * fs);
#pragma unroll
            for (int k = 0; k < 16; ++k) ek[k] = ekn[k];
            xw = xn; sx = sxn;
        }
    });
}
__device__ void ph_peer_weights(int bid, int nb, const bf16_t* __restrict__ part, const float* __restrict__ sel_g, bf16_t* __restrict__ sel_w, int ntok) {
    const size_t n = (size_t)ntok * 128, n4 = n / 4;
    for (size_t i = (size_t)bid * blockDim.x + tidx(); i < n4; i += (size_t)nb * blockDim.x) {
        float a[4] = {0.f, 0.f, 0.f, 0.f};
#pragma unroll
        for (int s = 0; s < 8; ++s) {
            const uint2 w = *(const uint2*)(part + (size_t)s * n + i * 4);
            a[0] += __uint_as_float(w.x << 16); a[1] += __uint_as_float(w.x & 0xffff0000u); a[2] += __uint_as_float(w.y << 16); a[3] += __uint_as_float(w.y & 0xffff0000u);
        }
        float4 gq = ((const float4*)sel_g)[i];
        float o[4] = {gq.x, gq.y, gq.z, gq.w};
#pragma unroll
        for (int j = 0; j < 4; ++j) { const float dot = a[j] * (1.0f / USCALE); o[j] *= 0.5f * dot * (1.0f + erff(dot * 0.70710678118654752f)); }
        uint2 ow; ow.x = pack2(o[0], o[1]); ow.y = pack2(o[2], o[3]);
        *(uint2*)(sel_w + i * 4) = ow;
    }
}
__device__ __forceinline__ void ph_peer_vsum(unsigned* heads, unsigned xcc, const unsigned char* __restrict__ V, const unsigned short* __restrict__ sel_e,
                                             const bf16_t* __restrict__ sel_w, const float* __restrict__ gate  ,
                                             bf16_t* __restrict__ h16, int ntok, unsigned* ldsw) {
    const int lane = tidx() & 63, wid = __builtin_amdgcn_readfirstlane(tidx() >> 6), c = lane & 7, g = lane >> 3;
    peer_queue_sweep(heads, ntok / 64, xcc, ldsw, [&](int s, int u) {
        const unsigned char* Vs = V + (size_t)s * NEXP * 128;
        const int rbase = u * 64 + wid * 16 + g;
        int ek[16]; float wk[16];
#pragma unroll
        for (int i = 0; i < 2; ++i) {
            const uint4 e4 = *(const uint4*)(sel_e + (size_t)rbase * 128 + 8 * i), w4 = *(const uint4*)(sel_w + (size_t)rbase * 128 + 8 * i);
            const unsigned ew[4] = {e4.x, e4.y, e4.z, e4.w}, ww[4] = {w4.x, w4.y, w4.z, w4.w};
#pragma unroll
            for (int j = 0; j < 4; ++j) {
                ek[8 * i + 2 * j] = (int)(ew[j] & 0xffffu); ek[8 * i + 2 * j + 1] = (int)(ew[j] >> 16);
                wk[8 * i + 2 * j] = __uint_as_float(ww[j] << 16); wk[8 * i + 2 * j + 1] = __uint_as_float(ww[j] & 0xffff0000u);
            }
        }
        f32x2 y2[8];
#pragma unroll
        for (int i = 0; i < 8; ++i) y2[i] = (f32x2){0.f, 0.f};
#pragma unroll 1
        for (int q = 0; q < 16; ++q) {
            const int row = rbase + 8 * (q >> 3), qn = q < 15 ? q + 1 : q;
            const size_t offn = (size_t)(rbase + 8 * (qn >> 3)) * 128 + 16 * (qn & 7);
            uint4 vr[16];
#pragma unroll
            for (int k = 0; k < 16; ++k) vr[k] = *(const uint4*)(Vs + ((unsigned)ek[k] * 128u + (unsigned)c * 16u));
            int ekn[16]; float wkn[16];
#pragma unroll
            for (int i = 0; i < 2; ++i) {
                const uint4 e4 = *(const uint4*)(sel_e + offn + 8 * i), w4 = *(const uint4*)(sel_w + offn + 8 * i);
                const unsigned ew[4] = {e4.x, e4.y, e4.z, e4.w}, ww[4] = {w4.x, w4.y, w4.z, w4.w};
#pragma unroll
                for (int j = 0; j < 4; ++j) {
                    ekn[8 * i + 2 * j] = (int)(ew[j] & 0xffffu); ekn[8 * i + 2 * j + 1] = (int)(ew[j] >> 16);
                    wkn[8 * i + 2 * j] = __uint_as_float(ww[j] << 16); wkn[8 * i + 2 * j + 1] = __uint_as_float(ww[j] & 0xffff0000u);
                }
            }
#pragma unroll
            for (int k = 0; k < 16; ++k) {
                const f32x2 w2 = (f32x2){wk[k], wk[k]};
                const unsigned vw[4] = {vr[k].x, vr[k].y, vr[k].z, vr[k].w};
#pragma unroll
                for (int j = 0; j < 4; ++j) {
                    y2[2 * j] = __builtin_amdgcn_cvt_pk_f32_fp8((int)vw[j], false) * w2 + y2[2 * j];
                    y2[2 * j + 1] = __builtin_amdgcn_cvt_pk_f32_fp8((int)vw[j], true) * w2 + y2[2 * j + 1];
                }
            }
            if ((q & 7) == 7) {
                bf16_t* hp = h16 + (size_t)row * D + s * 128 + c * 16;
                const float* gp = gate + (size_t)mod_row(row) * 6144 + s * 128 + c * 16;
                const uint4 h0 = *(const uint4*)hp, h1 = *(const uint4*)(hp + 8);
                const unsigned hw[8] = {h0.x, h0.y, h0.z, h0.w, h1.x, h1.y, h1.z, h1.w};
                unsigned ow[8];
#pragma unroll
                for (int j = 0; j < 4; ++j) {
                    const float4 g4 = *(const float4*)(gp + 4 * j);
                    ow[2 * j] = pack2(__uint_as_float(hw[2 * j] << 16) + g4.x * y2[2 * j].x, __uint_as_float(hw[2 * j] & 0xffff0000u) + g4.y * y2[2 * j].y);
                    ow[2 * j + 1] = pack2(__uint_as_float(hw[2 * j + 1] << 16) + g4.z * y2[2 * j + 1].x, __uint_as_float(hw[2 * j + 1] & 0xffff0000u) + g4.w * y2[2 * j + 1].y);
                }
                *(uint4*)hp = make_uint4(ow[0], ow[1], ow[2], ow[3]); *(uint4*)(hp + 8) = make_uint4(ow[4], ow[5], ow[6], ow[7]);
#pragma unroll
                for (int i = 0; i < 8; ++i) y2[i] = (f32x2){0.f, 0.f};
            }
#pragma unroll
            for (int k = 0; k < 16; ++k) { ek[k] = ekn[k]; wk[k] = wkn[k]; }
        }
    });
}

__device__ void ph_final(int bid, int nb, const bf16_t* __restrict__ h16, float* __restrict__ out, const float* __restrict__ g) {
    const int lane = tidx() & 63, wid = tidx() >> 6;
    const int nwv = nb * 4, per = (TL + nwv - 1) / nwv, r0 = (bid * 4 + wid) * per, r1 = (r0 + per < TL) ? r0 + per : TL;
    if (r0 >= r1) return;
    float4 gg[4];
#pragma unroll
    for (int i = 0; i < 4; ++i) gg[i] = ((const float4*)g)[i * 64 + lane];
    uint2 wn[4];
#pragma unroll
    for (int i = 0; i < 4; ++i) wn[i] = ((const uint2*)(h16 + (size_t)r0 * D))[i * 64 + lane];
    for (int row = r0; row < r1; ++row) {
        uint2 w[4];
#pragma unroll
        for (int i = 0; i < 4; ++i) w[i] = wn[i];
        const int rn = row + 1 < r1 ? row + 1 : row;
#pragma unroll
        for (int i = 0; i < 4; ++i) wn[i] = ((const uint2*)(h16 + (size_t)rn * D))[i * 64 + lane];
        float4 x[4]; float ss = 0.f;
#pragma unroll
        for (int i = 0; i < 4; ++i) {
            x[i].x = __uint_as_float(w[i].x << 16); x[i].y = __uint_as_float(w[i].x & 0xffff0000u); x[i].z = __uint_as_float(w[i].y << 16); x[i].w = __uint_as_float(w[i].y & 0xffff0000u);
            ss += x[i].x * x[i].x + x[i].y * x[i].y + x[i].z * x[i].z + x[i].w * x[i].w;
        }
        ss = wave_sum(ss);
        const float rinv = rsqrtf(ss * (1.0f / D) + EPS);
        float4* o4 = (float4*)(out + (size_t)row * D);
#pragma unroll
        for (int i = 0; i < 4; ++i) {
            float4 o; o.x = x[i].x * rinv * gg[i].x; o.y = x[i].y * rinv * gg[i].y; o.z = x[i].z * rinv * gg[i].z; o.w = x[i].w * rinv * gg[i].w;
            o4[i * 64 + lane] = o;
        }
    }
}

struct Params {
    const float *x, *c, *ctx, *c_ctx, *ada_w, *ada_b, *norm_mix_g, *norm_ffn_g, *ab_w_in, *ab_w_out, *hg_lb, *hg_norm_g, *sw_sink,
        *ga_w_in, *ga_w_out, *ga_qn, *ga_kn, *peer_wq, *peer_sk, *peer_u, *peer_v, *final_g;
    float* out; char* ws;
};

typedef __attribute__((address_space(1))) char gchar_t;
__device__ __forceinline__ gchar_t* ws_base(char* w) { gchar_t* g = (gchar_t*)w; asm volatile("" : "+s"(g)); return g; }
#define WSP(T, off) ((T*)(ws_base(p.ws) + (off)))

constexpr int XB_XCNT = 0, XB_XSUB = 1024, XB_XGEN = 2048, XB_TOP = 3072, XB_TOPGEN = 3136;
#define gb_state (*(uint4*)(dyn_lds + 65536 + 4096))
__device__ __forceinline__ unsigned xb_ld(unsigned* p) { return __hip_atomic_load(p, __ATOMIC_RELAXED, __HIP_MEMORY_SCOPE_AGENT); }
__device__ __forceinline__ unsigned xb_add(unsigned* p) { return __hip_atomic_fetch_add(p, 1u, __ATOMIC_RELAXED, __HIP_MEMORY_SCOPE_AGENT); }
__device__ __forceinline__ unsigned xcc_id() { return (unsigned)__builtin_amdgcn_s_getreg((3 << 11) | 20) & 0xFu; }
constexpr int SB_XCNT = 6144, SB_XSUB = 6400, SB_XGEN = 6656, SB_TOP = 6912, SB_TOPGEN = 6928;
__device__ __forceinline__ void grid_bar_post(unsigned* bar, bool in_subset) {
    if (threadIdx.x == 0) {
        gb_state = make_uint4(0u, 0u, 0u, 0u);
        (void)xb_add(&bar[XB_XCNT + 64 * xcc_id()]);
        if (in_subset) (void)xb_add(&bar[SB_XCNT + 16 * xcc_id()]);
    }
}
__device__ __forceinline__ void grid_bar(unsigned* bar) {
    asm volatile("s_waitcnt vmcnt(0)" ::: "memory");
    __syncthreads();
    if (threadIdx.x == 0) {
        const unsigned x = xcc_id();
        unsigned nloc = gb_state.x, nx = gb_state.y;
        if (nloc == 0u) {
            for (;;) {
                unsigned sum = 0u, cnt = 0u, mine = 0u;
#pragma unroll
                for (unsigned j = 0; j < 16; ++j) { const unsigned c = xb_ld(&bar[XB_XCNT + 64 * j]); sum += c; cnt += c > 0u ? 1u : 0u; mine = (j == x) ? c : mine; }
                if (sum == gridDim.x) { nloc = mine; nx = cnt; break; }
                __builtin_amdgcn_s_sleep(1);
            }
            gb_state.x = nloc; gb_state.y = nx;
        }
        const unsigned old = xb_add(&bar[XB_XSUB + 64 * x]);
        const unsigned gen = old / nloc;
        if (old + 1u == (gen + 1u) * nloc) {
            __builtin_amdgcn_fence(__ATOMIC_RELEASE, "agent");
            asm volatile("s_waitcnt vmcnt(0)" ::: "memory");
            const unsigned og = xb_add(&bar[XB_TOP]);
            if (og + 1u == (gen + 1u) * nx) (void)xb_add(&bar[XB_TOPGEN]);
        }
        while (xb_ld(&bar[XB_TOPGEN]) == gen) __builtin_amdgcn_s_sleep(1);
        __builtin_amdgcn_fence(__ATOMIC_ACQUIRE, "agent");
        asm volatile("s_waitcnt vmcnt(0)" ::: "memory");
    }
    __syncthreads();
}

__device__ __forceinline__ void sub_bar(unsigned* bar) {
    asm volatile("s_waitcnt vmcnt(0)" ::: "memory");
    __syncthreads();
    if (threadIdx.x == 0) {
        const unsigned x = xcc_id();
        unsigned nloc = 0u, nx = 0u;
#pragma unroll
        for (unsigned j = 0; j < 16; ++j) { const unsigned c = xb_ld(&bar[SB_XCNT + 16 * j]); nx += c > 0u ? 1u : 0u; nloc = (j == x) ? c : nloc; }
        const unsigned old = xb_add(&bar[SB_XSUB + 16 * x]);
        const unsigned gen = old / nloc;
        if (old + 1u == (gen + 1u) * nloc) {
            __builtin_amdgcn_fence(__ATOMIC_RELEASE, "agent");
            asm volatile("s_waitcnt vmcnt(0)" ::: "memory");
            const unsigned og = xb_add(&bar[SB_TOP]);
            if (og + 1u == (gen + 1u) * nx) (void)xb_add(&bar[SB_TOPGEN]);
        }
        while (xb_ld(&bar[SB_TOPGEN]) == gen) __builtin_amdgcn_s_sleep(1);
        __builtin_amdgcn_fence(__ATOMIC_ACQUIRE, "agent");
        asm volatile("s_waitcnt vmcnt(0)" ::: "memory");
    }
    __syncthreads();
}

namespace cg = cooperative_groups;
constexpr int MEGA_LDS = 65536 + 4096 + 256;
__global__ void __launch_bounds__(256, 2) k_mega(Params p) {
    cg::grid_group grid = cg::this_grid();
    const int bid = blockIdx.x, nb = gridDim.x;
    char* lds = dyn_lds;
    float* ldf = (float*)dyn_lds;
    grid_bar_post(WSP(unsigned, OFF_BAR), bid >= (nb >= 256 ? 128 : nb / 2));
    ph_mod(bid, nb, p.c, p.c_ctx, p.ada_w, p.ada_b, WSP(float, OFF_MOD), ldf);
    ph_tables(bid, nb, WSP(float, OFF_COSS), WSP(float, OFF_SINS), WSP(float, OFF_COSG), WSP(float, OFF_SING), p.hg_lb, WSP(float, OFF_LB));
    if (p.ws == nullptr) grid.sync();
    grid_bar(WSP(unsigned, OFF_BAR));
    ph_normmod(bid, nb, p.x, p.ctx, p.norm_mix_g, WSP(float, OFF_MOD), 1 * D, 0, WSP(bf16_t, OFF_A), TA);
    ph_transpose(bid, nb, p.ab_w_in, WSP(bf16_t, OFF_WABIN), D, AB_IN, ldf);
    ph_transpose(bid, nb, p.ab_w_out, WSP(bf16_t, OFF_WABOUT), D, D, ldf);
    ph_transpose(bid, nb, p.peer_wq, WSP(bf16_t, OFF_WPQ), D, PQ, ldf);
    ph_cvt(bid, nb, p.peer_sk, WSP(bf16_t, OFF_SK), (size_t)2 * 8 * 2 * 128 * 128);
    grid_bar(WSP(unsigned, OFF_BAR));
    { EpiStoreSplit<0> e{WSP(bf16_t, OFF_PROJH), HGW, WSP(bf16_t, OFF_PROJS), SWW, HGW};
      ph_gemm(bid, nb, WSP(bf16_t, OFF_A), TA, WSP(bf16_t, OFF_WABIN), AB_IN, TA, HGW, D, lds, e); }
    grid_bar(WSP(unsigned, OFF_BAR));
    {
        const int hgb = nb >= 256 ? 128 : nb / 2;
        if (bid < hgb) ph_hgrn(bid, hgb, WSP(bf16_t, OFF_PROJH), WSP(float, OFF_LB), WSP(bf16_t, OFF_OF), WSP(bf16_t, OFF_OB), lds);
        else {
            const int sb = bid - hgb, sn = nb - hgb;
            { EpiStoreSplit<1> e{WSP(bf16_t, OFF_PROJH), HGW, WSP(bf16_t, OFF_PROJS), SWW, HGW};
              ph_gemm(sb, sn, WSP(bf16_t, OFF_A), TA, WSP(bf16_t, OFF_WABIN), AB_IN, TA, SWW, D, lds, e, HGW); }
            sub_bar(WSP(unsigned, OFF_BAR));
            ph_prep_swa(sb, sn, WSP(bf16_t, OFF_PROJS), WSP(float, OFF_COSS), WSP(float, OFF_SINS));
            ph_vt<64>(sb, sn, WSP(bf16_t, OFF_PROJS), SWW, 640, WSP(bf16_t, OFF_VT64), (bf16_t*)lds);
            sub_bar(WSP(unsigned, OFF_BAR));
            ph_swa(sb, sn, WSP(bf16_t, OFF_PROJS), WSP(bf16_t, OFF_VT64), p.sw_sink, WSP(bf16_t, OFF_MIX), lds);
            ph_cvt8i(sb, sn, p.peer_u, WSP(unsigned char, OFF_U16), (size_t)2 * NEXP * D, UQ);
            ph_cvt8(sb, sn, p.peer_v, WSP(unsigned char, OFF_V16), (size_t)2 * NEXP * D, 1.0f);
            ph_transpose(sb, sn, p.ga_w_in, WSP(bf16_t, OFF_WGAIN), D, GA_IN, ldf);
            ph_transpose(sb, sn, p.ga_w_out, WSP(bf16_t, OFF_WGAOUT), D, D, ldf);
            ph_transpose(sb, sn, p.peer_wq + (size_t)D * PQ, WSP(bf16_t, OFF_WPQ) + (size_t)PQ * D, D, PQ, ldf);
        }
    }
    grid_bar(WSP(unsigned, OFF_BAR));
    ph_hgpost(bid, nb, WSP(bf16_t, OFF_OF), WSP(bf16_t, OFF_OB), WSP(bf16_t, OFF_PROJH), p.hg_norm_g, WSP(bf16_t, OFF_MIX));
    grid_bar(WSP(unsigned, OFF_BAR));
    { EpiResid<0> e{p.x, p.ctx, nullptr, WSP(bf16_t, OFF_H16), WSP(float, OFF_MOD) + 2 * D};
      ph_gemm(bid, nb, WSP(bf16_t, OFF_MIX), D, WSP(bf16_t, OFF_WABOUT), D, TA, D, D, lds, e); }
    grid_bar(WSP(unsigned, OFF_BAR));
    ph_normmod16(bid, nb, WSP(bf16_t, OFF_H16), p.norm_ffn_g, WSP(float, OFF_MOD), 4 * D, 3 * D, WSP(bf16_t, OFF_A), TA, WSP(unsigned char, OFF_XQ), WSP(float, OFF_XS));
    grid_bar(WSP(unsigned, OFF_BAR));
    { EpiStoreSplit<2> e{WSP(bf16_t, OFF_QPEER), PQ, WSP(bf16_t, OFF_QPEER), PQ, 1 << 30};
      ph_gemm(bid, nb, WSP(bf16_t, OFF_A), TA, WSP(bf16_t, OFF_WPQ), PQ, TA, PQ, D, lds, e); }
    grid_bar(WSP(unsigned, OFF_BAR));
    ph_peer_route(bid, nb, WSP(bf16_t, OFF_QPEER), WSP(bf16_t, OFF_SK), WSP(unsigned short, OFF_SELE), WSP(float, OFF_SELG), TA, lds);
    grid_bar(WSP(unsigned, OFF_BAR));
    ph_peer_dots((WSP(unsigned, OFF_BAR) + 4096) + 64 * 0, xcc_id(), WSP(unsigned char, OFF_XQ), WSP(float, OFF_XS), WSP(unsigned char, OFF_U16), WSP(unsigned short, OFF_SELE), WSP(bf16_t, OFF_PART), TA, (unsigned*)lds);
    grid_bar(WSP(unsigned, OFF_BAR));
    ph_peer_weights(bid, nb, WSP(bf16_t, OFF_PART), WSP(float, OFF_SELG), WSP(bf16_t, OFF_SELW), TA);
    grid_bar(WSP(unsigned, OFF_BAR));
    ph_peer_vsum((WSP(unsigned, OFF_BAR) + 4096) + 64 * 8, xcc_id(), WSP(unsigned char, OFF_V16), WSP(unsigned short, OFF_SELE), WSP(bf16_t, OFF_SELW), WSP(float, OFF_MOD) + 5 * D, WSP(bf16_t, OFF_H16), TA, (unsigned*)lds);
    grid_bar(WSP(unsigned, OFF_BAR));
    ph_normmod16(bid, nb, WSP(bf16_t, OFF_H16), p.norm_mix_g + D, (WSP(float, OFF_MOD) + (size_t)9 * 6144), 1 * D, 0, WSP(bf16_t, OFF_A), TA);
    grid_bar(WSP(unsigned, OFF_BAR));
    { EpiGA e{WSP(bf16_t, OFF_PROJ), WSP(bf16_t, OFF_VT), p.ga_qn, p.ga_kn, WSP(float, OFF_COSG), WSP(float, OFF_SING)};
      ph_gemm(bid, nb, WSP(bf16_t, OFF_A), TA, WSP(bf16_t, OFF_WGAIN), GA_IN, TA, GA_IN, D, lds, e); }
    grid_bar(WSP(unsigned, OFF_BAR));
    ph_dense(bid, nb, WSP(bf16_t, OFF_PROJ), WSP(bf16_t, OFF_VT), WSP(bf16_t, OFF_MIX), lds);
    grid_bar(WSP(unsigned, OFF_BAR));
    { EpiResid<1> e{nullptr, nullptr, WSP(bf16_t, OFF_H16), WSP(bf16_t, OFF_H16), (WSP(float, OFF_MOD) + (size_t)9 * 6144) + 2 * D};
      ph_gemm(bid, nb, WSP(bf16_t, OFF_MIX), D, WSP(bf16_t, OFF_WGAOUT), D, TL, D, D, lds, e); }
    grid_bar(WSP(unsigned, OFF_BAR));
    ph_normmod16(bid, nb, WSP(bf16_t, OFF_H16), p.norm_ffn_g + D, (WSP(float, OFF_MOD) + (size_t)9 * 6144), 4 * D, 3 * D, WSP(bf16_t, OFF_A), TL, WSP(unsigned char, OFF_XQ), WSP(float, OFF_XS));
    grid_bar(WSP(unsigned, OFF_BAR));
    { EpiStoreSplit<3> e{WSP(bf16_t, OFF_QPEER), PQ, WSP(bf16_t, OFF_QPEER), PQ, 1 << 30};
      ph_gemm(bid, nb, WSP(bf16_t, OFF_A), TA, WSP(bf16_t, OFF_WPQ) + (size_t)PQ * D, PQ, TL, PQ, D, lds, e); }
    grid_bar(WSP(unsigned, OFF_BAR));
    ph_peer_route(bid, nb, WSP(bf16_t, OFF_QPEER), WSP(bf16_t, OFF_SK) + (size_t)16 * 128 * 128, WSP(unsigned short, OFF_SELE), WSP(float, OFF_SELG), TL, lds);
    grid_bar(WSP(unsigned, OFF_BAR));
    ph_peer_dots((WSP(unsigned, OFF_BAR) + 4096) + 64 * 16, xcc_id(), WSP(unsigned char, OFF_XQ), WSP(float, OFF_XS), WSP(unsigned char, OFF_U16) + (size_t)NEXP * D, WSP(unsigned short, OFF_SELE), WSP(bf16_t, OFF_PART), TL, (unsigned*)lds);
    grid_bar(WSP(unsigned, OFF_BAR));
    ph_peer_weights(bid, nb, WSP(bf16_t, OFF_PART), WSP(float, OFF_SELG), WSP(bf16_t, OFF_SELW), TL);
    grid_bar(WSP(unsigned, OFF_BAR));
    ph_peer_vsum((WSP(unsigned, OFF_BAR) + 4096) + 64 * 24, xcc_id(), WSP(unsigned char, OFF_V16) + (size_t)NEXP * D, WSP(unsigned short, OFF_SELE), WSP(bf16_t, OFF_SELW), (WSP(float, OFF_MOD) + (size_t)9 * 6144) + 5 * D, WSP(bf16_t, OFF_H16), TL, (unsigned*)lds);
    grid_bar(WSP(unsigned, OFF_BAR));
    ph_final(bid, nb, WSP(bf16_t, OFF_H16), p.out, p.final_g);
}

extern "C" void kernel_launch(void* const* d_in, const int* in_sizes, int n_in, void* d_out, int out_size, void* d_ws, size_t ws_size,
                              hipStream_t stream) {
    Params p{};
    p.x = (const float*)d_in[0]; p.c = (const float*)d_in[1]; p.ctx = (const float*)d_in[2]; p.c_ctx = (const float*)d_in[3];
    p.ada_w = (const float*)d_in[4]; p.ada_b = (const float*)d_in[5]; p.norm_mix_g = (const float*)d_in[6]; p.norm_ffn_g = (const float*)d_in[7];
    p.ab_w_in = (const float*)d_in[8]; p.ab_w_out = (const float*)d_in[9]; p.hg_lb = (const float*)d_in[10]; p.hg_norm_g = (const float*)d_in[11];
    p.sw_sink = (const float*)d_in[12]; p.ga_w_in = (const float*)d_in[13]; p.ga_w_out = (const float*)d_in[14]; p.ga_qn = (const float*)d_in[15];
    p.ga_kn = (const float*)d_in[16]; p.peer_wq = (const float*)d_in[17]; p.peer_sk = (const float*)d_in[18]; p.peer_u = (const float*)d_in[19];
    p.peer_v = (const float*)d_in[20]; p.final_g = (const float*)d_in[21];
    p.out = (float*)d_out; p.ws = (char*)d_ws;
    if (ws_size < WS_NEED) { fprintf(stderr, "workspace too small: %zu < %zu\n", ws_size, WS_NEED); return; }
    static int grid_blocks = 0;
    if (!grid_blocks) {
        int dev = 0, cus = 0, per_cu = 0;
        (void)hipGetDevice(&dev);
        (void)hipDeviceGetAttribute(&cus, hipDeviceAttributeMultiprocessorCount, dev);
        (void)hipFuncSetAttribute((const void*)k_mega, hipFuncAttributeMaxDynamicSharedMemorySize, MEGA_LDS);
        (void)hipOccupancyMaxActiveBlocksPerMultiprocessor(&per_cu, k_mega, 256, MEGA_LDS);
        if (per_cu > 2) per_cu = 2;
        if (per_cu < 1) per_cu = 1;
        grid_blocks = cus * per_cu;
    }
    (void)hipMemsetAsync((char*)d_ws + OFF_BAR, 0, BAR_BYTES, stream);
    void* args[] = {&p};
    hipError_t e = hipLaunchCooperativeKernel((const void*)k_mega, dim3(grid_blocks), dim3(256), args, MEGA_LDS, stream);
    if (e != hipSuccess) fprintf(stderr, "cooperative launch failed: %s (grid %d)\n", hipGetErrorString(e), grid_blocks);
}
```
